# Optimizing an MI355X kernel written in HIP

```python
import jax, jax.numpy as jnp
from jax import lax
import numpy as np

D_MODEL = 1024
BATCH = 4
SEQ = 4096
DEPTH = 4

HEAD_DIM = 64
N_BRANCH = 4
BRANCH_WIDTH = D_MODEL // N_BRANCH
NSA_HEADS = BRANCH_WIDTH // HEAD_DIM
FOX_HEADS = BRANCH_WIDTH // HEAD_DIM
GMLP_GROUPS = BRANCH_WIDTH // HEAD_DIM
CONV_CH = BRANCH_WIDTH
ROPE_THETA = 500000.0
ROPE_DIM = HEAD_DIM // 4
Q_BLOCK = 128
CMP_LEN = 32
CMP_STRIDE = 16
SEL_LEN = 64
SEL_TOPK = 16
N_LOCAL_BLOCKS = 2
WINDOW = 512
GMLP_CHUNK = 128
CONV_WIDTH = 31
N_EXPERTS = 32
TOP_K = 4
D_FF = D_MODEL
SWIGLU_LIMIT = 7.0
SWIGLU_ALPHA = 1.702
MOE_BLOCK = 128
LN_EPS = 1e-5
DEEPNORM_ALPHA = (2 * DEPTH) ** 0.25
DEEPNORM_BETA = (8 * DEPTH) ** -0.25
MASK_VALUE = -1e30
FORCED_SCORE = 1e9
SPLIT_SIZES = (NSA_HEADS * HEAD_DIM, HEAD_DIM, HEAD_DIM, HEAD_DIM, HEAD_DIM, HEAD_DIM, HEAD_DIM, 3 * NSA_HEADS,
               FOX_HEADS * HEAD_DIM, FOX_HEADS * HEAD_DIM, FOX_HEADS * HEAD_DIM, FOX_HEADS,
               BRANCH_WIDTH, BRANCH_WIDTH,
               CONV_CH, CONV_CH,
               N_BRANCH * D_MODEL)
N_IN = sum(SPLIT_SIZES)

kernel_name = 'hybrid_nsa_fox_gmlp_conv_moe'


def layer_norm(x, g, b):
    xf = x.astype(jnp.float32)
    mu = jnp.mean(xf, axis=-1, keepdims=True)
    var = jnp.mean(jnp.square(xf - mu), axis=-1, keepdims=True)
    return ((xf - mu) * lax.rsqrt(var + LN_EPS) * g + b).astype(x.dtype)


def masked_softmax(logits, mask):
    p = jax.nn.softmax(jnp.where(mask, logits.astype(jnp.float32), MASK_VALUE), axis=-1)
    return jnp.where(mask, p, 0.0)


def partial_rope(t, positions):
    half = ROPE_DIM // 2
    inv_freq = ROPE_THETA ** (-jnp.arange(half, dtype=jnp.float32) / half)
    ang = positions.astype(jnp.float32)[:, :, None, None] * inv_freq
    cos, sin = jnp.cos(ang), jnp.sin(ang)
    tr = t[..., :ROPE_DIM].astype(jnp.float32)
    t1, t2 = tr[..., :half], tr[..., half:]
    rot = jnp.concatenate([t1 * cos - t2 * sin, t2 * cos + t1 * sin], axis=-1).astype(t.dtype)
    return jnp.concatenate([rot, t[..., ROPE_DIM:]], axis=-1)


def nsa_mixer(q, k_cmp, v_cmp, k_sel, v_sel, k_win, v_win, gate_logits,
              pe_k, pe_v, w1_k, w2_k, w1_v, w2_v):
    B, S, H, Dh = q.shape
    scale = Dh ** -0.5
    n_cmp = (S - CMP_LEN) // CMP_STRIDE + 1
    cmp_idx = np.arange(n_cmp)[:, None] * CMP_STRIDE + np.arange(CMP_LEN)[None, :]
    cmp_end = jnp.asarray(cmp_idx[:, -1], jnp.int32)

    def compress(t, pe, w1, w2):
        blocks = (t[:, cmp_idx] + pe).reshape(B, n_cmp, CMP_LEN * Dh)
        return jax.nn.gelu(blocks @ w1) @ w2

    kc = compress(k_cmp, pe_k, w1_k, w2_k)
    vc = compress(v_cmp, pe_v, w1_v, w2_v)
    n_sel = S // SEL_LEN
    top_k = min(SEL_TOPK, n_sel)
    sel_start = np.arange(n_sel) * SEL_LEN
    cmp_start = cmp_idx[:, 0]
    overlap = jnp.asarray(((cmp_start[:, None] <= sel_start[None, :] + SEL_LEN - 1)
                           & (cmp_start[:, None] + CMP_LEN - 1 >= sel_start[None, :])).astype(np.float32))
    k_blocks = k_sel.reshape(B, n_sel, SEL_LEN, Dh)
    v_blocks = v_sel.reshape(B, n_sel, SEL_LEN, Dh)
    k_pad = jnp.pad(k_win, ((0, 0), (WINDOW, 0), (0, 0)))
    v_pad = jnp.pad(v_win, ((0, 0), (WINDOW, 0), (0, 0)))
    gates = jax.nn.sigmoid(gate_logits.astype(jnp.float32)).reshape(B, S, H, 3).astype(q.dtype)
    blk_ids = jnp.arange(n_sel)

    def block(i):
        t0 = i * Q_BLOCK
        tq = t0 + jnp.arange(Q_BLOCK)
        qb = lax.dynamic_slice_in_dim(q, t0, Q_BLOCK, axis=1)
        s_c = jnp.einsum('bqhd,bcd->bhqc', qb, kc) * scale
        p_c = masked_softmax(s_c, cmp_end[None, :] <= tq[:, None])
        o_c = jnp.einsum('bhqc,bcd->bqhd', p_c.astype(vc.dtype), vc)
        imp = jnp.einsum('bhqc,cj->bqj', p_c, overlap)
        cur = (tq // SEL_LEN)[:, None]
        causal = blk_ids[None, :] <= cur
        forced = (blk_ids[None, :] == 0) | (causal & (blk_ids[None, :] > cur - N_LOCAL_BLOCKS))
        imp = jnp.where(forced, FORCED_SCORE, jnp.where(causal, imp, -1.0))
        top_val, top_idx = lax.top_k(imp, top_k)
        ks = jax.vmap(lambda kb, ix: kb[ix])(k_blocks, top_idx).reshape(B, Q_BLOCK, top_k * SEL_LEN, Dh)
        vs = jax.vmap(lambda vb, ix: vb[ix])(v_blocks, top_idx).reshape(B, Q_BLOCK, top_k * SEL_LEN, Dh)
        key_pos = (top_idx[..., None] * SEL_LEN + jnp.arange(SEL_LEN)).reshape(B, Q_BLOCK, top_k * SEL_LEN)
        valid = jnp.repeat(top_val >= 0.0, SEL_LEN, axis=-1) & (key_pos <= tq[None, :, None])
        s_s = jnp.einsum('bqhd,bqnd->bqhn', qb, ks) * scale
        p_s = masked_softmax(s_s, valid[:, :, None, :])
        o_s = jnp.einsum('bqhn,bqnd->bqhd', p_s.astype(vs.dtype), vs)
        kw = lax.dynamic_slice_in_dim(k_pad, t0, Q_BLOCK + WINDOW, axis=1)
        vw = lax.dynamic_slice_in_dim(v_pad, t0, Q_BLOCK + WINDOW, axis=1)
        kpos = t0 - WINDOW + jnp.arange(Q_BLOCK + WINDOW)
        diff = tq[:, None] - kpos[None, :]
        in_win = (diff >= 0) & (diff < WINDOW) & (kpos[None, :] >= 0)
        s_w = jnp.einsum('bqhd,bkd->bhqk', qb, kw) * scale
        p_w = masked_softmax(s_w, in_win)
        o_w = jnp.einsum('bhqk,bkd->bqhd', p_w.astype(vw.dtype), vw)
        g = lax.dynamic_slice_in_dim(gates, t0, Q_BLOCK, axis=1)
        return g[..., 0:1] * o_c + g[..., 1:2] * o_s + g[..., 2:3] * o_w

    out = lax.map(block, jnp.arange(S // Q_BLOCK))
    return out.transpose(1, 0, 2, 3, 4).reshape(B, S, H * Dh)


def fox_mixer(q, k, v, f_logits):
    B, S, H, Dh = q.shape
    scale = Dh ** -0.5
    log_f = jax.nn.log_sigmoid(f_logits.astype(jnp.float32))
    cum = lax.cumsum(log_f, axis=1).transpose(0, 2, 1)
    kpos = jnp.arange(S)

    def block(i):
        t0 = i * Q_BLOCK
        tq = t0 + jnp.arange(Q_BLOCK)
        qb = lax.dynamic_slice_in_dim(q, t0, Q_BLOCK, axis=1)
        cq = lax.dynamic_slice_in_dim(cum, t0, Q_BLOCK, axis=2)
        s = (jnp.einsum('bqhd,bkhd->bhqk', qb, k).astype(jnp.float32) * scale
             + (cq[..., None] - cum[:, :, None, :]))
        p = masked_softmax(s, kpos[None, :] <= tq[:, None])
        return jnp.einsum('bhqk,bkhd->bqhd', p.astype(v.dtype), v)

    out = lax.map(block, jnp.arange(S // Q_BLOCK))
    return out.transpose(1, 0, 2, 3, 4).reshape(B, S, H * Dh)


def gmlp_mixer(u, v, w_s, b_s, ln_g, ln_b):
    B, S, C = v.shape
    u = jax.nn.gelu(u)
    v = layer_norm(jax.nn.gelu(v), ln_g, ln_b)
    n_chunks = S // GMLP_CHUNK
    vr = v.reshape(B, n_chunks, GMLP_CHUNK, GMLP_GROUPS, C // GMLP_GROUPS)
    causal = jnp.tril(jnp.ones((GMLP_CHUNK, GMLP_CHUNK), dtype=bool))
    w = jnp.where(causal[None], w_s, 0.0)
    mixed = jnp.einsum('gts,bcsgd->bctgd', w, vr) + b_s.T[None, None, :, :, None]
    return u * mixed.reshape(B, S, C)


def conv_mixer(a, b_gate, w_dw, b_dw, ln_g, ln_b):
    h = a * jax.nn.sigmoid(b_gate)
    h = lax.conv_general_dilated(h, w_dw, window_strides=(1,), padding=((CONV_WIDTH - 1, 0),),
                                 dimension_numbers=('NWC', 'WIO', 'NWC'),
                                 feature_group_count=h.shape[-1]) + b_dw
    return jax.nn.silu(layer_norm(h, ln_g, ln_b))


def moe_ffn(x, w_router, b_router, w1, b1, w2, b2):
    B, S, D = x.shape
    T = B * S
    xf = x.reshape(T, D)
    logits = (xf @ w_router + b_router).astype(jnp.float32)
    top_val, top_idx = lax.top_k(logits, TOP_K)
    wts = jax.nn.softmax(top_val, axis=-1)
    e_flat = top_idx.reshape(-1)
    tok_flat = jnp.repeat(jnp.arange(T, dtype=jnp.int32), TOP_K)
    w_flat = wts.reshape(-1)
    order = jnp.argsort(e_flat)
    e_sorted = e_flat[order]
    counts = jnp.bincount(e_flat, length=N_EXPERTS)
    padded = ((counts + MOE_BLOCK - 1) // MOE_BLOCK) * MOE_BLOCK
    start = jnp.cumsum(counts) - counts
    pend = jnp.cumsum(padded)
    pstart = pend - padded
    dest = pstart[e_sorted] + (jnp.arange(T * TOP_K) - start[e_sorted])
    n_blocks = -(-(T * TOP_K) // MOE_BLOCK) + N_EXPERTS
    P = n_blocks * MOE_BLOCK
    row_tok = jnp.full((P,), T, jnp.int32).at[dest].set(tok_flat[order])
    row_w = jnp.zeros((P,), jnp.float32).at[dest].set(w_flat[order])
    blk_e = jnp.minimum(jnp.searchsorted(pend, jnp.arange(n_blocks) * MOE_BLOCK, side='right'), N_EXPERTS - 1)
    x_pad = jnp.concatenate([xf, jnp.zeros((1, D), xf.dtype)], axis=0)
    xr = x_pad[row_tok].reshape(n_blocks, MOE_BLOCK, D)

    def expert_block(args):
        xb, e = args
        h = xb @ w1[e] + b1[e]
        glu = jnp.minimum(h[:, 0::2], SWIGLU_LIMIT)
        lin = jnp.clip(h[:, 1::2], -SWIGLU_LIMIT, SWIGLU_LIMIT)
        act = glu * jax.nn.sigmoid(SWIGLU_ALPHA * glu) * (lin + 1.0)
        return act @ w2[e] + b2[e]

    yr = lax.map(expert_block, (xr, blk_e)).reshape(P, D)
    y = jax.ops.segment_sum(yr * row_w[:, None], row_tok, num_segments=T + 1)[:T]
    return y.reshape(B, S, D).astype(x.dtype)


def setup_inputs(seed: int = 0) -> dict:
    key = jax.random.key(seed)
    ks = jax.random.split(key, 30)

    def nrm(k, shape, scale):
        return jax.random.normal(k, shape, jnp.float32) * scale

    def gain(k, shape):
        return 1.0 + 0.1 * jax.random.normal(k, shape, jnp.float32)

    Dh = HEAD_DIM
    return {
        'x': nrm(ks[0], (BATCH, SEQ, D_MODEL), 1.0),
        'positions': jnp.arange(SEQ, dtype=jnp.int32)[None, :]
                     + jax.random.randint(ks[1], (BATCH, 1), 0, 1024, jnp.int32),
        'w_in': nrm(ks[2], (DEPTH, D_MODEL, N_IN), D_MODEL ** -0.5),
        'b_in': nrm(ks[3], (DEPTH, N_IN), 0.02),
        'nsa_pe_k': nrm(ks[4], (DEPTH, CMP_LEN, Dh), 0.1),
        'nsa_pe_v': nrm(ks[5], (DEPTH, CMP_LEN, Dh), 0.1),
        'nsa_cmp_w1_k': nrm(ks[6], (DEPTH, CMP_LEN * Dh, Dh), (CMP_LEN * Dh) ** -0.5),
        'nsa_cmp_w2_k': nrm(ks[7], (DEPTH, Dh, Dh), Dh ** -0.5),
        'nsa_cmp_w1_v': nrm(ks[8], (DEPTH, CMP_LEN * Dh, Dh), (CMP_LEN * Dh) ** -0.5),
        'nsa_cmp_w2_v': nrm(ks[9], (DEPTH, Dh, Dh), Dh ** -0.5),
        'gmlp_ln_g': gain(ks[10], (DEPTH, BRANCH_WIDTH)),
        'gmlp_ln_b': nrm(ks[11], (DEPTH, BRANCH_WIDTH), 0.02),
        'gmlp_w_s': nrm(ks[12], (DEPTH, GMLP_GROUPS, GMLP_CHUNK, GMLP_CHUNK), GMLP_CHUNK ** -0.5),
        'gmlp_b_s': gain(ks[13], (DEPTH, GMLP_GROUPS, GMLP_CHUNK)),
        'conv_w': nrm(ks[14], (DEPTH, CONV_WIDTH, 1, CONV_CH), CONV_WIDTH ** -0.5),
        'conv_b': nrm(ks[15], (DEPTH, CONV_CH), 0.02),
        'conv_ln_g': gain(ks[16], (DEPTH, CONV_CH)),
        'conv_ln_b': nrm(ks[17], (DEPTH, CONV_CH), 0.02),
        'w_br': nrm(ks[18], (DEPTH, N_BRANCH, BRANCH_WIDTH, D_MODEL), BRANCH_WIDTH ** -0.5 * DEEPNORM_BETA),
        'w_o': nrm(ks[19], (DEPTH, D_MODEL, D_MODEL), D_MODEL ** -0.5 * DEEPNORM_BETA),
        'ln1_g': gain(ks[20], (DEPTH, D_MODEL)),
        'ln1_b': nrm(ks[21], (DEPTH, D_MODEL), 0.02),
        'w_router': nrm(ks[22], (DEPTH, D_MODEL, N_EXPERTS), D_MODEL ** -0.5),
        'b_router': nrm(ks[23], (DEPTH, N_EXPERTS), 0.01),
        'w_exp1': nrm(ks[24], (DEPTH, N_EXPERTS, D_MODEL, 2 * D_FF), D_MODEL ** -0.5),
        'b_exp1': nrm(ks[25], (DEPTH, N_EXPERTS, 2 * D_FF), 0.02),
        'w_exp2': nrm(ks[26], (DEPTH, N_EXPERTS, D_FF, D_MODEL), D_FF ** -0.5 * DEEPNORM_BETA),
        'b_exp2': nrm(ks[27], (DEPTH, N_EXPERTS, D_MODEL), 0.02),
        'ln2_g': gain(ks[28], (DEPTH, D_MODEL)),
        'ln2_b': nrm(ks[29], (DEPTH, D_MODEL), 0.02),
    }


def reference(x, positions, w_in, b_in, nsa_pe_k, nsa_pe_v, nsa_cmp_w1_k, nsa_cmp_w2_k,
              nsa_cmp_w1_v, nsa_cmp_w2_v, gmlp_ln_g, gmlp_ln_b, gmlp_w_s, gmlp_b_s,
              conv_w, conv_b, conv_ln_g, conv_ln_b, w_br, w_o, ln1_g, ln1_b,
              w_router, b_router, w_exp1, b_exp1, w_exp2, b_exp2, ln2_g, ln2_b):
    B, S, D = x.shape
    Dh = HEAD_DIM
    split_points = np.cumsum(SPLIT_SIZES)[:-1].tolist()

    def rope_kv(t):
        return partial_rope(t[:, :, None, :], positions)[:, :, 0, :]

    for l in range(DEPTH):
        h = x @ w_in[l] + b_in[l]
        (nq, nkc, nvc, nks, nvs, nkw, nvw, ngate,
         fq, fk, fv, ff, gu, gv, ca, cb, mg) = jnp.split(h, split_points, axis=-1)
        o_nsa = nsa_mixer(partial_rope(nq.reshape(B, S, NSA_HEADS, Dh), positions),
                          rope_kv(nkc), nvc, rope_kv(nks), nvs, rope_kv(nkw), nvw, ngate,
                          nsa_pe_k[l], nsa_pe_v[l], nsa_cmp_w1_k[l], nsa_cmp_w2_k[l],
                          nsa_cmp_w1_v[l], nsa_cmp_w2_v[l])
        o_fox = fox_mixer(fq.reshape(B, S, FOX_HEADS, Dh), fk.reshape(B, S, FOX_HEADS, Dh),
                          fv.reshape(B, S, FOX_HEADS, Dh), ff)
        o_gmlp = gmlp_mixer(gu, gv, gmlp_w_s[l], gmlp_b_s[l], gmlp_ln_g[l], gmlp_ln_b[l])
        o_conv = conv_mixer(ca, cb, conv_w[l], conv_b[l], conv_ln_g[l], conv_ln_b[l])
        branches = jnp.stack([o_nsa, o_fox, o_gmlp, o_conv], axis=2)
        proj = jnp.einsum('bsnc,ncd->bsnd', branches, w_br[l])
        gate = jax.nn.sigmoid(mg.reshape(B, S, N_BRANCH, D))
        mixed = jnp.sum(gate * proj, axis=2) @ w_o[l]
        x = layer_norm(DEEPNORM_ALPHA * x + mixed, ln1_g[l], ln1_b[l])
        ffn = moe_ffn(x, w_router[l], b_router[l], w_exp1[l], b_exp1[l], w_exp2[l], b_exp2[l])
        x = layer_norm(DEEPNORM_ALPHA * x + ffn, ln2_g[l], ln2_b[l])
    return x
```

```cpp
#include <hip/hip_runtime.h>
#include <cstdio>
#include <cstdint>
#include <cmath>
#include <cstring>

#define DEV __device__ __forceinline__
#define LAS __attribute__((address_space(3)))
#define GAS __attribute__((address_space(1)))

typedef unsigned short bf16_t;
typedef short bf16x8 __attribute__((ext_vector_type(8)));
typedef short bf16x4 __attribute__((ext_vector_type(4)));
typedef float f32x4 __attribute__((ext_vector_type(4)));
typedef float f32x2 __attribute__((ext_vector_type(2)));
typedef unsigned u32x4 __attribute__((ext_vector_type(4)));
typedef unsigned u32x2 __attribute__((ext_vector_type(2)));

constexpr int NB = 4, SEQ = 4096, DM = 1024, NL = 4, NT = NB * SEQ;
constexpr int NIN = 6544, NP = 6656;
constexpr int NE = 32;
constexpr int NWAVES = 8, NTHR = 512;
constexpr float LN_EPS = 1e-5f;
constexpr float DN_ALPHA = 1.6817928305074292f;
constexpr float LOG2E = 1.4426950408889634f;
constexpr int HP_NQ = 0, HP_KC = 256, HP_VC = 320, HP_KS = 384, HP_VS = 448, HP_KW = 512, HP_VW = 576, HP_SP = 640;
constexpr int HP_FQ = 768, HP_FK = 1024, HP_FV = 1280, HP_GU = 1536, HP_GV = 1792, HP_CAB = 2048, HP_MG = 2560;

constexpr size_t al256(size_t x) { return (x + 255) & ~(size_t)255; }
constexpr size_t WS_CTL = 0, CTL_BYTES = 1u << 20;
constexpr size_t WS_WIN = CTL_BYTES;
constexpr size_t WS_BIN = WS_WIN + al256((size_t)NL * NP * 1024 * 2);
constexpr size_t WS_WBR = WS_BIN + al256((size_t)NL * NP * 4);
constexpr size_t WS_WO = WS_WBR + al256((size_t)NL * 4096 * 256 * 2);
constexpr size_t WS_W1 = WS_WO + al256((size_t)NL * 1024 * 1024 * 2);
constexpr size_t WS_W2 = WS_W1 + al256((size_t)NL * 32 * 2048 * 1024 * 2);
constexpr size_t WS_WC1 = WS_W2 + al256((size_t)NL * 32 * 1024 * 1024 * 2);
constexpr size_t WS_WC2 = WS_WC1 + al256((size_t)NL * 2 * 64 * 2048 * 2);
constexpr size_t WS_CB = WS_WC2 + al256((size_t)NL * 2 * 64 * 64 * 2);
constexpr size_t WS_WG = WS_CB + al256((size_t)NL * 2 * 32 * 64 * 4);
constexpr size_t WS_CS = WS_WG + al256((size_t)NL * 4 * 128 * 128 * 2);
constexpr size_t WS_XRES = WS_CS + al256((size_t)NT * 16 * 4);
constexpr size_t WS_XB = WS_XRES + al256((size_t)NT * 1024 * 4);
constexpr size_t WS_H = WS_XB + al256((size_t)NT * 1024 * 2);
constexpr size_t WS_SIDE = WS_H + al256((size_t)NT * NP * 2);
constexpr size_t WS_KNSA = WS_SIDE + al256((size_t)NT * 16 * 4);
constexpr size_t WS_VT = WS_KNSA + al256((size_t)NT * 128 * 2);
constexpr size_t WS_CUM = WS_VT + al256((size_t)NB * 384 * SEQ * 2);
constexpr size_t WS_KCMP = WS_CUM + al256((size_t)NB * 4 * SEQ * 4);
constexpr size_t WS_VCMPT = WS_KCMP + al256((size_t)NB * 256 * 64 * 2);
constexpr size_t WS_BR = WS_VCMPT + al256((size_t)NB * 64 * 256 * 2);
constexpr size_t WS_G32 = WS_BR + al256((size_t)NT * 1024 * 2);
constexpr size_t WS_GBF = WS_G32 + al256((size_t)NT * 1024 * 4);
constexpr size_t WS_MIX = WS_GBF + al256((size_t)NT * 1024 * 2);
constexpr size_t WS_TOKW = WS_MIX + al256((size_t)NT * 1024 * 4);
constexpr size_t WS_ROWTK = WS_TOKW + al256((size_t)NT * 4 * 4);
constexpr int PMAX_TILES = NT * 4 / 256 + NE;
constexpr size_t WS_ACT = WS_ROWTK + al256((size_t)NE * NT * 4);
constexpr size_t WS_YBUF = WS_ACT + al256((size_t)PMAX_TILES * 256 * 1024 * 2);
constexpr size_t WS_MGT = WS_YBUF + al256((size_t)NT * 4 * 1024 * 2);
constexpr size_t WS_KN = WS_MGT + al256((size_t)NT * 4096 * 2);
constexpr size_t WS_END = WS_KN + al256((size_t)NB * 4 * 64 * 4);

constexpr int CW_BAR = 4096;
constexpr int CW_CNT = 32768;
constexpr int CW_QUEUE = 20480;
constexpr int CW_BGQ = 24576;
constexpr int CW_DONE = 28672;

constexpr int RING_BYTES = 131072;
constexpr int MISC_OFF = RING_BYTES;
constexpr int LDS_BYTES = 147456;

DEV float bf2f(bf16_t v) { return __uint_as_float((unsigned)v << 16); }
DEV float bflo(unsigned w) { return __uint_as_float(w << 16); }
DEV float bfhi(unsigned w) { return __uint_as_float(w & 0xffff0000u); }
DEV unsigned pk2(float lo, float hi) { typedef __bf16 b2 __attribute__((ext_vector_type(2))); f32x2 v = {lo, hi}; b2 b = __builtin_convertvector(v, b2); return __builtin_bit_cast(unsigned, b); }
DEV bf16_t f2bf(float f) { return (bf16_t)(pk2(f, 0.f) & 0xffffu); }
DEV float fexp2(float x) { return __builtin_amdgcn_exp2f(x); }
DEV float frcp(float x) { return __builtin_amdgcn_rcpf(x); }
DEV float sigmoidf_(float x) { return frcp(1.f + fexp2(-x * LOG2E)); }
DEV float gelu_tanh(float x) { const float u = 1.5957691216057308f * (x + 0.044715f * x * x * x); return x * frcp(1.f + fexp2(-u * LOG2E)); }
#define WS_DPP(x, ctrl) __builtin_bit_cast(float, __builtin_amdgcn_update_dpp(0, __builtin_bit_cast(int, (x)), (ctrl), 0xf, 0xf, true))
DEV float wave_sum(float v) {
    v += WS_DPP(v, 0xB1); v += WS_DPP(v, 0x4E); v += WS_DPP(v, 0x141); v += WS_DPP(v, 0x140);
    const int vi = __builtin_bit_cast(int, v);
    const float r0 = __builtin_bit_cast(float, __builtin_amdgcn_readlane(vi, 0)), r1 = __builtin_bit_cast(float, __builtin_amdgcn_readlane(vi, 16));
    const float r2 = __builtin_bit_cast(float, __builtin_amdgcn_readlane(vi, 32)), r3 = __builtin_bit_cast(float, __builtin_amdgcn_readlane(vi, 48));
    return (r0 + r1) + (r2 + r3);
}
typedef unsigned u32x2_t __attribute__((ext_vector_type(2)));
DEV float xr_max(float v) {
    { const unsigned u = __float_as_uint(v); const auto r = __builtin_amdgcn_permlane16_swap(u, u, false, false); v = fmaxf(__uint_as_float(r[0]), __uint_as_float(r[1])); }
    { const unsigned u = __float_as_uint(v); const auto r = __builtin_amdgcn_permlane32_swap(u, u, false, false); v = fmaxf(__uint_as_float(r[0]), __uint_as_float(r[1])); }
    return v;
}
DEV float xr_sum(float v) {
    { const unsigned u = __float_as_uint(v); const auto r = __builtin_amdgcn_permlane16_swap(u, u, false, false); v = __uint_as_float(r[0]) + __uint_as_float(r[1]); }
    { const unsigned u = __float_as_uint(v); const auto r = __builtin_amdgcn_permlane32_swap(u, u, false, false); v = __uint_as_float(r[0]) + __uint_as_float(r[1]); }
    return v;
}
DEV unsigned xr_or(unsigned u) {
    { const auto r = __builtin_amdgcn_permlane16_swap(u, u, false, false); u = r[0] | r[1]; }
    { const auto r = __builtin_amdgcn_permlane32_swap(u, u, false, false); u = r[0] | r[1]; }
    return u;
}
DEV f32x4 mfma16(bf16x8 a, bf16x8 b, f32x4 c) { return __builtin_amdgcn_mfma_f32_16x16x32_bf16(a, b, c, 0, 0, 0); }
#define LDS_WAIT() asm volatile("s_waitcnt lgkmcnt(0)" ::: "memory")
#define VM_WAIT() asm volatile("s_waitcnt vmcnt(0)" ::: "memory")

__host__ __device__ __forceinline__ int perm16(int dp) { return dp < 16 ? ((dp & 1) ? 8 + (dp >> 1) : (dp >> 1)) : dp; }
__host__ __device__ __forceinline__ int hp_src_col(int c) {
    if (c < 256) return (c & ~63) + perm16(c & 63);
    if (c < 320) return 256 + perm16(c - 256);
    if (c < 384) return c;
    if (c < 448) return 384 + perm16(c - 384);
    if (c < 512) return c;
    if (c < 576) return 512 + perm16(c - 512);
    if (c < 640) return c;
    if (c < 652) return c;
    if (c < 656) return 1420 + (c - 652);
    if (c < 768) return -1;
    if (c < 1024) return 652 + (c - 768);
    if (c < 1280) return 908 + (c - 1024);
    if (c < 1536) return 1164 + (c - 1280);
    if (c < 1792) return 1424 + (c - 1536);
    if (c < 2048) return 1680 + (c - 1792);
    if (c < 2560) { const int i = c - 2048; return (i & 1) ? 2192 + (i >> 1) : 1936 + (i >> 1); }
    return 2448 + (c - 2560);
}

namespace pg8 {
constexpr int BM = 256, BK = 64, HALF = 128, HTB = HALF * BK * 2, STAGE_BYTES = 8 * HTB, NXCD = 8, WGM = 8;
__host__ __device__ __forceinline__ int lds_byte(int r, int c) { const int st = (r >> 4) * 2 + (c >> 5), rr = r & 15, cc = c & 31, ob = rr * 64 + cc * 2; return st * 1024 + (ob ^ (((ob >> 9) & 1) << 5)); }
__host__ __device__ __forceinline__ void stage_rc(int b, int& R, int& C) { const int st = b / 1024, sb = b % 1024, swz = sb ^ (((sb >> 9) & 1) << 5); R = (st >> 1) * 16 + swz / 64; C = (st & 1) * 32 + (swz % 64) / 2; }
__host__ __device__ __forceinline__ int perm32(int rho) { const int n = rho >> 4, i = rho & 15; return 8 * (i >> 2) + 4 * n + (i & 3); }

struct Unit { int pm, pn, e, mt, cnt; };
struct Gemm { const bf16_t* A; const bf16_t* Bt; int lda; int K; };

template <class Epi, class Sched, bool ALIGN_EPI, bool HALFN = false>
DEV void gemm_phase(LAS unsigned char* lds, const Gemm g, const Sched& S, const Epi& E) {
    int tid_ = threadIdx.x; asm volatile("" : "+v"(tid_));
    const int tid = tid_, wid = __builtin_amdgcn_readfirstlane(tid >> 6), lane = tid & 63, wr = wid >> 2, wc = wid & 3, fr = lane & 15, fq = lane >> 4;
    const int K = g.K, nt = K / BK;
    unsigned voffA[2], voffB[2];
#pragma unroll
    for (int i = 0; i < 2; ++i) { int R, C; stage_rc(tid * 16 + i * 8192, R, C); int Rb = Epi::PERM ? ((R & ~31) + perm32(R & 31)) : R;
        if constexpr (Epi::PAIR16) Rb = 16 * (Rb >> 3) + (Rb & 7);
        voffA[i] = (unsigned)(R * g.lda + C) * 2u; voffB[i] = (unsigned)(Rb * K + C) * 2u; }
    const unsigned hstepA = (unsigned)HALF * (unsigned)g.lda * 2u;
    const size_t kstep = (size_t)(BK * 2);
    const size_t hstepB = (size_t)(Epi::PAIR16 ? 8 : HALF) * K * 2;
    unsigned voffG[2];
#pragma unroll
    for (int i = 0; i < 2; ++i) { const unsigned off = (unsigned)tid * 16u + (unsigned)i * 8192u; voffG[i] = (off >> 8) * 512u + (off & 255u); }
    constexpr size_t GPIECE = 64 * 512;
    const unsigned ldsw = (unsigned)wid * 1024u;
    const int aoff = lds_byte(wr * 64 + fr, fq * 8), boff = lds_byte(wc * 32 + fr, fq * 8);
    const char* const Abase = (const char*)g.A;
#define PG8_SA(b, h) (((b) * 2 + (h)) * HTB)
#define PG8_SB(b, h) ((4 + (b) * 2 + (h)) * HTB)
#define PG8_STAGE_B(bufoff, gbase, voff) do { _Pragma("unroll") for (int _i = 0; _i < 2; ++_i) \
        __builtin_amdgcn_global_load_lds((const unsigned*)((const char*)(gbase) + (voff)[_i]), (LAS unsigned*)(lds + (bufoff) + ldsw + _i * 8192), 16, 0, 0); } while (0)
#define PG8_STAGE_B1(bufoff, gbase, gatep) do { if constexpr (HALFN) PG8_STAGE_B(bufoff, gatep, voffG); else PG8_STAGE_B(bufoff, (gbase) + hstepB, voffB); } while (0)
#define PG8_STAGE_A(bufoff, koff, offs) do { _Pragma("unroll") for (int _i = 0; _i < 2; ++_i) { \
        if constexpr (Sched::GATHER) __builtin_amdgcn_global_load_lds((const unsigned*)(Abase + (size_t)(koff) + (offs)[_i]), (LAS unsigned*)(lds + (bufoff) + ldsw + _i * 8192), 16, 0, 0); \
        else __builtin_amdgcn_global_load_lds((const unsigned*)(Abase + ((size_t)(koff) + (size_t)__builtin_amdgcn_readfirstlane((offs)[_i])) + voffA[_i]), (LAS unsigned*)(lds + (bufoff) + ldsw + _i * 8192), 16, 0, 0); } } while (0)
#define PG8_LDA(dst, b, h) do { _Pragma("unroll") for (int m = 0; m < 4; ++m) _Pragma("unroll") for (int k = 0; k < 2; ++k) dst[m][k] = *(const LAS bf16x8*)(lds + PG8_SA(b, h) + aoff + m * 2048 + k * 1024); } while (0)
#define PG8_LDB(dst, b, h) do { _Pragma("unroll") for (int n = 0; n < 2; ++n) _Pragma("unroll") for (int k = 0; k < 2; ++k) dst[n][k] = *(const LAS bf16x8*)(lds + PG8_SB(b, h) + boff + n * 2048 + k * 1024); } while (0)
#define PG8_MMA(ai, bj, At, Bt) do { __builtin_amdgcn_s_setprio(1); _Pragma("unroll") for (int m = 0; m < 4; ++m) _Pragma("unroll") for (int n = 0; n < 2; ++n) _Pragma("unroll") for (int k = 0; k < 2; ++k) \
        acc[ai][bj][m][n] = __builtin_amdgcn_mfma_f32_16x16x32_bf16(Bt[n][k], At[m][k], acc[ai][bj][m][n], 0, 0, 0); __builtin_amdgcn_s_setprio(0); } while (0)
#define PG8_WAIT_V(n) asm volatile("s_waitcnt vmcnt(" #n ")" ::: "memory")
#define PG8_WAIT_L(n) asm volatile("s_waitcnt lgkmcnt(" #n ")" ::: "memory")
#define PG8_BAR __builtin_amdgcn_s_barrier()
#define PG8_SCHED __builtin_amdgcn_sched_barrier(0)
#define PG8_MKOFF(dst, u) do { if constexpr (Sched::GATHER) { const unsigned _ao = S.aoff(u); _Pragma("unroll") for (int _h = 0; _h < 2; ++_h) _Pragma("unroll") for (int _i = 0; _i < 2; ++_i) { \
        int _R, _C; stage_rc(tid * 16 + _i * 8192, _R, _C); dst[_h][_i] = _ao + (S.arow(u, _h * HALF + _R) * (unsigned)g.lda + (unsigned)_C) * 2u; } } \
    else { const unsigned _ub = S.aoff(u) + S.arow(u, 0) * (unsigned)g.lda * 2u; _Pragma("unroll") for (int _h = 0; _h < 2; ++_h) _Pragma("unroll") for (int _i = 0; _i < 2; ++_i) dst[_h][_i] = _ub + (unsigned)_h * hstepA; } } while (0)
    Unit cur, nxt; int ui = 0;
    if (!S.next(0, cur)) return;
    f32x4 acc[2][2][4][2];
#pragma unroll
    for (int a = 0; a < 2; ++a)
#pragma unroll
        for (int b = 0; b < 2; ++b)
#pragma unroll
            for (int m = 0; m < 4; ++m)
#pragma unroll
                for (int n = 0; n < 2; ++n) acc[a][b][m][n] = (f32x4){0.f, 0.f, 0.f, 0.f};
    bf16x8 At[4][2], B0[2][2], B1[2][2];
    unsigned oc[2][2], on[2][2];
    PG8_MKOFF(oc, cur);
    const char* cB = (const char*)g.Bt + S.boff(cur);
    const char* cG = E.gate_base(cur);
    PG8_STAGE_B(PG8_SB(0, 0), cB, voffB); PG8_STAGE_B1(PG8_SB(0, 1), cB, cG); PG8_STAGE_A(PG8_SA(0, 0), 0, oc[0]); PG8_STAGE_A(PG8_SA(0, 1), 0, oc[1]);
    if (wr == 1) PG8_BAR;
    PG8_WAIT_V(2); PG8_BAR;
    PG8_STAGE_B(PG8_SB(1, 0), cB + kstep, voffB); PG8_STAGE_A(PG8_SA(1, 0), kstep, oc[0]); PG8_STAGE_B1(PG8_SB(1, 1), cB + kstep, cG + GPIECE);
    PG8_WAIT_V(6); PG8_BAR;
    typename Epi::Pre pre;
    for (;;) {
        const bool has_next = S.next(ui + 1, nxt);
        const char* nB = cB; const char* nG = cG;
        LAS int* const idxb = (LAS int*)(lds + STAGE_BYTES + 2048) + ((ui + 1) & 1) * 256;
        if (has_next) { nB = (const char*)g.Bt + S.boff(nxt); nG = E.gate_base(nxt);
            if constexpr (Sched::GATHER) { if (wid < 4) __builtin_amdgcn_global_load_lds((const unsigned*)(S.idx_ptr(nxt) + tid), (LAS unsigned*)(idxb + wid * 64), 4, 0, 0); }
            else PG8_MKOFF(on, nxt); }
        else {
#pragma unroll
            for (int h = 0; h < 2; ++h)
#pragma unroll
                for (int i = 0; i < 2; ++i) on[h][i] = oc[h][i];
        }
#pragma unroll 1
        for (int t = 0; t < nt; t += 2) {
            const bool last = (t == nt - 2);
            const size_t k1 = (size_t)(t + 1) * kstep;
            const size_t k2 = last ? (size_t)0 : (size_t)(t + 2) * kstep, k3 = k2 + kstep;
            if constexpr (Sched::GATHER) { if (last && has_next) {
                const unsigned ao_ = S.aoff(nxt);
#pragma unroll
                for (int h = 0; h < 2; ++h)
#pragma unroll
                    for (int i = 0; i < 2; ++i) { int R_, C_; stage_rc(tid * 16 + i * 8192, R_, C_); const int r_ = h * HALF + R_; const int ix_ = idxb[r_];
                        on[h][i] = ao_ + (S.arow_from(nxt, r_, ix_) * (unsigned)g.lda + (unsigned)C_) * 2u; } } }
            unsigned o2[2][2];
#pragma unroll
            for (int h = 0; h < 2; ++h)
#pragma unroll
                for (int i = 0; i < 2; ++i) o2[h][i] = last ? on[h][i] : oc[h][i];
            const char* b2 = last ? nB : cB + (size_t)(t + 2) * kstep; const char* b3 = b2 + kstep;
            const char* g2 = last ? nG : cG + (size_t)(t + 2) * GPIECE; const char* g3 = g2 + GPIECE;
            PG8_LDB(B0, 0, 0); if constexpr (!HALFN) PG8_LDB(B1, 0, 1); else { if (wr == 0) E.gate_read(pre, lds + PG8_SB(0, 1), t >> 1, wc, fr, fq); } PG8_SCHED; PG8_LDA(At, 0, 0); PG8_STAGE_A(PG8_SA(1, 1), k1, oc[1]);
            PG8_WAIT_V(8); PG8_WAIT_L(0); PG8_BAR; PG8_MMA(0, 0, At, B0); if constexpr (!HALFN) PG8_MMA(0, 1, At, B1); PG8_BAR; PG8_SCHED;
            PG8_LDA(At, 0, 1); PG8_STAGE_B(PG8_SB(0, 0), b2, voffB); PG8_STAGE_B1(PG8_SB(0, 1), b2, g2); PG8_STAGE_A(PG8_SA(0, 0), k2, o2[0]);
            PG8_WAIT_V(8); PG8_WAIT_L(0); PG8_BAR; PG8_MMA(1, 0, At, B0); if constexpr (!HALFN) PG8_MMA(1, 1, At, B1); PG8_BAR; PG8_SCHED;
            PG8_LDB(B0, 1, 0); if constexpr (!HALFN) PG8_LDB(B1, 1, 1); else { if (wr == 1) E.gate_read(pre, lds + PG8_SB(1, 1), t >> 1, wc, fr, fq); } PG8_SCHED; PG8_LDA(At, 1, 0); PG8_STAGE_A(PG8_SA(0, 1), k2, o2[1]);
            PG8_WAIT_V(8); PG8_WAIT_L(0); PG8_BAR; PG8_MMA(0, 0, At, B0); if constexpr (!HALFN) PG8_MMA(0, 1, At, B1); PG8_BAR; PG8_SCHED;
            PG8_LDA(At, 1, 1); PG8_STAGE_B(PG8_SB(1, 0), b3, voffB); PG8_STAGE_B1(PG8_SB(1, 1), b3, g3); PG8_STAGE_A(PG8_SA(1, 0), k3, o2[0]);
            PG8_WAIT_V(8); PG8_WAIT_L(0); PG8_BAR; PG8_MMA(1, 0, At, B0); if constexpr (!HALFN) PG8_MMA(1, 1, At, B1); PG8_BAR; PG8_SCHED;
        }
        if constexpr (ALIGN_EPI) { if (wr == 0) PG8_BAR; }
        if constexpr (HALFN) E.fold(acc, pre, cur, wr, wc, fr, fq); else E(acc, cur, wr, wc, fr, fq);
        if (!has_next) break;
#pragma unroll
        for (int a = 0; a < 2; ++a)
#pragma unroll
            for (int b = 0; b < 2; ++b)
#pragma unroll
                for (int m = 0; m < 4; ++m)
#pragma unroll
                    for (int n = 0; n < 2; ++n) { if (!HALFN || b == 0) acc[a][b][m][n] = (f32x4){0.f, 0.f, 0.f, 0.f}; }
        cur = nxt; cB = nB; cG = nG; ++ui;
#pragma unroll
        for (int h = 0; h < 2; ++h)
#pragma unroll
            for (int i = 0; i < 2; ++i) oc[h][i] = on[h][i];
        if constexpr (ALIGN_EPI) { if (wr == 1) PG8_BAR; }
    }
    PG8_WAIT_V(0);
    if constexpr (!ALIGN_EPI) { if (wr == 0) PG8_BAR; }
    PG8_BAR;
#undef PG8_SA
#undef PG8_SB
#undef PG8_STAGE_A
#undef PG8_STAGE_B1
#undef PG8_STAGE_B
#undef PG8_LDA
#undef PG8_LDB
#undef PG8_MMA
#undef PG8_WAIT_V
#undef PG8_WAIT_L
#undef PG8_BAR
#undef PG8_SCHED
#undef PG8_MKOFF
}

struct StaticOrder {
    int nM, nN, nwg, G, c;
    DEV void init(int nM_, int nN_, int G_, int c_) { nM = nM_; nN = nN_; nwg = nM * nN; G = G_; c = c_; }
    DEV bool next(int i, Unit& u) const {
        const long L = (long)i * G + c; if (L >= nwg) return false;
        int wgid = (int)L; { const int q = nwg / NXCD, r = nwg % NXCD, xcd = wgid % NXCD, off = wgid / NXCD; wgid = (xcd < r ? xcd * (q + 1) : r * (q + 1) + (xcd - r) * q) + off; }
        const int nig = WGM * nN, gid = wgid / nig, fm = gid * WGM, gsz = (nM - fm) < WGM ? (nM - fm) : WGM;
        u.pm = fm + ((wgid % nig) % gsz); u.pn = (wgid % nig) / gsz; u.e = 0; u.mt = 0; u.cnt = 256; return true;
    }
};
}

#define XB_TMO      128
#define XB_XCNT(j)  (256  + 64 * (j))
#define XB_XSUB(j)  (1280 + 64 * (j))
#define XB_XGEN(j)  (2304 + 64 * (j))
#define XB_TOP      3328
#define XB_TOPGEN   3392
#define XCD_BAR_WORDS 3456
#define XB_SPIN_CAP (1u << 20)
DEV unsigned xb_ld(unsigned* p)              { return __hip_atomic_load(p, __ATOMIC_RELAXED, __HIP_MEMORY_SCOPE_AGENT); }
DEV unsigned xb_add(unsigned* p, unsigned v) { return __hip_atomic_fetch_add(p, v, __ATOMIC_RELAXED, __HIP_MEMORY_SCOPE_AGENT); }
DEV unsigned xb_xcc_id() { return (unsigned)__builtin_amdgcn_s_getreg((3 << 11) | 20) & 0xFu; }
#define XB_SPIN(cond, bar) do { unsigned _sp = 0; while (cond) { __builtin_amdgcn_s_sleep(1); \
    if ((++_sp & 255u) == 0u) { if (xb_ld(&(bar)[XB_TMO])) break; if (_sp > XB_SPIN_CAP) { atomicAdd(&(bar)[XB_TMO], 1u); break; } } } } while (0)
struct XcdBarrier { unsigned* bar; unsigned x; volatile LAS unsigned* st; };
DEV XcdBarrier xcd_barrier_post(unsigned* bar, volatile LAS unsigned* st) {
    XcdBarrier b; b.bar = bar; b.x = xb_xcc_id(); b.st = st;
    if (threadIdx.x == 0) (void)xb_add(&bar[XB_XCNT(b.x)], 1u);
    return b;
}
DEV void xcd_barrier_complete(unsigned* bar, unsigned x, unsigned& nloc, unsigned& nx) {
    const unsigned G = gridDim.x * gridDim.y * gridDim.z;
    unsigned sum, cnt, mine, sp = 0u;
    for (;;) {
        sum = 0u; cnt = 0u; mine = 0u;
#pragma unroll
        for (unsigned j = 0; j < 16; ++j) { const unsigned c = xb_ld(&bar[XB_XCNT(j)]); sum += c; cnt += (c > 0u) ? 1u : 0u; mine = (j == x) ? c : mine; }
        if (sum == G) break;
        __builtin_amdgcn_s_sleep(1);
        if ((++sp & 255u) == 0u) { if (xb_ld(&bar[XB_TMO])) break; if (sp > XB_SPIN_CAP) { atomicAdd(&bar[XB_TMO], 1u); break; } }
    }
    nloc = mine > 0u ? mine : 1u; nx = cnt > 0u ? cnt : 1u;
}
DEV void xcd_barrier(const XcdBarrier& b) {
    asm volatile("s_waitcnt vmcnt(0)" ::: "memory");
    __syncthreads();
    if (threadIdx.x == 0) {
        unsigned* bar = b.bar;
        __builtin_amdgcn_s_waitcnt(0);
        unsigned nloc = b.st[0], nx = b.st[1];
        if (nloc == 0u) { xcd_barrier_complete(bar, b.x, nloc, nx); b.st[0] = nloc; b.st[1] = nx; }
        const unsigned old = xb_add(&bar[XB_XSUB(b.x)], 1u);
        const unsigned gen = old / nloc;
        if (old + 1u == (gen + 1u) * nloc) {
            __builtin_amdgcn_fence(__ATOMIC_RELEASE, "agent");
            asm volatile("s_waitcnt vmcnt(0)" ::: "memory");
            const unsigned og = xb_add(&bar[XB_TOP], 1u);
            const unsigned tg = og / nx;
            if (og + 1u == (tg + 1u) * nx) xb_add(&bar[XB_TOPGEN], 1u);
            else XB_SPIN(xb_ld(&bar[XB_TOPGEN]) == tg, bar);
            __builtin_amdgcn_fence(__ATOMIC_ACQUIRE, "agent");
            xb_add(&bar[XB_XGEN(b.x)], 1u);
            asm volatile("s_waitcnt vmcnt(0)" ::: "memory");
        } else {
            XB_SPIN(xb_ld(&bar[XB_XGEN(b.x)]) == gen, bar);
            __builtin_amdgcn_fence(__ATOMIC_ACQUIRE, "agent");
            asm volatile("s_waitcnt vmcnt(0)" ::: "memory");
        }
    }
    __syncthreads();
}

struct Params {
    const float* in[30];
    float* out;
    unsigned char* ws;
    int ph_lo, ph_hi;
    double invf[8];
};
enum { I_X = 0, I_POS, I_WIN, I_BIN, I_PEK, I_PEV, I_W1K, I_W2K, I_W1V, I_W2V, I_GLNG, I_GLNB, I_GWS, I_GBS, I_CW, I_CB, I_CLNG, I_CLNB,
       I_WBR, I_WO, I_LN1G, I_LN1B, I_WR, I_BR, I_WE1, I_BE1, I_WE2, I_BE2, I_LN2G, I_LN2B };

namespace pg8 {
struct EpiInProj {
    struct Pre {};
    DEV const char* gate_base(const Unit&) const { return nullptr; }
    static constexpr bool PERM = true, PAIR16 = true;
    bf16_t* H; const float* bias; float* side; bf16_t* MGT;
    DEV void operator()(const f32x4 (&acc)[2][2][4][2], const Unit& u, int wr, int wc, int fr, int fq) const {
        const int q = 4 * wc + fq; const int row0 = u.pm * BM + wr * 64 + fr, col0 = u.pn * BM + 16 * q;
        f32x4 bv[2][2];
#pragma unroll
        for (int bj = 0; bj < 2; ++bj)
#pragma unroll
            for (int n = 0; n < 2; ++n) bv[bj][n] = *(const f32x4*)(bias + col0 + bj * 8 + 4 * n);
        if (u.pn >= 10) {
            bf16_t* tile = MGT + ((size_t)u.pm * 16 + (u.pn - 10)) * 65536 + (wr * 64 + fr) * 256 + 16 * q;
#pragma unroll
            for (int ai = 0; ai < 2; ++ai)
#pragma unroll
                for (int m = 0; m < 4; ++m)
#pragma unroll
                    for (int bj = 0; bj < 2; ++bj) { const f32x4 v0 = acc[ai][bj][m][0] + bv[bj][0], v1 = acc[ai][bj][m][1] + bv[bj][1];
                        u32x4 w; w.x = pk2(sigmoidf_(v0[0]), sigmoidf_(v0[1])); w.y = pk2(sigmoidf_(v0[2]), sigmoidf_(v0[3])); w.z = pk2(sigmoidf_(v1[0]), sigmoidf_(v1[1])); w.w = pk2(sigmoidf_(v1[2]), sigmoidf_(v1[3]));
                        *(u32x4*)(tile + (ai * HALF + m * 16) * 256 + bj * 8) = w; }
            return; }
        const bool special = (u.pn == 2) && (q == 8);
#pragma unroll
        for (int ai = 0; ai < 2; ++ai)
#pragma unroll
            for (int m = 0; m < 4; ++m) { const int row = row0 + ai * HALF + m * 16; bf16_t* rowp = H + (size_t)row * NP + col0;
#pragma unroll
                for (int bj = 0; bj < 2; ++bj) { const f32x4 v0 = acc[ai][bj][m][0] + bv[bj][0], v1 = acc[ai][bj][m][1] + bv[bj][1];
                    u32x4 w; w.x = pk2(v0[0], v0[1]); w.y = pk2(v0[2], v0[3]); w.z = pk2(v1[0], v1[1]); w.w = pk2(v1[2], v1[3]);
                    *(u32x4*)(rowp + bj * 8) = w;
                    if (special) { float* sp = side + (size_t)row * 16 + 8 * bj; *(f32x4*)sp = v0; *(f32x4*)(sp + 4) = v1; } } }
    }
};
struct EpiBrGate {
    static constexpr bool PERM = true;
    struct Pre { u32x4 g[2][4]; };
    static constexpr bool PAIR16 = false;
    const bf16_t* MGT; bf16_t* GBF;
    DEV const char* gate_base(const Unit& u) const { return (const char*)(MGT + ((size_t)u.pm * 16 + u.e * 4 + (u.pn >> 1)) * 65536 + (u.pn & 1) * 128); }
    DEV void gate_read(Pre& p, const LAS unsigned char* slot, int idx, int wc, int fr, int fq) const {
        const LAS unsigned char* q = slot + fr * 256 + (wc * 32 + 8 * fq) * 2;
        if (idx == 0) {
#pragma unroll
            for (int m = 0; m < 4; ++m) p.g[0][m] = *(const LAS u32x4*)(q + m * 16 * 256); }
        else {
#pragma unroll
            for (int m = 0; m < 4; ++m) p.g[1][m] = *(const LAS u32x4*)(q + m * 16 * 256); }
    }
    DEV void fold(f32x4 (&acc)[2][2][4][2], const Pre& p, const Unit& u, int wr, int wc, int fr, int fq) const {
        const int n = u.e;
#pragma unroll
        for (int ai = 0; ai < 2; ++ai)
#pragma unroll
            for (int m = 0; m < 4; ++m) { const u32x4 g = p.g[ai][m]; const f32x4 a0 = acc[ai][0][m][0], a1 = acc[ai][0][m][1];
                f32x4 t0, t1;
                t0[0] = a0[0] * bflo(g.x); t0[1] = a0[1] * bfhi(g.x); t0[2] = a0[2] * bflo(g.y); t0[3] = a0[3] * bfhi(g.y);
                t1[0] = a1[0] * bflo(g.z); t1[1] = a1[1] * bfhi(g.z); t1[2] = a1[2] * bflo(g.w); t1[3] = a1[3] * bfhi(g.w);
                if (n == 0) { acc[ai][1][m][0] = t0; acc[ai][1][m][1] = t1; } else { acc[ai][1][m][0] += t0; acc[ai][1][m][1] += t1; } }
        if (n == 3) { const int row0 = u.pm * BM + wr * 64 + fr, col0 = u.pn * HALF + wc * 32 + 8 * fq;
#pragma unroll
            for (int ai = 0; ai < 2; ++ai)
#pragma unroll
                for (int m = 0; m < 4; ++m) { const f32x4 v0 = acc[ai][1][m][0], v1 = acc[ai][1][m][1];
                    u32x4 w; w.x = pk2(v0[0], v0[1]); w.y = pk2(v0[2], v0[3]); w.z = pk2(v1[0], v1[1]); w.w = pk2(v1[2], v1[3]);
                    *(u32x4*)(GBF + (size_t)(row0 + ai * HALF + m * 16) * 1024 + col0) = w; } }
    }
};
struct BrOrder {
    static constexpr bool GATHER = false;
    int G, c;
    DEV bool next(int i, Unit& u) const { const int x = c & 7, q = (c >> 3) + (i >> 2) * (G >> 3); if (q >= 64 || (G & 7)) { if (!(G & 7)) return false; const int tile = c + (i >> 2) * G; if (tile >= 512) return false; u.pm = tile >> 3; u.pn = tile & 7; }
        else { u.pm = x + 8 * (q >> 3); u.pn = q & 7; }
        u.e = i & 3; u.mt = 0; u.cnt = 256; return true; }
    DEV size_t boff(const Unit& u) const { return (size_t)(u.e * 1024 + u.pn * 128) * 256 * 2; }
    DEV unsigned aoff(const Unit& u) const { return (unsigned)(u.e * 256 * 2); }
    DEV unsigned arow(const Unit& u, int r) const { return (unsigned)(u.pm * BM + r); }
};
struct PlainOrder : StaticOrder {
    static constexpr bool GATHER = false;
    DEV size_t boff(const Unit& u) const { return (size_t)u.pn * 256 * 1024 * 2; }
    DEV unsigned aoff(const Unit&) const { return 0u; }
    DEV unsigned arow(const Unit& u, int r) const { return (unsigned)(u.pm * BM + r); }
};
struct EpiBf16Out {
    struct Pre {};
    DEV const char* gate_base(const Unit&) const { return nullptr; }
    static constexpr bool PERM = true, PAIR16 = true;
    bf16_t* C;
    DEV void operator()(const f32x4 (&acc)[2][2][4][2], const Unit& u, int wr, int wc, int fr, int fq) const {
        const int row0 = u.pm * BM + wr * 64 + fr, col0 = u.pn * BM + 16 * (4 * wc + fq);
#pragma unroll
        for (int ai = 0; ai < 2; ++ai)
#pragma unroll
            for (int m = 0; m < 4; ++m) { bf16_t* rowp = C + (size_t)(row0 + ai * HALF + m * 16) * 1024 + col0;
#pragma unroll
                for (int bj = 0; bj < 2; ++bj) { const f32x4 v0 = acc[ai][bj][m][0], v1 = acc[ai][bj][m][1];
                    u32x4 w; w.x = pk2(v0[0], v0[1]); w.y = pk2(v0[2], v0[3]); w.z = pk2(v1[0], v1[1]); w.w = pk2(v1[2], v1[3]); *(u32x4*)(rowp + bj * 8) = w; } }
    }
};
template <int MODE> struct MoeOrder {
    static constexpr bool GATHER = (MODE == 1);
    const LAS int* tp;
    const int* rowtk;
    int nnt, G, c;
    DEV bool next(int i, Unit& u) const {
        const int x = c & 7, j = c >> 3, W = G >> 3;
        const int t0 = tp[x + 1] - tp[x], t1 = tp[x + 9] - tp[x + 8], t2 = tp[x + 17] - tp[x + 16], t3 = tp[x + 25] - tp[x + 24];
        const int Lx = i * W + j, tgx = Lx / nnt; if (tgx >= t0 + t1 + t2 + t3) return false;
        u.pn = Lx - tgx * nnt;
        int e, mt;
        if (tgx < t0) { e = x; mt = tgx; } else if (tgx < t0 + t1) { e = x + 8; mt = tgx - t0; } else if (tgx < t0 + t1 + t2) { e = x + 16; mt = tgx - t0 - t1; } else { e = x + 24; mt = tgx - t0 - t1 - t2; }
        u.e = e; u.mt = mt; u.pm = tp[e] + mt; const int rem = tp[40 + e] - mt * 256; u.cnt = rem < 256 ? rem : 256; return true;
    }
    DEV size_t boff(const Unit& u) const { return MODE == 1 ? ((size_t)u.e * 2048 + u.pn * 256) * 1024 * 2 : ((size_t)u.e * 1024 + u.pn * 256) * 1024 * 2; }
    DEV unsigned aoff(const Unit&) const { return 0u; }
    DEV unsigned arow(const Unit& u, int r) const {
        if (MODE == 2) return (unsigned)(u.pm * 256 + r);
        return r < u.cnt ? (unsigned)(rowtk[(size_t)u.e * NT + u.mt * 256 + r] >> 2) : 0u;
    }
    DEV const int* idx_ptr(const Unit& u) const { return rowtk + (size_t)u.e * NT + u.mt * 256; }
    DEV unsigned arow_from(const Unit& u, int r, int ix) const { return r < u.cnt ? (unsigned)(ix >> 2) : 0u; }
};
struct EpiMoe1 {
    struct Pre {};
    DEV const char* gate_base(const Unit&) const { return nullptr; }
    static constexpr bool PERM = true, PAIR16 = true;
    bf16_t* ACT; const float* b1;
    DEV void operator()(const f32x4 (&acc)[2][2][4][2], const Unit& u, int wr, int wc, int fr, int fq) const {
        const int row0 = u.pm * BM + wr * 64 + fr, q = 4 * wc + fq, hcol0 = u.pn * BM + 16 * q;
        const float* bp = b1 + (size_t)u.e * 2048 + hcol0;
        f32x4 bv[2][2];
#pragma unroll
        for (int bj = 0; bj < 2; ++bj)
#pragma unroll
            for (int n = 0; n < 2; ++n) bv[bj][n] = *(const f32x4*)(bp + 8 * bj + 4 * n);
#pragma unroll
        for (int ai = 0; ai < 2; ++ai)
#pragma unroll
            for (int m = 0; m < 4; ++m) { bf16_t* rowp = ACT + (size_t)(row0 + ai * HALF + m * 16) * 1024 + (hcol0 >> 1);
                float o[8];
#pragma unroll
                for (int bj = 0; bj < 2; ++bj) { const f32x4 v0 = acc[ai][bj][m][0] + bv[bj][0], v1 = acc[ai][bj][m][1] + bv[bj][1];
#pragma unroll
                    for (int j = 0; j < 4; ++j) { const float hg = j < 2 ? v0[2 * j] : v1[2 * j - 4], hl = j < 2 ? v0[2 * j + 1] : v1[2 * j - 3];
                        const float glu = fminf(hg, 7.f), lin = fminf(fmaxf(hl, -7.f), 7.f); o[4 * bj + j] = glu * sigmoidf_(1.702f * glu) * (lin + 1.f); } }
                u32x4 w; w.x = pk2(o[0], o[1]); w.y = pk2(o[2], o[3]); w.z = pk2(o[4], o[5]); w.w = pk2(o[6], o[7]); *(u32x4*)rowp = w; }
    }
};
struct EpiMoe2 {
    struct Pre {};
    DEV const char* gate_base(const Unit&) const { return nullptr; }
    static constexpr bool PERM = true, PAIR16 = true;
    bf16_t* Y; const float* b2; const int* rowtk;
    DEV void operator()(const f32x4 (&acc)[2][2][4][2], const Unit& u, int wr, int wc, int fr, int fq) const {
        const int col0 = u.pn * BM + 16 * (4 * wc + fq);
        const float* bp = b2 + (size_t)u.e * 1024 + col0;
        f32x4 bv[2][2];
#pragma unroll
        for (int bj = 0; bj < 2; ++bj)
#pragma unroll
            for (int n = 0; n < 2; ++n) bv[bj][n] = *(const f32x4*)(bp + bj * 8 + 4 * n);
#pragma unroll
        for (int ai = 0; ai < 2; ++ai)
#pragma unroll
            for (int m = 0; m < 4; ++m) { const int r = ai * HALF + wr * 64 + m * 16 + fr;
                if (r < u.cnt) { const int dst = rowtk[(size_t)u.e * NT + u.mt * 256 + r]; bf16_t* rowp = Y + (size_t)dst * 1024 + col0;
#pragma unroll
                    for (int bj = 0; bj < 2; ++bj) { const f32x4 v0 = acc[ai][bj][m][0] + bv[bj][0], v1 = acc[ai][bj][m][1] + bv[bj][1];
                        u32x4 w; w.x = pk2(v0[0], v0[1]); w.y = pk2(v0[2], v0[3]); w.z = pk2(v1[0], v1[1]); w.w = pk2(v1[2], v1[3]); *(u32x4*)(rowp + bj * 8) = w; } } }
    }
};
}

struct Frame {
    LAS unsigned char* lds;
    volatile LAS unsigned* MISC;
    unsigned* ctl;
    unsigned char* ws;
    int tid, lane, wave, G, bid;
};
template <class T> DEV T* wsp(const Frame& F, size_t off) { return (T*)(F.ws + off); }
DEV void frame_refresh(Frame& F) {
    int t_ = threadIdx.x; asm volatile("" : "+v"(t_)); F.tid = t_; F.lane = t_ & 63; F.wave = __builtin_amdgcn_readfirstlane(t_ >> 6);
    unsigned long long w_ = (unsigned long long)F.ws; asm volatile("" : "+s"(w_)); F.ws = (unsigned char*)(GAS unsigned char*)w_; F.ctl = (unsigned*)F.ws;
}

struct IdMap { DEV int operator()(int i) const { return i; } };
struct HpColMap { DEV int operator()(int c) const { return hp_src_col(c); } };
struct CmpRowMap { DEV int operator()(int k) const { return (k & ~63) + perm16(k & 63); } };
template <class RM, class CM>
DEV void transpose_item(const float* W, int ldw, bf16_t* WT, int ldt, int k0, int n0, LAS float* scr, int lane, RM rm, CM cm) {
    const int nn = lane & 31; const int sc = cm(n0 + nn);
#pragma unroll 8
    for (int i = 0; i < 32; ++i) { const int kk = 2 * i + (lane >> 5); scr[kk * 33 + nn] = sc >= 0 ? W[(size_t)rm(k0 + kk) * ldw + sc] : 0.f; }
    LDS_WAIT(); asm volatile("" ::: "memory");
    const int c = lane & 7;
#pragma unroll
    for (int j = 0; j < 4; ++j) { const int n = (lane >> 3) + 8 * j; const LAS float* s = scr + (8 * c) * 33 + n;
        u32x4 o; o.x = pk2(s[0 * 33], s[1 * 33]); o.y = pk2(s[2 * 33], s[3 * 33]); o.z = pk2(s[4 * 33], s[5 * 33]); o.w = pk2(s[6 * 33], s[7 * 33]);
        *(u32x4*)(WT + (size_t)(n0 + n) * ldt + k0 + 8 * c) = o; }
    LDS_WAIT(); asm volatile("" ::: "memory");
}
struct TItem { const float* W; bf16_t* WT; int ldw, ldt, k0, n0, rmap; };
DEV void titem_load(const TItem& it, f32x4 (&v)[16], int lane) {
    const int nq = lane & 15, kr = lane >> 4;
    if (it.rmap == 2) { const int n = it.n0 + 4 * nq; const int c0 = hp_src_col(n), c1 = hp_src_col(n + 1), c2 = hp_src_col(n + 2), c3 = hp_src_col(n + 3);
        const bool quad = (c0 >= 0) && (c1 == c0 + 1) && (c2 == c0 + 2) && (c3 == c0 + 3);
#pragma unroll
        for (int i = 0; i < 16; ++i) { const float* rp = it.W + (size_t)(it.k0 + 4 * i + kr) * it.ldw;
            if (quad) v[i] = __builtin_nontemporal_load((const f32x4*)(rp + c0));
            else v[i] = (f32x4){c0 >= 0 ? rp[c0] : 0.f, c1 >= 0 ? rp[c1] : 0.f, c2 >= 0 ? rp[c2] : 0.f, c3 >= 0 ? rp[c3] : 0.f}; }
        return; }
#pragma unroll
    for (int i = 0; i < 16; ++i) { int k = it.k0 + 4 * i + kr; if (it.rmap) k = (k & ~63) + perm16(k & 63); v[i] = __builtin_nontemporal_load((const f32x4*)(it.W + (size_t)k * it.ldw + it.n0 + 4 * nq)); }
}
DEV void titem_store(const TItem& it, const f32x4 (&v)[16], LAS bf16_t* scr, int lane) {
    const int nq = lane & 15, kr = lane >> 4; constexpr int SP = 66;
#pragma unroll
    for (int i = 0; i < 16; ++i) { LAS unsigned* d = (LAS unsigned*)(scr + (4 * i + kr) * SP + 4 * nq); d[0] = pk2(v[i][0], v[i][1]); d[1] = pk2(v[i][2], v[i][3]); }
    LDS_WAIT(); asm volatile("" ::: "memory");
    const int c = lane & 7;
#pragma unroll
    for (int j = 0; j < 8; ++j) { const int n = (lane >> 3) + 8 * j; const LAS bf16_t* sp = scr + (8 * c) * SP + n;
        u32x4 o; o.x = sp[0] | ((unsigned)sp[SP] << 16); o.y = sp[2 * SP] | ((unsigned)sp[3 * SP] << 16); o.z = sp[4 * SP] | ((unsigned)sp[5 * SP] << 16); o.w = sp[6 * SP] | ((unsigned)sp[7 * SP] << 16);
        __builtin_nontemporal_store(o, (u32x4*)(it.WT + (size_t)(it.n0 + n) * it.ldt + it.k0 + 8 * c)); }
    LDS_WAIT(); asm volatile("" ::: "memory");
}
constexpr long BG_PER_LAYER = 32L * 512 + 32L * 256, BG_TOTAL = NL * BG_PER_LAYER;
DEV void bg_item(const Frame& F, const Params& P, long idx, LAS bf16_t* scr, int lane) {
    const int l = (int)(idx / BG_PER_LAYER); long r = idx - (long)l * BG_PER_LAYER; TItem it;
    if (r < 32L * 512) { const int mat = l * 32 + (int)(r >> 9), q = (int)(r & 511); it = TItem{P.in[I_WE1] + (size_t)mat * 1024 * 2048, wsp<bf16_t>(F, WS_W1) + (size_t)mat * 2048 * 1024, 2048, 1024, (q >> 5) * 64, (q & 31) * 64, 0}; }
    else { r -= 32L * 512; const int mat = l * 32 + (int)(r >> 8), q = (int)(r & 255); it = TItem{P.in[I_WE2] + (size_t)mat * 1024 * 1024, wsp<bf16_t>(F, WS_W2) + (size_t)mat * 1024 * 1024, 1024, 1024, (q >> 4) * 64, (q & 15) * 64, 0}; }
    f32x4 v[16]; titem_load(it, v, lane); titem_store(it, v, scr, lane);
}
constexpr int BG_CHUNK = 8, BG_FILL_STRIDE = 4;
DEV void bg_fill(Frame F, const Params& P, unsigned* done, long limit) {
    frame_refresh(F);
    unsigned* head = F.ctl + CW_BGQ; LAS bf16_t* scr = (LAS bf16_t*)(F.lds + F.wave * 16384); const int lane = F.lane;
    if (done && (F.wave % BG_FILL_STRIDE) != 0) return;
#pragma unroll 1
    for (;;) {
        if (done) { if ((unsigned)__builtin_amdgcn_readfirstlane(__hip_atomic_load(done, __ATOMIC_RELAXED, __HIP_MEMORY_SCOPE_AGENT)) >= (unsigned)F.G) break; }
        else { if ((long)(unsigned)__builtin_amdgcn_readfirstlane(__hip_atomic_load(head, __ATOMIC_RELAXED, __HIP_MEMORY_SCOPE_AGENT)) >= limit) break; }
        unsigned base = 0u; if (lane == 0) base = atomicAdd(head, (unsigned)BG_CHUNK);
        base = (unsigned)__builtin_amdgcn_readfirstlane(base);
        if ((long)base >= BG_TOTAL) break;
#pragma unroll 1
        for (int i = 0; i < BG_CHUNK; ++i) if ((long)base + i < BG_TOTAL) bg_item(F, P, (long)base + i, scr, lane);
    }
}
DEV void p0_prologue(Frame F, const Params& P) {
    frame_refresh(F);
    LAS float* scr = (LAS float*)(F.lds + F.wave * 16384);
    const int gw = F.bid * NWAVES + F.wave, NGW = F.G * NWAVES, lane = F.lane;
    LAS bf16_t* scrh = (LAS bf16_t*)scr;
    constexpr long I_E1 = 0, I_E2 = 0, I_BRI = (long)NL * 4 * 64, I_OI = (long)NL * 256, I_C1 = (long)NL * 2 * 32;
    constexpr long I_IN64 = (long)NL * 16 * 104;
    constexpr long N64 = I_E1 + I_E2 + I_BRI + I_OI + I_C1 + I_IN64;
#define P0_DECODE(it, r_) do { long r = (r_); \
        if (r < I_E1) { const int mat = (int)(r >> 9), q = (int)(r & 511); it = TItem{P.in[I_WE1] + (size_t)mat * 1024 * 2048, wsp<bf16_t>(F, WS_W1) + (size_t)mat * 2048 * 1024, 2048, 1024, (q >> 5) * 64, (q & 31) * 64, 0}; break; } \
        r -= I_E1; \
        if (r < I_E2) { const int mat = (int)(r >> 8), q = (int)(r & 255); it = TItem{P.in[I_WE2] + (size_t)mat * 1024 * 1024, wsp<bf16_t>(F, WS_W2) + (size_t)mat * 1024 * 1024, 1024, 1024, (q >> 4) * 64, (q & 15) * 64, 0}; break; } \
        r -= I_E2; \
        if (r < I_BRI) { const int mat = (int)(r >> 6), q = (int)(r & 63); it = TItem{P.in[I_WBR] + (size_t)mat * 256 * 1024, wsp<bf16_t>(F, WS_WBR) + (size_t)mat * 1024 * 256, 1024, 256, (q >> 4) * 64, (q & 15) * 64, 0}; break; } \
        r -= I_BRI; \
        if (r < I_OI) { const int l_ = (int)(r >> 8), q = (int)(r & 255); it = TItem{P.in[I_WO] + (size_t)l_ * 1024 * 1024, wsp<bf16_t>(F, WS_WO) + (size_t)l_ * 1024 * 1024, 1024, 1024, (q >> 4) * 64, (q & 15) * 64, 0}; break; } \
        r -= I_OI; \
        if (r < I_C1) { const int mat = (int)(r >> 5), l_ = mat >> 1, kv = mat & 1; it = TItem{P.in[kv ? I_W1V : I_W1K] + (size_t)l_ * 2048 * 64, wsp<bf16_t>(F, WS_WC1) + (size_t)mat * 64 * 2048, 64, 2048, (int)(r & 31) * 64, 0, kv == 0 ? 1 : 0}; break; } \
        r -= I_C1; \
        { const int l_ = (int)(r / (16 * 104)), q = (int)(r % (16 * 104)); it = TItem{P.in[I_WIN] + (size_t)l_ * 1024 * NIN, wsp<bf16_t>(F, WS_WIN) + (size_t)l_ * NP * 1024, NIN, 1024, (q / 104) * 64, (q % 104) * 64, 2}; } } while (0)
    { f32x4 va[16], vb[16]; TItem ia, ib; long it = gw;
        if (it < N64) { P0_DECODE(ia, it); titem_load(ia, va, lane); }
#pragma unroll 1
        for (; it < N64; it += 2 * (long)NGW) {
            const long i2 = it + NGW, i3 = it + 2 * (long)NGW;
            if (i2 < N64) { P0_DECODE(ib, i2); titem_load(ib, vb, lane); }
            titem_store(ia, va, scrh, lane);
            if (i3 < N64) { P0_DECODE(ia, i3); titem_load(ia, va, lane); }
            if (i2 < N64) titem_store(ib, vb, scrh, lane);
        } }
#undef P0_DECODE
    constexpr long I_C2 = (long)NL * 2 * 2;
    for (long it = gw; it < I_C2; it += NGW) { const long r = it;
        { const int mat = (int)(r >> 1), l = mat >> 1, kv = mat & 1, nb = (int)(r & 1);
            transpose_item(P.in[kv ? I_W2V : I_W2K] + (size_t)l * 64 * 64, 64, wsp<bf16_t>(F, WS_WC2) + (size_t)mat * 64 * 64, 64, 0, nb * 32, scr, lane, IdMap(), IdMap()); }
    }
    const int gt = F.bid * NTHR + F.tid, NGT = F.G * NTHR;
    {
        const float* ws_ = P.in[I_GWS]; bf16_t* wg = wsp<bf16_t>(F, WS_WG);
        for (int i = gt; i < NL * 4 * 128 * 128; i += NGT) { const int s = i & 127, t = (i >> 7) & 127; wg[i] = (s <= t) ? f2bf(ws_[i]) : (bf16_t)0; }
    }
    {
        float* bp = wsp<float>(F, WS_BIN);
        for (int i = gt; i < NL * NP; i += NGT) { const int l = i / NP, c = i % NP, sc = hp_src_col(c); bp[i] = sc >= 0 ? P.in[I_BIN][(size_t)l * NIN + sc] : 0.f; }
    }
    {
        float* cs = wsp<float>(F, WS_CS); const int* pos = (const int*)P.in[I_POS];
        for (int i = gt; i < NT * 8; i += NGT) { const int t = i >> 3, f = i & 7;
            const double ang = (double)pos[t] * P.invf[f];
            const double twopi = 6.283185307179586476925286766559; double r = ang - twopi * rint(ang / twopi);
            const double r2 = r * r; double sn = 0.0, cn = 0.0, term = r;
#pragma unroll 1
            for (int k = 1; k <= 29; k += 2) { sn += term; term *= -r2 / (double)((k + 1) * (k + 2)); }
            term = 1.0;
#pragma unroll 1
            for (int k = 0; k <= 28; k += 2) { cn += term; term *= -r2 / (double)((k + 1) * (k + 2)); }
            cs[(size_t)t * 16 + f] = (float)cn; cs[(size_t)t * 16 + 8 + f] = (float)sn; }
    }
    {
        const f32x4* x4 = (const f32x4*)P.in[I_X]; u32x2* xb = wsp<u32x2>(F, WS_XB);
        for (int i = gt; i < NT * 256; i += NGT) { const f32x4 v = x4[i]; u32x2 w; w.x = pk2(v[0], v[1]); w.y = pk2(v[2], v[3]); xb[i] = w; }
    }
    for (int task = gw; task < NL * 2 * 32; task += NGW) { const int lk = task >> 5, part = task & 31, l = lk >> 1, kv = lk & 1;
        const float* pe = P.in[kv ? I_PEV : I_PEK] + (size_t)l * 2048 + part * 64; const float* w1 = P.in[kv ? I_W1V : I_W1K] + ((size_t)l * 2048 + part * 64) * 64;
        float a = 0.f;
#pragma unroll 16
        for (int k = 0; k < 64; ++k) a += pe[k] * w1[(size_t)k * 64 + lane];
        wsp<float>(F, WS_CB)[task * 64 + lane] = a; }
}

DEV void pb_transpose_unit(Frame F, int unit) {
    frame_refresh(F);
    const int b = unit >> 6, t0 = (unit & 63) * 64; const int tid = F.tid;
    const bf16_t* H = wsp<bf16_t>(F, WS_H); const float* cs = wsp<float>(F, WS_CS);
    const size_t rowb = (size_t)b * SEQ + t0;
    LAS bf16_t* tile = (LAS bf16_t*)F.lds; constexpr int TP = 392;
    LAS unsigned* nmx = (LAS unsigned*)(F.lds + 65536);
    u32x4 rw[2]; f32x4 rc[2], rs[2]; u32x4 vw[6], kw[4];
#pragma unroll
    for (int it = 0; it < 2; ++it) { const int task = tid + it * NTHR, tok = task >> 4, hd = (task >> 3) & 1, ch = task & 7; const size_t row = rowb + tok;
        rw[it] = *(const u32x4*)(H + row * NP + (hd ? HP_KW : HP_KS) + ch * 8);
        const float* c = cs + row * 16 + 4 * (ch & 1); rc[it] = *(const f32x4*)c; rs[it] = *(const f32x4*)(c + 8); }
#pragma unroll
    for (int it = 0; it < 6; ++it) { const int task = tid + it * NTHR, tok = task / 48, ch = task % 48;
        const int scol = ch < 8 ? HP_VS + ch * 8 : (ch < 16 ? HP_VW + (ch - 8) * 8 : HP_FV + (ch - 16) * 8);
        vw[it] = *(const u32x4*)(H + (rowb + tok) * NP + scol); }
    { const int tok = tid >> 3, part = tid & 7;
#pragma unroll
        for (int q = 0; q < 4; ++q) kw[q] = *(const u32x4*)(H + (rowb + tok) * NP + HP_FK + part * 32 + q * 8); }
    if (tid < 4) nmx[tid] = 0u;
#pragma unroll
    for (int it = 0; it < 2; ++it) { const int task = tid + it * NTHR, tok = task >> 4, hd = (task >> 3) & 1, ch = task & 7; const size_t row = rowb + tok;
        u32x4 w = rw[it]; unsigned* wp = (unsigned*)&w;
#pragma unroll
        for (int j = 0; j < 4; ++j) { const float t1 = bflo(wp[j]), t2 = bfhi(wp[j]); const unsigned rot = pk2(t1 * rc[it][j] - t2 * rs[it][j], t2 * rc[it][j] + t1 * rs[it][j]); wp[j] = (ch < 2) ? rot : wp[j]; }
        *(u32x4*)(wsp<bf16_t>(F, WS_KNSA) + row * 128 + hd * 64 + ch * 8) = w; }
#pragma unroll
    for (int it = 0; it < 6; ++it) { const int task = tid + it * NTHR, tok = task / 48, ch = task % 48; const u32x4 w = vw[it];
        *(LAS u32x2*)(tile + tok * TP + ch * 8) = (u32x2){w.x, w.y}; *(LAS u32x2*)(tile + tok * TP + ch * 8 + 4) = (u32x2){w.z, w.w}; }
    __syncthreads();
    { const int part = tid & 7; float ss = 0.f;
#pragma unroll
        for (int q = 0; q < 4; ++q) { const unsigned* wp = (const unsigned*)&kw[q];
#pragma unroll
            for (int j = 0; j < 4; ++j) { const float a = bflo(wp[j]), c = bfhi(wp[j]); ss += a * a + c * c; } }
        ss += __shfl_xor(ss, 1);
        if ((part & 1) == 0) (void)__hip_atomic_fetch_max(nmx + (part >> 1), __float_as_uint(ss), __ATOMIC_RELAXED, __HIP_MEMORY_SCOPE_WORKGROUP); }
    bf16_t* VT = wsp<bf16_t>(F, WS_VT);
#pragma unroll
    for (int it = 0; it < 6; ++it) { const int task = tid + it * NTHR, d = task % 384, sc = task / 384;
        unsigned short v[8];
#pragma unroll
        for (int j = 0; j < 8; ++j) v[j] = tile[(sc * 8 + j) * TP + d];
        u32x4 w; w.x = v[0] | ((unsigned)v[1] << 16); w.y = v[2] | ((unsigned)v[3] << 16); w.z = v[4] | ((unsigned)v[5] << 16); w.w = v[6] | ((unsigned)v[7] << 16);
        *(u32x4*)(VT + ((size_t)b * 384 + d) * SEQ + t0 + sc * 8) = w; }
    __syncthreads();
    if (tid < 4) wsp<float>(F, WS_KN)[((size_t)b * 4 + tid) * 64 + (t0 >> 6)] = sqrtf(__uint_as_float(nmx[tid])) * 1.0001f;
    __syncthreads();
}
DEV void pb_cum_unit(Frame F, int unit) {
    frame_refresh(F);
    const int b = unit >> 2, h = unit & 3, tid = F.tid;
    const float* side = wsp<float>(F, WS_SIDE);
    LAS double* sc = (LAS double*)F.lds;
    double loc[8]; double s = 0.0;
#pragma unroll
    for (int j = 0; j < 8; ++j) { const float x = side[((size_t)b * SEQ + tid * 8 + j) * 16 + 12 + h];
        const float ls = fminf(x, 0.f) - __logf(1.f + __expf(-fabsf(x)));
        s += (double)ls; loc[j] = s; }
    double inc = s;
#pragma unroll
    for (int o = 1; o < 64; o <<= 1) { const double t = __shfl_up(inc, o); if (F.lane >= o) inc += t; }
    if (F.lane == 63) sc[F.wave] = inc;
    __syncthreads();
    double wbase = 0.0;
#pragma unroll
    for (int w = 0; w < 8; ++w) wbase += (w < F.wave) ? sc[w] : 0.0;
    __syncthreads();
    sc[8 + tid] = wbase + inc - s;
    const double base = sc[8 + tid]; float* cum = wsp<float>(F, WS_CUM) + ((size_t)b * 4 + h) * SEQ + tid * 8;
#pragma unroll
    for (int j = 0; j < 8; ++j) cum[j] = (float)((base + loc[j]) * 1.4426950408889634);
    __syncthreads();
}
DEV void pb_conv_unit(Frame F, const Params& P, int l, int unit) {
    frame_refresh(F);
    const int b = unit >> 6, t0 = (unit & 63) * 64, tid = F.tid, lane = F.lane, wave = F.wave;
    const bf16_t* H = wsp<bf16_t>(F, WS_H);
    float w[31]; { const float* cw = P.in[I_CW] + (size_t)l * 31 * 256 + (tid & 255);
#pragma unroll
        for (int j = 0; j < 31; ++j) w[j] = cw[j * 256]; }
    const float bias = P.in[I_CB][l * 256 + (tid & 255)];
    LAS bf16_t* xg = (LAS bf16_t*)F.lds;
    LAS float* cv = (LAS float*)(F.lds + 49152);
    { u32x4 wv[12];
#pragma unroll
        for (int it = 0; it < 12; ++it) { const int task = tid + it * NTHR, r = task >> 6, c4 = (task & 63) * 4; const int t = t0 - 30 + r;
            wv[it] = (task < 94 * 64 && t >= 0) ? *(const u32x4*)(H + ((size_t)b * SEQ + t) * NP + HP_CAB + 2 * c4) : (u32x4){0u, 0u, 0u, 0u}; }
#pragma unroll
        for (int it = 0; it < 12; ++it) { const int task = tid + it * NTHR, r = task >> 6, c4 = (task & 63) * 4;
            if (task < 94 * 64) { const unsigned* wp = (const unsigned*)&wv[it]; float g[4];
#pragma unroll
                for (int j = 0; j < 4; ++j) g[j] = bflo(wp[j]) * sigmoidf_(bfhi(wp[j]));
                *(LAS u32x2*)(xg + r * 256 + c4) = (u32x2){pk2(g[0], g[1]), pk2(g[2], g[3])}; } } }
    __syncthreads();
    { const int c = tid & 255, half = tid >> 8;
        float xw[62];
#pragma unroll
        for (int j = 0; j < 62; ++j) xw[j] = bf2f(xg[(half * 32 + j) * 256 + c]);
#pragma unroll
        for (int tt = 0; tt < 32; ++tt) { float a = bias;
#pragma unroll
            for (int j = 0; j < 31; ++j) a += w[j] * xw[tt + j];
            cv[(half * 32 + tt) * 256 + c] = a; } }
    __syncthreads();
    { const f32x4 gg = *(const f32x4*)(P.in[I_CLNG] + l * 256 + lane * 4), bb = *(const f32x4*)(P.in[I_CLNB] + l * 256 + lane * 4);
        bf16_t* BR = wsp<bf16_t>(F, WS_BR);
#pragma unroll 1
        for (int i = 0; i < 8; ++i) { const int tt = wave * 8 + i; f32x4 v = *(const LAS f32x4*)(cv + tt * 256 + lane * 4);
            const float mean = wave_sum((v[0] + v[1]) + (v[2] + v[3])) * (1.f / 256.f); v = v - mean;
            const float var = wave_sum((v[0] * v[0] + v[1] * v[1]) + (v[2] * v[2] + v[3] * v[3])) * (1.f / 256.f);
            const float rstd = 1.f / sqrtf(var + LN_EPS); v = v * rstd * gg + bb;
#pragma unroll
            for (int j = 0; j < 4; ++j) v[j] = v[j] * sigmoidf_(v[j]);
            u32x2 o; o.x = pk2(v[0], v[1]); o.y = pk2(v[2], v[3]);
            *(u32x2*)(BR + ((size_t)b * SEQ + t0 + tt) * 1024 + 768 + lane * 4) = o; } }
    __syncthreads();
}
DEV void pb_gmlp_unit(Frame F, const Params& P, int l, int unit) {
    frame_refresh(F);
    const int t0 = unit * 128, tid = F.tid, lane = F.lane, wave = F.wave, fr = lane & 15, fq = lane >> 4;
    const bf16_t* H = wsp<bf16_t>(F, WS_H);
    LAS bf16_t* vt = (LAS bf16_t*)F.lds; constexpr int VP = 136;
    { const f32x4 gg = *(const f32x4*)(P.in[I_GLNG] + l * 256 + lane * 4), bb = *(const f32x4*)(P.in[I_GLNB] + l * 256 + lane * 4);
        u32x2 wv[16];
#pragma unroll
        for (int i = 0; i < 16; ++i) wv[i] = *(const u32x2*)(H + (size_t)(t0 + wave * 16 + i) * NP + HP_GV + lane * 4);
#pragma unroll
        for (int i = 0; i < 16; ++i) { const int s = wave * 16 + i; const u32x2 w = wv[i];
            f32x4 v = {gelu_tanh(bflo(w.x)), gelu_tanh(bfhi(w.x)), gelu_tanh(bflo(w.y)), gelu_tanh(bfhi(w.y))};
            const float mean = wave_sum((v[0] + v[1]) + (v[2] + v[3])) * (1.f / 256.f); v = v - mean;
            const float var = wave_sum((v[0] * v[0] + v[1] * v[1]) + (v[2] * v[2] + v[3] * v[3])) * (1.f / 256.f);
            const float rstd = 1.f / sqrtf(var + LN_EPS); v = v * rstd * gg + bb;
#pragma unroll
            for (int j = 0; j < 4; ++j) vt[(lane * 4 + j) * VP + s] = f2bf(v[j]); } }
    __syncthreads();
    { const int g = wave & 3, th = wave >> 2;
        const bf16_t* Wg = wsp<bf16_t>(F, WS_WG) + ((size_t)l * 4 + g) * 128 * 128;
        bf16_t* BR = wsp<bf16_t>(F, WS_BR);
        bf16x8 wf[4][4]; u32x2 uw[4][4]; float bs[4];
#pragma unroll
        for (int tb = 0; tb < 4; ++tb) { const int trow = th * 64 + tb * 16;
#pragma unroll
            for (int ks = 0; ks < 4; ++ks) wf[tb][ks] = (ks * 32 <= trow + 15) ? *(const bf16x8*)(Wg + (size_t)(trow + fr) * 128 + ks * 32 + fq * 8) : (bf16x8){0, 0, 0, 0, 0, 0, 0, 0};
#pragma unroll
            for (int db = 0; db < 4; ++db) uw[tb][db] = *(const u32x2*)(H + (size_t)(t0 + trow + fr) * NP + HP_GU + g * 64 + db * 16 + fq * 4);
            bs[tb] = P.in[I_GBS][((size_t)l * 4 + g) * 128 + trow + fr]; }
#pragma unroll
        for (int tb = 0; tb < 4; ++tb) { const int trow = th * 64 + tb * 16;
            f32x4 acc[4];
#pragma unroll
            for (int db = 0; db < 4; ++db) acc[db] = (f32x4){0.f, 0.f, 0.f, 0.f};
#pragma unroll
            for (int ks = 0; ks < 4; ++ks) if (ks * 32 <= trow + 15) {
#pragma unroll
                for (int db = 0; db < 4; ++db) { const bf16x8 vf = *(const LAS bf16x8*)(vt + (g * 64 + db * 16 + fr) * VP + ks * 32 + fq * 8);
                    acc[db] = mfma16(vf, wf[tb][ks], acc[db]); } }
            const int t = t0 + trow + fr;
#pragma unroll
            for (int db = 0; db < 4; ++db) { const int c = g * 64 + db * 16 + fq * 4; const u32x2 u2 = uw[tb][db]; const float b_ = bs[tb];
                const float o0 = gelu_tanh(bflo(u2.x)) * (acc[db][0] + b_), o1 = gelu_tanh(bfhi(u2.x)) * (acc[db][1] + b_), o2 = gelu_tanh(bflo(u2.y)) * (acc[db][2] + b_), o3 = gelu_tanh(bfhi(u2.y)) * (acc[db][3] + b_);
                u32x2 o; o.x = pk2(o0, o1); o.y = pk2(o2, o3); *(u32x2*)(BR + (size_t)t * 1024 + 512 + c) = o; } } }
    __syncthreads();
}
DEV void pb_compress_unit(Frame F, int l, int unit) {
    frame_refresh(F);
    const int kv = unit & 1, mb = (unit >> 1) & 15, b = unit >> 5; const int tid = F.tid, lane = F.lane, wave = F.wave, fr = lane & 15, fq = lane >> 4;
    const bf16_t* H = wsp<bf16_t>(F, WS_H); const float* cs = wsp<float>(F, WS_CS);
    const bf16_t* W1 = wsp<bf16_t>(F, WS_WC1) + ((size_t)l * 2 + kv) * 64 * 2048; const bf16_t* W2 = wsp<bf16_t>(F, WS_WC2) + ((size_t)l * 2 + kv) * 64 * 64;
    const f32x4 cbv = *(const f32x4*)(wsp<float>(F, WS_CB) + ((size_t)l * 2 + kv) * 32 * 64 + tid * 4);
    LAS float* red = (LAS float*)F.lds;
    LAS bf16_t* h1 = (LAS bf16_t*)(F.lds + 32768);
    f32x4 acc[4];
#pragma unroll
    for (int nb = 0; nb < 4; ++nb) acc[nb] = (f32x4){0.f, 0.f, 0.f, 0.f};
    const int c = mb * 16 + fr;
    { u32x4 aw[8]; f32x4 cco[4], csi[4];
#pragma unroll
        for (int ks_ = 0; ks_ < 8; ++ks_) { const int ks = wave * 8 + ks_; const int j = ks >> 1, dch = (ks & 1) * 32 + fq * 8; int tok = c * 16 + j; tok = tok > SEQ - 1 ? SEQ - 1 : tok;
            const size_t row = (size_t)b * SEQ + tok;
            aw[ks_] = *(const u32x4*)(H + row * NP + (kv ? HP_VC : HP_KC) + dch);
            if ((ks_ & 1) == 0) { const float* cc = cs + row * 16 + ((fq & 1) * 4); cco[ks_ >> 1] = *(const f32x4*)cc; csi[ks_ >> 1] = *(const f32x4*)(cc + 8); } }
#pragma unroll
        for (int hb = 0; hb < 2; ++hb) { bf16x8 bw[4][4];
#pragma unroll
            for (int k4 = 0; k4 < 4; ++k4)
#pragma unroll
                for (int nb = 0; nb < 4; ++nb) bw[k4][nb] = *(const bf16x8*)(W1 + (size_t)(nb * 16 + fr) * 2048 + (wave * 8 + hb * 4 + k4) * 32 + fq * 8);
#pragma unroll
            for (int k4 = 0; k4 < 4; ++k4) { const int ks_ = hb * 4 + k4; u32x4 w = aw[ks_];
                if ((ks_ & 1) == 0) { const bool rp = (kv == 0) && (fq < 2); unsigned* wp = (unsigned*)&w; const f32x4 co = cco[ks_ >> 1], si = csi[ks_ >> 1];
#pragma unroll
                    for (int q = 0; q < 4; ++q) { const float t1 = bflo(wp[q]), t2 = bfhi(wp[q]); const unsigned rot = pk2(t1 * co[q] - t2 * si[q], t2 * co[q] + t1 * si[q]); wp[q] = rp ? rot : wp[q]; } }
                const bf16x8 af = __builtin_bit_cast(bf16x8, w);
#pragma unroll
                for (int nb = 0; nb < 4; ++nb) acc[nb] = mfma16(af, bw[k4][nb], acc[nb]); } } }
#pragma unroll
    for (int nb = 0; nb < 4; ++nb)
#pragma unroll
        for (int i = 0; i < 4; ++i) red[(wave * 16 + fq * 4 + i) * 64 + nb * 16 + fr] = acc[nb][i];
    __syncthreads();
    { LAS float* cbl = (LAS float*)(F.lds + 36864);
        *(LAS f32x4*)(cbl + tid * 4) = cbv;
        __syncthreads();
#pragma unroll
        for (int it = 0; it < 2; ++it) { const int e = tid + it * NTHR, r = e >> 6, n = e & 63; float s = 0.f;
#pragma unroll
            for (int pp = 0; pp < 32; ++pp) s += cbl[pp * 64 + n];
#pragma unroll
            for (int w = 0; w < 8; ++w) s += red[(w * 16 + r) * 64 + n];
            h1[r * 72 + n] = f2bf(gelu_tanh(s)); } }
    __syncthreads();
    if (wave == 0) {
#pragma unroll
        for (int nb = 0; nb < 4; ++nb) { f32x4 o = (f32x4){0.f, 0.f, 0.f, 0.f};
#pragma unroll
            for (int ks = 0; ks < 2; ++ks) { const bf16x8 hf = *(const LAS bf16x8*)(h1 + fr * 72 + ks * 32 + fq * 8); const bf16x8 wf = *(const bf16x8*)(W2 + (size_t)(nb * 16 + fr) * 64 + ks * 32 + fq * 8);
                o = kv ? mfma16(hf, wf, o) : mfma16(wf, hf, o); }
            u32x2 w; w.x = pk2(o[0], o[1]); w.y = pk2(o[2], o[3]);
            if (kv == 0) *(u32x2*)(wsp<bf16_t>(F, WS_KCMP) + ((size_t)b * 256 + mb * 16 + fr) * 64 + nb * 16 + fq * 4) = w;
            else *(u32x2*)(wsp<bf16_t>(F, WS_VCMPT) + ((size_t)b * 64 + nb * 16 + fr) * 256 + mb * 16 + fq * 4) = w; } }
    __syncthreads();
}

constexpr int TILE_B = 9216, AT_KT = 0, AT_VT = 36864, AT_CK = 73728, AT_KC = 0, AT_VC = 36864, AT_XCH = 0, AT_TAB = 32768, AT_FXT = 74752, AT_XST = 77824;
constexpr int KTP = 72, VCP = 264, TABP = 65;
constexpr float QSCALE = 0.125f * LOG2E;
struct FlashSt { float m, l; f32x4 o[4]; };
DEV void flash_init(FlashSt& s) { s.m = -1e30f; s.l = 0.f;
#pragma unroll
    for (int d = 0; d < 4; ++d) s.o[d] = (f32x4){0.f, 0.f, 0.f, 0.f}; }
DEV bf16x8 pack_p(const f32x4& a, const f32x4& b) { u32x4 w; w.x = pk2(a[0], a[1]); w.y = pk2(a[2], a[3]); w.z = pk2(b[0], b[1]); w.w = pk2(b[2], b[3]); return __builtin_bit_cast(bf16x8, w); }
DEV bf16x8 vfrag(const LAS bf16_t* p) { const bf16x4 lo = *(const LAS bf16x4*)p, hi = *(const LAS bf16x4*)(p + 16); return __builtin_shufflevector(lo, hi, 0, 1, 2, 3, 4, 5, 6, 7); }
struct KVFrags { bf16x8 k[4][2]; bf16x8 v[4][2]; };
DEV void load_frags(KVFrags& f, const LAS bf16_t* kt, const LAS bf16_t* vt, int fr, int fq) {
#pragma unroll
    for (int kb = 0; kb < 4; ++kb) { const LAS bf16_t* kp = kt + (16 * kb + fr) * KTP + 8 * fq; f.k[kb][0] = *(const LAS bf16x8*)kp; f.k[kb][1] = *(const LAS bf16x8*)(kp + 32); }
#pragma unroll
    for (int d = 0; d < 4; ++d)
#pragma unroll
        for (int c = 0; c < 2; ++c) f.v[d][c] = vfrag(vt + (16 * d + fr) * KTP + 32 * c + 4 * fq);
}
DEV void qk_frags(f32x4 (&s)[4], const KVFrags& f, const bf16x8 (&qf)[2]) {
#pragma unroll
    for (int kb = 0; kb < 4; ++kb) { f32x4 a = mfma16(f.k[kb][0], qf[0], (f32x4){0.f, 0.f, 0.f, 0.f}); s[kb] = mfma16(f.k[kb][1], qf[1], a); }
}
DEV void flash_update(FlashSt& st, f32x4 (&s)[4], const KVFrags& f, bool on) {
    float mx = fmaxf(fmaxf(fmaxf(s[0][0], s[0][1]), fmaxf(s[0][2], s[0][3])), fmaxf(fmaxf(s[1][0], s[1][1]), fmaxf(s[1][2], s[1][3])));
    mx = fmaxf(mx, fmaxf(fmaxf(fmaxf(s[2][0], s[2][1]), fmaxf(s[2][2], s[2][3])), fmaxf(fmaxf(s[3][0], s[3][1]), fmaxf(s[3][2], s[3][3]))));
    mx = on ? mx : -INFINITY;
    mx = xr_max(mx);
    const float mn = fmaxf(st.m, mx), alpha = fexp2(st.m - mn); st.m = mn;
    const float mref = on ? mn : INFINITY;
    float sum = 0.f;
#pragma unroll
    for (int kb = 0; kb < 4; ++kb)
#pragma unroll
        for (int i = 0; i < 4; ++i) { const float p = fexp2(s[kb][i] - mref); s[kb][i] = p; sum += p; }
    st.l = st.l * alpha + sum;
#pragma unroll
    for (int d = 0; d < 4; ++d) st.o[d] = st.o[d] * alpha;
#pragma unroll
    for (int c = 0; c < 2; ++c) { const bf16x8 pf = pack_p(s[2 * c], s[2 * c + 1]);
#pragma unroll
        for (int d = 0; d < 4; ++d) st.o[d] = mfma16(f.v[d][c], pf, st.o[d]); }
}
DEV float flash_inv_l(const FlashSt& st) { const float l = xr_sum(st.l); return l > 0.f ? 1.f / l : 0.f; }
DEV bf16x8 load_q(const bf16_t* p, const float* c, bool rope, float scale) {
    u32x4 w = *(const u32x4*)p; unsigned* wp = (unsigned*)&w;
    f32x4 co = {1.f, 1.f, 1.f, 1.f}, si = {0.f, 0.f, 0.f, 0.f};
    if (c) { co = *(const f32x4*)c; si = *(const f32x4*)(c + 8); }
#pragma unroll
    for (int j = 0; j < 4; ++j) { const float t1 = bflo(wp[j]), t2 = bfhi(wp[j]);
        const float a = rope ? t1 * co[j] - t2 * si[j] : t1, bq = rope ? t2 * co[j] + t1 * si[j] : t2;
        wp[j] = pk2(a * scale, bq * scale); }
    return __builtin_bit_cast(bf16x8, w);
}
struct TileRegs { u32x4 k, v; };
DEV void tile_load(TileRegs& r, const bf16_t* kbase, size_t kpitch, const bf16_t* vtbase, int key0, int tid) {
    r.k = *(const u32x4*)(kbase + (size_t)(key0 + (tid >> 3)) * kpitch + (tid & 7) * 8);
    r.v = *(const u32x4*)(vtbase + (size_t)(tid >> 3) * SEQ + key0 + (tid & 7) * 8);
}
DEV void tile_store(const TileRegs& r, LAS bf16_t* kt, LAS bf16_t* vt, int tid) {
    *(LAS u32x4*)(kt + (tid >> 3) * KTP + (tid & 7) * 8) = r.k; *(LAS u32x4*)(vt + (tid >> 3) * KTP + (tid & 7) * 8) = r.v;
}

DEV void nsa_unit(Frame F, int b, int qt, int half) {
    frame_refresh(F);
    const int tid = F.tid, lane = F.lane, wave = F.wave, fr = lane & 15, fq = lane >> 4, sq = wave & 1, hp = (wave >> 1) & 1, ks = wave >> 2, head = 2 * hp + ks, qid = wave >> 1;
    const int ql = 32 * half + 16 * sq + fr, tq = qt * 64 + ql, cur = qt; const size_t rowq = (size_t)b * SEQ + tq;
    const bf16_t* H = wsp<bf16_t>(F, WS_H); const float* cs = wsp<float>(F, WS_CS); const float* side = wsp<float>(F, WS_SIDE);
    LAS bf16_t* KT = (LAS bf16_t*)(F.lds + AT_KT); LAS bf16_t* VT = (LAS bf16_t*)(F.lds + AT_VT);
    LAS bf16_t* KC = (LAS bf16_t*)(F.lds + AT_KC); LAS bf16_t* VC = (LAS bf16_t*)(F.lds + AT_VC);
    bf16x8 qf2[2][2], qf[2]; float gate[3];
#pragma unroll
    for (int hh = 0; hh < 2; ++hh)
#pragma unroll
        for (int dc = 0; dc < 2; ++dc) qf2[hh][dc] = load_q(H + rowq * NP + HP_NQ + (2 * hp + hh) * 64 + 32 * dc + 8 * fq, cs + rowq * 16 + 4 * (fq & 1), dc == 0 && fq < 2, QSCALE);
#pragma unroll
    for (int dc = 0; dc < 2; ++dc) qf[dc] = ks ? qf2[1][dc] : qf2[0][dc];
#pragma unroll
    for (int i = 0; i < 3; ++i) gate[i] = sigmoidf_(side[rowq * 16 + head * 3 + i]);
    { const bf16_t* kc = wsp<bf16_t>(F, WS_KCMP) + (size_t)b * 256 * 64; const bf16_t* vc = wsp<bf16_t>(F, WS_VCMPT) + (size_t)b * 64 * 256;
#pragma unroll
        for (int it = 0; it < 4; ++it) { const int id = tid + it * NTHR;
            *(LAS u32x4*)(KC + (id >> 3) * KTP + (id & 7) * 8) = *(const u32x4*)(kc + (size_t)id * 8);
            *(LAS u32x4*)(VC + (id >> 5) * VCP + (id & 31) * 8) = *(const u32x4*)(vc + (size_t)id * 8); } }
    __syncthreads();
    f32x4 res[4]; float imp[16];
    const int nkb = (4 * qt + 2 * half) / 16 + 1;
    const int cl = (tq - 31) >> 4;
    const int srcl = (lane - 16) & 63;
    {
        f32x4 sc[16]; float mx = -1e30f;
#pragma unroll
        for (int kb = 0; kb < 16; ++kb) {
            if (kb < nkb) { const LAS bf16_t* kp = KC + (16 * kb + fr) * KTP + 8 * fq;
                f32x4 a = mfma16(*(const LAS bf16x8*)kp, qf[0], (f32x4){0.f, 0.f, 0.f, 0.f}); a = mfma16(*(const LAS bf16x8*)(kp + 32), qf[1], a);
#pragma unroll
                for (int i = 0; i < 4; ++i) { a[i] = (16 * kb + 4 * fq + i <= cl) ? a[i] : -INFINITY; mx = fmaxf(mx, a[i]); }
                sc[kb] = a; }
            else sc[kb] = (f32x4){-INFINITY, -INFINITY, -INFINITY, -INFINITY}; }
        mx = xr_max(mx);
        float sum = 0.f;
#pragma unroll
        for (int kb = 0; kb < 16; ++kb) if (kb < nkb) {
#pragma unroll
            for (int i = 0; i < 4; ++i) { const float p = fexp2(sc[kb][i] - mx); sc[kb][i] = p; sum += p; } }
        else sc[kb] = (f32x4){0.f, 0.f, 0.f, 0.f};
        sum = xr_sum(sum);
        const float inv = sum > 0.f ? 1.f / sum : 0.f;
        f32x4 o[4];
#pragma unroll
        for (int d = 0; d < 4; ++d) o[d] = (f32x4){0.f, 0.f, 0.f, 0.f};
        float prevx = 0.f;
#pragma unroll
        for (int kb = 0; kb < 16; ++kb) { if (kb < nkb) { sc[kb] = sc[kb] * inv; const float x = __shfl(sc[kb][3], srcl);
                imp[kb] = ((sc[kb][0] + sc[kb][1]) + (sc[kb][2] + sc[kb][3])) + (fq > 0 ? x : prevx); prevx = x; }
            else imp[kb] = 0.f; }
#pragma unroll
        for (int cc = 0; cc < 8; ++cc) if (2 * cc < nkb) { const bf16x8 pf = pack_p(sc[2 * cc], sc[2 * cc + 1]);
#pragma unroll
            for (int d = 0; d < 4; ++d) o[d] = mfma16(vfrag(VC + (16 * d + fr) * VCP + 32 * cc + 4 * fq), pf, o[d]); }
#pragma unroll
        for (int d = 0; d < 4; ++d) res[d] = o[d] * gate[0];
    }
    unsigned mlo, mhi;
    if (cur < 16) { mlo = (2u << cur) - 1u; mhi = 0u; }
    else {
        LAS float* XCH = (LAS float*)(F.lds + AT_XCH); LAS float* TAB = (LAS float*)(F.lds + AT_TAB) + (wave * 16 + fr) * TABP;
        __syncthreads();
#pragma unroll
        for (int kb = 0; kb < 16; ++kb) XCH[(wave * 16 + kb) * 64 + lane] = imp[kb];
        __syncthreads();
#pragma unroll
        for (int kb = 0; kb < 16; ++kb) { const int j = 4 * kb + fq;
            float v = (XCH[((0 + sq) * 16 + kb) * 64 + lane] + XCH[((2 + sq) * 16 + kb) * 64 + lane]) + (XCH[((4 + sq) * 16 + kb) * 64 + lane] + XCH[((6 + sq) * 16 + kb) * 64 + lane]);
            const bool forced = (j == 0) || (j == cur) || (j == cur - 1);
            v = forced ? 1e9f : (j <= cur ? v : -1.f); imp[kb] = v; TAB[j] = v; }
        LDS_WAIT();
        int cnt[4];
#pragma unroll
        for (int k4 = 0; k4 < 4; ++k4) cnt[k4] = 0;
        float myv[4];
#pragma unroll
        for (int k4 = 0; k4 < 4; ++k4) myv[k4] = qid == 0 ? imp[k4] : (qid == 1 ? imp[4 + k4] : (qid == 2 ? imp[8 + k4] : imp[12 + k4]));
#pragma unroll 4
        for (int jj = 0; jj < 64; ++jj) { const float vv = TAB[jj];
#pragma unroll
            for (int k4 = 0; k4 < 4; ++k4) { const int j = 4 * (4 * qid + k4) + fq; cnt[k4] += ((vv > myv[k4]) || (vv == myv[k4] && jj < j)) ? 1 : 0; } }
        mlo = 0u; mhi = 0u;
#pragma unroll
        for (int k4 = 0; k4 < 4; ++k4) { const int j = 4 * (4 * qid + k4) + fq; const unsigned bit = (cnt[k4] < 16 && j <= cur) ? 1u : 0u; if (j < 32) mlo |= bit << (j & 31); else mhi |= bit << (j & 31); }
        mlo = xr_or(mlo); mhi = xr_or(mhi);
        LAS unsigned* MSK = (LAS unsigned*)(F.lds + AT_CK);
        if (fq == 0) { MSK[(wave * 16 + fr) * 2] = mlo; MSK[(wave * 16 + fr) * 2 + 1] = mhi; }
        __syncthreads();
        mlo = (MSK[((0 + sq) * 16 + fr) * 2] | MSK[((2 + sq) * 16 + fr) * 2]) | (MSK[((4 + sq) * 16 + fr) * 2] | MSK[((6 + sq) * 16 + fr) * 2]);
        mhi = (MSK[((0 + sq) * 16 + fr) * 2 + 1] | MSK[((2 + sq) * 16 + fr) * 2 + 1]) | (MSK[((4 + sq) * 16 + fr) * 2 + 1] | MSK[((6 + sq) * 16 + fr) * 2 + 1]);
    }
    __syncthreads();
#pragma unroll 1
    for (int br = 0; br < 2; ++br) {
        const bf16_t* kbase = wsp<bf16_t>(F, WS_KNSA) + (size_t)b * SEQ * 128 + br * 64;
        const bf16_t* vtb = wsp<bf16_t>(F, WS_VT) + ((size_t)b * 384 + br * 64) * SEQ;
        const int j0 = br == 0 ? 0 : (qt > 8 ? qt - 8 : 0);
        const int np = (cur - j0 + 2) >> 1;
        FlashSt st2[2]; flash_init(st2[0]); flash_init(st2[1]);
        TileRegs ra[2], rb[2];
#define NSA_LOADP(R, p) do { _Pragma("unroll") for (int tt_ = 0; tt_ < 2; ++tt_) { const int j_ = j0 + 2 * (p) + tt_; if (j_ <= cur) tile_load(R[tt_], kbase, 128, vtb, j_ * 64, tid); } } while (0)
#define NSA_STOREP(R, p, buf) do { _Pragma("unroll") for (int tt_ = 0; tt_ < 2; ++tt_) { const int j_ = j0 + 2 * (p) + tt_; if (j_ <= cur) tile_store(R[tt_], KT + ((buf) * 2 + tt_) * 64 * KTP, VT + ((buf) * 2 + tt_) * 64 * KTP, tid); } } while (0)
#define NSA_COMPP(p, buf) do { const int j = j0 + 2 * (p) + ks; if (j <= cur) { \
            const LAS bf16_t* kt = KT + ((buf) * 2 + ks) * 64 * KTP; const LAS bf16_t* vt = VT + ((buf) * 2 + ks) * 64 * KTP; \
            const bool on = (br == 0) ? (((j < 32 ? (mlo >> j) : (mhi >> (j - 32))) & 1u) != 0u) : true; \
            if (__any(on)) { KVFrags fg; load_frags(fg, kt, vt, fr, fq); asm volatile("" ::: "memory"); \
                const bool edge = (j == cur) || (br == 1 && j == qt - 8); const int hi = (j == cur) ? ql : 63, lo = (br == 1 && j == qt - 8) ? ql : -1; \
                _Pragma("unroll") for (int hh = 0; hh < 2; ++hh) { f32x4 s[4]; qk_frags(s, fg, qf2[hh]); \
                    if (edge) { _Pragma("unroll") for (int kb = 0; kb < 4; ++kb) _Pragma("unroll") for (int i = 0; i < 4; ++i) { const int kl = 16 * kb + 4 * fq + i; s[kb][i] = (kl <= hi && kl > lo) ? s[kb][i] : -INFINITY; } } \
                    flash_update(st2[hh], s, fg, on); } } } } while (0)
        NSA_LOADP(ra, 0); NSA_LOADP(rb, 1);
#pragma unroll 1
        for (int p = 0; p < np; p += 2) {
            NSA_STOREP(ra, p, 0); __syncthreads(); NSA_LOADP(ra, p + 2); NSA_COMPP(p, 0);
            if (p + 1 < np) { NSA_STOREP(rb, p + 1, 1); __syncthreads(); NSA_LOADP(rb, p + 3); NSA_COMPP(p + 1, 1); }
        }
#undef NSA_LOADP
#undef NSA_STOREP
#undef NSA_COMPP
        { LAS float* XS = (LAS float*)(F.lds + AT_XST) + wave * (18 * 64) + lane;
            XS[0] = ks ? st2[0].m : st2[1].m; XS[64] = ks ? st2[0].l : st2[1].l;
#pragma unroll
            for (int d = 0; d < 4; ++d)
#pragma unroll
                for (int i = 0; i < 4; ++i) XS[(2 + 4 * d + i) * 64] = ks ? st2[0].o[d][i] : st2[1].o[d][i];
            __syncthreads();
            const LAS float* XP = (const LAS float*)(F.lds + AT_XST) + (wave ^ 4) * (18 * 64) + lane;
            FlashSt st; st.m = ks ? st2[1].m : st2[0].m; st.l = ks ? st2[1].l : st2[0].l;
#pragma unroll
            for (int d = 0; d < 4; ++d) st.o[d] = ks ? st2[1].o[d] : st2[0].o[d];
            const float mb = XP[0], lb = XP[64]; const float m = fmaxf(st.m, mb), fa = fexp2(st.m - m), fb = fexp2(mb - m);
            st.l = st.l * fa + lb * fb;
#pragma unroll
            for (int d = 0; d < 4; ++d)
#pragma unroll
                for (int i = 0; i < 4; ++i) st.o[d][i] = st.o[d][i] * fa + XP[(2 + 4 * d + i) * 64] * fb;
            const float sc = flash_inv_l(st) * (br == 0 ? gate[1] : gate[2]);
#pragma unroll
            for (int d = 0; d < 4; ++d) res[d] += st.o[d] * sc; }
        __syncthreads();
    }
    bf16_t* BR = wsp<bf16_t>(F, WS_BR);
#pragma unroll
    for (int d = 0; d < 4; ++d) { u32x2 w; w.x = pk2(res[d][0], res[d][1]); w.y = pk2(res[d][2], res[d][3]);
        *(u32x2*)(BR + rowq * 1024 + head * 64 + 16 * d + 4 * fq) = w; }
}

DEV void fox_unit(Frame F, int b, int h, int qb) {
    frame_refresh(F);
    const int tid = F.tid, lane = F.lane, wave = F.wave, fr = lane & 15, fq = lane >> 4;
    const int q0 = qb * 256, qw = q0 + 32 * wave;
    const bf16_t* H = wsp<bf16_t>(F, WS_H); const float* cum = wsp<float>(F, WS_CUM) + ((size_t)b * 4 + h) * SEQ;
    LAS bf16_t* KT = (LAS bf16_t*)(F.lds + AT_KT); LAS bf16_t* VT = (LAS bf16_t*)(F.lds + AT_VT); LAS float* CK = (LAS float*)(F.lds + AT_CK);
    LAS float* KNP = (LAS float*)(F.lds + AT_FXT); LAS float* CKL = KNP + 64; LAS float* WMIN = KNP + 128; LAS float* WQN = KNP + 136;
    const float cref = cum[q0];
    bf16x8 qf[2][2]; float qn2 = 0.f;
#pragma unroll
    for (int sb = 0; sb < 2; ++sb) { float ss = 0.f;
#pragma unroll
        for (int dc = 0; dc < 2; ++dc) { qf[sb][dc] = load_q(H + ((size_t)b * SEQ + qw + 16 * sb + fr) * NP + HP_FQ + h * 64 + 32 * dc + 8 * fq, nullptr, false, QSCALE);
            const u32x4 w = __builtin_bit_cast(u32x4, qf[sb][dc]); const unsigned* wp = (const unsigned*)&w;
#pragma unroll
            for (int j = 0; j < 4; ++j) { const float a = bflo(wp[j]), c = bfhi(wp[j]); ss += a * a + c * c; } }
        ss = xr_sum(ss); qn2 = fmaxf(qn2, ss); }
#pragma unroll
    for (int o = 1; o < 16; o <<= 1) qn2 = fmaxf(qn2, __shfl_xor(qn2, o));
    if (lane == 0) WQN[wave] = sqrtf(qn2) * 1.0001f;
    if (tid < 64) {
        float kn = wsp<float>(F, WS_KN)[((size_t)b * 4 + h) * 64 + tid];
#pragma unroll
        for (int o = 1; o < 64; o <<= 1) { const float t = __shfl_up(kn, o); if (tid >= o) kn = fmaxf(kn, t); }
        KNP[tid] = kn; CKL[tid] = cum[64 * tid + 63] - cref; }
    const bf16_t* kbase = H + (size_t)b * SEQ * NP + HP_FK + h * 64; const bf16_t* vtb = wsp<bf16_t>(F, WS_VT) + ((size_t)b * 384 + 128 + h * 64) * SEQ;
    FlashSt st[2]; flash_init(st[0]); flash_init(st[1]);
    __syncthreads();
    int np = 2;
    { float qn = WQN[0];
#pragma unroll
        for (int w = 1; w < 8; ++w) qn = fmaxf(qn, WQN[w]);
        const float wk = wsp<float>(F, WS_KN)[((size_t)b * 4 + h) * 64 + 4 * qb + (lane & 3)];
        float kown = fmaxf(wk, __shfl_xor(wk, 1)); kown = fmaxf(kown, __shfl_xor(kown, 2)); kown = __shfl(kown, 0);
        const float thr = -qn * kown - 40.f;
#pragma unroll 1
        for (int Jn = 4 * qb - 1; Jn >= 0; Jn -= 2) { if (qn * KNP[Jn] - CKL[Jn] < thr) break; ++np; } }
    np = __builtin_amdgcn_readfirstlane(np);
#define FOX_TILE(p, tt) ((p) < 2 ? 4 * qb + 2 * (p) + (tt) : 4 * qb - 1 - 2 * ((p) - 2) - (tt))
    TileRegs ra[2], rb[2]; f32x4 cka[2], ckb[2];
#define FOX_LOADP(R, C, p) do { if ((p) < np) { _Pragma("unroll") for (int tt_ = 0; tt_ < 2; ++tt_) { const int j_ = FOX_TILE(p, tt_); if (j_ >= 0) { tile_load(R[tt_], kbase, NP, vtb, j_ * 64, tid); if (tid < 16) C[tt_] = *(const f32x4*)(cum + j_ * 64 + 4 * tid); } } } } while (0)
#define FOX_STOREP(R, C, p, buf) do { _Pragma("unroll") for (int tt_ = 0; tt_ < 2; ++tt_) { const int j_ = FOX_TILE(p, tt_); if (j_ >= 0) { tile_store(R[tt_], KT + ((buf) * 2 + tt_) * 64 * KTP, VT + ((buf) * 2 + tt_) * 64 * KTP, tid); \
            if (tid < 16) *(LAS f32x4*)(CK + ((buf) * 2 + tt_) * 64 + 4 * tid) = C[tt_] - cref; } } } while (0)
#define FOX_COMPP(p, buf) do { _Pragma("unroll") for (int tt_ = 0; tt_ < 2; ++tt_) { const int J = FOX_TILE(p, tt_); const int key0 = 64 * J; if (J >= 0 && key0 <= qw + 31) { \
            const LAS bf16_t* kt = KT + ((buf) * 2 + tt_) * 64 * KTP; const LAS bf16_t* vt = VT + ((buf) * 2 + tt_) * 64 * KTP; const LAS float* ck = CK + ((buf) * 2 + tt_) * 64; \
            KVFrags fg; load_frags(fg, kt, vt, fr, fq); \
            f32x4 dk[4]; _Pragma("unroll") for (int kb = 0; kb < 4; ++kb) dk[kb] = *(const LAS f32x4*)(ck + 16 * kb + 4 * fq); \
            asm volatile("" ::: "memory"); \
            const bool diag = key0 + 63 > qw; \
            _Pragma("unroll") for (int sb = 0; sb < 2; ++sb) { f32x4 s[4]; qk_frags(s, fg, qf[sb]); const int qa = qw + 16 * sb + fr; \
                _Pragma("unroll") for (int kb = 0; kb < 4; ++kb) { s[kb] = s[kb] - dk[kb]; \
                    if (diag) { _Pragma("unroll") for (int i = 0; i < 4; ++i) s[kb][i] = (key0 + 16 * kb + 4 * fq + i <= qa) ? s[kb][i] : -INFINITY; } } \
                flash_update(st[sb], s, fg, true); } } } } while (0)
    FOX_LOADP(ra, cka, 0); FOX_LOADP(rb, ckb, 1);
#pragma unroll 1
    for (int p = 0; p < np; p += 2) {
        FOX_STOREP(ra, cka, p, 0); __syncthreads(); FOX_LOADP(ra, cka, p + 2); FOX_COMPP(p, 0);
        if (p + 1 < np) { FOX_STOREP(rb, ckb, p + 1, 1); __syncthreads(); FOX_LOADP(rb, ckb, p + 3); FOX_COMPP(p + 1, 1); }
    }
#undef FOX_TILE
#undef FOX_LOADP
#undef FOX_STOREP
#undef FOX_COMPP
    bf16_t* BR = wsp<bf16_t>(F, WS_BR);
#pragma unroll
    for (int sb = 0; sb < 2; ++sb) { const float sc = flash_inv_l(st[sb]); const size_t row = (size_t)b * SEQ + qw + 16 * sb + fr;
#pragma unroll
        for (int d = 0; d < 4; ++d) { const f32x4 o = st[sb].o[d] * sc; u32x2 w; w.x = pk2(o[0], o[1]); w.y = pk2(o[2], o[3]);
            *(u32x2*)(BR + row * 1024 + 256 + h * 64 + 16 * d + 4 * fq) = w; } }
    __syncthreads();
}

DEV void ln1_router_phase(Frame F, const Params& P, int l) {
    frame_refresh(F);
    const int tid = F.tid, lane = F.lane, wave = F.wave, fr = lane & 15, fq = lane >> 4;
    LAS float* xs = (LAS float*)F.lds;
    LAS float* part = (LAS float*)(F.lds + 69632);
    constexpr int XP = 1028;
    const bf16_t* mix = wsp<bf16_t>(F, WS_MIX); bf16_t* xb = wsp<bf16_t>(F, WS_XB);
    const float* g1 = P.in[I_LN1G] + (size_t)l * 1024; const float* b1 = P.in[I_LN1B] + (size_t)l * 1024;
    float wf[2][32];
    { const float* wr = P.in[I_WR] + (size_t)l * 1024 * 32 + (size_t)(128 * wave + 32 * fq) * 32 + fr;
#pragma unroll
        for (int s_ = 0; s_ < 32; ++s_) { wf[0][s_] = wr[s_ * 32]; wf[1][s_] = wr[s_ * 32 + 16]; } }
    const float brt = P.in[I_BR][l * 32 + (tid & 31)];
    unsigned* cnt = F.ctl + CW_CNT + l * 32 * 64; int* rowtk = wsp<int>(F, WS_ROWTK); float* tokw = wsp<float>(F, WS_TOKW);
    LAS unsigned* lcnt = (LAS unsigned*)(F.lds + 90112);
    LAS unsigned* lsel = lcnt + 64;
    if (tid < 64) lcnt[tid] = 0u;
    int nsel = 0;
    __syncthreads();
    u32x4 va[2][2], vm[2][2];
    f32x4 gg1[2][2], bb1[2][2];
#pragma unroll
    for (int j = 0; j < 2; ++j)
#pragma unroll
        for (int h = 0; h < 2; ++h) { gg1[j][h] = *(const f32x4*)(g1 + j * 512 + lane * 8 + 4 * h); bb1[j][h] = *(const f32x4*)(b1 + j * 512 + lane * 8 + 4 * h); }
    int unit = F.bid;
    if (unit < NT / 16) {
#pragma unroll
        for (int i = 0; i < 2; ++i)
#pragma unroll
            for (int j = 0; j < 2; ++j) { const size_t o = (size_t)(unit * 16 + wave * 2 + i) * 1024 + j * 512 + lane * 8; va[i][j] = *(const u32x4*)(xb + o); vm[i][j] = *(const u32x4*)(mix + o); } }
#pragma unroll 1
    for (; unit < NT / 16; unit += F.G) {
        const int r0 = unit * 16;
#pragma unroll
        for (int i = 0; i < 2; ++i) { const int r = wave * 2 + i; const size_t row = (size_t)(r0 + r);
            f32x4 v[2][2]; float s = 0.f;
#pragma unroll
            for (int j = 0; j < 2; ++j) { const unsigned* xp_ = (const unsigned*)&va[i][j]; const unsigned* mp_ = (const unsigned*)&vm[i][j];
#pragma unroll
                for (int h = 0; h < 2; ++h) { const f32x4 xa = {bflo(xp_[2 * h]), bfhi(xp_[2 * h]), bflo(xp_[2 * h + 1]), bfhi(xp_[2 * h + 1])}, ma = {bflo(mp_[2 * h]), bfhi(mp_[2 * h]), bflo(mp_[2 * h + 1]), bfhi(mp_[2 * h + 1])};
                    v[j][h] = xa * DN_ALPHA + ma; s += (v[j][h][0] + v[j][h][1]) + (v[j][h][2] + v[j][h][3]); } }
            const float mean = wave_sum(s) * (1.f / 1024.f); float q = 0.f;
#pragma unroll
            for (int j = 0; j < 2; ++j)
#pragma unroll
                for (int h = 0; h < 2; ++h) { v[j][h] = v[j][h] - mean; q += (v[j][h][0] * v[j][h][0] + v[j][h][1] * v[j][h][1]) + (v[j][h][2] * v[j][h][2] + v[j][h][3] * v[j][h][3]); }
            const float rstd = 1.f / sqrtf(wave_sum(q) * (1.f / 1024.f) + LN_EPS);
#pragma unroll
            for (int j = 0; j < 2; ++j) { const f32x4 o0 = v[j][0] * rstd * gg1[j][0] + bb1[j][0], o1 = v[j][1] * rstd * gg1[j][1] + bb1[j][1];
                *(LAS f32x4*)(xs + r * XP + j * 512 + lane * 8) = o0; *(LAS f32x4*)(xs + r * XP + j * 512 + lane * 8 + 4) = o1;
                u32x4 w; w.x = pk2(o0[0], o0[1]); w.y = pk2(o0[2], o0[3]); w.z = pk2(o1[0], o1[1]); w.w = pk2(o1[2], o1[3]); *(u32x4*)(xb + row * 1024 + j * 512 + lane * 8) = w; } }
        { const int un = unit + F.G;
            if (un < NT / 16) {
#pragma unroll
                for (int i = 0; i < 2; ++i)
#pragma unroll
                    for (int j = 0; j < 2; ++j) { const size_t o = (size_t)(un * 16 + wave * 2 + i) * 1024 + j * 512 + lane * 8; va[i][j] = *(const u32x4*)(xb + o); vm[i][j] = *(const u32x4*)(mix + o); } } }
        __syncthreads();
        { f32x4 c0 = (f32x4){0.f, 0.f, 0.f, 0.f}, c1 = c0; const LAS float* xp = xs + fr * XP + 128 * wave + 32 * fq;
#pragma unroll
            for (int s4 = 0; s4 < 8; ++s4) { const f32x4 xa = *(const LAS f32x4*)(xp + 4 * s4);
#pragma unroll
                for (int i = 0; i < 4; ++i) { c0 = __builtin_amdgcn_mfma_f32_16x16x4f32(xa[i], wf[0][4 * s4 + i], c0, 0, 0, 0); c1 = __builtin_amdgcn_mfma_f32_16x16x4f32(xa[i], wf[1][4 * s4 + i], c1, 0, 0, 0); } }
#pragma unroll
            for (int i = 0; i < 4; ++i) { part[(wave * 16 + 4 * fq + i) * 32 + fr] = c0[i]; part[(wave * 16 + 4 * fq + i) * 32 + 16 + fr] = c1[i]; } }
        __syncthreads();
        { const int r = tid >> 5, e = tid & 31; float v = brt;
#pragma unroll
            for (int w = 0; w < 8; ++w) v += part[(w * 16 + r) * 32 + e];
            float bv[4]; int bi[4]; float cur = v;
#define DPP_F(x, ctrl) __builtin_bit_cast(float, __builtin_amdgcn_update_dpp(0, __builtin_bit_cast(int, (x)), (ctrl), 0xf, 0xf, true))
#define DPP_I(x, ctrl) __builtin_amdgcn_update_dpp(0, (x), (ctrl), 0xf, 0xf, true)
#define ARGMAX_STEP(OV, OI) do { const float ov_ = (OV); const int oi_ = (OI); const bool take_ = (ov_ > mv) || (ov_ == mv && oi_ < mi); mv = take_ ? ov_ : mv; mi = take_ ? oi_ : mi; } while (0)
#pragma unroll
            for (int k = 0; k < 4; ++k) { float mv = cur; int mi = e;
                ARGMAX_STEP(DPP_F(mv, 0xB1), DPP_I(mi, 0xB1));
                ARGMAX_STEP(DPP_F(mv, 0x4E), DPP_I(mi, 0x4E));
                ARGMAX_STEP(DPP_F(mv, 0x141), DPP_I(mi, 0x141));
                ARGMAX_STEP(DPP_F(mv, 0x140), DPP_I(mi, 0x140));
                { const auto rv_ = __builtin_amdgcn_permlane16_swap(__float_as_uint(mv), __float_as_uint(mv), false, false); const auto ri_ = __builtin_amdgcn_permlane16_swap((unsigned)mi, (unsigned)mi, false, false);
                    mv = __uint_as_float(rv_[0]); mi = (int)ri_[0]; ARGMAX_STEP(__uint_as_float(rv_[1]), (int)ri_[1]); }
                bv[k] = mv; bi[k] = mi; if (e == mi) cur = -INFINITY; }
#undef DPP_F
#undef DPP_I
#undef ARGMAX_STEP
            if (e < 4) { float ex[4], sum = 0.f;
#pragma unroll
                for (int k = 0; k < 4; ++k) { ex[k] = __expf(bv[k] - bv[0]); sum += ex[k]; }
                const int k = e; const int t = r0 + r; const int ide = k == 0 ? bi[0] : (k == 1 ? bi[1] : (k == 2 ? bi[2] : bi[3])); const float exk = k == 0 ? ex[0] : (k == 1 ? ex[1] : (k == 2 ? ex[2] : ex[3]));
                const unsigned ls = __hip_atomic_fetch_add(lcnt + ide, 1u, __ATOMIC_RELAXED, __HIP_MEMORY_SCOPE_WORKGROUP);
                const int li = nsel + r * 4 + k; lsel[2 * li] = ((unsigned)ide << 24) | ls; lsel[2 * li + 1] = (unsigned)(t * 4 + k); tokw[t * 4 + k] = exk / sum; } }
        nsel += 64;
        __syncthreads();
    }
    if (tid < 32) { const unsigned c = lcnt[tid]; lcnt[32 + tid] = c ? atomicAdd(cnt + tid * 64, c) : 0u; }
    __syncthreads();
    for (int i = tid; i < nsel; i += NTHR) { const unsigned a = lsel[2 * i], tk = lsel[2 * i + 1]; const unsigned e = a >> 24; rowtk[(size_t)e * NT + lcnt[32 + e] + (a & 0xffffffu)] = (int)tk; }
    __syncthreads();
}
DEV void ln2_rows(Frame F, const Params& P, int l) {
    frame_refresh(F);
    const int lane = F.lane; const int gw = F.bid * NWAVES + F.wave, NGW = F.G * NWAVES;
    bf16_t* xb = wsp<bf16_t>(F, WS_XB); const bf16_t* yb = wsp<bf16_t>(F, WS_YBUF); const float* tokw = wsp<float>(F, WS_TOKW);
    const float* g2 = P.in[I_LN2G] + (size_t)l * 1024; const float* b2 = P.in[I_LN2B] + (size_t)l * 1024;
    float* dst = (l == NL - 1) ? P.out : nullptr;
    f32x4 wkn; u32x4 xn[2]; u32x4 yn[2][4];
#define LN2_LOAD(row_) do { wkn = *(const f32x4*)(tokw + (size_t)(row_) * 4); _Pragma("unroll") for (int j = 0; j < 2; ++j) { xn[j] = *(const u32x4*)(xb + (size_t)(row_) * 1024 + j * 512 + lane * 8); \
        _Pragma("unroll") for (int k = 0; k < 4; ++k) yn[j][k] = *(const u32x4*)(yb + ((size_t)(row_) * 4 + k) * 1024 + j * 512 + lane * 8); } } while (0)
    f32x4 gg[2][2], bb[2][2];
#pragma unroll
    for (int j = 0; j < 2; ++j)
#pragma unroll
        for (int h = 0; h < 2; ++h) { gg[j][h] = *(const f32x4*)(g2 + j * 512 + lane * 8 + 4 * h); bb[j][h] = *(const f32x4*)(b2 + j * 512 + lane * 8 + 4 * h); }
    if (gw < NT) LN2_LOAD(gw);
#pragma unroll 1
    for (int row = gw; row < NT; row += NGW) {
        const f32x4 wk = wkn;
        f32x4 v[2][2]; float s = 0.f;
#pragma unroll
        for (int j = 0; j < 2; ++j) { const unsigned* xp = (const unsigned*)&xn[j];
            f32x4 a0 = (f32x4){bflo(xp[0]), bfhi(xp[0]), bflo(xp[1]), bfhi(xp[1])} * DN_ALPHA, a1 = (f32x4){bflo(xp[2]), bfhi(xp[2]), bflo(xp[3]), bfhi(xp[3])} * DN_ALPHA;
#pragma unroll
            for (int k = 0; k < 4; ++k) { const unsigned* yp = (const unsigned*)&yn[j][k]; const float w = wk[k];
                a0[0] += w * bflo(yp[0]); a0[1] += w * bfhi(yp[0]); a0[2] += w * bflo(yp[1]); a0[3] += w * bfhi(yp[1]);
                a1[0] += w * bflo(yp[2]); a1[1] += w * bfhi(yp[2]); a1[2] += w * bflo(yp[3]); a1[3] += w * bfhi(yp[3]); }
            v[j][0] = a0; v[j][1] = a1; s += ((a0[0] + a0[1]) + (a0[2] + a0[3])) + ((a1[0] + a1[1]) + (a1[2] + a1[3])); }
        if (row + NGW < NT) LN2_LOAD(row + NGW);
        const float mean = wave_sum(s) * (1.f / 1024.f); float q = 0.f;
#pragma unroll
        for (int j = 0; j < 2; ++j)
#pragma unroll
            for (int h = 0; h < 2; ++h) { v[j][h] = v[j][h] - mean; q += (v[j][h][0] * v[j][h][0] + v[j][h][1] * v[j][h][1]) + (v[j][h][2] * v[j][h][2] + v[j][h][3] * v[j][h][3]); }
        const float rstd = 1.f / sqrtf(wave_sum(q) * (1.f / 1024.f) + LN_EPS);
#pragma unroll
        for (int j = 0; j < 2; ++j) { const f32x4 o0 = v[j][0] * rstd * gg[j][0] + bb[j][0], o1 = v[j][1] * rstd * gg[j][1] + bb[j][1];
            if (dst) { *(f32x4*)(dst + (size_t)row * 1024 + j * 512 + lane * 8) = o0; *(f32x4*)(dst + (size_t)row * 1024 + j * 512 + lane * 8 + 4) = o1; }
            else { u32x4 w; w.x = pk2(o0[0], o0[1]); w.y = pk2(o0[2], o0[3]); w.z = pk2(o1[0], o1[1]); w.w = pk2(o1[2], o1[3]); *(u32x4*)(xb + (size_t)row * 1024 + j * 512 + lane * 8) = w; } } }
#undef LN2_LOAD
}

constexpr int NPH = 9;
constexpr int N_PHASES = 1 + NL * NPH;
__global__ void __launch_bounds__(NTHR, 2) fwd_kernel(Params P) {
    extern __shared__ __attribute__((aligned(16))) unsigned char lds_raw[];
    Frame F;
    F.lds = (LAS unsigned char*)lds_raw; F.MISC = (volatile LAS unsigned*)(F.lds + MISC_OFF);
    F.tid = threadIdx.x; F.lane = F.tid & 63; F.wave = __builtin_amdgcn_readfirstlane(F.tid >> 6); F.G = gridDim.x; F.bid = blockIdx.x;
    F.ws = P.ws; F.ctl = (unsigned*)(P.ws + WS_CTL);
    for (int u = F.tid; u < 1024; u += NTHR) F.MISC[u] = 0u;
    __syncthreads();
    const int lo = P.ph_lo, hi = P.ph_hi;
    const bool multi = (hi - lo) > 1;
    XcdBarrier bar; bar.bar = F.ctl + CW_BAR; bar.x = 0; bar.st = F.MISC + 8;
    if (multi) bar = xcd_barrier_post(F.ctl + CW_BAR, F.MISC + 8);
#ifndef PHMASK
#define PHMASK 0xFFFF
#endif
#define IN(k) (lo <= (k) && (k) < hi)
#define EN(i) ((PHMASK >> (i)) & 1)
#ifndef DUP_PHASE
#define DUP_PHASE -1
#endif
#define REP(i) for (int rep_ = 0; rep_ < ((DUP_PHASE) == (i) ? 2 : 1); ++rep_)
#define SEAM(k) do { if (IN(k) && IN((k) + 1)) xcd_barrier(bar); } while (0)
#define FILL(k) do { __syncthreads(); if (F.tid == 0) atomicAdd(F.ctl + CW_DONE + (k) * 64, 1u); bg_fill(F, P, F.ctl + CW_DONE + (k) * 64, BG_TOTAL); } while (0)

    if (EN(9) && IN(0)) { REP(9) p0_prologue(F, P); }
    SEAM(0);
#pragma unroll 1
    for (int l = 0; l < NL; ++l) {
        const int pb = 1 + l * NPH;
        if (EN(0) && IN(pb + 0)) REP(0) {
            pg8::Gemm g{wsp<bf16_t>(F, WS_XB), wsp<bf16_t>(F, WS_WIN) + (size_t)l * NP * 1024, 1024, 1024};
            pg8::PlainOrder S; S.init(NT / 256, NP / 256, F.G, F.bid);
            pg8::EpiInProj E{wsp<bf16_t>(F, WS_H), wsp<float>(F, WS_BIN) + (size_t)l * NP, wsp<float>(F, WS_SIDE), wsp<bf16_t>(F, WS_MGT)};
            pg8::gemm_phase<pg8::EpiInProj, pg8::PlainOrder, true>(F.lds, g, S, E);
            FILL(pb + 0);
        }
        SEAM(pb + 0);
        if (EN(1) && IN(pb + 1)) REP(1) {
            unsigned* qctr = F.ctl + CW_QUEUE + l * 64 + 16;
            for (;;) {
                if (F.tid == 0) F.MISC[16] = atomicAdd(qctr, 1u);
                __syncthreads();
                const int L = (int)F.MISC[16];
                __syncthreads();
                if (L >= 528) break;
                if (L < 128) pb_gmlp_unit(F, P, l, L);
                else if (L < 256) pb_compress_unit(F, l, L - 128);
                else if (L < 512) { pb_conv_unit(F, P, l, L - 256); pb_transpose_unit(F, L - 256); }
                else pb_cum_unit(F, L - 512);
            }
        }
        SEAM(pb + 1);
        if (EN(2) && IN(pb + 2)) REP(2) {
            unsigned* qctr = F.ctl + CW_QUEUE + l * 64 + rep_ * 32;
            for (;;) {
                if (F.tid == 0) F.MISC[16] = atomicAdd(qctr, 1u);
                __syncthreads();
                const unsigned L = F.MISC[16];
                __syncthreads();
#ifdef ATT_TWICE
                if (L >= 1536u) break;
                const int Lm = (int)(L % 768u);
#else
                if (L >= 768u) break;
                const int Lm = (int)L;
#endif
                if (Lm < 512) nsa_unit(F, Lm & 3, 63 - (Lm >> 3), (Lm >> 2) & 1);
                else { const int idx = Lm - 512; fox_unit(F, idx & 3, (idx >> 2) & 3, 15 - (idx >> 4)); }
            }
            FILL(pb + 2);
        }
        SEAM(pb + 2);
        if (EN(3) && IN(pb + 3)) REP(3) {
            pg8::Gemm g{wsp<bf16_t>(F, WS_BR), wsp<bf16_t>(F, WS_WBR) + (size_t)l * 4096 * 256, 1024, 256};
            pg8::BrOrder S{F.G, F.bid};
            pg8::EpiBrGate E{wsp<bf16_t>(F, WS_MGT), wsp<bf16_t>(F, WS_GBF)};
            pg8::gemm_phase<pg8::EpiBrGate, pg8::BrOrder, true, true>(F.lds, g, S, E);
        }
        SEAM(pb + 3);
        if (EN(4) && IN(pb + 4)) REP(4) {
            pg8::Gemm g{wsp<bf16_t>(F, WS_GBF), wsp<bf16_t>(F, WS_WO) + (size_t)l * 1024 * 1024, 1024, 1024};
            pg8::PlainOrder S; S.init(NT / 256, 4, F.G, F.bid);
            pg8::EpiBf16Out E{wsp<bf16_t>(F, WS_MIX)};
            pg8::gemm_phase<pg8::EpiBf16Out, pg8::PlainOrder, true>(F.lds, g, S, E);
        }
        SEAM(pb + 4);
        if (EN(5) && IN(pb + 5)) { ln1_router_phase(F, P, l); bg_fill(F, P, nullptr, (long)(l + 1) * BG_PER_LAYER); }
        SEAM(pb + 5);
        if ((EN(6) || EN(7)) && (IN(pb + 6) || IN(pb + 7))) {
            LAS int* tp = (LAS int*)(F.lds + MISC_OFF + 1024);
            if (F.tid == 0) { int run = 0; const unsigned* cnt = F.ctl + CW_CNT + l * 32 * 64;
                for (int e = 0; e < 32; ++e) { const int c = (int)__hip_atomic_load(cnt + e * 64, __ATOMIC_RELAXED, __HIP_MEMORY_SCOPE_AGENT); tp[e] = run; tp[40 + e] = c; run += (c + 255) >> 8; }
                tp[32] = run; }
            __syncthreads();
            if (EN(6) && IN(pb + 6)) REP(6) {
                pg8::Gemm g{wsp<bf16_t>(F, WS_XB), wsp<bf16_t>(F, WS_W1) + (size_t)l * 32 * 2048 * 1024, 1024, 1024};
                pg8::MoeOrder<1> S{tp, wsp<int>(F, WS_ROWTK), 8, F.G, F.bid};
                pg8::EpiMoe1 E{wsp<bf16_t>(F, WS_ACT), P.in[I_BE1] + (size_t)l * 32 * 2048};
                pg8::gemm_phase<pg8::EpiMoe1, pg8::MoeOrder<1>, true>(F.lds, g, S, E);
                FILL(pb + 6);
            }
            SEAM(pb + 6);
            if (EN(7) && IN(pb + 7)) REP(7) {
                pg8::Gemm g{wsp<bf16_t>(F, WS_ACT), wsp<bf16_t>(F, WS_W2) + (size_t)l * 32 * 1024 * 1024, 1024, 1024};
                pg8::MoeOrder<2> S{tp, wsp<int>(F, WS_ROWTK), 4, F.G, F.bid};
                pg8::EpiMoe2 E{wsp<bf16_t>(F, WS_YBUF), P.in[I_BE2] + (size_t)l * 32 * 1024, wsp<int>(F, WS_ROWTK)};
                pg8::gemm_phase<pg8::EpiMoe2, pg8::MoeOrder<2>, true>(F.lds, g, S, E);
                FILL(pb + 7);
            }
        }
        SEAM(pb + 7);
        if (EN(8) && IN(pb + 8)) REP(8) ln2_rows(F, P, l);
        SEAM(pb + 8);
    }
#undef IN
#undef SEAM
}

#ifndef MK_SPLIT
#define MK_SPLIT 0
#endif
extern "C" void kernel_launch(void* const* d_in, const int* in_sizes, int n_in, void* d_out, int out_size, void* d_ws, size_t ws_size, hipStream_t stream) {
    static int grid = 0;
    if (grid == 0) {
        if (n_in != 30 || out_size != NT * 1024 || ws_size < WS_END) { fprintf(stderr, "kernel_launch: unexpected shapes (n_in %d out %d ws %zu need %zu)\n", n_in, out_size, ws_size, (size_t)WS_END); grid = -1; return; }
        int dev = 0, cus = 0, per_cu = 0;
        if (hipGetDevice(&dev) != hipSuccess || hipDeviceGetAttribute(&cus, hipDeviceAttributeMultiprocessorCount, dev) != hipSuccess) { grid = -1; return; }
        if (hipFuncSetAttribute((const void*)fwd_kernel, hipFuncAttributeMaxDynamicSharedMemorySize, LDS_BYTES) != hipSuccess) { fprintf(stderr, "kernel_launch: hipFuncSetAttribute failed\n"); grid = -1; return; }
        if (hipOccupancyMaxActiveBlocksPerMultiprocessor(&per_cu, (const void*)fwd_kernel, NTHR, LDS_BYTES) != hipSuccess || per_cu < 1) fprintf(stderr, "kernel_launch: occupancy query says %d\n", per_cu);
        (void)hipGetLastError();
        grid = cus;
    }
    if (grid < 0) return;
    (void)hipMemsetAsync((char*)d_ws + WS_CTL, 0, CTL_BYTES, stream);
    Params p; memset(&p, 0, sizeof(p));
    for (int i = 0; i < 30; ++i) p.in[i] = (const float*)d_in[i];
    p.out = (float*)d_out; p.ws = (unsigned char*)d_ws;
    for (int i = 0; i < 8; ++i) p.invf[i] = std::pow(500000.0, -(double)i / 8.0);
#if MK_SPLIT
    for (int ph = 0; ph < N_PHASES; ++ph) { p.ph_lo = ph; p.ph_hi = ph + 1; hipLaunchKernelGGL(fwd_kernel, dim3(grid), dim3(NTHR), LDS_BYTES, stream, p); }
#else
    p.ph_lo = 0; p.ph_hi = N_PHASES; hipLaunchKernelGGL(fwd_kernel, dim3(grid), dim3(NTHR), LDS_BYTES, stream, p);
#endif
}
```

```cpp
#include <hip/hip_runtime.h>
#include <cstdio>
#include <cstdint>
#include <cmath>
#include <cstring>

#define DEV __device__ __forceinline__
#define LAS __attribute__((address_space(3)))
#define GAS __attribute__((address_space(1)))

typedef unsigned short bf16_t;
typedef short bf16x8 __attribute__((ext_vector_type(8)));
typedef short bf16x4 __attribute__((ext_vector_type(4)));
typedef float f32x4 __attribute__((ext_vector_type(4)));
typedef float f32x2 __attribute__((ext_vector_type(2)));
typedef unsigned u32x4 __attribute__((ext_vector_type(4)));
typedef unsigned u32x2 __attribute__((ext_vector_type(2)));

constexpr int NB = 4, SEQ = 4096, DM = 1024, NL = 4, NT = NB * SEQ;
constexpr int NIN = 6544, NP = 6656;
constexpr int NE = 32;
constexpr int NWAVES = 8, NTHR = 512;
constexpr float LN_EPS = 1e-5f;
constexpr float DN_ALPHA = 1.6817928305074292f;
constexpr float LOG2E = 1.4426950408889634f;
constexpr int HP_NQ = 0, HP_KC = 256, HP_VC = 320, HP_KS = 384, HP_VS = 448, HP_KW = 512, HP_VW = 576, HP_SP = 640;
constexpr int HP_FQ = 768, HP_FK = 1024, HP_FV = 1280, HP_GU = 1536, HP_GV = 1792, HP_CAB = 2048, HP_MG = 2560;

constexpr size_t al256(size_t x) { return (x + 255) & ~(size_t)255; }
constexpr size_t WS_CTL = 0, CTL_BYTES = 1u << 20;
constexpr size_t WS_WIN = CTL_BYTES;
constexpr size_t WS_BIN = WS_WIN + al256((size_t)NL * NP * 1024 * 2);
constexpr size_t WS_WBR = WS_BIN + al256((size_t)NL * NP * 4);
constexpr size_t WS_WO = WS_WBR + al256((size_t)NL * 4096 * 256 * 2);
constexpr size_t WS_W1 = WS_WO + al256((size_t)NL * 1024 * 1024 * 2);
constexpr size_t WS_W2 = WS_W1 + al256((size_t)NL * 32 * 2048 * 1024 * 2);
constexpr size_t WS_WC1 = WS_W2 + al256((size_t)NL * 32 * 1024 * 1024 * 2);
constexpr size_t WS_WC2 = WS_WC1 + al256((size_t)NL * 2 * 64 * 2048 * 2);
constexpr size_t WS_CB = WS_WC2 + al256((size_t)NL * 2 * 64 * 64 * 2);
constexpr size_t WS_WG = WS_CB + al256((size_t)NL * 2 * 32 * 64 * 4);
constexpr size_t WS_CS = WS_WG + al256((size_t)NL * 4 * 128 * 128 * 2);
constexpr size_t WS_XRES = WS_CS + al256((size_t)NT * 16 * 4);
constexpr size_t WS_XB = WS_XRES + al256((size_t)NT * 1024 * 4);
constexpr size_t WS_H = WS_XB + al256((size_t)NT * 1024 * 2);
constexpr size_t WS_SIDE = WS_H + al256((size_t)NT * NP * 2);
constexpr size_t WS_KNSA = WS_SIDE + al256((size_t)NT * 16 * 4);
constexpr size_t WS_VT = WS_KNSA + al256((size_t)NT * 128 * 2);
constexpr size_t WS_CUM = WS_VT + al256((size_t)NB * 384 * SEQ * 2);
constexpr size_t WS_KCMP = WS_CUM + al256((size_t)NB * 4 * SEQ * 4);
constexpr size_t WS_VCMPT = WS_KCMP + al256((size_t)NB * 256 * 64 * 2);
constexpr size_t WS_BR = WS_VCMPT + al256((size_t)NB * 64 * 256 * 2);
constexpr size_t WS_G32 = WS_BR + al256((size_t)NT * 1024 * 2);
constexpr size_t WS_GBF = WS_G32 + al256((size_t)NT * 1024 * 4);
constexpr size_t WS_MIX = WS_GBF + al256((size_t)NT * 1024 * 2);
constexpr size_t WS_TOKW = WS_MIX + al256((size_t)NT * 1024 * 4);
constexpr size_t WS_ROWTK = WS_TOKW + al256((size_t)NT * 4 * 4);
constexpr int PMAX_TILES = NT * 4 / 256 + NE;
constexpr size_t WS_ACT = WS_ROWTK + al256((size_t)NE * NT * 4);
constexpr size_t WS_YBUF = WS_ACT + al256((size_t)PMAX_TILES * 256 * 1024 * 2);
constexpr size_t WS_MGT = WS_YBUF + al256((size_t)NT * 4 * 1024 * 2);
constexpr size_t WS_KN = WS_MGT + al256((size_t)NT * 4096 * 2);
constexpr size_t WS_END = WS_KN + al256((size_t)NB * 4 * 64 * 4);

constexpr int CW_BAR = 4096;
constexpr int CW_CNT = 32768;
constexpr int CW_QUEUE = 20480;
constexpr int CW_BGQ = 24576;
constexpr int CW_DONE = 28672;

constexpr int RING_BYTES = 131072;
constexpr int MISC_OFF = RING_BYTES;
constexpr int LDS_BYTES = 147456;

DEV float bf2f(bf16_t v) { return __uint_as_float((unsigned)v << 16); }
DEV float bflo(unsigned w) { return __uint_as_float(w << 16); }
DEV float bfhi(unsigned w) { return __uint_as_float(w & 0xffff0000u); }
DEV unsigned pk2(float lo, float hi) { typedef __bf16 b2 __attribute__((ext_vector_type(2))); f32x2 v = {lo, hi}; b2 b = __builtin_convertvector(v, b2); return __builtin_bit_cast(unsigned, b); }
DEV bf16_t f2bf(float f) { return (bf16_t)(pk2(f, 0.f) & 0xffffu); }
DEV float fexp2(float x) { return __builtin_amdgcn_exp2f(x); }
DEV float frcp(float x) { return __builtin_amdgcn_rcpf(x); }
DEV float sigmoidf_(float x) { return frcp(1.f + fexp2(-x * LOG2E)); }
DEV float gelu_tanh(float x) { const float u = 1.5957691216057308f * (x + 0.044715f * x * x * x); return x * frcp(1.f + fexp2(-u * LOG2E)); }
#define WS_DPP(x, ctrl) __builtin_bit_cast(float, __builtin_amdgcn_update_dpp(0, __builtin_bit_cast(int, (x)), (ctrl), 0xf, 0xf, true))
DEV float wave_sum(float v) {
    v += WS_DPP(v, 0xB1); v += WS_DPP(v, 0x4E); v += WS_DPP(v, 0x141); v += WS_DPP(v, 0x140);
    const int vi = __builtin_bit_cast(int, v);
    const float r0 = __builtin_bit_cast(float, __builtin_amdgcn_readlane(vi, 0)), r1 = __builtin_bit_cast(float, __builtin_amdgcn_readlane(vi, 16));
    const float r2 = __builtin_bit_cast(float, __builtin_amdgcn_readlane(vi, 32)), r3 = __builtin_bit_cast(float, __builtin_amdgcn_readlane(vi, 48));
    return (r0 + r1) + (r2 + r3);
}
typedef unsigned u32x2_t __attribute__((ext_vector_type(2)));
DEV float xr_max(float v) {
    { const unsigned u = __float_as_uint(v); const auto r = __builtin_amdgcn_permlane16_swap(u, u, false, false); v = fmaxf(__uint_as_float(r[0]), __uint_as_float(r[1])); }
    { const unsigned u = __float_as_uint(v); const auto r = __builtin_amdgcn_permlane32_swap(u, u, false, false); v = fmaxf(__uint_as_float(r[0]), __uint_as_float(r[1])); }
    return v;
}
DEV float xr_sum(float v) {
    { const unsigned u = __float_as_uint(v); const auto r = __builtin_amdgcn_permlane16_swap(u, u, false, false); v = __uint_as_float(r[0]) + __uint_as_float(r[1]); }
    { const unsigned u = __float_as_uint(v); const auto r = __builtin_amdgcn_permlane32_swap(u, u, false, false); v = __uint_as_float(r[0]) + __uint_as_float(r[1]); }
    return v;
}
DEV unsigned xr_or(unsigned u) {
    { const auto r = __builtin_amdgcn_permlane16_swap(u, u, false, false); u = r[0] | r[1]; }
    { const auto r = __builtin_amdgcn_permlane32_swap(u, u, false, false); u = r[0] | r[1]; }
    return u;
}
DEV f32x4 mfma16(bf16x8 a, bf16x8 b, f32x4 c) { return __builtin_amdgcn_mfma_f32_16x16x32_bf16(a, b, c, 0, 0, 0); }
#define LDS_WAIT() asm volatile("s_waitcnt lgkmcnt(0)" ::: "memory")
#define VM_WAIT() asm volatile("s_waitcnt vmcnt(0)" ::: "memory")

__host__ __device__ __forceinline__ int perm16(int dp) { return dp < 16 ? ((dp & 1) ? 8 + (dp >> 1) : (dp >> 1)) : dp; }
__host__ __device__ __forceinline__ int hp_src_col(int c) {
    if (c < 256) return (c & ~63) + perm16(c & 63);
    if (c < 320) return 256 + perm16(c - 256);
    if (c < 384) return c;
    if (c < 448) return 384 + perm16(c - 384);
    if (c < 512) return c;
    if (c < 576) return 512 + perm16(c - 512);
    if (c < 640) return c;
    if (c < 652) return c;
    if (c < 656) return 1420 + (c - 652);
    if (c < 768) return -1;
    if (c < 1024) return 652 + (c - 768);
    if (c < 1280) return 908 + (c - 1024);
    if (c < 1536) return 1164 + (c - 1280);
    if (c < 1792) return 1424 + (c - 1536);
    if (c < 2048) return 1680 + (c - 1792);
    if (c < 2560) { const int i = c - 2048; return (i & 1) ? 2192 + (i >> 1) : 1936 + (i >> 1); }
    return 2448 + (c - 2560);
}

namespace pg8 {
constexpr int BM = 256, BK = 64, HALF = 128, HTB = HALF * BK * 2, STAGE_BYTES = 8 * HTB, NXCD = 8, WGM = 8;
__host__ __device__ __forceinline__ int lds_byte(int r, int c) { const int st = (r >> 4) * 2 + (c >> 5), rr = r & 15, cc = c & 31, ob = rr * 64 + cc * 2; return st * 1024 + (ob ^ (((ob >> 9) & 1) << 5)); }
__host__ __device__ __forceinline__ void stage_rc(int b, int& R, int& C) { const int st = b / 1024, sb = b % 1024, swz = sb ^ (((sb >> 9) & 1) << 5); R = (st >> 1) * 16 + swz / 64; C = (st & 1) * 32 + (swz % 64) / 2; }
__host__ __device__ __forceinline__ int perm32(int rho) { const int n = rho >> 4, i = rho & 15; return 8 * (i >> 2) + 4 * n + (i & 3); }

struct Unit { int pm, pn, e, mt, cnt; };
struct Gemm { const bf16_t* A; const bf16_t* Bt; int lda; int K; };

template <class Epi, class Sched, bool ALIGN_EPI, bool HALFN = false>
DEV void gemm_phase(LAS unsigned char* lds, const Gemm g, const Sched& S, const Epi& E) {
    int tid_ = threadIdx.x; asm volatile("" : "+v"(tid_));
    const int tid = tid_, wid = __builtin_amdgcn_readfirstlane(tid >> 6), lane = tid & 63, wr = wid >> 2, wc = wid & 3, fr = lane & 15, fq = lane >> 4;
    const int K = g.K, nt = K / BK;
    unsigned voffA[2], voffB[2];
#pragma unroll
    for (int i = 0; i < 2; ++i) { int R, C; stage_rc(tid * 16 + i * 8192, R, C); int Rb = Epi::PERM ? ((R & ~31) + perm32(R & 31)) : R;
        if constexpr (Epi::PAIR16) Rb = 16 * (Rb >> 3) + (Rb & 7);
        voffA[i] = (unsigned)(R * g.lda + C) * 2u; voffB[i] = (unsigned)(Rb * K + C) * 2u; }
    const unsigned hstepA = (unsigned)HALF * (unsigned)g.lda * 2u;
    const size_t kstep = (size_t)(BK * 2);
    const size_t hstepB = (size_t)(Epi::PAIR16 ? 8 : HALF) * K * 2;
    unsigned voffG[2];
#pragma unroll
    for (int i = 0; i < 2; ++i) { const unsigned off = (unsigned)tid * 16u + (unsigned)i * 8192u; voffG[i] = (off >> 8) * 512u + (off & 255u); }
    constexpr size_t GPIECE = 64 * 512;
    const unsigned ldsw = (unsigned)wid * 1024u;
    const int aoff = lds_byte(wr * 64 + fr, fq * 8), boff = lds_byte(wc * 32 + fr, fq * 8);
    const char* const Abase = (const char*)g.A;
#define PG8_SA(b, h) (((b) * 2 + (h)) * HTB)
#define PG8_SB(b, h) ((4 + (b) * 2 + (h)) * HTB)
#define PG8_STAGE_B(bufoff, gbase, voff) do { _Pragma("unroll") for (int _i = 0; _i < 2; ++_i) \
        __builtin_amdgcn_global_load_lds((const unsigned*)((const char*)(gbase) + (voff)[_i]), (LAS unsigned*)(lds + (bufoff) + ldsw + _i * 8192), 16, 0, 0); } while (0)
#define PG8_STAGE_B1(bufoff, gbase, gatep) do { if constexpr (HALFN) PG8_STAGE_B(bufoff, gatep, voffG); else PG8_STAGE_B(bufoff, (gbase) + hstepB, voffB); } while (0)
#define PG8_STAGE_A(bufoff, koff, offs) do { _Pragma("unroll") for (int _i = 0; _i < 2; ++_i) { \
        if constexpr (Sched::GATHER) __builtin_amdgcn_global_load_lds((const unsigned*)(Abase + (size_t)(koff) + (offs)[_i]), (LAS unsigned*)(lds + (bufoff) + ldsw + _i * 8192), 16, 0, 0); \
        else __builtin_amdgcn_global_load_lds((const unsigned*)(Abase + ((size_t)(koff) + (size_t)__builtin_amdgcn_readfirstlane((offs)[_i])) + voffA[_i]), (LAS unsigned*)(lds + (bufoff) + ldsw + _i * 8192), 16, 0, 0); } } while (0)
#define PG8_LDA(dst, b, h) do { _Pragma("unroll") for (int m = 0; m < 4; ++m) _Pragma("unroll") for (int k = 0; k < 2; ++k) dst[m][k] = *(const LAS bf16x8*)(lds + PG8_SA(b, h) + aoff + m * 2048 + k * 1024); } while (0)
#define PG8_LDB(dst, b, h) do { _Pragma("unroll") for (int n = 0; n < 2; ++n) _Pragma("unroll") for (int k = 0; k < 2; ++k) dst[n][k] = *(const LAS bf16x8*)(lds + PG8_SB(b, h) + boff + n * 2048 + k * 1024); } while (0)
#define PG8_MMA(ai, bj, At, Bt) do { __builtin_amdgcn_s_setprio(1); _Pragma("unroll") for (int m = 0; m < 4; ++m) _Pragma("unroll") for (int n = 0; n < 2; ++n) _Pragma("unroll") for (int k = 0; k < 2; ++k) \
        acc[ai][bj][m][n] = __builtin_amdgcn_mfma_f32_16x16x32_bf16(Bt[n][k], At[m][k], acc[ai][bj][m][n], 0, 0, 0); __builtin_amdgcn_s_setprio(0); } while (0)
#define PG8_WAIT_V(n) asm volatile("s_waitcnt vmcnt(" #n ")" ::: "memory")
#define PG8_WAIT_L(n) asm volatile("s_waitcnt lgkmcnt(" #n ")" ::: "memory")
#define PG8_BAR __builtin_amdgcn_s_barrier()
#define PG8_SCHED __builtin_amdgcn_sched_barrier(0)
#define PG8_MKOFF(dst, u) do { if constexpr (Sched::GATHER) { const unsigned _ao = S.aoff(u); _Pragma("unroll") for (int _h = 0; _h < 2; ++_h) _Pragma("unroll") for (int _i = 0; _i < 2; ++_i) { \
        int _R, _C; stage_rc(tid * 16 + _i * 8192, _R, _C); dst[_h][_i] = _ao + (S.arow(u, _h * HALF + _R) * (unsigned)g.lda + (unsigned)_C) * 2u; } } \
    else { const unsigned _ub = S.aoff(u) + S.arow(u, 0) * (unsigned)g.lda * 2u; _Pragma("unroll") for (int _h = 0; _h < 2; ++_h) _Pragma("unroll") for (int _i = 0; _i < 2; ++_i) dst[_h][_i] = _ub + (unsigned)_h * hstepA; } } while (0)
    Unit cur, nxt; int ui = 0;
    if (!S.next(0, cur)) return;
    f32x4 acc[2][2][4][2];
#pragma unroll
    for (int a = 0; a < 2; ++a)
#pragma unroll
        for (int b = 0; b < 2; ++b)
#pragma unroll
            for (int m = 0; m < 4; ++m)
#pragma unroll
                for (int n = 0; n < 2; ++n) acc[a][b][m][n] = (f32x4){0.f, 0.f, 0.f, 0.f};
    bf16x8 At[4][2], B0[2][2], B1[2][2];
    unsigned oc[2][2], on[2][2];
    PG8_MKOFF(oc, cur);
    const char* cB = (const char*)g.Bt + S.boff(cur);
    const char* cG = E.gate_base(cur);
    PG8_STAGE_B(PG8_SB(0, 0), cB, voffB); PG8_STAGE_B1(PG8_SB(0, 1), cB, cG); PG8_STAGE_A(PG8_SA(0, 0), 0, oc[0]); PG8_STAGE_A(PG8_SA(0, 1), 0, oc[1]);
    if (wr == 1) PG8_BAR;
    PG8_WAIT_V(2); PG8_BAR;
    PG8_STAGE_B(PG8_SB(1, 0), cB + kstep, voffB); PG8_STAGE_A(PG8_SA(1, 0), kstep, oc[0]); PG8_STAGE_B1(PG8_SB(1, 1), cB + kstep, cG + GPIECE);
    PG8_WAIT_V(6); PG8_BAR;
    typename Epi::Pre pre;
    for (;;) {
        const bool has_next = S.next(ui + 1, nxt);
        const char* nB = cB; const char* nG = cG;
        LAS int* const idxb = (LAS int*)(lds + STAGE_BYTES + 2048) + ((ui + 1) & 1) * 256;
        if (has_next) { nB = (const char*)g.Bt + S.boff(nxt); nG = E.gate_base(nxt);
            if constexpr (Sched::GATHER) { if (wid < 4) __builtin_amdgcn_global_load_lds((const unsigned*)(S.idx_ptr(nxt) + tid), (LAS unsigned*)(idxb + wid * 64), 4, 0, 0); }
            else PG8_MKOFF(on, nxt); }
        else {
#pragma unroll
            for (int h = 0; h < 2; ++h)
#pragma unroll
                for (int i = 0; i < 2; ++i) on[h][i] = oc[h][i];
        }
#pragma unroll 1
        for (int t = 0; t < nt; t += 2) {
            const bool last = (t == nt - 2);
            const size_t k1 = (size_t)(t + 1) * kstep;
            const size_t k2 = last ? (size_t)0 : (size_t)(t + 2) * kstep, k3 = k2 + kstep;
            if constexpr (Sched::GATHER) { if (last && has_next) {
                const unsigned ao_ = S.aoff(nxt);
#pragma unroll
                for (int h = 0; h < 2; ++h)
#pragma unroll
                    for (int i = 0; i < 2; ++i) { int R_, C_; stage_rc(tid * 16 + i * 8192, R_, C_); const int r_ = h * HALF + R_; const int ix_ = idxb[r_];
                        on[h][i] = ao_ + (S.arow_from(nxt, r_, ix_) * (unsigned)g.lda + (unsigned)C_) * 2u; } } }
            unsigned o2[2][2];
#pragma unroll
            for (int h = 0; h < 2; ++h)
#pragma unroll
                for (int i = 0; i < 2; ++i) o2[h][i] = last ? on[h][i] : oc[h][i];
            const char* b2 = last ? nB : cB + (size_t)(t + 2) * kstep; const char* b3 = b2 + kstep;
            const char* g2 = last ? nG : cG + (size_t)(t + 2) * GPIECE; const char* g3 = g2 + GPIECE;
            PG8_LDB(B0, 0, 0); if constexpr (!HALFN) PG8_LDB(B1, 0, 1); else { if (wr == 0) E.gate_read(pre, lds + PG8_SB(0, 1), t >> 1, wc, fr, fq); } PG8_SCHED; PG8_LDA(At, 0, 0); PG8_STAGE_A(PG8_SA(1, 1), k1, oc[1]);
            PG8_WAIT_V(8); PG8_WAIT_L(0); PG8_BAR; PG8_MMA(0, 0, At, B0); if constexpr (!HALFN) PG8_MMA(0, 1, At, B1); PG8_BAR; PG8_SCHED;
            PG8_LDA(At, 0, 1); PG8_STAGE_B(PG8_SB(0, 0), b2, voffB); PG8_STAGE_B1(PG8_SB(0, 1), b2, g2); PG8_STAGE_A(PG8_SA(0, 0), k2, o2[0]);
            PG8_WAIT_V(8); PG8_WAIT_L(0); PG8_BAR; PG8_MMA(1, 0, At, B0); if constexpr (!HALFN) PG8_MMA(1, 1, At, B1); PG8_BAR; PG8_SCHED;
            PG8_LDB(B0, 1, 0); if constexpr (!HALFN) PG8_LDB(B1, 1, 1); else { if (wr == 1) E.gate_read(pre, lds + PG8_SB(1, 1), t >> 1, wc, fr, fq); } PG8_SCHED; PG8_LDA(At, 1, 0); PG8_STAGE_A(PG8_SA(0, 1), k2, o2[1]);
            PG8_WAIT_V(8); PG8_WAIT_L(0); PG8_BAR; PG8_MMA(0, 0, At, B0); if constexpr (!HALFN) PG8_MMA(0, 1, At, B1); PG8_BAR; PG8_SCHED;
            PG8_LDA(At, 1, 1); PG8_STAGE_B(PG8_SB(1, 0), b3, voffB); PG8_STAGE_B1(PG8_SB(1, 1), b3, g3); PG8_STAGE_A(PG8_SA(1, 0), k3, o2[0]);
            PG8_WAIT_V(8); PG8_WAIT_L(0); PG8_BAR; PG8_MMA(1, 0, At, B0); if constexpr (!HALFN) PG8_MMA(1, 1, At, B1); PG8_BAR; PG8_SCHED;
        }
        if constexpr (ALIGN_EPI) { if (wr == 0) PG8_BAR; }
        if constexpr (HALFN) E.fold(acc, pre, cur, wr, wc, fr, fq); else E(acc, cur, wr, wc, fr, fq);
        if (!has_next) break;
#pragma unroll
        for (int a = 0; a < 2; ++a)
#pragma unroll
            for (int b = 0; b < 2; ++b)
#pragma unroll
                for (int m = 0; m < 4; ++m)
#pragma unroll
                    for (int n = 0; n < 2; ++n) { if (!HALFN || b == 0) acc[a][b][m][n] = (f32x4){0.f, 0.f, 0.f, 0.f}; }
        cur = nxt; cB = nB; cG = nG; ++ui;
#pragma unroll
        for (int h = 0; h < 2; ++h)
#pragma unroll
            for (int i = 0; i < 2; ++i) oc[h][i] = on[h][i];
        if constexpr (ALIGN_EPI) { if (wr == 1) PG8_BAR; }
    }
    PG8_WAIT_V(0);
    if constexpr (!ALIGN_EPI) { if (wr == 0) PG8_BAR; }
    PG8_BAR;
#undef PG8_SA
#undef PG8_SB
#undef PG8_STAGE_A
#undef PG8_STAGE_B1
#undef PG8_STAGE_B
#undef PG8_LDA
#undef PG8_LDB
#undef PG8_MMA
#undef PG8_WAIT_V
#undef PG8_WAIT_L
#undef PG8_BAR
#undef PG8_SCHED
#undef PG8_MKOFF
}

struct StaticOrder {
    int nM, nN, nwg, G, c;
    DEV void init(int nM_, int nN_, int G_, int c_) { nM = nM_; nN = nN_; nwg = nM * nN; G = G_; c = c_; }
    DEV bool next(int i, Unit& u) const {
        const long L = (long)i * G + c; if (L >= nwg) return false;
        int wgid = (int)L; { const int q = nwg / NXCD, r = nwg % NXCD, xcd = wgid % NXCD, off = wgid / NXCD; wgid = (xcd < r ? xcd * (q + 1) : r * (q + 1) + (xcd - r) * q) + off; }
        const int nig = WGM * nN, gid = wgid / nig, fm = gid * WGM, gsz = (nM - fm) < WGM ? (nM - fm) : WGM;
        u.pm = fm + ((wgid % nig) % gsz); u.pn = (wgid % nig) / gsz; u.e = 0; u.mt = 0; u.cnt = 256; return true;
    }
};
}

#define XB_TMO      128
#define XB_XCNT(j)  (256  + 64 * (j))
#define XB_XSUB(j)  (1280 + 64 * (j))
#define XB_XGEN(j)  (2304 + 64 * (j))
#define XB_TOP      3328
#define XB_TOPGEN   3392
#define XCD_BAR_WORDS 3456
#define XB_SPIN_CAP (1u << 20)
DEV unsigned xb_ld(unsigned* p)              { return __hip_atomic_load(p, __ATOMIC_RELAXED, __HIP_MEMORY_SCOPE_AGENT); }
DEV unsigned xb_add(unsigned* p, unsigned v) { return __hip_atomic_fetch_add(p, v, __ATOMIC_RELAXED, __HIP_MEMORY_SCOPE_AGENT); }
DEV unsigned xb_xcc_id() { return (unsigned)__builtin_amdgcn_s_getreg((3 << 11) | 20) & 0xFu; }
#define XB_SPIN(cond, bar) do { unsigned _sp = 0; while (cond) { __builtin_amdgcn_s_sleep(1); \
    if ((++_sp & 255u) == 0u) { if (xb_ld(&(bar)[XB_TMO])) break; if (_sp > XB_SPIN_CAP) { atomicAdd(&(bar)[XB_TMO], 1u); break; } } } } while (0)
struct XcdBarrier { unsigned* bar; unsigned x; volatile LAS unsigned* st; };
DEV XcdBarrier xcd_barrier_post(unsigned* bar, volatile LAS unsigned* st) {
    XcdBarrier b; b.bar = bar; b.x = xb_xcc_id(); b.st = st;
    if (threadIdx.x == 0) (void)xb_add(&bar[XB_XCNT(b.x)], 1u);
    return b;
}
DEV void xcd_barrier_complete(unsigned* bar, unsigned x, unsigned& nloc, unsigned& nx) {
    const unsigned G = gridDim.x * gridDim.y * gridDim.z;
    unsigned sum, cnt, mine, sp = 0u;
    for (;;) {
        sum = 0u; cnt = 0u; mine = 0u;
#pragma unroll
        for (unsigned j = 0; j < 16; ++j) { const unsigned c = xb_ld(&bar[XB_XCNT(j)]); sum += c; cnt += (c > 0u) ? 1u : 0u; mine = (j == x) ? c : mine; }
        if (sum == G) break;
        __builtin_amdgcn_s_sleep(1);
        if ((++sp & 255u) == 0u) { if (xb_ld(&bar[XB_TMO])) break; if (sp > XB_SPIN_CAP) { atomicAdd(&bar[XB_TMO], 1u); break; } }
    }
    nloc = mine > 0u ? mine : 1u; nx = cnt > 0u ? cnt : 1u;
}
DEV void xcd_barrier(const XcdBarrier& b) {
    asm volatile("s_waitcnt vmcnt(0)" ::: "memory");
    __syncthreads();
    if (threadIdx.x == 0) {
        unsigned* bar = b.bar;
        __builtin_amdgcn_s_waitcnt(0);
        unsigned nloc = b.st[0], nx = b.st[1];
        if (nloc == 0u) { xcd_barrier_complete(bar, b.x, nloc, nx); b.st[0] = nloc; b.st[1] = nx; }
        const unsigned old = xb_add(&bar[XB_XSUB(b.x)], 1u);
        const unsigned gen = old / nloc;
        if (old + 1u == (gen + 1u) * nloc) {
            __builtin_amdgcn_fence(__ATOMIC_RELEASE, "agent");
            asm volatile("s_waitcnt vmcnt(0)" ::: "memory");
            const unsigned og = xb_add(&bar[XB_TOP], 1u);
            const unsigned tg = og / nx;
            if (og + 1u == (tg + 1u) * nx) xb_add(&bar[XB_TOPGEN], 1u);
            else XB_SPIN(xb_ld(&bar[XB_TOPGEN]) == tg, bar);
            __builtin_amdgcn_fence(__ATOMIC_ACQUIRE, "agent");
            xb_add(&bar[XB_XGEN(b.x)], 1u);
            asm volatile("s_waitcnt vmcnt(0)" ::: "memory");
        } else {
            XB_SPIN(xb_ld(&bar[XB_XGEN(b.x)]) == gen, bar);
            __builtin_amdgcn_fence(__ATOMIC_ACQUIRE, "agent");
            asm volatile("s_waitcnt vmcnt(0)" ::: "memory");
        }
    }
    __syncthreads();
}

struct Params {
    const float* in[30];
    float* out;
    unsigned char* ws;
    int ph_lo, ph_hi;
    double invf[8];
};
enum { I_X = 0, I_POS, I_WIN, I_BIN, I_PEK, I_PEV, I_W1K, I_W2K, I_W1V, I_W2V, I_GLNG, I_GLNB, I_GWS, I_GBS, I_CW, I_CB, I_CLNG, I_CLNB,
       I_WBR, I_WO, I_LN1G, I_LN1B, I_WR, I_BR, I_WE1, I_BE1, I_WE2, I_BE2, I_LN2G, I_LN2B };

namespace pg8 {
struct EpiInProj {
    struct Pre {};
    static constexpr bool PAIR16 = false;
    DEV const char* gate_base(const Unit&) const { return nullptr; }
    static constexpr bool PERM = true;
    bf16_t* H; const float* bias; float* side; bf16_t* MGT;
    DEV void operator()(const f32x4 (&acc)[2][2][4][2], const Unit& u, int wr, int wc, int fr, int fq) const {
        const int row0 = u.pm * BM + wr * 64 + fr, col0 = u.pn * BM + wc * 32 + 8 * fq;
        f32x4 bv[2][2];
#pragma unroll
        for (int bj = 0; bj < 2; ++bj)
#pragma unroll
            for (int n = 0; n < 2; ++n) bv[bj][n] = *(const f32x4*)(bias + col0 + bj * HALF + 4 * n);
        if (u.pn >= 10) {
            bf16_t* tile = MGT + ((size_t)u.pm * 16 + (u.pn - 10)) * 65536 + (wr * 64 + fr) * 256 + wc * 32 + 8 * fq;
#pragma unroll
            for (int ai = 0; ai < 2; ++ai)
#pragma unroll
                for (int m = 0; m < 4; ++m)
#pragma unroll
                    for (int bj = 0; bj < 2; ++bj) { const f32x4 v0 = acc[ai][bj][m][0] + bv[bj][0], v1 = acc[ai][bj][m][1] + bv[bj][1];
                        u32x4 w; w.x = pk2(sigmoidf_(v0[0]), sigmoidf_(v0[1])); w.y = pk2(sigmoidf_(v0[2]), sigmoidf_(v0[3])); w.z = pk2(sigmoidf_(v1[0]), sigmoidf_(v1[1])); w.w = pk2(sigmoidf_(v1[2]), sigmoidf_(v1[3]));
                        *(u32x4*)(tile + (ai * HALF + m * 16) * 256 + bj * HALF) = w; }
            return; }
        const bool special = (u.pn == 2) && (wc == 0) && (fq < 2);
#pragma unroll
        for (int ai = 0; ai < 2; ++ai)
#pragma unroll
            for (int m = 0; m < 4; ++m) { const int row = row0 + ai * HALF + m * 16; bf16_t* rowp = H + (size_t)row * NP + col0;
#pragma unroll
                for (int bj = 0; bj < 2; ++bj) { const f32x4 v0 = acc[ai][bj][m][0] + bv[bj][0], v1 = acc[ai][bj][m][1] + bv[bj][1];
                    u32x4 w; w.x = pk2(v0[0], v0[1]); w.y = pk2(v0[2], v0[3]); w.z = pk2(v1[0], v1[1]); w.w = pk2(v1[2], v1[3]);
                    *(u32x4*)(rowp + bj * HALF) = w;
                    if (bj == 1 && special) { float* sp = side + (size_t)row * 16 + 8 * fq; *(f32x4*)sp = v0; *(f32x4*)(sp + 4) = v1; } } }
    }
};
struct EpiBrGate {
    static constexpr bool PERM = true;
    struct Pre { u32x4 g[2][4]; };
    static constexpr bool PAIR16 = false;
    const bf16_t* MGT; bf16_t* GBF;
    DEV const char* gate_base(const Unit& u) const { return (const char*)(MGT + ((size_t)u.pm * 16 + u.e * 4 + (u.pn >> 1)) * 65536 + (u.pn & 1) * 128); }
    DEV void gate_read(Pre& p, const LAS unsigned char* slot, int idx, int wc, int fr, int fq) const {
        const LAS unsigned char* q = slot + fr * 256 + (wc * 32 + 8 * fq) * 2;
        if (idx == 0) {
#pragma unroll
            for (int m = 0; m < 4; ++m) p.g[0][m] = *(const LAS u32x4*)(q + m * 16 * 256); }
        else {
#pragma unroll
            for (int m = 0; m < 4; ++m) p.g[1][m] = *(const LAS u32x4*)(q + m * 16 * 256); }
    }
    DEV void fold(f32x4 (&acc)[2][2][4][2], const Pre& p, const Unit& u, int wr, int wc, int fr, int fq) const {
        const int n = u.e;
#pragma unroll
        for (int ai = 0; ai < 2; ++ai)
#pragma unroll
            for (int m = 0; m < 4; ++m) { const u32x4 g = p.g[ai][m]; const f32x4 a0 = acc[ai][0][m][0], a1 = acc[ai][0][m][1];
                f32x4 t0, t1;
                t0[0] = a0[0] * bflo(g.x); t0[1] = a0[1] * bfhi(g.x); t0[2] = a0[2] * bflo(g.y); t0[3] = a0[3] * bfhi(g.y);
                t1[0] = a1[0] * bflo(g.z); t1[1] = a1[1] * bfhi(g.z); t1[2] = a1[2] * bflo(g.w); t1[3] = a1[3] * bfhi(g.w);
                if (n == 0) { acc[ai][1][m][0] = t0; acc[ai][1][m][1] = t1; } else { acc[ai][1][m][0] += t0; acc[ai][1][m][1] += t1; } }
        if (n == 3) { const int row0 = u.pm * BM + wr * 64 + fr, col0 = u.pn * HALF + wc * 32 + 8 * fq;
#pragma unroll
            for (int ai = 0; ai < 2; ++ai)
#pragma unroll
                for (int m = 0; m < 4; ++m) { const f32x4 v0 = acc[ai][1][m][0], v1 = acc[ai][1][m][1];
                    u32x4 w; w.x = pk2(v0[0], v0[1]); w.y = pk2(v0[2], v0[3]); w.z = pk2(v1[0], v1[1]); w.w = pk2(v1[2], v1[3]);
                    *(u32x4*)(GBF + (size_t)(row0 + ai * HALF + m * 16) * 1024 + col0) = w; } }
    }
};
struct BrOrder {
    static constexpr bool GATHER = false;
    int G, c;
    DEV bool next(int i, Unit& u) const { const int x = c & 7, q = (c >> 3) + (i >> 2) * (G >> 3); if (q >= 64 || (G & 7)) { if (!(G & 7)) return false; const int tile = c + (i >> 2) * G; if (tile >= 512) return false; u.pm = tile >> 3; u.pn = tile & 7; }
        else { u.pm = x + 8 * (q >> 3); u.pn = q & 7; }
        u.e = i & 3; u.mt = 0; u.cnt = 256; return true; }
    DEV size_t boff(const Unit& u) const { return (size_t)(u.e * 1024 + u.pn * 128) * 256 * 2; }
    DEV unsigned aoff(const Unit& u) const { return (unsigned)(u.e * 256 * 2); }
    DEV unsigned arow(const Unit& u, int r) const { return (unsigned)(u.pm * BM + r); }
};
struct PlainOrder : StaticOrder {
    static constexpr bool GATHER = false;
    DEV size_t boff(const Unit& u) const { return (size_t)u.pn * 256 * 1024 * 2; }
    DEV unsigned aoff(const Unit&) const { return 0u; }
    DEV unsigned arow(const Unit& u, int r) const { return (unsigned)(u.pm * BM + r); }
};
struct EpiBf16Out {
    struct Pre {};
    static constexpr bool PAIR16 = false;
    DEV const char* gate_base(const Unit&) const { return nullptr; }
    static constexpr bool PERM = true;
    bf16_t* C;
    DEV void operator()(const f32x4 (&acc)[2][2][4][2], const Unit& u, int wr, int wc, int fr, int fq) const {
        const int row0 = u.pm * BM + wr * 64 + fr, col0 = u.pn * BM + wc * 32 + 8 * fq;
#pragma unroll
        for (int ai = 0; ai < 2; ++ai)
#pragma unroll
            for (int m = 0; m < 4; ++m) { bf16_t* rowp = C + (size_t)(row0 + ai * HALF + m * 16) * 1024 + col0;
#pragma unroll
                for (int bj = 0; bj < 2; ++bj) { const f32x4 v0 = acc[ai][bj][m][0], v1 = acc[ai][bj][m][1];
                    u32x4 w; w.x = pk2(v0[0], v0[1]); w.y = pk2(v0[2], v0[3]); w.z = pk2(v1[0], v1[1]); w.w = pk2(v1[2], v1[3]); *(u32x4*)(rowp + bj * HALF) = w; } }
    }
};
template <int MODE> struct MoeOrder {
    static constexpr bool GATHER = (MODE == 1);
    const LAS unsigned* ul;
    const int* rowtk;
    DEV bool next(int i, Unit& u) const {
        const unsigned p = (unsigned)__builtin_amdgcn_readfirstlane((int)ul[i]); if (p == 0xffffffffu) return false;
        u.pn = (int)(p & 7u); u.e = (int)((p >> 3) & 31u); u.mt = (int)((p >> 8) & 127u); u.pm = (int)((p >> 15) & 511u); u.cnt = (int)(p >> 24) + 1; return true;
    }
    DEV size_t boff(const Unit& u) const { return MODE == 1 ? ((size_t)u.e * 2048 + u.pn * 256) * 1024 * 2 : ((size_t)u.e * 1024 + u.pn * 256) * 1024 * 2; }
    DEV unsigned aoff(const Unit&) const { return 0u; }
    DEV unsigned arow(const Unit& u, int r) const {
        if (MODE == 2) return (unsigned)(u.pm * 256 + r);
        return r < u.cnt ? (unsigned)(rowtk[(size_t)u.e * NT + u.mt * 256 + r] >> 2) : 0u;
    }
    DEV const int* idx_ptr(const Unit& u) const { return rowtk + (size_t)u.e * NT + u.mt * 256; }
    DEV unsigned arow_from(const Unit& u, int r, int ix) const { return r < u.cnt ? (unsigned)(ix >> 2) : 0u; }
};
struct EpiMoe1 {
    struct Pre {};
    DEV const char* gate_base(const Unit&) const { return nullptr; }
    static constexpr bool PERM = true, PAIR16 = true;
    bf16_t* ACT; const float* b1;
    DEV void operator()(const f32x4 (&acc)[2][2][4][2], const Unit& u, int wr, int wc, int fr, int fq) const {
        const int row0 = u.pm * BM + wr * 64 + fr, q = 4 * wc + fq, hcol0 = u.pn * BM + 16 * q;
        const float* bp = b1 + (size_t)u.e * 2048 + hcol0;
        f32x4 bv[2][2];
#pragma unroll
        for (int bj = 0; bj < 2; ++bj)
#pragma unroll
            for (int n = 0; n < 2; ++n) bv[bj][n] = *(const f32x4*)(bp + 8 * bj + 4 * n);
#pragma unroll
        for (int ai = 0; ai < 2; ++ai)
#pragma unroll
            for (int m = 0; m < 4; ++m) { bf16_t* rowp = ACT + (size_t)(row0 + ai * HALF + m * 16) * 1024 + (hcol0 >> 1);
                float o[8];
#pragma unroll
                for (int bj = 0; bj < 2; ++bj) { const f32x4 v0 = acc[ai][bj][m][0] + bv[bj][0], v1 = acc[ai][bj][m][1] + bv[bj][1];
#pragma unroll
                    for (int j = 0; j < 4; ++j) { const float hg = j < 2 ? v0[2 * j] : v1[2 * j - 4], hl = j < 2 ? v0[2 * j + 1] : v1[2 * j - 3];
                        const float glu = fminf(hg, 7.f), lin = fminf(fmaxf(hl, -7.f), 7.f); o[4 * bj + j] = glu * sigmoidf_(1.702f * glu) * (lin + 1.f); } }
                u32x4 w; w.x = pk2(o[0], o[1]); w.y = pk2(o[2], o[3]); w.z = pk2(o[4], o[5]); w.w = pk2(o[6], o[7]); *(u32x4*)rowp = w; }
    }
};
struct EpiMoe2 {
    struct Pre {};
    static constexpr bool PAIR16 = false;
    DEV const char* gate_base(const Unit&) const { return nullptr; }
    static constexpr bool PERM = true;
    bf16_t* Y; const float* b2; const int* rowtk;
    DEV void operator()(const f32x4 (&acc)[2][2][4][2], const Unit& u, int wr, int wc, int fr, int fq) const {
        const int col0 = u.pn * BM + wc * 32 + 8 * fq;
        const float* bp = b2 + (size_t)u.e * 1024 + col0;
        f32x4 bv[2][2];
#pragma unroll
        for (int bj = 0; bj < 2; ++bj)
#pragma unroll
            for (int n = 0; n < 2; ++n) bv[bj][n] = *(const f32x4*)(bp + bj * HALF + 4 * n);
#pragma unroll
        for (int ai = 0; ai < 2; ++ai)
#pragma unroll
            for (int m = 0; m < 4; ++m) { const int r = ai * HALF + wr * 64 + m * 16 + fr;
                if (r < u.cnt) { const int dst = rowtk[(size_t)u.e * NT + u.mt * 256 + r]; bf16_t* rowp = Y + (size_t)dst * 1024 + col0;
#pragma unroll
                    for (int bj = 0; bj < 2; ++bj) { const f32x4 v0 = acc[ai][bj][m][0] + bv[bj][0], v1 = acc[ai][bj][m][1] + bv[bj][1];
                        u32x4 w; w.x = pk2(v0[0], v0[1]); w.y = pk2(v0[2], v0[3]); w.z = pk2(v1[0], v1[1]); w.w = pk2(v1[2], v1[3]); *(u32x4*)(rowp + bj * HALF) = w; } } }
    }
};
}

struct Frame {
    LAS unsigned char* lds;
    volatile LAS unsigned* MISC;
    unsigned* ctl;
    unsigned char* ws;
    int tid, lane, wave, G, bid;
};
template <class T> DEV T* wsp(const Frame& F, size_t off) { return (T*)(F.ws + off); }
DEV void frame_refresh(Frame& F) {
    int t_ = threadIdx.x; asm volatile("" : "+v"(t_)); F.tid = t_; F.lane = t_ & 63; F.wave = __builtin_amdgcn_readfirstlane(t_ >> 6);
    unsigned long long w_ = (unsigned long long)F.ws; asm volatile("" : "+s"(w_)); F.ws = (unsigned char*)(GAS unsigned char*)w_; F.ctl = (unsigned*)F.ws;
}

struct IdMap { DEV int operator()(int i) const { return i; } };
struct HpColMap { DEV int operator()(int c) const { return hp_src_col(c); } };
struct CmpRowMap { DEV int operator()(int k) const { return (k & ~63) + perm16(k & 63); } };
template <class RM, class CM>
DEV void transpose_item(const float* W, int ldw, bf16_t* WT, int ldt, int k0, int n0, LAS float* scr, int lane, RM rm, CM cm) {
    const int nn = lane & 31; const int sc = cm(n0 + nn);
#pragma unroll 8
    for (int i = 0; i < 32; ++i) { const int kk = 2 * i + (lane >> 5); scr[kk * 33 + nn] = sc >= 0 ? W[(size_t)rm(k0 + kk) * ldw + sc] : 0.f; }
    LDS_WAIT(); asm volatile("" ::: "memory");
    const int c = lane & 7;
#pragma unroll
    for (int j = 0; j < 4; ++j) { const int n = (lane >> 3) + 8 * j; const LAS float* s = scr + (8 * c) * 33 + n;
        u32x4 o; o.x = pk2(s[0 * 33], s[1 * 33]); o.y = pk2(s[2 * 33], s[3 * 33]); o.z = pk2(s[4 * 33], s[5 * 33]); o.w = pk2(s[6 * 33], s[7 * 33]);
        *(u32x4*)(WT + (size_t)(n0 + n) * ldt + k0 + 8 * c) = o; }
    LDS_WAIT(); asm volatile("" ::: "memory");
}
struct TItem { const float* W; bf16_t* WT; int ldw, ldt, k0, n0, rmap; };
DEV void titem_load(const TItem& it, f32x4 (&v)[16], int lane) {
    const int nq = lane & 15, kr = lane >> 4;
    if (it.rmap == 2) { const int n = it.n0 + 4 * nq; const int c0 = hp_src_col(n), c1 = hp_src_col(n + 1), c2 = hp_src_col(n + 2), c3 = hp_src_col(n + 3);
        const bool quad = (c0 >= 0) && (c1 == c0 + 1) && (c2 == c0 + 2) && (c3 == c0 + 3);
#pragma unroll
        for (int i = 0; i < 16; ++i) { const float* rp = it.W + (size_t)(it.k0 + 4 * i + kr) * it.ldw;
            if (quad) v[i] = __builtin_nontemporal_load((const f32x4*)(rp + c0));
            else v[i] = (f32x4){c0 >= 0 ? rp[c0] : 0.f, c1 >= 0 ? rp[c1] : 0.f, c2 >= 0 ? rp[c2] : 0.f, c3 >= 0 ? rp[c3] : 0.f}; }
        return; }
#pragma unroll
    for (int i = 0; i < 16; ++i) { int k = it.k0 + 4 * i + kr; if (it.rmap) k = (k & ~63) + perm16(k & 63); v[i] = __builtin_nontemporal_load((const f32x4*)(it.W + (size_t)k * it.ldw + it.n0 + 4 * nq)); }
}
DEV void titem_store(const TItem& it, const f32x4 (&v)[16], LAS bf16_t* scr, int lane) {
    const int nq = lane & 15, kr = lane >> 4; constexpr int SP = 66;
#pragma unroll
    for (int i = 0; i < 16; ++i) { LAS unsigned* d = (LAS unsigned*)(scr + (4 * i + kr) * SP + 4 * nq); d[0] = pk2(v[i][0], v[i][1]); d[1] = pk2(v[i][2], v[i][3]); }
    LDS_WAIT(); asm volatile("" ::: "memory");
    const int c = lane & 7;
#pragma unroll
    for (int j = 0; j < 8; ++j) { const int n = (lane >> 3) + 8 * j; const LAS bf16_t* sp = scr + (8 * c) * SP + n;
        u32x4 o; o.x = sp[0] | ((unsigned)sp[SP] << 16); o.y = sp[2 * SP] | ((unsigned)sp[3 * SP] << 16); o.z = sp[4 * SP] | ((unsigned)sp[5 * SP] << 16); o.w = sp[6 * SP] | ((unsigned)sp[7 * SP] << 16);
        __builtin_nontemporal_store(o, (u32x4*)(it.WT + (size_t)(it.n0 + n) * it.ldt + it.k0 + 8 * c)); }
    LDS_WAIT(); asm volatile("" ::: "memory");
}
constexpr long BG_PER_LAYER = 32L * 512 + 32L * 256, BG_TOTAL = NL * BG_PER_LAYER;
DEV void bg_item(const Frame& F, const Params& P, long idx, LAS bf16_t* scr, int lane) {
    const int l = (int)(idx / BG_PER_LAYER); long r = idx - (long)l * BG_PER_LAYER; TItem it;
    if (r < 32L * 512) { const int mat = l * 32 + (int)(r >> 9), q = (int)(r & 511); it = TItem{P.in[I_WE1] + (size_t)mat * 1024 * 2048, wsp<bf16_t>(F, WS_W1) + (size_t)mat * 2048 * 1024, 2048, 1024, (q >> 5) * 64, (q & 31) * 64, 0}; }
    else { r -= 32L * 512; const int mat = l * 32 + (int)(r >> 8), q = (int)(r & 255); it = TItem{P.in[I_WE2] + (size_t)mat * 1024 * 1024, wsp<bf16_t>(F, WS_W2) + (size_t)mat * 1024 * 1024, 1024, 1024, (q >> 4) * 64, (q & 15) * 64, 0}; }
    f32x4 v[16]; titem_load(it, v, lane); titem_store(it, v, scr, lane);
}
constexpr int BG_CHUNK = 8, BG_FILL_STRIDE = 4;
DEV void bg_fill(Frame F, const Params& P, unsigned* done, long limit) {
    frame_refresh(F);
    unsigned* head = F.ctl + CW_BGQ; LAS bf16_t* scr = (LAS bf16_t*)(F.lds + F.wave * 16384); const int lane = F.lane;
    if (done && (F.wave % BG_FILL_STRIDE) != 0) return;
#pragma unroll 1
    for (;;) {
        if (done) { if ((unsigned)__builtin_amdgcn_readfirstlane(__hip_atomic_load(done, __ATOMIC_RELAXED, __HIP_MEMORY_SCOPE_AGENT)) >= (unsigned)F.G) break; }
        else { if ((long)(unsigned)__builtin_amdgcn_readfirstlane(__hip_atomic_load(head, __ATOMIC_RELAXED, __HIP_MEMORY_SCOPE_AGENT)) >= limit) break; }
        unsigned base = 0u; if (lane == 0) base = atomicAdd(head, (unsigned)BG_CHUNK);
        base = (unsigned)__builtin_amdgcn_readfirstlane(base);
        if ((long)base >= BG_TOTAL) break;
#pragma unroll 1
        for (int i = 0; i < BG_CHUNK; ++i) if ((long)base + i < BG_TOTAL) bg_item(F, P, (long)base + i, scr, lane);
    }
}
DEV void p0_prologue(Frame F, const Params& P) {
    frame_refresh(F);
    LAS float* scr = (LAS float*)(F.lds + F.wave * 16384);
    const int gw = F.bid * NWAVES + F.wave, NGW = F.G * NWAVES, lane = F.lane;
    LAS bf16_t* scrh = (LAS bf16_t*)scr;
    constexpr long I_E1 = 0, I_E2 = 0, I_BRI = (long)NL * 4 * 64, I_OI = (long)NL * 256, I_C1 = (long)NL * 2 * 32;
    constexpr long I_IN64 = (long)NL * 16 * 104;
    constexpr long N64 = I_E1 + I_E2 + I_BRI + I_OI + I_C1 + I_IN64;
#define P0_DECODE(it, r_) do { long r = (r_); \
        if (r < I_E1) { const int mat = (int)(r >> 9), q = (int)(r & 511); it = TItem{P.in[I_WE1] + (size_t)mat * 1024 * 2048, wsp<bf16_t>(F, WS_W1) + (size_t)mat * 2048 * 1024, 2048, 1024, (q >> 5) * 64, (q & 31) * 64, 0}; break; } \
        r -= I_E1; \
        if (r < I_E2) { const int mat = (int)(r >> 8), q = (int)(r & 255); it = TItem{P.in[I_WE2] + (size_t)mat * 1024 * 1024, wsp<bf16_t>(F, WS_W2) + (size_t)mat * 1024 * 1024, 1024, 1024, (q >> 4) * 64, (q & 15) * 64, 0}; break; } \
        r -= I_E2; \
        if (r < I_BRI) { const int mat = (int)(r >> 6), q = (int)(r & 63); it = TItem{P.in[I_WBR] + (size_t)mat * 256 * 1024, wsp<bf16_t>(F, WS_WBR) + (size_t)mat * 1024 * 256, 1024, 256, (q >> 4) * 64, (q & 15) * 64, 0}; break; } \
        r -= I_BRI; \
        if (r < I_OI) { const int l_ = (int)(r >> 8), q = (int)(r & 255); it = TItem{P.in[I_WO] + (size_t)l_ * 1024 * 1024, wsp<bf16_t>(F, WS_WO) + (size_t)l_ * 1024 * 1024, 1024, 1024, (q >> 4) * 64, (q & 15) * 64, 0}; break; } \
        r -= I_OI; \
        if (r < I_C1) { const int mat = (int)(r >> 5), l_ = mat >> 1, kv = mat & 1; it = TItem{P.in[kv ? I_W1V : I_W1K] + (size_t)l_ * 2048 * 64, wsp<bf16_t>(F, WS_WC1) + (size_t)mat * 64 * 2048, 64, 2048, (int)(r & 31) * 64, 0, kv == 0 ? 1 : 0}; break; } \
        r -= I_C1; \
        { const int l_ = (int)(r / (16 * 104)), q = (int)(r % (16 * 104)); it = TItem{P.in[I_WIN] + (size_t)l_ * 1024 * NIN, wsp<bf16_t>(F, WS_WIN) + (size_t)l_ * NP * 1024, NIN, 1024, (q / 104) * 64, (q % 104) * 64, 2}; } } while (0)
    { f32x4 va[16], vb[16]; TItem ia, ib; long it = gw;
        if (it < N64) { P0_DECODE(ia, it); titem_load(ia, va, lane); }
#pragma unroll 1
        for (; it < N64; it += 2 * (long)NGW) {
            const long i2 = it + NGW, i3 = it + 2 * (long)NGW;
            if (i2 < N64) { P0_DECODE(ib, i2); titem_load(ib, vb, lane); }
            titem_store(ia, va, scrh, lane);
            if (i3 < N64) { P0_DECODE(ia, i3); titem_load(ia, va, lane); }
            if (i2 < N64) titem_store(ib, vb, scrh, lane);
        } }
#undef P0_DECODE
    constexpr long I_C2 = (long)NL * 2 * 2;
    for (long it = gw; it < I_C2; it += NGW) { const long r = it;
        { const int mat = (int)(r >> 1), l = mat >> 1, kv = mat & 1, nb = (int)(r & 1);
            transpose_item(P.in[kv ? I_W2V : I_W2K] + (size_t)l * 64 * 64, 64, wsp<bf16_t>(F, WS_WC2) + (size_t)mat * 64 * 64, 64, 0, nb * 32, scr, lane, IdMap(), IdMap()); }
    }
    const int gt = F.bid * NTHR + F.tid, NGT = F.G * NTHR;
    {
        const float* ws_ = P.in[I_GWS]; bf16_t* wg = wsp<bf16_t>(F, WS_WG);
        for (int i = gt; i < NL * 4 * 128 * 128; i += NGT) { const int s = i & 127, t = (i >> 7) & 127; wg[i] = (s <= t) ? f2bf(ws_[i]) : (bf16_t)0; }
    }
    {
        float* bp = wsp<float>(F, WS_BIN);
        for (int i = gt; i < NL * NP; i += NGT) { const int l = i / NP, c = i % NP, sc = hp_src_col(c); bp[i] = sc >= 0 ? P.in[I_BIN][(size_t)l * NIN + sc] : 0.f; }
    }
    {
        float* cs = wsp<float>(F, WS_CS); const int* pos = (const int*)P.in[I_POS];
        for (int i = gt; i < NT * 8; i += NGT) { const int t = i >> 3, f = i & 7;
            const double ang = (double)pos[t] * P.invf[f];
            const double twopi = 6.283185307179586476925286766559; double r = ang - twopi * rint(ang / twopi);
            const double r2 = r * r; double sn = 0.0, cn = 0.0, term = r;
#pragma unroll 1
            for (int k = 1; k <= 29; k += 2) { sn += term; term *= -r2 / (double)((k + 1) * (k + 2)); }
            term = 1.0;
#pragma unroll 1
            for (int k = 0; k <= 28; k += 2) { cn += term; term *= -r2 / (double)((k + 1) * (k + 2)); }
            cs[(size_t)t * 16 + f] = (float)cn; cs[(size_t)t * 16 + 8 + f] = (float)sn; }
    }
    {
        const f32x4* x4 = (const f32x4*)P.in[I_X]; u32x2* xb = wsp<u32x2>(F, WS_XB);
        for (int i = gt; i < NT * 256; i += NGT) { const f32x4 v = x4[i]; u32x2 w; w.x = pk2(v[0], v[1]); w.y = pk2(v[2], v[3]); xb[i] = w; }
    }
    for (int task = gw; task < NL * 2 * 32; task += NGW) { const int lk = task >> 5, part = task & 31, l = lk >> 1, kv = lk & 1;
        const float* pe = P.in[kv ? I_PEV : I_PEK] + (size_t)l * 2048 + part * 64; const float* w1 = P.in[kv ? I_W1V : I_W1K] + ((size_t)l * 2048 + part * 64) * 64;
        float a = 0.f;
#pragma unroll 16
        for (int k = 0; k < 64; ++k) a += pe[k] * w1[(size_t)k * 64 + lane];
        wsp<float>(F, WS_CB)[task * 64 + lane] = a; }
}

DEV void pb_transpose_unit(Frame F, int unit) {
    frame_refresh(F);
    const int b = unit >> 6, t0 = (unit & 63) * 64; const int tid = F.tid;
    const bf16_t* H = wsp<bf16_t>(F, WS_H); const float* cs = wsp<float>(F, WS_CS);
    const size_t rowb = (size_t)b * SEQ + t0;
    LAS bf16_t* tile = (LAS bf16_t*)F.lds; constexpr int TP = 392;
    LAS unsigned* nmx = (LAS unsigned*)(F.lds + 65536);
    u32x4 rw[2]; f32x4 rc[2], rs[2]; u32x4 vw[6], kw[4];
#pragma unroll
    for (int it = 0; it < 2; ++it) { const int task = tid + it * NTHR, tok = task >> 4, hd = (task >> 3) & 1, ch = task & 7; const size_t row = rowb + tok;
        rw[it] = *(const u32x4*)(H + row * NP + (hd ? HP_KW : HP_KS) + ch * 8);
        const float* c = cs + row * 16 + 4 * (ch & 1); rc[it] = *(const f32x4*)c; rs[it] = *(const f32x4*)(c + 8); }
#pragma unroll
    for (int it = 0; it < 6; ++it) { const int task = tid + it * NTHR, tok = task / 48, ch = task % 48;
        const int scol = ch < 8 ? HP_VS + ch * 8 : (ch < 16 ? HP_VW + (ch - 8) * 8 : HP_FV + (ch - 16) * 8);
        vw[it] = *(const u32x4*)(H + (rowb + tok) * NP + scol); }
    { const int tok = tid >> 3, part = tid & 7;
#pragma unroll
        for (int q = 0; q < 4; ++q) kw[q] = *(const u32x4*)(H + (rowb + tok) * NP + HP_FK + part * 32 + q * 8); }
    if (tid < 4) nmx[tid] = 0u;
#pragma unroll
    for (int it = 0; it < 2; ++it) { const int task = tid + it * NTHR, tok = task >> 4, hd = (task >> 3) & 1, ch = task & 7; const size_t row = rowb + tok;
        u32x4 w = rw[it]; unsigned* wp = (unsigned*)&w;
#pragma unroll
        for (int j = 0; j < 4; ++j) { const float t1 = bflo(wp[j]), t2 = bfhi(wp[j]); const unsigned rot = pk2(t1 * rc[it][j] - t2 * rs[it][j], t2 * rc[it][j] + t1 * rs[it][j]); wp[j] = (ch < 2) ? rot : wp[j]; }
        *(u32x4*)(wsp<bf16_t>(F, WS_KNSA) + row * 128 + hd * 64 + ch * 8) = w; }
#pragma unroll
    for (int it = 0; it < 6; ++it) { const int task = tid + it * NTHR, tok = task / 48, ch = task % 48; const u32x4 w = vw[it];
        *(LAS u32x2*)(tile + tok * TP + ch * 8) = (u32x2){w.x, w.y}; *(LAS u32x2*)(tile + tok * TP + ch * 8 + 4) = (u32x2){w.z, w.w}; }
    __syncthreads();
    { const int part = tid & 7; float ss = 0.f;
#pragma unroll
        for (int q = 0; q < 4; ++q) { const unsigned* wp = (const unsigned*)&kw[q];
#pragma unroll
            for (int j = 0; j < 4; ++j) { const float a = bflo(wp[j]), c = bfhi(wp[j]); ss += a * a + c * c; } }
        ss += __shfl_xor(ss, 1);
        if ((part & 1) == 0) (void)__hip_atomic_fetch_max(nmx + (part >> 1), __float_as_uint(ss), __ATOMIC_RELAXED, __HIP_MEMORY_SCOPE_WORKGROUP); }
    bf16_t* VT = wsp<bf16_t>(F, WS_VT);
#pragma unroll
    for (int it = 0; it < 6; ++it) { const int task = tid + it * NTHR, d = task % 384, sc = task / 384;
        unsigned short v[8];
#pragma unroll
        for (int j = 0; j < 8; ++j) v[j] = tile[(sc * 8 + j) * TP + d];
        u32x4 w; w.x = v[0] | ((unsigned)v[1] << 16); w.y = v[2] | ((unsigned)v[3] << 16); w.z = v[4] | ((unsigned)v[5] << 16); w.w = v[6] | ((unsigned)v[7] << 16);
        *(u32x4*)(VT + ((size_t)b * 384 + d) * SEQ + t0 + sc * 8) = w; }
    __syncthreads();
    if (tid < 4) wsp<float>(F, WS_KN)[((size_t)b * 4 + tid) * 64 + (t0 >> 6)] = sqrtf(__uint_as_float(nmx[tid])) * 1.0001f;
    __syncthreads();
}
DEV void pb_cum_unit(Frame F, int unit) {
    frame_refresh(F);
    const int b = unit >> 2, h = unit & 3, tid = F.tid;
    const float* side = wsp<float>(F, WS_SIDE);
    LAS double* sc = (LAS double*)F.lds;
    double loc[8]; double s = 0.0;
#pragma unroll
    for (int j = 0; j < 8; ++j) { const float x = side[((size_t)b * SEQ + tid * 8 + j) * 16 + 12 + h];
        const float ls = fminf(x, 0.f) - __logf(1.f + __expf(-fabsf(x)));
        s += (double)ls; loc[j] = s; }
    double inc = s;
#pragma unroll
    for (int o = 1; o < 64; o <<= 1) { const double t = __shfl_up(inc, o); if (F.lane >= o) inc += t; }
    if (F.lane == 63) sc[F.wave] = inc;
    __syncthreads();
    double wbase = 0.0;
#pragma unroll
    for (int w = 0; w < 8; ++w) wbase += (w < F.wave) ? sc[w] : 0.0;
    __syncthreads();
    sc[8 + tid] = wbase + inc - s;
    const double base = sc[8 + tid]; float* cum = wsp<float>(F, WS_CUM) + ((size_t)b * 4 + h) * SEQ + tid * 8;
#pragma unroll
    for (int j = 0; j < 8; ++j) cum[j] = (float)((base + loc[j]) * 1.4426950408889634);
    __syncthreads();
}
DEV void pb_conv_unit(Frame F, const Params& P, int l, int unit) {
    frame_refresh(F);
    const int b = unit >> 6, t0 = (unit & 63) * 64, tid = F.tid, lane = F.lane, wave = F.wave;
    const bf16_t* H = wsp<bf16_t>(F, WS_H);
    float w[31]; { const float* cw = P.in[I_CW] + (size_t)l * 31 * 256 + (tid & 255);
#pragma unroll
        for (int j = 0; j < 31; ++j) w[j] = cw[j * 256]; }
    const float bias = P.in[I_CB][l * 256 + (tid & 255)];
    LAS bf16_t* xg = (LAS bf16_t*)F.lds;
    LAS float* cv = (LAS float*)(F.lds + 49152);
    { u32x4 wv[12];
#pragma unroll
        for (int it = 0; it < 12; ++it) { const int task = tid + it * NTHR, r = task >> 6, c4 = (task & 63) * 4; const int t = t0 - 30 + r;
            wv[it] = (task < 94 * 64 && t >= 0) ? *(const u32x4*)(H + ((size_t)b * SEQ + t) * NP + HP_CAB + 2 * c4) : (u32x4){0u, 0u, 0u, 0u}; }
#pragma unroll
        for (int it = 0; it < 12; ++it) { const int task = tid + it * NTHR, r = task >> 6, c4 = (task & 63) * 4;
            if (task < 94 * 64) { const unsigned* wp = (const unsigned*)&wv[it]; float g[4];
#pragma unroll
                for (int j = 0; j < 4; ++j) g[j] = bflo(wp[j]) * sigmoidf_(bfhi(wp[j]));
                *(LAS u32x2*)(xg + r * 256 + c4) = (u32x2){pk2(g[0], g[1]), pk2(g[2], g[3])}; } } }
    __syncthreads();
    { const int c = tid & 255, half = tid >> 8;
        float xw[62];
#pragma unroll
        for (int j = 0; j < 62; ++j) xw[j] = bf2f(xg[(half * 32 + j) * 256 + c]);
#pragma unroll
        for (int tt = 0; tt < 32; ++tt) { float a = bias;
#pragma unroll
            for (int j = 0; j < 31; ++j) a += w[j] * xw[tt + j];
            cv[(half * 32 + tt) * 256 + c] = a; } }
    __syncthreads();
    { const f32x4 gg = *(const f32x4*)(P.in[I_CLNG] + l * 256 + lane * 4), bb = *(const f32x4*)(P.in[I_CLNB] + l * 256 + lane * 4);
        bf16_t* BR = wsp<bf16_t>(F, WS_BR);
#pragma unroll 1
        for (int i = 0; i < 8; ++i) { const int tt = wave * 8 + i; f32x4 v = *(const LAS f32x4*)(cv + tt * 256 + lane * 4);
            const float mean = wave_sum((v[0] + v[1]) + (v[2] + v[3])) * (1.f / 256.f); v = v - mean;
            const float var = wave_sum((v[0] * v[0] + v[1] * v[1]) + (v[2] * v[2] + v[3] * v[3])) * (1.f / 256.f);
            const float rstd = 1.f / sqrtf(var + LN_EPS); v = v * rstd * gg + bb;
#pragma unroll
            for (int j = 0; j < 4; ++j) v[j] = v[j] * sigmoidf_(v[j]);
            u32x2 o; o.x = pk2(v[0], v[1]); o.y = pk2(v[2], v[3]);
            *(u32x2*)(BR + ((size_t)b * SEQ + t0 + tt) * 1024 + 768 + lane * 4) = o; } }
    __syncthreads();
}
DEV void pb_gmlp_unit(Frame F, const Params& P, int l, int unit) {
    frame_refresh(F);
    const int t0 = unit * 128, tid = F.tid, lane = F.lane, wave = F.wave, fr = lane & 15, fq = lane >> 4;
    const bf16_t* H = wsp<bf16_t>(F, WS_H);
    LAS bf16_t* vt = (LAS bf16_t*)F.lds; constexpr int VP = 136;
    { const f32x4 gg = *(const f32x4*)(P.in[I_GLNG] + l * 256 + lane * 4), bb = *(const f32x4*)(P.in[I_GLNB] + l * 256 + lane * 4);
        u32x2 wv[16];
#pragma unroll
        for (int i = 0; i < 16; ++i) wv[i] = *(const u32x2*)(H + (size_t)(t0 + wave * 16 + i) * NP + HP_GV + lane * 4);
#pragma unroll
        for (int i = 0; i < 16; ++i) { const int s = wave * 16 + i; const u32x2 w = wv[i];
            f32x4 v = {gelu_tanh(bflo(w.x)), gelu_tanh(bfhi(w.x)), gelu_tanh(bflo(w.y)), gelu_tanh(bfhi(w.y))};
            const float mean = wave_sum((v[0] + v[1]) + (v[2] + v[3])) * (1.f / 256.f); v = v - mean;
            const float var = wave_sum((v[0] * v[0] + v[1] * v[1]) + (v[2] * v[2] + v[3] * v[3])) * (1.f / 256.f);
            const float rstd = 1.f / sqrtf(var + LN_EPS); v = v * rstd * gg + bb;
#pragma unroll
            for (int j = 0; j < 4; ++j) vt[(lane * 4 + j) * VP + s] = f2bf(v[j]); } }
    __syncthreads();
    { const int g = wave & 3, th = wave >> 2;
        const bf16_t* Wg = wsp<bf16_t>(F, WS_WG) + ((size_t)l * 4 + g) * 128 * 128;
        bf16_t* BR = wsp<bf16_t>(F, WS_BR);
        bf16x8 wf[4][4]; u32x2 uw[4][4]; float bs[4];
#pragma unroll
        for (int tb = 0; tb < 4; ++tb) { const int trow = th * 64 + tb * 16;
#pragma unroll
            for (int ks = 0; ks < 4; ++ks) wf[tb][ks] = (ks * 32 <= trow + 15) ? *(const bf16x8*)(Wg + (size_t)(trow + fr) * 128 + ks * 32 + fq * 8) : (bf16x8){0, 0, 0, 0, 0, 0, 0, 0};
#pragma unroll
            for (int db = 0; db < 4; ++db) uw[tb][db] = *(const u32x2*)(H + (size_t)(t0 + trow + fr) * NP + HP_GU + g * 64 + db * 16 + fq * 4);
            bs[tb] = P.in[I_GBS][((size_t)l * 4 + g) * 128 + trow + fr]; }
#pragma unroll
        for (int tb = 0; tb < 4; ++tb) { const int trow = th * 64 + tb * 16;
            f32x4 acc[4];
#pragma unroll
            for (int db = 0; db < 4; ++db) acc[db] = (f32x4){0.f, 0.f, 0.f, 0.f};
#pragma unroll
            for (int ks = 0; ks < 4; ++ks) if (ks * 32 <= trow + 15) {
#pragma unroll
                for (int db = 0; db < 4; ++db) { const bf16x8 vf = *(const LAS bf16x8*)(vt + (g * 64 + db * 16 + fr) * VP + ks * 32 + fq * 8);
                    acc[db] = mfma16(vf, wf[tb][ks], acc[db]); } }
            const int t = t0 + trow + fr;
#pragma unroll
            for (int db = 0; db < 4; ++db) { const int c = g * 64 + db * 16 + fq * 4; const u32x2 u2 = uw[tb][db]; const float b_ = bs[tb];
                const float o0 = gelu_tanh(bflo(u2.x)) * (acc[db][0] + b_), o1 = gelu_tanh(bfhi(u2.x)) * (acc[db][1] + b_), o2 = gelu_tanh(bflo(u2.y)) * (acc[db][2] + b_), o3 = gelu_tanh(bfhi(u2.y)) * (acc[db][3] + b_);
                u32x2 o; o.x = pk2(o0, o1); o.y = pk2(o2, o3); *(u32x2*)(BR + (size_t)t * 1024 + 512 + c) = o; } } }
    __syncthreads();
}
DEV void pb_compress_unit(Frame F, int l, int unit) {
    frame_refresh(F);
    const int kv = unit & 1, mb = (unit >> 1) & 15, b = unit >> 5; const int tid = F.tid, lane = F.lane, wave = F.wave, fr = lane & 15, fq = lane >> 4;
    const bf16_t* H = wsp<bf16_t>(F, WS_H); const float* cs = wsp<float>(F, WS_CS);
    const bf16_t* W1 = wsp<bf16_t>(F, WS_WC1) + ((size_t)l * 2 + kv) * 64 * 2048; const bf16_t* W2 = wsp<bf16_t>(F, WS_WC2) + ((size_t)l * 2 + kv) * 64 * 64;
    const f32x4 cbv = *(const f32x4*)(wsp<float>(F, WS_CB) + ((size_t)l * 2 + kv) * 32 * 64 + tid * 4);
    LAS float* red = (LAS float*)F.lds;
    LAS bf16_t* h1 = (LAS bf16_t*)(F.lds + 32768);
    f32x4 acc[4];
#pragma unroll
    for (int nb = 0; nb < 4; ++nb) acc[nb] = (f32x4){0.f, 0.f, 0.f, 0.f};
    const int c = mb * 16 + fr;
    { u32x4 aw[8]; f32x4 cco[4], csi[4];
#pragma unroll
        for (int ks_ = 0; ks_ < 8; ++ks_) { const int ks = wave * 8 + ks_; const int j = ks >> 1, dch = (ks & 1) * 32 + fq * 8; int tok = c * 16 + j; tok = tok > SEQ - 1 ? SEQ - 1 : tok;
            const size_t row = (size_t)b * SEQ + tok;
            aw[ks_] = *(const u32x4*)(H + row * NP + (kv ? HP_VC : HP_KC) + dch);
            if ((ks_ & 1) == 0) { const float* cc = cs + row * 16 + ((fq & 1) * 4); cco[ks_ >> 1] = *(const f32x4*)cc; csi[ks_ >> 1] = *(const f32x4*)(cc + 8); } }
#pragma unroll
        for (int hb = 0; hb < 2; ++hb) { bf16x8 bw[4][4];
#pragma unroll
            for (int k4 = 0; k4 < 4; ++k4)
#pragma unroll
                for (int nb = 0; nb < 4; ++nb) bw[k4][nb] = *(const bf16x8*)(W1 + (size_t)(nb * 16 + fr) * 2048 + (wave * 8 + hb * 4 + k4) * 32 + fq * 8);
#pragma unroll
            for (int k4 = 0; k4 < 4; ++k4) { const int ks_ = hb * 4 + k4; u32x4 w = aw[ks_];
                if ((ks_ & 1) == 0) { const bool rp = (kv == 0) && (fq < 2); unsigned* wp = (unsigned*)&w; const f32x4 co = cco[ks_ >> 1], si = csi[ks_ >> 1];
#pragma unroll
                    for (int q = 0; q < 4; ++q) { const float t1 = bflo(wp[q]), t2 = bfhi(wp[q]); const unsigned rot = pk2(t1 * co[q] - t2 * si[q], t2 * co[q] + t1 * si[q]); wp[q] = rp ? rot : wp[q]; } }
                const bf16x8 af = __builtin_bit_cast(bf16x8, w);
#pragma unroll
                for (int nb = 0; nb < 4; ++nb) acc[nb] = mfma16(af, bw[k4][nb], acc[nb]); } } }
#pragma unroll
    for (int nb = 0; nb < 4; ++nb)
#pragma unroll
        for (int i = 0; i < 4; ++i) red[(wave * 16 + fq * 4 + i) * 64 + nb * 16 + fr] = acc[nb][i];
    __syncthreads();
    { LAS float* cbl = (LAS float*)(F.lds + 36864);
        *(LAS f32x4*)(cbl + tid * 4) = cbv;
        __syncthreads();
#pragma unroll
        for (int it = 0; it < 2; ++it) { const int e = tid + it * NTHR, r = e >> 6, n = e & 63; float s = 0.f;
#pragma unroll
            for (int pp = 0; pp < 32; ++pp) s += cbl[pp * 64 + n];
#pragma unroll
            for (int w = 0; w < 8; ++w) s += red[(w * 16 + r) * 64 + n];
            h1[r * 72 + n] = f2bf(gelu_tanh(s)); } }
    __syncthreads();
    if (wave == 0) {
#pragma unroll
        for (int nb = 0; nb < 4; ++nb) { f32x4 o = (f32x4){0.f, 0.f, 0.f, 0.f};
#pragma unroll
            for (int ks = 0; ks < 2; ++ks) { const bf16x8 hf = *(const LAS bf16x8*)(h1 + fr * 72 + ks * 32 + fq * 8); const bf16x8 wf = *(const bf16x8*)(W2 + (size_t)(nb * 16 + fr) * 64 + ks * 32 + fq * 8);
                o = kv ? mfma16(hf, wf, o) : mfma16(wf, hf, o); }
            u32x2 w; w.x = pk2(o[0], o[1]); w.y = pk2(o[2], o[3]);
            if (kv == 0) *(u32x2*)(wsp<bf16_t>(F, WS_KCMP) + ((size_t)b * 256 + mb * 16 + fr) * 64 + nb * 16 + fq * 4) = w;
            else *(u32x2*)(wsp<bf16_t>(F, WS_VCMPT) + ((size_t)b * 64 + nb * 16 + fr) * 256 + mb * 16 + fq * 4) = w; } }
    __syncthreads();
}

constexpr int TILE_B = 9216, AT_KT = 0, AT_VT = 36864, AT_CK = 73728, AT_KC = 0, AT_VC = 36864, AT_XCH = 0, AT_TAB = 32768, AT_FXT = 74752, AT_XST = 77824;
constexpr int KTP = 72, VCP = 264, TABP = 65;
constexpr float QSCALE = 0.125f * LOG2E;
struct FlashSt { float m, l; f32x4 o[4]; };
DEV void flash_init(FlashSt& s) { s.m = -1e30f; s.l = 0.f;
#pragma unroll
    for (int d = 0; d < 4; ++d) s.o[d] = (f32x4){0.f, 0.f, 0.f, 0.f}; }
DEV bf16x8 pack_p(const f32x4& a, const f32x4& b) { u32x4 w; w.x = pk2(a[0], a[1]); w.y = pk2(a[2], a[3]); w.z = pk2(b[0], b[1]); w.w = pk2(b[2], b[3]); return __builtin_bit_cast(bf16x8, w); }
DEV bf16x8 vfrag(const LAS bf16_t* p) { const bf16x4 lo = *(const LAS bf16x4*)p, hi = *(const LAS bf16x4*)(p + 16); return __builtin_shufflevector(lo, hi, 0, 1, 2, 3, 4, 5, 6, 7); }
struct KVFrags { bf16x8 k[4][2]; bf16x8 v[4][2]; };
DEV void load_frags(KVFrags& f, const LAS bf16_t* kt, const LAS bf16_t* vt, int fr, int fq) {
#pragma unroll
    for (int kb = 0; kb < 4; ++kb) { const LAS bf16_t* kp = kt + (16 * kb + fr) * KTP + 8 * fq; f.k[kb][0] = *(const LAS bf16x8*)kp; f.k[kb][1] = *(const LAS bf16x8*)(kp + 32); }
#pragma unroll
    for (int d = 0; d < 4; ++d)
#pragma unroll
        for (int c = 0; c < 2; ++c) f.v[d][c] = vfrag(vt + (16 * d + fr) * KTP + 32 * c + 4 * fq);
}
DEV void qk_frags(f32x4 (&s)[4], const KVFrags& f, const bf16x8 (&qf)[2]) {
#pragma unroll
    for (int kb = 0; kb < 4; ++kb) { f32x4 a = mfma16(f.k[kb][0], qf[0], (f32x4){0.f, 0.f, 0.f, 0.f}); s[kb] = mfma16(f.k[kb][1], qf[1], a); }
}
DEV void flash_update(FlashSt& st, f32x4 (&s)[4], const KVFrags& f, bool on) {
    float mx = fmaxf(fmaxf(fmaxf(s[0][0], s[0][1]), fmaxf(s[0][2], s[0][3])), fmaxf(fmaxf(s[1][0], s[1][1]), fmaxf(s[1][2], s[1][3])));
    mx = fmaxf(mx, fmaxf(fmaxf(fmaxf(s[2][0], s[2][1]), fmaxf(s[2][2], s[2][3])), fmaxf(fmaxf(s[3][0], s[3][1]), fmaxf(s[3][2], s[3][3]))));
    mx = on ? mx : -INFINITY;
    mx = xr_max(mx);
    const float mn = fmaxf(st.m, mx), alpha = fexp2(st.m - mn); st.m = mn;
    const float mref = on ? mn : INFINITY;
    float sum = 0.f;
#pragma unroll
    for (int kb = 0; kb < 4; ++kb)
#pragma unroll
        for (int i = 0; i < 4; ++i) { const float p = fexp2(s[kb][i] - mref); s[kb][i] = p; sum += p; }
    st.l = st.l * alpha + sum;
#pragma unroll
    for (int d = 0; d < 4; ++d) st.o[d] = st.o[d] * alpha;
#pragma unroll
    for (int c = 0; c < 2; ++c) { const bf16x8 pf = pack_p(s[2 * c], s[2 * c + 1]);
#pragma unroll
        for (int d = 0; d < 4; ++d) st.o[d] = mfma16(f.v[d][c], pf, st.o[d]); }
}
DEV float flash_inv_l(const FlashSt& st) { const float l = xr_sum(st.l); return l > 0.f ? 1.f / l : 0.f; }
DEV bf16x8 load_q(const bf16_t* p, const float* c, bool rope, float scale) {
    u32x4 w = *(const u32x4*)p; unsigned* wp = (unsigned*)&w;
    f32x4 co = {1.f, 1.f, 1.f, 1.f}, si = {0.f, 0.f, 0.f, 0.f};
    if (c) { co = *(const f32x4*)c; si = *(const f32x4*)(c + 8); }
#pragma unroll
    for (int j = 0; j < 4; ++j) { const float t1 = bflo(wp[j]), t2 = bfhi(wp[j]);
        const float a = rope ? t1 * co[j] - t2 * si[j] : t1, bq = rope ? t2 * co[j] + t1 * si[j] : t2;
        wp[j] = pk2(a * scale, bq * scale); }
    return __builtin_bit_cast(bf16x8, w);
}
struct TileRegs { u32x4 k, v; };
DEV void tile_load(TileRegs& r, const bf16_t* kbase, size_t kpitch, const bf16_t* vtbase, int key0, int tid) {
    r.k = *(const u32x4*)(kbase + (size_t)(key0 + (tid >> 3)) * kpitch + (tid & 7) * 8);
    r.v = *(const u32x4*)(vtbase + (size_t)(tid >> 3) * SEQ + key0 + (tid & 7) * 8);
}
DEV void tile_store(const TileRegs& r, LAS bf16_t* kt, LAS bf16_t* vt, int tid) {
    *(LAS u32x4*)(kt + (tid >> 3) * KTP + (tid & 7) * 8) = r.k; *(LAS u32x4*)(vt + (tid >> 3) * KTP + (tid & 7) * 8) = r.v;
}

DEV void nsa_unit(Frame F, int b, int qt, int half) {
    frame_refresh(F);
    const int tid = F.tid, lane = F.lane, wave = F.wave, fr = lane & 15, fq = lane >> 4, sq = wave & 1, hp = (wave >> 1) & 1, ks = wave >> 2, head = 2 * hp + ks, qid = wave >> 1;
    const int ql = 32 * half + 16 * sq + fr, tq = qt * 64 + ql, cur = qt; const size_t rowq = (size_t)b * SEQ + tq;
    const bf16_t* H = wsp<bf16_t>(F, WS_H); const float* cs = wsp<float>(F, WS_CS); const float* side = wsp<float>(F, WS_SIDE);
    LAS bf16_t* KT = (LAS bf16_t*)(F.lds + AT_KT); LAS bf16_t* VT = (LAS bf16_t*)(F.lds + AT_VT);
    LAS bf16_t* KC = (LAS bf16_t*)(F.lds + AT_KC); LAS bf16_t* VC = (LAS bf16_t*)(F.lds + AT_VC);
    bf16x8 qf2[2][2], qf[2]; float gate[3];
#pragma unroll
    for (int hh = 0; hh < 2; ++hh)
#pragma unroll
        for (int dc = 0; dc < 2; ++dc) qf2[hh][dc] = load_q(H + rowq * NP + HP_NQ + (2 * hp + hh) * 64 + 32 * dc + 8 * fq, cs + rowq * 16 + 4 * (fq & 1), dc == 0 && fq < 2, QSCALE);
#pragma unroll
    for (int dc = 0; dc < 2; ++dc) qf[dc] = ks ? qf2[1][dc] : qf2[0][dc];
#pragma unroll
    for (int i = 0; i < 3; ++i) gate[i] = sigmoidf_(side[rowq * 16 + head * 3 + i]);
    { const bf16_t* kc = wsp<bf16_t>(F, WS_KCMP) + (size_t)b * 256 * 64; const bf16_t* vc = wsp<bf16_t>(F, WS_VCMPT) + (size_t)b * 64 * 256;
#pragma unroll
        for (int it = 0; it < 4; ++it) { const int id = tid + it * NTHR;
            *(LAS u32x4*)(KC + (id >> 3) * KTP + (id & 7) * 8) = *(const u32x4*)(kc + (size_t)id * 8);
            *(LAS u32x4*)(VC + (id >> 5) * VCP + (id & 31) * 8) = *(const u32x4*)(vc + (size_t)id * 8); } }
    __syncthreads();
    f32x4 res[4]; float imp[16];
    const int nkb = (4 * qt + 2 * half) / 16 + 1;
    const int cl = (tq - 31) >> 4;
    const int srcl = (lane - 16) & 63;
    {
        f32x4 sc[16]; float mx = -1e30f;
#pragma unroll
        for (int kb = 0; kb < 16; ++kb) {
            if (kb < nkb) { const LAS bf16_t* kp = KC + (16 * kb + fr) * KTP + 8 * fq;
                f32x4 a = mfma16(*(const LAS bf16x8*)kp, qf[0], (f32x4){0.f, 0.f, 0.f, 0.f}); a = mfma16(*(const LAS bf16x8*)(kp + 32), qf[1], a);
#pragma unroll
                for (int i = 0; i < 4; ++i) { a[i] = (16 * kb + 4 * fq + i <= cl) ? a[i] : -INFINITY; mx = fmaxf(mx, a[i]); }
                sc[kb] = a; }
            else sc[kb] = (f32x4){-INFINITY, -INFINITY, -INFINITY, -INFINITY}; }
        mx = xr_max(mx);
        float sum = 0.f;
#pragma unroll
        for (int kb = 0; kb < 16; ++kb) if (kb < nkb) {
#pragma unroll
            for (int i = 0; i < 4; ++i) { const float p = fexp2(sc[kb][i] - mx); sc[kb][i] = p; sum += p; } }
        else sc[kb] = (f32x4){0.f, 0.f, 0.f, 0.f};
        sum = xr_sum(sum);
        const float inv = sum > 0.f ? 1.f / sum : 0.f;
        f32x4 o[4];
#pragma unroll
        for (int d = 0; d < 4; ++d) o[d] = (f32x4){0.f, 0.f, 0.f, 0.f};
        float prevx = 0.f;
#pragma unroll
        for (int kb = 0; kb < 16; ++kb) { if (kb < nkb) { sc[kb] = sc[kb] * inv; const float x = __shfl(sc[kb][3], srcl);
                imp[kb] = ((sc[kb][0] + sc[kb][1]) + (sc[kb][2] + sc[kb][3])) + (fq > 0 ? x : prevx); prevx = x; }
            else imp[kb] = 0.f; }
#pragma unroll
        for (int cc = 0; cc < 8; ++cc) if (2 * cc < nkb) { const bf16x8 pf = pack_p(sc[2 * cc], sc[2 * cc + 1]);
#pragma unroll
            for (int d = 0; d < 4; ++d) o[d] = mfma16(vfrag(VC + (16 * d + fr) * VCP + 32 * cc + 4 * fq), pf, o[d]); }
#pragma unroll
        for (int d = 0; d < 4; ++d) res[d] = o[d] * gate[0];
    }
    unsigned mlo, mhi;
    if (cur < 16) { mlo = (2u << cur) - 1u; mhi = 0u; }
    else {
        LAS float* XCH = (LAS float*)(F.lds + AT_XCH); LAS float* TAB = (LAS float*)(F.lds + AT_TAB) + (wave * 16 + fr) * TABP;
        __syncthreads();
#pragma unroll
        for (int kb = 0; kb < 16; ++kb) XCH[(wave * 16 + kb) * 64 + lane] = imp[kb];
        __syncthreads();
#pragma unroll
        for (int kb = 0; kb < 16; ++kb) { const int j = 4 * kb + fq;
            float v = (XCH[((0 + sq) * 16 + kb) * 64 + lane] + XCH[((2 + sq) * 16 + kb) * 64 + lane]) + (XCH[((4 + sq) * 16 + kb) * 64 + lane] + XCH[((6 + sq) * 16 + kb) * 64 + lane]);
            const bool forced = (j == 0) || (j == cur) || (j == cur - 1);
            v = forced ? 1e9f : (j <= cur ? v : -1.f); imp[kb] = v; TAB[j] = v; }
        LDS_WAIT();
        int cnt[4];
#pragma unroll
        for (int k4 = 0; k4 < 4; ++k4) cnt[k4] = 0;
        float myv[4];
#pragma unroll
        for (int k4 = 0; k4 < 4; ++k4) myv[k4] = qid == 0 ? imp[k4] : (qid == 1 ? imp[4 + k4] : (qid == 2 ? imp[8 + k4] : imp[12 + k4]));
#pragma unroll 4
        for (int jj = 0; jj < 64; ++jj) { const float vv = TAB[jj];
#pragma unroll
            for (int k4 = 0; k4 < 4; ++k4) { const int j = 4 * (4 * qid + k4) + fq; cnt[k4] += ((vv > myv[k4]) || (vv == myv[k4] && jj < j)) ? 1 : 0; } }
        mlo = 0u; mhi = 0u;
#pragma unroll
        for (int k4 = 0; k4 < 4; ++k4) { const int j = 4 * (4 * qid + k4) + fq; const unsigned bit = (cnt[k4] < 16 && j <= cur) ? 1u : 0u; if (j < 32) mlo |= bit << (j & 31); else mhi |= bit << (j & 31); }
        mlo = xr_or(mlo); mhi = xr_or(mhi);
        LAS unsigned* MSK = (LAS unsigned*)(F.lds + AT_CK);
        if (fq == 0) { MSK[(wave * 16 + fr) * 2] = mlo; MSK[(wave * 16 + fr) * 2 + 1] = mhi; }
        __syncthreads();
        mlo = (MSK[((0 + sq) * 16 + fr) * 2] | MSK[((2 + sq) * 16 + fr) * 2]) | (MSK[((4 + sq) * 16 + fr) * 2] | MSK[((6 + sq) * 16 + fr) * 2]);
        mhi = (MSK[((0 + sq) * 16 + fr) * 2 + 1] | MSK[((2 + sq) * 16 + fr) * 2 + 1]) | (MSK[((4 + sq) * 16 + fr) * 2 + 1] | MSK[((6 + sq) * 16 + fr) * 2 + 1]);
    }
    __syncthreads();
#pragma unroll 1
    for (int br = 0; br < 2; ++br) {
        const bf16_t* kbase = wsp<bf16_t>(F, WS_KNSA) + (size_t)b * SEQ * 128 + br * 64;
        const bf16_t* vtb = wsp<bf16_t>(F, WS_VT) + ((size_t)b * 384 + br * 64) * SEQ;
        const int j0 = br == 0 ? 0 : (qt > 8 ? qt - 8 : 0);
        const int np = (cur - j0 + 2) >> 1;
        FlashSt st2[2]; flash_init(st2[0]); flash_init(st2[1]);
        TileRegs ra[2], rb[2];
#define NSA_LOADP(R, p) do { _Pragma("unroll") for (int tt_ = 0; tt_ < 2; ++tt_) { const int j_ = j0 + 2 * (p) + tt_; if (j_ <= cur) tile_load(R[tt_], kbase, 128, vtb, j_ * 64, tid); } } while (0)
#define NSA_STOREP(R, p, buf) do { _Pragma("unroll") for (int tt_ = 0; tt_ < 2; ++tt_) { const int j_ = j0 + 2 * (p) + tt_; if (j_ <= cur) tile_store(R[tt_], KT + ((buf) * 2 + tt_) * 64 * KTP, VT + ((buf) * 2 + tt_) * 64 * KTP, tid); } } while (0)
#define NSA_COMPP(p, buf) do { const int j = j0 + 2 * (p) + ks; if (j <= cur) { \
            const LAS bf16_t* kt = KT + ((buf) * 2 + ks) * 64 * KTP; const LAS bf16_t* vt = VT + ((buf) * 2 + ks) * 64 * KTP; \
            const bool on = (br == 0) ? (((j < 32 ? (mlo >> j) : (mhi >> (j - 32))) & 1u) != 0u) : true; \
            if (__any(on)) { KVFrags fg; load_frags(fg, kt, vt, fr, fq); asm volatile("" ::: "memory"); \
                const bool edge = (j == cur) || (br == 1 && j == qt - 8); const int hi = (j == cur) ? ql : 63, lo = (br == 1 && j == qt - 8) ? ql : -1; \
                _Pragma("unroll") for (int hh = 0; hh < 2; ++hh) { f32x4 s[4]; qk_frags(s, fg, qf2[hh]); \
                    if (edge) { _Pragma("unroll") for (int kb = 0; kb < 4; ++kb) _Pragma("unroll") for (int i = 0; i < 4; ++i) { const int kl = 16 * kb + 4 * fq + i; s[kb][i] = (kl <= hi && kl > lo) ? s[kb][i] : -INFINITY; } } \
                    flash_update(st2[hh], s, fg, on); } } } } while (0)
        NSA_LOADP(ra, 0); NSA_LOADP(rb, 1);
#pragma unroll 1
        for (int p = 0; p < np; p += 2) {
            NSA_STOREP(ra, p, 0); __syncthreads(); NSA_LOADP(ra, p + 2); NSA_COMPP(p, 0);
            if (p + 1 < np) { NSA_STOREP(rb, p + 1, 1); __syncthreads(); NSA_LOADP(rb, p + 3); NSA_COMPP(p + 1, 1); }
        }
#undef NSA_LOADP
#undef NSA_STOREP
#undef NSA_COMPP
        { LAS float* XS = (LAS float*)(F.lds + AT_XST) + wave * (18 * 64) + lane;
            XS[0] = ks ? st2[0].m : st2[1].m; XS[64] = ks ? st2[0].l : st2[1].l;
#pragma unroll
            for (int d = 0; d < 4; ++d)
#pragma unroll
                for (int i = 0; i < 4; ++i) XS[(2 + 4 * d + i) * 64] = ks ? st2[0].o[d][i] : st2[1].o[d][i];
            __syncthreads();
            const LAS float* XP = (const LAS float*)(F.lds + AT_XST) + (wave ^ 4) * (18 * 64) + lane;
            FlashSt st; st.m = ks ? st2[1].m : st2[0].m; st.l = ks ? st2[1].l : st2[0].l;
#pragma unroll
            for (int d = 0; d < 4; ++d) st.o[d] = ks ? st2[1].o[d] : st2[0].o[d];
            const float mb = XP[0], lb = XP[64]; const float m = fmaxf(st.m, mb), fa = fexp2(st.m - m), fb = fexp2(mb - m);
            st.l = st.l * fa + lb * fb;
#pragma unroll
            for (int d = 0; d < 4; ++d)
#pragma unroll
                for (int i = 0; i < 4; ++i) st.o[d][i] = st.o[d][i] * fa + XP[(2 + 4 * d + i) * 64] * fb;
            const float sc = flash_inv_l(st) * (br == 0 ? gate[1] : gate[2]);
#pragma unroll
            for (int d = 0; d < 4; ++d) res[d] += st.o[d] * sc; }
        __syncthreads();
    }
    bf16_t* BR = wsp<bf16_t>(F, WS_BR);
#pragma unroll
    for (int d = 0; d < 4; ++d) { u32x2 w; w.x = pk2(res[d][0], res[d][1]); w.y = pk2(res[d][2], res[d][3]);
        *(u32x2*)(BR + rowq * 1024 + head * 64 + 16 * d + 4 * fq) = w; }
}

DEV void fox_unit(Frame F, int b, int h, int qb) {
    frame_refresh(F);
    const int tid = F.tid, lane = F.lane, wave = F.wave, fr = lane & 15, fq = lane >> 4;
    const int q0 = qb * 256, qw = q0 + 32 * wave;
    const bf16_t* H = wsp<bf16_t>(F, WS_H); const float* cum = wsp<float>(F, WS_CUM) + ((size_t)b * 4 + h) * SEQ;
    LAS bf16_t* KT = (LAS bf16_t*)(F.lds + AT_KT); LAS bf16_t* VT = (LAS bf16_t*)(F.lds + AT_VT); LAS float* CK = (LAS float*)(F.lds + AT_CK);
    LAS float* KNP = (LAS float*)(F.lds + AT_FXT); LAS float* CKL = KNP + 64; LAS float* WMIN = KNP + 128; LAS float* WQN = KNP + 136;
    const float cref = cum[q0];
    bf16x8 qf[2][2]; float qn2 = 0.f;
#pragma unroll
    for (int sb = 0; sb < 2; ++sb) { float ss = 0.f;
#pragma unroll
        for (int dc = 0; dc < 2; ++dc) { qf[sb][dc] = load_q(H + ((size_t)b * SEQ + qw + 16 * sb + fr) * NP + HP_FQ + h * 64 + 32 * dc + 8 * fq, nullptr, false, QSCALE);
            const u32x4 w = __builtin_bit_cast(u32x4, qf[sb][dc]); const unsigned* wp = (const unsigned*)&w;
#pragma unroll
            for (int j = 0; j < 4; ++j) { const float a = bflo(wp[j]), c = bfhi(wp[j]); ss += a * a + c * c; } }
        ss = xr_sum(ss); qn2 = fmaxf(qn2, ss); }
#pragma unroll
    for (int o = 1; o < 16; o <<= 1) qn2 = fmaxf(qn2, __shfl_xor(qn2, o));
    if (lane == 0) WQN[wave] = sqrtf(qn2) * 1.0001f;
    if (tid < 64) {
        float kn = wsp<float>(F, WS_KN)[((size_t)b * 4 + h) * 64 + tid];
#pragma unroll
        for (int o = 1; o < 64; o <<= 1) { const float t = __shfl_up(kn, o); if (tid >= o) kn = fmaxf(kn, t); }
        KNP[tid] = kn; CKL[tid] = cum[64 * tid + 63] - cref; }
    const bf16_t* kbase = H + (size_t)b * SEQ * NP + HP_FK + h * 64; const bf16_t* vtb = wsp<bf16_t>(F, WS_VT) + ((size_t)b * 384 + 128 + h * 64) * SEQ;
    FlashSt st[2]; flash_init(st[0]); flash_init(st[1]);
    __syncthreads();
    int np = 2;
    { float qn = WQN[0];
#pragma unroll
        for (int w = 1; w < 8; ++w) qn = fmaxf(qn, WQN[w]);
        const float wk = wsp<float>(F, WS_KN)[((size_t)b * 4 + h) * 64 + 4 * qb + (lane & 3)];
        float kown = fmaxf(wk, __shfl_xor(wk, 1)); kown = fmaxf(kown, __shfl_xor(kown, 2)); kown = __shfl(kown, 0);
        const float thr = -qn * kown - 40.f;
#pragma unroll 1
        for (int Jn = 4 * qb - 1; Jn >= 0; Jn -= 2) { if (qn * KNP[Jn] - CKL[Jn] < thr) break; ++np; } }
    np = __builtin_amdgcn_readfirstlane(np);
#define FOX_TILE(p, tt) ((p) < 2 ? 4 * qb + 2 * (p) + (tt) : 4 * qb - 1 - 2 * ((p) - 2) - (tt))
    TileRegs ra[2], rb[2]; f32x4 cka[2], ckb[2];
#define FOX_LOADP(R, C, p) do { if ((p) < np) { _Pragma("unroll") for (int tt_ = 0; tt_ < 2; ++tt_) { const int j_ = FOX_TILE(p, tt_); if (j_ >= 0) { tile_load(R[tt_], kbase, NP, vtb, j_ * 64, tid); if (tid < 16) C[tt_] = *(const f32x4*)(cum + j_ * 64 + 4 * tid); } } } } while (0)
#define FOX_STOREP(R, C, p, buf) do { _Pragma("unroll") for (int tt_ = 0; tt_ < 2; ++tt_) { const int j_ = FOX_TILE(p, tt_); if (j_ >= 0) { tile_store(R[tt_], KT + ((buf) * 2 + tt_) * 64 * KTP, VT + ((buf) * 2 + tt_) * 64 * KTP, tid); \
            if (tid < 16) *(LAS f32x4*)(CK + ((buf) * 2 + tt_) * 64 + 4 * tid) = C[tt_] - cref; } } } while (0)
#define FOX_COMPP(p, buf) do { _Pragma("unroll") for (int tt_ = 0; tt_ < 2; ++tt_) { const int J = FOX_TILE(p, tt_); const int key0 = 64 * J; if (J >= 0 && key0 <= qw + 31) { \
            const LAS bf16_t* kt = KT + ((buf) * 2 + tt_) * 64 * KTP; const LAS bf16_t* vt = VT + ((buf) * 2 + tt_) * 64 * KTP; const LAS float* ck = CK + ((buf) * 2 + tt_) * 64; \
            KVFrags fg; load_frags(fg, kt, vt, fr, fq); \
            f32x4 dk[4]; _Pragma("unroll") for (int kb = 0; kb < 4; ++kb) dk[kb] = *(const LAS f32x4*)(ck + 16 * kb + 4 * fq); \
            asm volatile("" ::: "memory"); \
            const bool diag = key0 + 63 > qw; \
            _Pragma("unroll") for (int sb = 0; sb < 2; ++sb) { f32x4 s[4]; qk_frags(s, fg, qf[sb]); const int qa = qw + 16 * sb + fr; \
                _Pragma("unroll") for (int kb = 0; kb < 4; ++kb) { s[kb] = s[kb] - dk[kb]; \
                    if (diag) { _Pragma("unroll") for (int i = 0; i < 4; ++i) s[kb][i] = (key0 + 16 * kb + 4 * fq + i <= qa) ? s[kb][i] : -INFINITY; } } \
                flash_update(st[sb], s, fg, true); } } } } while (0)
    FOX_LOADP(ra, cka, 0); FOX_LOADP(rb, ckb, 1);
#pragma unroll 1
    for (int p = 0; p < np; p += 2) {
        FOX_STOREP(ra, cka, p, 0); __syncthreads(); FOX_LOADP(ra, cka, p + 2); FOX_COMPP(p, 0);
        if (p + 1 < np) { FOX_STOREP(rb, ckb, p + 1, 1); __syncthreads(); FOX_LOADP(rb, ckb, p + 3); FOX_COMPP(p + 1, 1); }
    }
#undef FOX_TILE
#undef FOX_LOADP
#undef FOX_STOREP
#undef FOX_COMPP
    bf16_t* BR = wsp<bf16_t>(F, WS_BR);
#pragma unroll
    for (int sb = 0; sb < 2; ++sb) { const float sc = flash_inv_l(st[sb]); const size_t row = (size_t)b * SEQ + qw + 16 * sb + fr;
#pragma unroll
        for (int d = 0; d < 4; ++d) { const f32x4 o = st[sb].o[d] * sc; u32x2 w; w.x = pk2(o[0], o[1]); w.y = pk2(o[2], o[3]);
            *(u32x2*)(BR + row * 1024 + 256 + h * 64 + 16 * d + 4 * fq) = w; } }
    __syncthreads();
}

DEV void ln1_router_phase(Frame F, const Params& P, int l) {
    frame_refresh(F);
    const int tid = F.tid, lane = F.lane, wave = F.wave, fr = lane & 15, fq = lane >> 4;
    LAS float* xs = (LAS float*)F.lds;
    LAS float* part = (LAS float*)(F.lds + 69632);
    constexpr int XP = 1028;
    const bf16_t* mix = wsp<bf16_t>(F, WS_MIX); bf16_t* xb = wsp<bf16_t>(F, WS_XB);
    const float* g1 = P.in[I_LN1G] + (size_t)l * 1024; const float* b1 = P.in[I_LN1B] + (size_t)l * 1024;
    float wf[2][32];
    { const float* wr = P.in[I_WR] + (size_t)l * 1024 * 32 + (size_t)(128 * wave + 32 * fq) * 32 + fr;
#pragma unroll
        for (int s_ = 0; s_ < 32; ++s_) { wf[0][s_] = wr[s_ * 32]; wf[1][s_] = wr[s_ * 32 + 16]; } }
    const float brt = P.in[I_BR][l * 32 + (tid & 31)];
    unsigned* cnt = F.ctl + CW_CNT + l * 32 * 64; int* rowtk = wsp<int>(F, WS_ROWTK); float* tokw = wsp<float>(F, WS_TOKW);
    LAS unsigned* lcnt = (LAS unsigned*)(F.lds + 90112);
    LAS unsigned* lsel = lcnt + 64;
    if (tid < 64) lcnt[tid] = 0u;
    int nsel = 0;
    __syncthreads();
    u32x4 va[2][2], vm[2][2];
    f32x4 gg1[2][2], bb1[2][2];
#pragma unroll
    for (int j = 0; j < 2; ++j)
#pragma unroll
        for (int h = 0; h < 2; ++h) { gg1[j][h] = *(const f32x4*)(g1 + j * 512 + lane * 8 + 4 * h); bb1[j][h] = *(const f32x4*)(b1 + j * 512 + lane * 8 + 4 * h); }
    int unit = F.bid;
    if (unit < NT / 16) {
#pragma unroll
        for (int i = 0; i < 2; ++i)
#pragma unroll
            for (int j = 0; j < 2; ++j) { const size_t o = (size_t)(unit * 16 + wave * 2 + i) * 1024 + j * 512 + lane * 8; va[i][j] = *(const u32x4*)(xb + o); vm[i][j] = *(const u32x4*)(mix + o); } }
#pragma unroll 1
    for (; unit < NT / 16; unit += F.G) {
        const int r0 = unit * 16;
#pragma unroll
        for (int i = 0; i < 2; ++i) { const int r = wave * 2 + i; const size_t row = (size_t)(r0 + r);
            f32x4 v[2][2]; float s = 0.f;
#pragma unroll
            for (int j = 0; j < 2; ++j) { const unsigned* xp_ = (const unsigned*)&va[i][j]; const unsigned* mp_ = (const unsigned*)&vm[i][j];
#pragma unroll
                for (int h = 0; h < 2; ++h) { const f32x4 xa = {bflo(xp_[2 * h]), bfhi(xp_[2 * h]), bflo(xp_[2 * h + 1]), bfhi(xp_[2 * h + 1])}, ma = {bflo(mp_[2 * h]), bfhi(mp_[2 * h]), bflo(mp_[2 * h + 1]), bfhi(mp_[2 * h + 1])};
                    v[j][h] = xa * DN_ALPHA + ma; s += (v[j][h][0] + v[j][h][1]) + (v[j][h][2] + v[j][h][3]); } }
            const float mean = wave_sum(s) * (1.f / 1024.f); float q = 0.f;
#pragma unroll
            for (int j = 0; j < 2; ++j)
#pragma unroll
                for (int h = 0; h < 2; ++h) { v[j][h] = v[j][h] - mean; q += (v[j][h][0] * v[j][h][0] + v[j][h][1] * v[j][h][1]) + (v[j][h][2] * v[j][h][2] + v[j][h][3] * v[j][h][3]); }
            const float rstd = 1.f / sqrtf(wave_sum(q) * (1.f / 1024.f) + LN_EPS);
#pragma unroll
            for (int j = 0; j < 2; ++j) { const f32x4 o0 = v[j][0] * rstd * gg1[j][0] + bb1[j][0], o1 = v[j][1] * rstd * gg1[j][1] + bb1[j][1];
                *(LAS f32x4*)(xs + r * XP + j * 512 + lane * 8) = o0; *(LAS f32x4*)(xs + r * XP + j * 512 + lane * 8 + 4) = o1;
                u32x4 w; w.x = pk2(o0[0], o0[1]); w.y = pk2(o0[2], o0[3]); w.z = pk2(o1[0], o1[1]); w.w = pk2(o1[2], o1[3]); *(u32x4*)(xb + row * 1024 + j * 512 + lane * 8) = w; } }
        { const int un = unit + F.G;
            if (un < NT / 16) {
#pragma unroll
                for (int i = 0; i < 2; ++i)
#pragma unroll
                    for (int j = 0; j < 2; ++j) { const size_t o = (size_t)(un * 16 + wave * 2 + i) * 1024 + j * 512 + lane * 8; va[i][j] = *(const u32x4*)(xb + o); vm[i][j] = *(const u32x4*)(mix + o); } } }
        __syncthreads();
        { f32x4 c0 = (f32x4){0.f, 0.f, 0.f, 0.f}, c1 = c0; const LAS float* xp = xs + fr * XP + 128 * wave + 32 * fq;
#pragma unroll
            for (int s4 = 0; s4 < 8; ++s4) { const f32x4 xa = *(const LAS f32x4*)(xp + 4 * s4);
#pragma unroll
                for (int i = 0; i < 4; ++i) { c0 = __builtin_amdgcn_mfma_f32_16x16x4f32(xa[i], wf[0][4 * s4 + i], c0, 0, 0, 0); c1 = __builtin_amdgcn_mfma_f32_16x16x4f32(xa[i], wf[1][4 * s4 + i], c1, 0, 0, 0); } }
#pragma unroll
            for (int i = 0; i < 4; ++i) { part[(wave * 16 + 4 * fq + i) * 32 + fr] = c0[i]; part[(wave * 16 + 4 * fq + i) * 32 + 16 + fr] = c1[i]; } }
        __syncthreads();
        { const int r = tid >> 5, e = tid & 31; float v = brt;
#pragma unroll
            for (int w = 0; w < 8; ++w) v += part[(w * 16 + r) * 32 + e];
            float bv[4]; int bi[4]; float cur = v;
#define DPP_F(x, ctrl) __builtin_bit_cast(float, __builtin_amdgcn_update_dpp(0, __builtin_bit_cast(int, (x)), (ctrl), 0xf, 0xf, true))
#define DPP_I(x, ctrl) __builtin_amdgcn_update_dpp(0, (x), (ctrl), 0xf, 0xf, true)
#define ARGMAX_STEP(OV, OI) do { const float ov_ = (OV); const int oi_ = (OI); const bool take_ = (ov_ > mv) || (ov_ == mv && oi_ < mi); mv = take_ ? ov_ : mv; mi = take_ ? oi_ : mi; } while (0)
#pragma unroll
            for (int k = 0; k < 4; ++k) { float mv = cur; int mi = e;
                ARGMAX_STEP(DPP_F(mv, 0xB1), DPP_I(mi, 0xB1));
                ARGMAX_STEP(DPP_F(mv, 0x4E), DPP_I(mi, 0x4E));
                ARGMAX_STEP(DPP_F(mv, 0x141), DPP_I(mi, 0x141));
                ARGMAX_STEP(DPP_F(mv, 0x140), DPP_I(mi, 0x140));
                { const auto rv_ = __builtin_amdgcn_permlane16_swap(__float_as_uint(mv), __float_as_uint(mv), false, false); const auto ri_ = __builtin_amdgcn_permlane16_swap((unsigned)mi, (unsigned)mi, false, false);
                    mv = __uint_as_float(rv_[0]); mi = (int)ri_[0]; ARGMAX_STEP(__uint_as_float(rv_[1]), (int)ri_[1]); }
                bv[k] = mv; bi[k] = mi; if (e == mi) cur = -INFINITY; }
#undef DPP_F
#undef DPP_I
#undef ARGMAX_STEP
            if (e < 4) { float ex[4], sum = 0.f;
#pragma unroll
                for (int k = 0; k < 4; ++k) { ex[k] = __expf(bv[k] - bv[0]); sum += ex[k]; }
                const int k = e; const int t = r0 + r; const int ide = k == 0 ? bi[0] : (k == 1 ? bi[1] : (k == 2 ? bi[2] : bi[3])); const float exk = k == 0 ? ex[0] : (k == 1 ? ex[1] : (k == 2 ? ex[2] : ex[3]));
                const unsigned ls = __hip_atomic_fetch_add(lcnt + ide, 1u, __ATOMIC_RELAXED, __HIP_MEMORY_SCOPE_WORKGROUP);
                const int li = nsel + r * 4 + k; lsel[2 * li] = ((unsigned)ide << 24) | ls; lsel[2 * li + 1] = (unsigned)(t * 4 + k); tokw[t * 4 + k] = exk / sum; } }
        nsel += 64;
        __syncthreads();
    }
    if (tid < 32) { const unsigned c = lcnt[tid]; lcnt[32 + tid] = c ? atomicAdd(cnt + tid * 64, c) : 0u; }
    __syncthreads();
    for (int i = tid; i < nsel; i += NTHR) { const unsigned a = lsel[2 * i], tk = lsel[2 * i + 1]; const unsigned e = a >> 24; rowtk[(size_t)e * NT + lcnt[32 + e] + (a & 0xffffffu)] = (int)tk; }
    __syncthreads();
}
DEV void ln2_rows(Frame F, const Params& P, int l) {
    frame_refresh(F);
    const int lane = F.lane; const int gw = F.bid * NWAVES + F.wave, NGW = F.G * NWAVES;
    bf16_t* xb = wsp<bf16_t>(F, WS_XB); const bf16_t* yb = wsp<bf16_t>(F, WS_YBUF); const float* tokw = wsp<float>(F, WS_TOKW);
    const float* g2 = P.in[I_LN2G] + (size_t)l * 1024; const float* b2 = P.in[I_LN2B] + (size_t)l * 1024;
    float* dst = (l == NL - 1) ? P.out : nullptr;
    f32x4 wkn; u32x4 xn[2]; u32x4 yn[2][4];
#define LN2_LOAD(row_) do { wkn = *(const f32x4*)(tokw + (size_t)(row_) * 4); _Pragma("unroll") for (int j = 0; j < 2; ++j) { xn[j] = *(const u32x4*)(xb + (size_t)(row_) * 1024 + j * 512 + lane * 8); \
        _Pragma("unroll") for (int k = 0; k < 4; ++k) yn[j][k] = *(const u32x4*)(yb + ((size_t)(row_) * 4 + k) * 1024 + j * 512 + lane * 8); } } while (0)
    f32x4 gg[2][2], bb[2][2];
#pragma unroll
    for (int j = 0; j < 2; ++j)
#pragma unroll
        for (int h = 0; h < 2; ++h) { gg[j][h] = *(const f32x4*)(g2 + j * 512 + lane * 8 + 4 * h); bb[j][h] = *(const f32x4*)(b2 + j * 512 + lane * 8 + 4 * h); }
    if (gw < NT) LN2_LOAD(gw);
#pragma unroll 1
    for (int row = gw; row < NT; row += NGW) {
        const f32x4 wk = wkn;
        f32x4 v[2][2]; float s = 0.f;
#pragma unroll
        for (int j = 0; j < 2; ++j) { const unsigned* xp = (const unsigned*)&xn[j];
            f32x4 a0 = (f32x4){bflo(xp[0]), bfhi(xp[0]), bflo(xp[1]), bfhi(xp[1])} * DN_ALPHA, a1 = (f32x4){bflo(xp[2]), bfhi(xp[2]), bflo(xp[3]), bfhi(xp[3])} * DN_ALPHA;
#pragma unroll
            for (int k = 0; k < 4; ++k) { const unsigned* yp = (const unsigned*)&yn[j][k]; const float w = wk[k];
                a0[0] += w * bflo(yp[0]); a0[1] += w * bfhi(yp[0]); a0[2] += w * bflo(yp[1]); a0[3] += w * bfhi(yp[1]);
                a1[0] += w * bflo(yp[2]); a1[1] += w * bfhi(yp[2]); a1[2] += w * bflo(yp[3]); a1[3] += w * bfhi(yp[3]); }
            v[j][0] = a0; v[j][1] = a1; s += ((a0[0] + a0[1]) + (a0[2] + a0[3])) + ((a1[0] + a1[1]) + (a1[2] + a1[3])); }
        if (row + NGW < NT) LN2_LOAD(row + NGW);
        const float mean = wave_sum(s) * (1.f / 1024.f); float q = 0.f;
#pragma unroll
        for (int j = 0; j < 2; ++j)
#pragma unroll
            for (int h = 0; h < 2; ++h) { v[j][h] = v[j][h] - mean; q += (v[j][h][0] * v[j][h][0] + v[j][h][1] * v[j][h][1]) + (v[j][h][2] * v[j][h][2] + v[j][h][3] * v[j][h][3]); }
        const float rstd = 1.f / sqrtf(wave_sum(q) * (1.f / 1024.f) + LN_EPS);
#pragma unroll
        for (int j = 0; j < 2; ++j) { const f32x4 o0 = v[j][0] * rstd * gg[j][0] + bb[j][0], o1 = v[j][1] * rstd * gg[j][1] + bb[j][1];
            if (dst) { *(f32x4*)(dst + (size_t)row * 1024 + j * 512 + lane * 8) = o0; *(f32x4*)(dst + (size_t)row * 1024 + j * 512 + lane * 8 + 4) = o1; }
            else { u32x4 w; w.x = pk2(o0[0], o0[1]); w.y = pk2(o0[2], o0[3]); w.z = pk2(o1[0], o1[1]); w.w = pk2(o1[2], o1[3]); *(u32x4*)(xb + (size_t)row * 1024 + j * 512 + lane * 8) = w; } } }
#undef LN2_LOAD
}

constexpr int NPH = 9;
constexpr int N_PHASES = 1 + NL * NPH;
__global__ void __launch_bounds__(NTHR, 2) fwd_kernel(Params P) {
    extern __shared__ __attribute__((aligned(16))) unsigned char lds_raw[];
    Frame F;
    F.lds = (LAS unsigned char*)lds_raw; F.MISC = (volatile LAS unsigned*)(F.lds + MISC_OFF);
    F.tid = threadIdx.x; F.lane = F.tid & 63; F.wave = __builtin_amdgcn_readfirstlane(F.tid >> 6); F.G = gridDim.x; F.bid = blockIdx.x;
    F.ws = P.ws; F.ctl = (unsigned*)(P.ws + WS_CTL);
    for (int u = F.tid; u < 1024; u += NTHR) F.MISC[u] = 0u;
    __syncthreads();
    const int lo = P.ph_lo, hi = P.ph_hi;
    const bool multi = (hi - lo) > 1;
    XcdBarrier bar; bar.bar = F.ctl + CW_BAR; bar.x = 0; bar.st = F.MISC + 8;
    if (multi) bar = xcd_barrier_post(F.ctl + CW_BAR, F.MISC + 8);
#ifndef PHMASK
#define PHMASK 0xFFFF
#endif
#define IN(k) (lo <= (k) && (k) < hi)
#define EN(i) ((PHMASK >> (i)) & 1)
#ifndef DUP_PHASE
#define DUP_PHASE -1
#endif
#define REP(i) for (int rep_ = 0; rep_ < ((DUP_PHASE) == (i) ? 2 : 1); ++rep_)
#define SEAM(k) do { if (IN(k) && IN((k) + 1)) xcd_barrier(bar); } while (0)
#define FILL(k) do { __syncthreads(); if (F.tid == 0) atomicAdd(F.ctl + CW_DONE + (k) * 64, 1u); bg_fill(F, P, F.ctl + CW_DONE + (k) * 64, BG_TOTAL); } while (0)

    if (EN(9) && IN(0)) { REP(9) p0_prologue(F, P); }
    SEAM(0);
#pragma unroll 1
    for (int l = 0; l < NL; ++l) {
        const int pb = 1 + l * NPH;
        if (EN(0) && IN(pb + 0)) REP(0) {
            pg8::Gemm g{wsp<bf16_t>(F, WS_XB), wsp<bf16_t>(F, WS_WIN) + (size_t)l * NP * 1024, 1024, 1024};
            pg8::PlainOrder S; S.init(NT / 256, NP / 256, F.G, F.bid);
            pg8::EpiInProj E{wsp<bf16_t>(F, WS_H), wsp<float>(F, WS_BIN) + (size_t)l * NP, wsp<float>(F, WS_SIDE), wsp<bf16_t>(F, WS_MGT)};
            pg8::gemm_phase<pg8::EpiInProj, pg8::PlainOrder, true>(F.lds, g, S, E);
            FILL(pb + 0);
        }
        SEAM(pb + 0);
        if (EN(1) && IN(pb + 1)) REP(1) {
            unsigned* qctr = F.ctl + CW_QUEUE + l * 64 + 16;
            for (;;) {
                if (F.tid == 0) F.MISC[16] = atomicAdd(qctr, 1u);
                __syncthreads();
                const int L = (int)F.MISC[16];
                __syncthreads();
                if (L >= 528) break;
                if (L < 128) pb_gmlp_unit(F, P, l, L);
                else if (L < 256) pb_compress_unit(F, l, L - 128);
                else if (L < 512) { pb_conv_unit(F, P, l, L - 256); pb_transpose_unit(F, L - 256); }
                else pb_cum_unit(F, L - 512);
            }
        }
        SEAM(pb + 1);
        if (EN(2) && IN(pb + 2)) REP(2) {
            unsigned* qctr = F.ctl + CW_QUEUE + l * 64 + rep_ * 32;
            for (;;) {
                if (F.tid == 0) F.MISC[16] = atomicAdd(qctr, 1u);
                __syncthreads();
                const unsigned L = F.MISC[16];
                __syncthreads();
#ifdef ATT_TWICE
                if (L >= 1536u) break;
                const int Lm = (int)(L % 768u);
#else
                if (L >= 768u) break;
                const int Lm = (int)L;
#endif
                if (Lm < 512) nsa_unit(F, Lm & 3, 63 - (Lm >> 3), (Lm >> 2) & 1);
                else { const int idx = Lm - 512; fox_unit(F, idx & 3, (idx >> 2) & 3, 15 - (idx >> 4)); }
            }
            FILL(pb + 2);
        }
        SEAM(pb + 2);
        if (EN(3) && IN(pb + 3)) REP(3) {
            pg8::Gemm g{wsp<bf16_t>(F, WS_BR), wsp<bf16_t>(F, WS_WBR) + (size_t)l * 4096 * 256, 1024, 256};
            pg8::BrOrder S{F.G, F.bid};
            pg8::EpiBrGate E{wsp<bf16_t>(F, WS_MGT), wsp<bf16_t>(F, WS_GBF)};
            pg8::gemm_phase<pg8::EpiBrGate, pg8::BrOrder, true, true>(F.lds, g, S, E);
        }
        SEAM(pb + 3);
        if (EN(4) && IN(pb + 4)) REP(4) {
            pg8::Gemm g{wsp<bf16_t>(F, WS_GBF), wsp<bf16_t>(F, WS_WO) + (size_t)l * 1024 * 1024, 1024, 1024};
            pg8::PlainOrder S; S.init(NT / 256, 4, F.G, F.bid);
            pg8::EpiBf16Out E{wsp<bf16_t>(F, WS_MIX)};
            pg8::gemm_phase<pg8::EpiBf16Out, pg8::PlainOrder, true>(F.lds, g, S, E);
        }
        SEAM(pb + 4);
        if (EN(5) && IN(pb + 5)) { ln1_router_phase(F, P, l); bg_fill(F, P, nullptr, (long)(l + 1) * BG_PER_LAYER); }
        SEAM(pb + 5);
        if ((EN(6) || EN(7)) && (IN(pb + 6) || IN(pb + 7))) {
            LAS int* tp = (LAS int*)(F.lds + MISC_OFF + 1024);
            if (F.tid == 0) { int run = 0; const unsigned* cnt = F.ctl + CW_CNT + l * 32 * 64;
                for (int e = 0; e < 32; ++e) { const int c = (int)__hip_atomic_load(cnt + e * 64, __ATOMIC_RELAXED, __HIP_MEMORY_SCOPE_AGENT); tp[e] = run; tp[40 + e] = c; run += (c + 255) >> 8; }
                tp[32] = run; }
            __syncthreads();
            LAS unsigned* ul = (LAS unsigned*)(F.lds + MISC_OFF + 1536);
            int ut_ = F.tid; asm volatile("" : "+v"(ut_));
            if (ut_ < 128) { const int m2 = ut_ >> 6, i = ut_ & 63, sh = m2 ? 2 : 3;
                const int x = F.bid & 7, j = F.bid >> 3, W = F.G >> 3;
                const int U = tp[32] << sh, s0 = (x * U) >> 3, s1 = ((x + 1) * U) >> 3, L = s0 + i * W + j;
                unsigned pk = 0xffffffffu;
                if (L < s1) { const int tile = L >> sh, pn = L & ((1 << sh) - 1);
                    int e = (tp[16] <= tile) ? 16 : 0;
                    e += (tp[e + 8] <= tile) ? 8 : 0; e += (tp[e + 4] <= tile) ? 4 : 0; e += (tp[e + 2] <= tile) ? 2 : 0; e += (tp[e + 1] <= tile) ? 1 : 0;
                    const int mt = tile - tp[e], rem = tp[40 + e] - mt * 256, cn = rem < 256 ? rem : 256;
                    pk = (unsigned)pn | ((unsigned)e << 3) | ((unsigned)mt << 8) | ((unsigned)tile << 15) | ((unsigned)(cn - 1) << 24); }
                ul[ut_] = pk; }
            __syncthreads();
            if (EN(6) && IN(pb + 6)) REP(6) {
                pg8::Gemm g{wsp<bf16_t>(F, WS_XB), wsp<bf16_t>(F, WS_W1) + (size_t)l * 32 * 2048 * 1024, 1024, 1024};
                pg8::MoeOrder<1> S{ul, wsp<int>(F, WS_ROWTK)};
                pg8::EpiMoe1 E{wsp<bf16_t>(F, WS_ACT), P.in[I_BE1] + (size_t)l * 32 * 2048};
                pg8::gemm_phase<pg8::EpiMoe1, pg8::MoeOrder<1>, true>(F.lds, g, S, E);
                FILL(pb + 6);
            }
            SEAM(pb + 6);
            if (EN(7) && IN(pb + 7)) REP(7) {
                pg8::Gemm g{wsp<bf16_t>(F, WS_ACT), wsp<bf16_t>(F, WS_W2) + (size_t)l * 32 * 1024 * 1024, 1024, 1024};
                pg8::MoeOrder<2> S{ul + 64, wsp<int>(F, WS_ROWTK)};
                pg8::EpiMoe2 E{wsp<bf16_t>(F, WS_YBUF), P.in[I_BE2] + (size_t)l * 32 * 1024, wsp<int>(F, WS_ROWTK)};
                pg8::gemm_phase<pg8::EpiMoe2, pg8::MoeOrder<2>, true>(F.lds, g, S, E);
                FILL(pb + 7);
            }
        }
        SEAM(pb + 7);
        if (EN(8) && IN(pb + 8)) REP(8) ln2_rows(F, P, l);
        SEAM(pb + 8);
    }
#undef IN
#undef SEAM
}

#ifndef MK_SPLIT
#define MK_SPLIT 0
#endif
extern "C" void kernel_launch(void* const* d_in, const int* in_sizes, int n_in, void* d_out, int out_size, void* d_ws, size_t ws_size, hipStream_t stream) {
    static int grid = 0;
    if (grid == 0) {
        if (n_in != 30 || out_size != NT * 1024 || ws_size < WS_END) { fprintf(stderr, "kernel_launch: unexpected shapes (n_in %d out %d ws %zu need %zu)\n", n_in, out_size, ws_size, (size_t)WS_END); grid = -1; return; }
        int dev = 0, cus = 0, per_cu = 0;
        if (hipGetDevice(&dev) != hipSuccess || hipDeviceGetAttribute(&cus, hipDeviceAttributeMultiprocessorCount, dev) != hipSuccess) { grid = -1; return; }
        if (hipFuncSetAttribute((const void*)fwd_kernel, hipFuncAttributeMaxDynamicSharedMemorySize, LDS_BYTES) != hipSuccess) { fprintf(stderr, "kernel_launch: hipFuncSetAttribute failed\n"); grid = -1; return; }
        if (hipOccupancyMaxActiveBlocksPerMultiprocessor(&per_cu, (const void*)fwd_kernel, NTHR, LDS_BYTES) != hipSuccess || per_cu < 1) fprintf(stderr, "kernel_launch: occupancy query says %d\n", per_cu);
        (void)hipGetLastError();
        grid = cus;
    }
    if (grid < 0) return;
    (void)hipMemsetAsync((char*)d_ws + WS_CTL, 0, CTL_BYTES, stream);
    Params p; memset(&p, 0, sizeof(p));
    for (int i = 0; i < 30; ++i) p.in[i] = (const float*)d_in[i];
    p.out = (float*)d_out; p.ws = (unsigned char*)d_ws;
    for (int i = 0; i < 8; ++i) p.invf[i] = std::pow(500000.0, -(double)i / 8.0);
#if MK_SPLIT
    for (int ph = 0; ph < N_PHASES; ++ph) { p.ph_lo = ph; p.ph_hi = ph + 1; hipLaunchKernelGGL(fwd_kernel, dim3(grid), dim3(NTHR), LDS_BYTES, stream, p); }
#else
    p.ph_lo = 0; p.ph_hi = N_PHASES; hipLaunchKernelGGL(fwd_kernel, dim3(grid), dim3(NTHR), LDS_BYTES, stream, p);
#endif
}
```

```cpp
#include <hip/hip_runtime.h>
#include <cstdio>
#include <cstdint>
#include <cmath>
#include <cstring>

#define DEV __device__ __forceinline__
#define LAS __attribute__((address_space(3)))
#define GAS __attribute__((address_space(1)))

typedef unsigned short bf16_t;
typedef short bf16x8 __attribute__((ext_vector_type(8)));
typedef short bf16x4 __attribute__((ext_vector_type(4)));
typedef float f32x4 __attribute__((ext_vector_type(4)));
typedef float f32x2 __attribute__((ext_vector_type(2)));
typedef unsigned u32x4 __attribute__((ext_vector_type(4)));
typedef unsigned u32x2 __attribute__((ext_vector_type(2)));

constexpr int NB = 4, SEQ = 4096, DM = 1024, NL = 4, NT = NB * SEQ;
constexpr int NIN = 6544, NP = 6656;
constexpr int NE = 32;
constexpr int NWAVES = 8, NTHR = 512;
constexpr float LN_EPS = 1e-5f;
constexpr float DN_ALPHA = 1.6817928305074292f;
constexpr float LOG2E = 1.4426950408889634f;
constexpr int HP_NQ = 0, HP_KC = 256, HP_VC = 320, HP_KS = 384, HP_VS = 448, HP_KW = 512, HP_VW = 576, HP_SP = 640;
constexpr int HP_FQ = 768, HP_FK = 1024, HP_FV = 1280, HP_GU = 1536, HP_GV = 1792, HP_CAB = 2048, HP_MG = 2560;

constexpr size_t al256(size_t x) { return (x + 255) & ~(size_t)255; }
constexpr size_t WS_CTL = 0, CTL_BYTES = 1u << 20;
constexpr size_t WS_WIN = CTL_BYTES;
constexpr size_t WS_BIN = WS_WIN + al256((size_t)NL * NP * 1024 * 2);
constexpr size_t WS_WBR = WS_BIN + al256((size_t)NL * NP * 4);
constexpr size_t WS_WO = WS_WBR + al256((size_t)NL * 4096 * 256 * 2);
constexpr size_t WS_W1 = WS_WO + al256((size_t)NL * 1024 * 1024 * 2);
constexpr size_t WS_W2 = WS_W1 + al256((size_t)NL * 32 * 2048 * 1024 * 2);
constexpr size_t WS_WC1 = WS_W2 + al256((size_t)NL * 32 * 1024 * 1024 * 2);
constexpr size_t WS_WC2 = WS_WC1 + al256((size_t)NL * 2 * 64 * 2048 * 2);
constexpr size_t WS_CB = WS_WC2 + al256((size_t)NL * 2 * 64 * 64 * 2);
constexpr size_t WS_WG = WS_CB + al256((size_t)NL * 2 * 32 * 64 * 4);
constexpr size_t WS_CS = WS_WG + al256((size_t)NL * 4 * 128 * 128 * 2);
constexpr size_t WS_XRES = WS_CS + al256((size_t)NT * 16 * 4);
constexpr size_t WS_XB = WS_XRES + al256((size_t)NT * 1024 * 4);
constexpr size_t WS_H = WS_XB + al256((size_t)NT * 1024 * 2);
constexpr size_t WS_SIDE = WS_H + al256((size_t)NT * NP * 2);
constexpr size_t WS_KNSA = WS_SIDE + al256((size_t)NT * 16 * 4);
constexpr size_t WS_VT = WS_KNSA + al256((size_t)NT * 128 * 2);
constexpr size_t WS_CUM = WS_VT + al256((size_t)NB * 384 * SEQ * 2);
constexpr size_t WS_KCMP = WS_CUM + al256((size_t)NB * 4 * SEQ * 4);
constexpr size_t WS_VCMPT = WS_KCMP + al256((size_t)NB * 256 * 64 * 2);
constexpr size_t WS_BR = WS_VCMPT + al256((size_t)NB * 64 * 256 * 2);
constexpr size_t WS_G32 = WS_BR + al256((size_t)NT * 1024 * 2);
constexpr size_t WS_GBF = WS_G32 + al256((size_t)NT * 1024 * 4);
constexpr size_t WS_MIX = WS_GBF + al256((size_t)NT * 1024 * 2);
constexpr size_t WS_TOKW = WS_MIX + al256((size_t)NT * 1024 * 4);
constexpr size_t WS_ROWTK = WS_TOKW + al256((size_t)NT * 4 * 4);
constexpr int PMAX_TILES = NT * 4 / 256 + NE;
constexpr size_t WS_ACT = WS_ROWTK + al256((size_t)NE * NT * 4);
constexpr size_t WS_YBUF = WS_ACT + al256((size_t)PMAX_TILES * 256 * 1024 * 2);
constexpr size_t WS_MGT = WS_YBUF + al256((size_t)NT * 4 * 1024 * 2);
constexpr size_t WS_KN = WS_MGT + al256((size_t)NT * 4096 * 2);
constexpr size_t WS_END = WS_KN + al256((size_t)NB * 4 * 64 * 4);

constexpr int CW_BAR = 4096;
constexpr int CW_CNT = 32768;
constexpr int CW_QUEUE = 20480;
constexpr int CW_BGQ = 24576;
constexpr int CW_DONE = 28672;

constexpr int RING_BYTES = 131072;
constexpr int MISC_OFF = RING_BYTES;
constexpr int LDS_BYTES = 147456;

DEV float bf2f(bf16_t v) { return __uint_as_float((unsigned)v << 16); }
DEV float bflo(unsigned w) { return __uint_as_float(w << 16); }
DEV float bfhi(unsigned w) { return __uint_as_float(w & 0xffff0000u); }
DEV unsigned pk2(float lo, float hi) { typedef __bf16 b2 __attribute__((ext_vector_type(2))); f32x2 v = {lo, hi}; b2 b = __builtin_convertvector(v, b2); return __builtin_bit_cast(unsigned, b); }
DEV bf16_t f2bf(float f) { return (bf16_t)(pk2(f, 0.f) & 0xffffu); }
DEV float fexp2(float x) { return __builtin_amdgcn_exp2f(x); }
DEV float frcp(float x) { return __builtin_amdgcn_rcpf(x); }
DEV float sigmoidf_(float x) { return frcp(1.f + fexp2(-x * LOG2E)); }
DEV float gelu_tanh(float x) { const float u = 1.5957691216057308f * (x + 0.044715f * x * x * x); return x * frcp(1.f + fexp2(-u * LOG2E)); }
#define WS_DPP(x, ctrl) __builtin_bit_cast(float, __builtin_amdgcn_update_dpp(0, __builtin_bit_cast(int, (x)), (ctrl), 0xf, 0xf, true))
DEV float wave_sum(float v) {
    v += WS_DPP(v, 0xB1); v += WS_DPP(v, 0x4E); v += WS_DPP(v, 0x141); v += WS_DPP(v, 0x140);
    const int vi = __builtin_bit_cast(int, v);
    const float r0 = __builtin_bit_cast(float, __builtin_amdgcn_readlane(vi, 0)), r1 = __builtin_bit_cast(float, __builtin_amdgcn_readlane(vi, 16));
    const float r2 = __builtin_bit_cast(float, __builtin_amdgcn_readlane(vi, 32)), r3 = __builtin_bit_cast(float, __builtin_amdgcn_readlane(vi, 48));
    return (r0 + r1) + (r2 + r3);
}
typedef unsigned u32x2_t __attribute__((ext_vector_type(2)));
DEV float xr_max(float v) {
    { const unsigned u = __float_as_uint(v); const auto r = __builtin_amdgcn_permlane16_swap(u, u, false, false); v = fmaxf(__uint_as_float(r[0]), __uint_as_float(r[1])); }
    { const unsigned u = __float_as_uint(v); const auto r = __builtin_amdgcn_permlane32_swap(u, u, false, false); v = fmaxf(__uint_as_float(r[0]), __uint_as_float(r[1])); }
    return v;
}
DEV float xr_sum(float v) {
    { const unsigned u = __float_as_uint(v); const auto r = __builtin_amdgcn_permlane16_swap(u, u, false, false); v = __uint_as_float(r[0]) + __uint_as_float(r[1]); }
    { const unsigned u = __float_as_uint(v); const auto r = __builtin_amdgcn_permlane32_swap(u, u, false, false); v = __uint_as_float(r[0]) + __uint_as_float(r[1]); }
    return v;
}
DEV unsigned xr_or(unsigned u) {
    { const auto r = __builtin_amdgcn_permlane16_swap(u, u, false, false); u = r[0] | r[1]; }
    { const auto r = __builtin_amdgcn_permlane32_swap(u, u, false, false); u = r[0] | r[1]; }
    return u;
}
DEV f32x4 mfma16(bf16x8 a, bf16x8 b, f32x4 c) { return __builtin_amdgcn_mfma_f32_16x16x32_bf16(a, b, c, 0, 0, 0); }
#define LDS_WAIT() asm volatile("s_waitcnt lgkmcnt(0)" ::: "memory")
#define VM_WAIT() asm volatile("s_waitcnt vmcnt(0)" ::: "memory")

__host__ __device__ __forceinline__ int perm16(int dp) { return dp < 16 ? ((dp & 1) ? 8 + (dp >> 1) : (dp >> 1)) : dp; }
__host__ __device__ __forceinline__ int hp_src_col(int c) {
    if (c < 256) return (c & ~63) + perm16(c & 63);
    if (c < 320) return 256 + perm16(c - 256);
    if (c < 384) return c;
    if (c < 448) return 384 + perm16(c - 384);
    if (c < 512) return c;
    if (c < 576) return 512 + perm16(c - 512);
    if (c < 640) return c;
    if (c < 652) return c;
    if (c < 656) return 1420 + (c - 652);
    if (c < 768) return -1;
    if (c < 1024) return 652 + (c - 768);
    if (c < 1280) return 908 + (c - 1024);
    if (c < 1536) return 1164 + (c - 1280);
    if (c < 1792) return 1424 + (c - 1536);
    if (c < 2048) return 1680 + (c - 1792);
    if (c < 2560) { const int i = c - 2048; return (i & 1) ? 2192 + (i >> 1) : 1936 + (i >> 1); }
    return 2448 + (c - 2560);
}

namespace pg8 {
constexpr int BM = 256, BK = 64, HALF = 128, HTB = HALF * BK * 2, STAGE_BYTES = 8 * HTB, NXCD = 8, WGM = 8;
__host__ __device__ __forceinline__ int lds_byte(int r, int c) { const int st = (r >> 4) * 2 + (c >> 5), rr = r & 15, cc = c & 31, ob = rr * 64 + cc * 2; return st * 1024 + (ob ^ (((ob >> 9) & 1) << 5)); }
__host__ __device__ __forceinline__ void stage_rc(int b, int& R, int& C) { const int st = b / 1024, sb = b % 1024, swz = sb ^ (((sb >> 9) & 1) << 5); R = (st >> 1) * 16 + swz / 64; C = (st & 1) * 32 + (swz % 64) / 2; }
__host__ __device__ __forceinline__ int perm32(int rho) { const int n = rho >> 4, i = rho & 15; return 8 * (i >> 2) + 4 * n + (i & 3); }

struct Unit { int pm, pn, e, mt, cnt; };
struct Gemm { const bf16_t* A; const bf16_t* Bt; int lda; int K; };

template <class Epi, class Sched, bool ALIGN_EPI, bool HALFN = false>
DEV void gemm_phase(LAS unsigned char* lds, const Gemm g, const Sched& S, const Epi& E) {
    int tid_ = threadIdx.x; asm volatile("" : "+v"(tid_));
    const int tid = tid_, wid = __builtin_amdgcn_readfirstlane(tid >> 6), lane = tid & 63, wr = wid >> 2, wc = wid & 3, fr = lane & 15, fq = lane >> 4;
    const int K = g.K, nt = K / BK;
    unsigned voffA[2], voffB[2];
#pragma unroll
    for (int i = 0; i < 2; ++i) { int R, C; stage_rc(tid * 16 + i * 8192, R, C); int Rb = Epi::PERM ? ((R & ~31) + perm32(R & 31)) : R;
        if constexpr (Epi::PAIR16) Rb = 16 * (Rb >> 3) + (Rb & 7);
        voffA[i] = (unsigned)(R * g.lda + C) * 2u; voffB[i] = (unsigned)(Rb * K + C) * 2u; }
    const unsigned hstepA = (unsigned)HALF * (unsigned)g.lda * 2u;
    const size_t kstep = (size_t)(BK * 2);
    const size_t hstepB = (size_t)(Epi::PAIR16 ? 8 : HALF) * K * 2;
    unsigned voffG[2];
#pragma unroll
    for (int i = 0; i < 2; ++i) { const unsigned off = (unsigned)tid * 16u + (unsigned)i * 8192u; voffG[i] = (off >> 8) * 512u + (off & 255u); }
    constexpr size_t GPIECE = 64 * 512;
    const unsigned ldsw = (unsigned)wid * 1024u;
    const int aoff = lds_byte(wr * 64 + fr, fq * 8), boff = lds_byte(wc * 32 + fr, fq * 8);
    const char* const Abase = (const char*)g.A;
#define PG8_SA(b, h) (((b) * 2 + (h)) * HTB)
#define PG8_SB(b, h) ((4 + (b) * 2 + (h)) * HTB)
#define PG8_STAGE_B(bufoff, gbase, voff) do { _Pragma("unroll") for (int _i = 0; _i < 2; ++_i) \
        __builtin_amdgcn_global_load_lds((const unsigned*)((const char*)(gbase) + (voff)[_i]), (LAS unsigned*)(lds + (bufoff) + ldsw + _i * 8192), 16, 0, 0); } while (0)
#define PG8_STAGE_B1(bufoff, gbase, gatep) do { if constexpr (HALFN) PG8_STAGE_B(bufoff, gatep, voffG); else PG8_STAGE_B(bufoff, (gbase) + hstepB, voffB); } while (0)
#define PG8_STAGE_A(bufoff, koff, offs) do { _Pragma("unroll") for (int _i = 0; _i < 2; ++_i) { \
        if constexpr (Sched::GATHER) __builtin_amdgcn_global_load_lds((const unsigned*)(Abase + (size_t)(koff) + (offs)[_i]), (LAS unsigned*)(lds + (bufoff) + ldsw + _i * 8192), 16, 0, 0); \
        else __builtin_amdgcn_global_load_lds((const unsigned*)(Abase + ((size_t)(koff) + (size_t)__builtin_amdgcn_readfirstlane((offs)[_i])) + voffA[_i]), (LAS unsigned*)(lds + (bufoff) + ldsw + _i * 8192), 16, 0, 0); } } while (0)
#define PG8_LDA(dst, b, h) do { _Pragma("unroll") for (int m = 0; m < 4; ++m) _Pragma("unroll") for (int k = 0; k < 2; ++k) dst[m][k] = *(const LAS bf16x8*)(lds + PG8_SA(b, h) + aoff + m * 2048 + k * 1024); } while (0)
#define PG8_LDB(dst, b, h) do { _Pragma("unroll") for (int n = 0; n < 2; ++n) _Pragma("unroll") for (int k = 0; k < 2; ++k) dst[n][k] = *(const LAS bf16x8*)(lds + PG8_SB(b, h) + boff + n * 2048 + k * 1024); } while (0)
#define PG8_MMA(ai, bj, At, Bt) do { __builtin_amdgcn_s_setprio(1); _Pragma("unroll") for (int m = 0; m < 4; ++m) _Pragma("unroll") for (int n = 0; n < 2; ++n) _Pragma("unroll") for (int k = 0; k < 2; ++k) \
        acc[ai][bj][m][n] = __builtin_amdgcn_mfma_f32_16x16x32_bf16(Bt[n][k], At[m][k], acc[ai][bj][m][n], 0, 0, 0); __builtin_amdgcn_s_setprio(0); } while (0)
#define PG8_WAIT_V(n) asm volatile("s_waitcnt vmcnt(" #n ")" ::: "memory")
#define PG8_WAIT_L(n) asm volatile("s_waitcnt lgkmcnt(" #n ")" ::: "memory")
#define PG8_BAR __builtin_amdgcn_s_barrier()
#define PG8_SCHED __builtin_amdgcn_sched_barrier(0)
#define PG8_MKOFF(dst, u) do { if constexpr (Sched::GATHER) { const unsigned _ao = S.aoff(u); _Pragma("unroll") for (int _h = 0; _h < 2; ++_h) _Pragma("unroll") for (int _i = 0; _i < 2; ++_i) { \
        int _R, _C; stage_rc(tid * 16 + _i * 8192, _R, _C); dst[_h][_i] = _ao + (S.arow(u, _h * HALF + _R) * (unsigned)g.lda + (unsigned)_C) * 2u; } } \
    else { const unsigned _ub = S.aoff(u) + S.arow(u, 0) * (unsigned)g.lda * 2u; _Pragma("unroll") for (int _h = 0; _h < 2; ++_h) _Pragma("unroll") for (int _i = 0; _i < 2; ++_i) dst[_h][_i] = _ub + (unsigned)_h * hstepA; } } while (0)
    Unit cur, nxt; int ui = 0;
    if (!S.next(0, cur)) return;
    f32x4 acc[2][2][4][2];
#pragma unroll
    for (int a = 0; a < 2; ++a)
#pragma unroll
        for (int b = 0; b < 2; ++b)
#pragma unroll
            for (int m = 0; m < 4; ++m)
#pragma unroll
                for (int n = 0; n < 2; ++n) acc[a][b][m][n] = (f32x4){0.f, 0.f, 0.f, 0.f};
    bf16x8 At[4][2], B0[2][2], B1[2][2];
    unsigned oc[2][2], on[2][2];
    PG8_MKOFF(oc, cur);
    const char* cB = (const char*)g.Bt + S.boff(cur);
    const char* cG = E.gate_base(cur);
    PG8_STAGE_B(PG8_SB(0, 0), cB, voffB); PG8_STAGE_B1(PG8_SB(0, 1), cB, cG); PG8_STAGE_A(PG8_SA(0, 0), 0, oc[0]); PG8_STAGE_A(PG8_SA(0, 1), 0, oc[1]);
    if (wr == 1) PG8_BAR;
    PG8_WAIT_V(2); PG8_BAR;
    PG8_STAGE_B(PG8_SB(1, 0), cB + kstep, voffB); PG8_STAGE_A(PG8_SA(1, 0), kstep, oc[0]); PG8_STAGE_B1(PG8_SB(1, 1), cB + kstep, cG + GPIECE);
    PG8_WAIT_V(6); PG8_BAR;
    typename Epi::Pre pre;
    for (;;) {
        const bool has_next = S.next(ui + 1, nxt);
        const char* nB = cB; const char* nG = cG;
        LAS int* const idxb = (LAS int*)(lds + STAGE_BYTES + 2048) + ((ui + 1) & 1) * 256;
        if (has_next) { nB = (const char*)g.Bt + S.boff(nxt); nG = E.gate_base(nxt);
            if constexpr (Sched::GATHER) { if (wid < 4) __builtin_amdgcn_global_load_lds((const unsigned*)(S.idx_ptr(nxt) + tid), (LAS unsigned*)(idxb + wid * 64), 4, 0, 0); }
            else PG8_MKOFF(on, nxt); }
        else {
#pragma unroll
            for (int h = 0; h < 2; ++h)
#pragma unroll
                for (int i = 0; i < 2; ++i) on[h][i] = oc[h][i];
        }
#pragma unroll 1
        for (int t = 0; t < nt; t += 2) {
            const bool last = (t == nt - 2);
            const size_t k1 = (size_t)(t + 1) * kstep;
            const size_t k2 = last ? (size_t)0 : (size_t)(t + 2) * kstep, k3 = k2 + kstep;
            if constexpr (Sched::GATHER) { if (last && has_next) {
                const unsigned ao_ = S.aoff(nxt);
#pragma unroll
                for (int h = 0; h < 2; ++h)
#pragma unroll
                    for (int i = 0; i < 2; ++i) { int R_, C_; stage_rc(tid * 16 + i * 8192, R_, C_); const int r_ = h * HALF + R_; const int ix_ = idxb[r_];
                        on[h][i] = ao_ + (S.arow_from(nxt, r_, ix_) * (unsigned)g.lda + (unsigned)C_) * 2u; } } }
            unsigned o2[2][2];
#pragma unroll
            for (int h = 0; h < 2; ++h)
#pragma unroll
                for (int i = 0; i < 2; ++i) o2[h][i] = last ? on[h][i] : oc[h][i];
            const char* b2 = last ? nB : cB + (size_t)(t + 2) * kstep; const char* b3 = b2 + kstep;
            const char* g2 = last ? nG : cG + (size_t)(t + 2) * GPIECE; const char* g3 = g2 + GPIECE;
            PG8_LDB(B0, 0, 0); if constexpr (!HALFN) PG8_LDB(B1, 0, 1); else { if (wr == 0) E.gate_read(pre, lds + PG8_SB(0, 1), t >> 1, wc, fr, fq); } PG8_SCHED; PG8_LDA(At, 0, 0); PG8_STAGE_A(PG8_SA(1, 1), k1, oc[1]);
            PG8_WAIT_V(8); PG8_WAIT_L(0); PG8_BAR; PG8_MMA(0, 0, At, B0); if constexpr (!HALFN) PG8_MMA(0, 1, At, B1); PG8_BAR; PG8_SCHED;
            PG8_LDA(At, 0, 1); PG8_STAGE_B(PG8_SB(0, 0), b2, voffB); PG8_STAGE_B1(PG8_SB(0, 1), b2, g2); PG8_STAGE_A(PG8_SA(0, 0), k2, o2[0]);
            PG8_WAIT_V(8); PG8_WAIT_L(0); PG8_BAR; PG8_MMA(1, 0, At, B0); if constexpr (!HALFN) PG8_MMA(1, 1, At, B1); PG8_BAR; PG8_SCHED;
            PG8_LDB(B0, 1, 0); if constexpr (!HALFN) PG8_LDB(B1, 1, 1); else { if (wr == 1) E.gate_read(pre, lds + PG8_SB(1, 1), t >> 1, wc, fr, fq); } PG8_SCHED; PG8_LDA(At, 1, 0); PG8_STAGE_A(PG8_SA(0, 1), k2, o2[1]);
            PG8_WAIT_V(8); PG8_WAIT_L(0); PG8_BAR; PG8_MMA(0, 0, At, B0); if constexpr (!HALFN) PG8_MMA(0, 1, At, B1); PG8_BAR; PG8_SCHED;
            PG8_LDA(At, 1, 1); PG8_STAGE_B(PG8_SB(1, 0), b3, voffB); PG8_STAGE_B1(PG8_SB(1, 1), b3, g3); PG8_STAGE_A(PG8_SA(1, 0), k3, o2[0]);
            PG8_WAIT_V(8); PG8_WAIT_L(0); PG8_BAR; PG8_MMA(1, 0, At, B0); if constexpr (!HALFN) PG8_MMA(1, 1, At, B1); PG8_BAR; PG8_SCHED;
        }
        if constexpr (ALIGN_EPI) { if (wr == 0) PG8_BAR; }
        if constexpr (HALFN) E.fold(acc, pre, cur, wr, wc, fr, fq); else E(acc, cur, wr, wc, fr, fq);
        if (!has_next) break;
#pragma unroll
        for (int a = 0; a < 2; ++a)
#pragma unroll
            for (int b = 0; b < 2; ++b)
#pragma unroll
                for (int m = 0; m < 4; ++m)
#pragma unroll
                    for (int n = 0; n < 2; ++n) { if (!HALFN || b == 0) acc[a][b][m][n] = (f32x4){0.f, 0.f, 0.f, 0.f}; }
        cur = nxt; cB = nB; cG = nG; ++ui;
#pragma unroll
        for (int h = 0; h < 2; ++h)
#pragma unroll
            for (int i = 0; i < 2; ++i) oc[h][i] = on[h][i];
        if constexpr (ALIGN_EPI) { if (wr == 1) PG8_BAR; }
    }
    PG8_WAIT_V(0);
    if constexpr (!ALIGN_EPI) { if (wr == 0) PG8_BAR; }
    PG8_BAR;
#undef PG8_SA
#undef PG8_SB
#undef PG8_STAGE_A
#undef PG8_STAGE_B1
#undef PG8_STAGE_B
#undef PG8_LDA
#undef PG8_LDB
#undef PG8_MMA
#undef PG8_WAIT_V
#undef PG8_WAIT_L
#undef PG8_BAR
#undef PG8_SCHED
#undef PG8_MKOFF
}

struct StaticOrder {
    int nM, nN, nwg, G, c;
    DEV void init(int nM_, int nN_, int G_, int c_) { nM = nM_; nN = nN_; nwg = nM * nN; G = G_; c = c_; }
    DEV bool next(int i, Unit& u) const {
        const long L = (long)i * G + c; if (L >= nwg) return false;
        int wgid = (int)L; { const int q = nwg / NXCD, r = nwg % NXCD, xcd = wgid % NXCD, off = wgid / NXCD; wgid = (xcd < r ? xcd * (q + 1) : r * (q + 1) + (xcd - r) * q) + off; }
        const int nig = WGM * nN, gid = wgid / nig, fm = gid * WGM, gsz = (nM - fm) < WGM ? (nM - fm) : WGM;
        u.pm = fm + ((wgid % nig) % gsz); u.pn = (wgid % nig) / gsz; u.e = 0; u.mt = 0; u.cnt = 256; return true;
    }
};
}

#define XB_TMO      128
#define XB_XCNT(j)  (256  + 64 * (j))
#define XB_XSUB(j)  (1280 + 64 * (j))
#define XB_XGEN(j)  (2304 + 64 * (j))
#define XB_TOP      3328
#define XB_TOPGEN   3392
#define XCD_BAR_WORDS 3456
#define XB_SPIN_CAP (1u << 20)
DEV unsigned xb_ld(unsigned* p)              { return __hip_atomic_load(p, __ATOMIC_RELAXED, __HIP_MEMORY_SCOPE_AGENT); }
DEV unsigned xb_add(unsigned* p, unsigned v) { return __hip_atomic_fetch_add(p, v, __ATOMIC_RELAXED, __HIP_MEMORY_SCOPE_AGENT); }
DEV unsigned xb_xcc_id() { return (unsigned)__builtin_amdgcn_s_getreg((3 << 11) | 20) & 0xFu; }
#define XB_SPIN(cond, bar) do { unsigned _sp = 0; while (cond) { __builtin_amdgcn_s_sleep(1); \
    if ((++_sp & 255u) == 0u) { if (xb_ld(&(bar)[XB_TMO])) break; if (_sp > XB_SPIN_CAP) { atomicAdd(&(bar)[XB_TMO], 1u); break; } } } } while (0)
struct XcdBarrier { unsigned* bar; unsigned x; volatile LAS unsigned* st; };
DEV XcdBarrier xcd_barrier_post(unsigned* bar, volatile LAS unsigned* st) {
    XcdBarrier b; b.bar = bar; b.x = xb_xcc_id(); b.st = st;
    if (threadIdx.x == 0) (void)xb_add(&bar[XB_XCNT(b.x)], 1u);
    return b;
}
DEV void xcd_barrier_complete(unsigned* bar, unsigned x, unsigned& nloc, unsigned& nx) {
    const unsigned G = gridDim.x * gridDim.y * gridDim.z;
    unsigned sum, cnt, mine, sp = 0u;
    for (;;) {
        sum = 0u; cnt = 0u; mine = 0u;
#pragma unroll
        for (unsigned j = 0; j < 16; ++j) { const unsigned c = xb_ld(&bar[XB_XCNT(j)]); sum += c; cnt += (c > 0u) ? 1u : 0u; mine = (j == x) ? c : mine; }
        if (sum == G) break;
        __builtin_amdgcn_s_sleep(1);
        if ((++sp & 255u) == 0u) { if (xb_ld(&bar[XB_TMO])) break; if (sp > XB_SPIN_CAP) { atomicAdd(&bar[XB_TMO], 1u); break; } }
    }
    nloc = mine > 0u ? mine : 1u; nx = cnt > 0u ? cnt : 1u;
}
DEV void xcd_barrier(const XcdBarrier& b) {
    asm volatile("s_waitcnt vmcnt(0)" ::: "memory");
    __syncthreads();
    if (threadIdx.x == 0) {
        unsigned* bar = b.bar;
        __builtin_amdgcn_s_waitcnt(0);
        unsigned nloc = b.st[0], nx = b.st[1];
        if (nloc == 0u) { xcd_barrier_complete(bar, b.x, nloc, nx); b.st[0] = nloc; b.st[1] = nx; }
        const unsigned old = xb_add(&bar[XB_XSUB(b.x)], 1u);
        const unsigned gen = old / nloc;
        if (old + 1u == (gen + 1u) * nloc) {
            __builtin_amdgcn_fence(__ATOMIC_RELEASE, "agent");
            asm volatile("s_waitcnt vmcnt(0)" ::: "memory");
            const unsigned og = xb_add(&bar[XB_TOP], 1u);
            const unsigned tg = og / nx;
            if (og + 1u == (tg + 1u) * nx) xb_add(&bar[XB_TOPGEN], 1u);
            else XB_SPIN(xb_ld(&bar[XB_TOPGEN]) == tg, bar);
            __builtin_amdgcn_fence(__ATOMIC_ACQUIRE, "agent");
            xb_add(&bar[XB_XGEN(b.x)], 1u);
            asm volatile("s_waitcnt vmcnt(0)" ::: "memory");
        } else {
            XB_SPIN(xb_ld(&bar[XB_XGEN(b.x)]) == gen, bar);
            __builtin_amdgcn_fence(__ATOMIC_ACQUIRE, "agent");
            asm volatile("s_waitcnt vmcnt(0)" ::: "memory");
        }
    }
    __syncthreads();
}

struct Params {
    const float* in[30];
    float* out;
    unsigned char* ws;
    int ph_lo, ph_hi;
    double invf[8];
};
enum { I_X = 0, I_POS, I_WIN, I_BIN, I_PEK, I_PEV, I_W1K, I_W2K, I_W1V, I_W2V, I_GLNG, I_GLNB, I_GWS, I_GBS, I_CW, I_CB, I_CLNG, I_CLNB,
       I_WBR, I_WO, I_LN1G, I_LN1B, I_WR, I_BR, I_WE1, I_BE1, I_WE2, I_BE2, I_LN2G, I_LN2B };

namespace pg8 {
struct EpiInProj {
    struct Pre {};
    static constexpr bool PAIR16 = false;
    DEV const char* gate_base(const Unit&) const { return nullptr; }
    static constexpr bool PERM = true;
    bf16_t* H; const float* bias; float* side; bf16_t* MGT;
    DEV void operator()(const f32x4 (&acc)[2][2][4][2], const Unit& u, int wr, int wc, int fr, int fq) const {
        const int row0 = u.pm * BM + wr * 64 + fr, col0 = u.pn * BM + wc * 32 + 8 * fq;
        f32x4 bv[2][2];
#pragma unroll
        for (int bj = 0; bj < 2; ++bj)
#pragma unroll
            for (int n = 0; n < 2; ++n) bv[bj][n] = *(const f32x4*)(bias + col0 + bj * HALF + 4 * n);
        if (u.pn >= 10) {
            bf16_t* tile = MGT + ((size_t)u.pm * 16 + (u.pn - 10)) * 65536 + (wr * 64 + fr) * 256 + wc * 32 + 8 * fq;
#pragma unroll
            for (int ai = 0; ai < 2; ++ai)
#pragma unroll
                for (int m = 0; m < 4; ++m)
#pragma unroll
                    for (int bj = 0; bj < 2; ++bj) { const f32x4 v0 = acc[ai][bj][m][0] + bv[bj][0], v1 = acc[ai][bj][m][1] + bv[bj][1];
                        u32x4 w; w.x = pk2(sigmoidf_(v0[0]), sigmoidf_(v0[1])); w.y = pk2(sigmoidf_(v0[2]), sigmoidf_(v0[3])); w.z = pk2(sigmoidf_(v1[0]), sigmoidf_(v1[1])); w.w = pk2(sigmoidf_(v1[2]), sigmoidf_(v1[3]));
                        *(u32x4*)(tile + (ai * HALF + m * 16) * 256 + bj * HALF) = w; }
            return; }
        const bool special = (u.pn == 2) && (wc == 0) && (fq < 2);
#pragma unroll
        for (int ai = 0; ai < 2; ++ai)
#pragma unroll
            for (int m = 0; m < 4; ++m) { const int row = row0 + ai * HALF + m * 16; bf16_t* rowp = H + (size_t)row * NP + col0;
#pragma unroll
                for (int bj = 0; bj < 2; ++bj) { const f32x4 v0 = acc[ai][bj][m][0] + bv[bj][0], v1 = acc[ai][bj][m][1] + bv[bj][1];
                    u32x4 w; w.x = pk2(v0[0], v0[1]); w.y = pk2(v0[2], v0[3]); w.z = pk2(v1[0], v1[1]); w.w = pk2(v1[2], v1[3]);
                    *(u32x4*)(rowp + bj * HALF) = w;
                    if (bj == 1 && special) { float* sp = side + (size_t)row * 16 + 8 * fq; *(f32x4*)sp = v0; *(f32x4*)(sp + 4) = v1; } } }
    }
};
struct EpiBrGate {
    static constexpr bool PERM = true;
    struct Pre { u32x4 g[2][4]; };
    static constexpr bool PAIR16 = false;
    const bf16_t* MGT; bf16_t* GBF;
    DEV const char* gate_base(const Unit& u) const { return (const char*)(MGT + ((size_t)u.pm * 16 + u.e * 4 + (u.pn >> 1)) * 65536 + (u.pn & 1) * 128); }
    DEV void gate_read(Pre& p, const LAS unsigned char* slot, int idx, int wc, int fr, int fq) const {
        const LAS unsigned char* q = slot + fr * 256 + (wc * 32 + 8 * fq) * 2;
        if (idx == 0) {
#pragma unroll
            for (int m = 0; m < 4; ++m) p.g[0][m] = *(const LAS u32x4*)(q + m * 16 * 256); }
        else {
#pragma unroll
            for (int m = 0; m < 4; ++m) p.g[1][m] = *(const LAS u32x4*)(q + m * 16 * 256); }
    }
    DEV void fold(f32x4 (&acc)[2][2][4][2], const Pre& p, const Unit& u, int wr, int wc, int fr, int fq) const {
        const int n = u.e;
#pragma unroll
        for (int ai = 0; ai < 2; ++ai)
#pragma unroll
            for (int m = 0; m < 4; ++m) { const u32x4 g = p.g[ai][m]; const f32x4 a0 = acc[ai][0][m][0], a1 = acc[ai][0][m][1];
                f32x4 t0, t1;
                t0[0] = a0[0] * bflo(g.x); t0[1] = a0[1] * bfhi(g.x); t0[2] = a0[2] * bflo(g.y); t0[3] = a0[3] * bfhi(g.y);
                t1[0] = a1[0] * bflo(g.z); t1[1] = a1[1] * bfhi(g.z); t1[2] = a1[2] * bflo(g.w); t1[3] = a1[3] * bfhi(g.w);
                if (n == 0) { acc[ai][1][m][0] = t0; acc[ai][1][m][1] = t1; } else { acc[ai][1][m][0] += t0; acc[ai][1][m][1] += t1; } }
        if (n == 3) { const int row0 = u.pm * BM + wr * 64 + fr, col0 = u.pn * HALF + wc * 32 + 8 * fq;
#pragma unroll
            for (int ai = 0; ai < 2; ++ai)
#pragma unroll
                for (int m = 0; m < 4; ++m) { const f32x4 v0 = acc[ai][1][m][0], v1 = acc[ai][1][m][1];
                    u32x4 w; w.x = pk2(v0[0], v0[1]); w.y = pk2(v0[2], v0[3]); w.z = pk2(v1[0], v1[1]); w.w = pk2(v1[2], v1[3]);
                    *(u32x4*)(GBF + (size_t)(row0 + ai * HALF + m * 16) * 1024 + col0) = w; } }
    }
};
struct BrOrder {
    static constexpr bool GATHER = false;
    int G, c;
    DEV bool next(int i, Unit& u) const { const int x = c & 7, q = (c >> 3) + (i >> 2) * (G >> 3); if (q >= 64 || (G & 7)) { if (!(G & 7)) return false; const int tile = c + (i >> 2) * G; if (tile >= 512) return false; u.pm = tile >> 3; u.pn = tile & 7; }
        else { u.pm = x + 8 * (q >> 3); u.pn = q & 7; }
        u.e = i & 3; u.mt = 0; u.cnt = 256; return true; }
    DEV size_t boff(const Unit& u) const { return (size_t)(u.e * 1024 + u.pn * 128) * 256 * 2; }
    DEV unsigned aoff(const Unit& u) const { return (unsigned)(u.e * 256 * 2); }
    DEV unsigned arow(const Unit& u, int r) const { return (unsigned)(u.pm * BM + r); }
};
struct PlainOrder : StaticOrder {
    static constexpr bool GATHER = false;
    DEV size_t boff(const Unit& u) const { return (size_t)u.pn * 256 * 1024 * 2; }
    DEV unsigned aoff(const Unit&) const { return 0u; }
    DEV unsigned arow(const Unit& u, int r) const { return (unsigned)(u.pm * BM + r); }
};
struct EpiBf16Out {
    struct Pre {};
    static constexpr bool PAIR16 = false;
    DEV const char* gate_base(const Unit&) const { return nullptr; }
    static constexpr bool PERM = true;
    bf16_t* C;
    DEV void operator()(const f32x4 (&acc)[2][2][4][2], const Unit& u, int wr, int wc, int fr, int fq) const {
        const int row0 = u.pm * BM + wr * 64 + fr, col0 = u.pn * BM + wc * 32 + 8 * fq;
#pragma unroll
        for (int ai = 0; ai < 2; ++ai)
#pragma unroll
            for (int m = 0; m < 4; ++m) { bf16_t* rowp = C + (size_t)(row0 + ai * HALF + m * 16) * 1024 + col0;
#pragma unroll
                for (int bj = 0; bj < 2; ++bj) { const f32x4 v0 = acc[ai][bj][m][0], v1 = acc[ai][bj][m][1];
                    u32x4 w; w.x = pk2(v0[0], v0[1]); w.y = pk2(v0[2], v0[3]); w.z = pk2(v1[0], v1[1]); w.w = pk2(v1[2], v1[3]); *(u32x4*)(rowp + bj * HALF) = w; } }
    }
};
template <int MODE> struct MoeOrder {
    static constexpr bool GATHER = (MODE == 1);
    const LAS unsigned* ul;
    const int* rowtk;
    DEV bool next(int i, Unit& u) const {
        const unsigned p = (unsigned)__builtin_amdgcn_readfirstlane((int)ul[i]); if (p == 0xffffffffu) return false;
        u.pn = (int)(p & 7u); u.e = (int)((p >> 3) & 31u); u.mt = (int)((p >> 8) & 127u); u.pm = (int)((p >> 15) & 511u); u.cnt = (int)(p >> 24) + 1; return true;
    }
    DEV size_t boff(const Unit& u) const { return MODE == 1 ? ((size_t)u.e * 2048 + u.pn * 256) * 1024 * 2 : ((size_t)u.e * 1024 + u.pn * 256) * 1024 * 2; }
    DEV unsigned aoff(const Unit&) const { return 0u; }
    DEV unsigned arow(const Unit& u, int r) const {
        if (MODE == 2) return (unsigned)(u.pm * 256 + r);
        return r < u.cnt ? (unsigned)(rowtk[(size_t)u.e * NT + u.mt * 256 + r] >> 2) : 0u;
    }
    DEV const int* idx_ptr(const Unit& u) const { return rowtk + (size_t)u.e * NT + u.mt * 256; }
    DEV unsigned arow_from(const Unit& u, int r, int ix) const { return r < u.cnt ? (unsigned)(ix >> 2) : 0u; }
};
struct EpiMoe1 {
    struct Pre {};
    DEV const char* gate_base(const Unit&) const { return nullptr; }
    static constexpr bool PERM = true, PAIR16 = true;
    bf16_t* ACT; const float* b1;
    DEV void operator()(const f32x4 (&acc)[2][2][4][2], const Unit& u, int wr, int wc, int fr, int fq) const {
        const int row0 = u.pm * BM + wr * 64 + fr, q = 4 * wc + fq, hcol0 = u.pn * BM + 16 * q;
        const float* bp = b1 + (size_t)u.e * 2048 + hcol0;
        f32x4 bv[2][2];
#pragma unroll
        for (int bj = 0; bj < 2; ++bj)
#pragma unroll
            for (int n = 0; n < 2; ++n) bv[bj][n] = *(const f32x4*)(bp + 8 * bj + 4 * n);
#pragma unroll
        for (int ai = 0; ai < 2; ++ai)
#pragma unroll
            for (int m = 0; m < 4; ++m) { bf16_t* rowp = ACT + (size_t)(row0 + ai * HALF + m * 16) * 1024 + (hcol0 >> 1);
                float o[8];
#pragma unroll
                for (int bj = 0; bj < 2; ++bj) { const f32x4 v0 = acc[ai][bj][m][0] + bv[bj][0], v1 = acc[ai][bj][m][1] + bv[bj][1];
#pragma unroll
                    for (int j = 0; j < 4; ++j) { const float hg = j < 2 ? v0[2 * j] : v1[2 * j - 4], hl = j < 2 ? v0[2 * j + 1] : v1[2 * j - 3];
                        const float glu = fminf(hg, 7.f), lin = fminf(fmaxf(hl, -7.f), 7.f); o[4 * bj + j] = glu * sigmoidf_(1.702f * glu) * (lin + 1.f); } }
                u32x4 w; w.x = pk2(o[0], o[1]); w.y = pk2(o[2], o[3]); w.z = pk2(o[4], o[5]); w.w = pk2(o[6], o[7]); *(u32x4*)rowp = w; }
    }
};
struct EpiMoe2 {
    struct Pre {};
    static constexpr bool PAIR16 = false;
    DEV const char* gate_base(const Unit&) const { return nullptr; }
    static constexpr bool PERM = true;
    bf16_t* Y; const float* b2; const int* rowtk;
    DEV void operator()(const f32x4 (&acc)[2][2][4][2], const Unit& u, int wr, int wc, int fr, int fq) const {
        const int col0 = u.pn * BM + wc * 32 + 8 * fq;
        const float* bp = b2 + (size_t)u.e * 1024 + col0;
        f32x4 bv[2][2];
#pragma unroll
        for (int bj = 0; bj < 2; ++bj)
#pragma unroll
            for (int n = 0; n < 2; ++n) bv[bj][n] = *(const f32x4*)(bp + bj * HALF + 4 * n);
        const int* rt = rowtk + (size_t)u.e * NT + u.mt * 256 + wr * 64 + fr;
        int dst[2][4];
#pragma unroll
        for (int ai = 0; ai < 2; ++ai)
#pragma unroll
            for (int m = 0; m < 4; ++m) dst[ai][m] = rt[ai * HALF + m * 16];
        asm volatile("" :: "v"(bv[0][0]), "v"(bv[0][1]), "v"(bv[1][0]), "v"(bv[1][1]), "v"(dst[0][0]), "v"(dst[0][1]), "v"(dst[0][2]), "v"(dst[0][3]), "v"(dst[1][0]), "v"(dst[1][1]), "v"(dst[1][2]), "v"(dst[1][3]));
#pragma unroll
        for (int ai = 0; ai < 2; ++ai)
#pragma unroll
            for (int m = 0; m < 4; ++m) { const int r = ai * HALF + wr * 64 + m * 16 + fr;
                if (r < u.cnt) { bf16_t* rowp = Y + (size_t)dst[ai][m] * 1024 + col0;
#pragma unroll
                    for (int bj = 0; bj < 2; ++bj) { const f32x4 v0 = acc[ai][bj][m][0] + bv[bj][0], v1 = acc[ai][bj][m][1] + bv[bj][1];
                        u32x4 w; w.x = pk2(v0[0], v0[1]); w.y = pk2(v0[2], v0[3]); w.z = pk2(v1[0], v1[1]); w.w = pk2(v1[2], v1[3]); *(u32x4*)(rowp + bj * HALF) = w; } } }
    }
};
}

struct Frame {
    LAS unsigned char* lds;
    volatile LAS unsigned* MISC;
    unsigned* ctl;
    unsigned char* ws;
    int tid, lane, wave, G, bid;
};
template <class T> DEV T* wsp(const Frame& F, size_t off) { return (T*)(F.ws + off); }
DEV void frame_refresh(Frame& F) {
    int t_ = threadIdx.x; asm volatile("" : "+v"(t_)); F.tid = t_; F.lane = t_ & 63; F.wave = __builtin_amdgcn_readfirstlane(t_ >> 6);
    unsigned long long w_ = (unsigned long long)F.ws; asm volatile("" : "+s"(w_)); F.ws = (unsigned char*)(GAS unsigned char*)w_; F.ctl = (unsigned*)F.ws;
}

struct IdMap { DEV int operator()(int i) const { return i; } };
struct HpColMap { DEV int operator()(int c) const { return hp_src_col(c); } };
struct CmpRowMap { DEV int operator()(int k) const { return (k & ~63) + perm16(k & 63); } };
template <class RM, class CM>
DEV void transpose_item(const float* W, int ldw, bf16_t* WT, int ldt, int k0, int n0, LAS float* scr, int lane, RM rm, CM cm) {
    const int nn = lane & 31; const int sc = cm(n0 + nn);
#pragma unroll 8
    for (int i = 0; i < 32; ++i) { const int kk = 2 * i + (lane >> 5); scr[kk * 33 + nn] = sc >= 0 ? W[(size_t)rm(k0 + kk) * ldw + sc] : 0.f; }
    LDS_WAIT(); asm volatile("" ::: "memory");
    const int c = lane & 7;
#pragma unroll
    for (int j = 0; j < 4; ++j) { const int n = (lane >> 3) + 8 * j; const LAS float* s = scr + (8 * c) * 33 + n;
        u32x4 o; o.x = pk2(s[0 * 33], s[1 * 33]); o.y = pk2(s[2 * 33], s[3 * 33]); o.z = pk2(s[4 * 33], s[5 * 33]); o.w = pk2(s[6 * 33], s[7 * 33]);
        *(u32x4*)(WT + (size_t)(n0 + n) * ldt + k0 + 8 * c) = o; }
    LDS_WAIT(); asm volatile("" ::: "memory");
}
struct TItem { const float* W; bf16_t* WT; int ldw, ldt, k0, n0, rmap; };
DEV void titem_load(const TItem& it, f32x4 (&v)[16], int lane) {
    const int nq = lane & 15, kr = lane >> 4;
    if (it.rmap == 2) { const int n = it.n0 + 4 * nq; const int c0 = hp_src_col(n), c1 = hp_src_col(n + 1), c2 = hp_src_col(n + 2), c3 = hp_src_col(n + 3);
        const bool quad = (c0 >= 0) && (c1 == c0 + 1) && (c2 == c0 + 2) && (c3 == c0 + 3);
#pragma unroll
        for (int i = 0; i < 16; ++i) { const float* rp = it.W + (size_t)(it.k0 + 4 * i + kr) * it.ldw;
            if (quad) v[i] = __builtin_nontemporal_load((const f32x4*)(rp + c0));
            else v[i] = (f32x4){c0 >= 0 ? rp[c0] : 0.f, c1 >= 0 ? rp[c1] : 0.f, c2 >= 0 ? rp[c2] : 0.f, c3 >= 0 ? rp[c3] : 0.f}; }
        return; }
#pragma unroll
    for (int i = 0; i < 16; ++i) { int k = it.k0 + 4 * i + kr; if (it.rmap) k = (k & ~63) + perm16(k & 63); v[i] = __builtin_nontemporal_load((const f32x4*)(it.W + (size_t)k * it.ldw + it.n0 + 4 * nq)); }
}
DEV void titem_store(const TItem& it, const f32x4 (&v)[16], LAS bf16_t* scr, int lane) {
    const int nq = lane & 15, kr = lane >> 4; constexpr int SP = 66;
#pragma unroll
    for (int i = 0; i < 16; ++i) { LAS unsigned* d = (LAS unsigned*)(scr + (4 * i + kr) * SP + 4 * nq); d[0] = pk2(v[i][0], v[i][1]); d[1] = pk2(v[i][2], v[i][3]); }
    LDS_WAIT(); asm volatile("" ::: "memory");
    const int c = lane & 7;
#pragma unroll
    for (int j = 0; j < 8; ++j) { const int n = (lane >> 3) + 8 * j; const LAS bf16_t* sp = scr + (8 * c) * SP + n;
        u32x4 o; o.x = sp[0] | ((unsigned)sp[SP] << 16); o.y = sp[2 * SP] | ((unsigned)sp[3 * SP] << 16); o.z = sp[4 * SP] | ((unsigned)sp[5 * SP] << 16); o.w = sp[6 * SP] | ((unsigned)sp[7 * SP] << 16);
        __builtin_nontemporal_store(o, (u32x4*)(it.WT + (size_t)(it.n0 + n) * it.ldt + it.k0 + 8 * c)); }
    LDS_WAIT(); asm volatile("" ::: "memory");
}
constexpr long BG_PER_LAYER = 32L * 512 + 32L * 256, BG_TOTAL = NL * BG_PER_LAYER;
DEV void bg_item(const Frame& F, const Params& P, long idx, LAS bf16_t* scr, int lane) {
    const int l = (int)(idx / BG_PER_LAYER); long r = idx - (long)l * BG_PER_LAYER; TItem it;
    if (r < 32L * 512) { const int mat = l * 32 + (int)(r >> 9), q = (int)(r & 511); it = TItem{P.in[I_WE1] + (size_t)mat * 1024 * 2048, wsp<bf16_t>(F, WS_W1) + (size_t)mat * 2048 * 1024, 2048, 1024, (q >> 5) * 64, (q & 31) * 64, 0}; }
    else { r -= 32L * 512; const int mat = l * 32 + (int)(r >> 8), q = (int)(r & 255); it = TItem{P.in[I_WE2] + (size_t)mat * 1024 * 1024, wsp<bf16_t>(F, WS_W2) + (size_t)mat * 1024 * 1024, 1024, 1024, (q >> 4) * 64, (q & 15) * 64, 0}; }
    f32x4 v[16]; titem_load(it, v, lane); titem_store(it, v, scr, lane);
}
constexpr int BG_CHUNK = 8, BG_FILL_STRIDE = 4;
DEV void bg_fill(Frame F, const Params& P, unsigned* done, long limit) {
    frame_refresh(F);
    unsigned* head = F.ctl + CW_BGQ; LAS bf16_t* scr = (LAS bf16_t*)(F.lds + F.wave * 16384); const int lane = F.lane;
    if (done && (F.wave % BG_FILL_STRIDE) != 0) return;
#pragma unroll 1
    for (;;) {
        if (done) { if ((unsigned)__builtin_amdgcn_readfirstlane(__hip_atomic_load(done, __ATOMIC_RELAXED, __HIP_MEMORY_SCOPE_AGENT)) >= (unsigned)F.G) break; }
        else { if ((long)(unsigned)__builtin_amdgcn_readfirstlane(__hip_atomic_load(head, __ATOMIC_RELAXED, __HIP_MEMORY_SCOPE_AGENT)) >= limit) break; }
        unsigned base = 0u; if (lane == 0) base = atomicAdd(head, (unsigned)BG_CHUNK);
        base = (unsigned)__builtin_amdgcn_readfirstlane(base);
        if ((long)base >= BG_TOTAL) break;
#pragma unroll 1
        for (int i = 0; i < BG_CHUNK; ++i) if ((long)base + i < BG_TOTAL) bg_item(F, P, (long)base + i, scr, lane);
    }
}
DEV void p0_prologue(Frame F, const Params& P) {
    frame_refresh(F);
    LAS float* scr = (LAS float*)(F.lds + F.wave * 16384);
    const int gw = F.bid * NWAVES + F.wave, NGW = F.G * NWAVES, lane = F.lane;
    LAS bf16_t* scrh = (LAS bf16_t*)scr;
    constexpr long I_E1 = 0, I_E2 = 0, I_BRI = (long)NL * 4 * 64, I_OI = (long)NL * 256, I_C1 = (long)NL * 2 * 32;
    constexpr long I_IN64 = (long)NL * 16 * 104;
    constexpr long N64 = I_E1 + I_E2 + I_BRI + I_OI + I_C1 + I_IN64;
#define P0_DECODE(it, r_) do { long r = (r_); \
        if (r < I_E1) { const int mat = (int)(r >> 9), q = (int)(r & 511); it = TItem{P.in[I_WE1] + (size_t)mat * 1024 * 2048, wsp<bf16_t>(F, WS_W1) + (size_t)mat * 2048 * 1024, 2048, 1024, (q >> 5) * 64, (q & 31) * 64, 0}; break; } \
        r -= I_E1; \
        if (r < I_E2) { const int mat = (int)(r >> 8), q = (int)(r & 255); it = TItem{P.in[I_WE2] + (size_t)mat * 1024 * 1024, wsp<bf16_t>(F, WS_W2) + (size_t)mat * 1024 * 1024, 1024, 1024, (q >> 4) * 64, (q & 15) * 64, 0}; break; } \
        r -= I_E2; \
        if (r < I_BRI) { const int mat = (int)(r >> 6), q = (int)(r & 63); it = TItem{P.in[I_WBR] + (size_t)mat * 256 * 1024, wsp<bf16_t>(F, WS_WBR) + (size_t)mat * 1024 * 256, 1024, 256, (q >> 4) * 64, (q & 15) * 64, 0}; break; } \
        r -= I_BRI; \
        if (r < I_OI) { const int l_ = (int)(r >> 8), q = (int)(r & 255); it = TItem{P.in[I_WO] + (size_t)l_ * 1024 * 1024, wsp<bf16_t>(F, WS_WO) + (size_t)l_ * 1024 * 1024, 1024, 1024, (q >> 4) * 64, (q & 15) * 64, 0}; break; } \
        r -= I_OI; \
        if (r < I_C1) { const int mat = (int)(r >> 5), l_ = mat >> 1, kv = mat & 1; it = TItem{P.in[kv ? I_W1V : I_W1K] + (size_t)l_ * 2048 * 64, wsp<bf16_t>(F, WS_WC1) + (size_t)mat * 64 * 2048, 64, 2048, (int)(r & 31) * 64, 0, kv == 0 ? 1 : 0}; break; } \
        r -= I_C1; \
        { const int l_ = (int)(r / (16 * 104)), q = (int)(r % (16 * 104)); it = TItem{P.in[I_WIN] + (size_t)l_ * 1024 * NIN, wsp<bf16_t>(F, WS_WIN) + (size_t)l_ * NP * 1024, NIN, 1024, (q / 104) * 64, (q % 104) * 64, 2}; } } while (0)
    { f32x4 va[16], vb[16]; TItem ia, ib; long it = gw;
        if (it < N64) { P0_DECODE(ia, it); titem_load(ia, va, lane); }
#pragma unroll 1
        for (; it < N64; it += 2 * (long)NGW) {
            const long i2 = it + NGW, i3 = it + 2 * (long)NGW;
            if (i2 < N64) { P0_DECODE(ib, i2); titem_load(ib, vb, lane); }
            titem_store(ia, va, scrh, lane);
            if (i3 < N64) { P0_DECODE(ia, i3); titem_load(ia, va, lane); }
            if (i2 < N64) titem_store(ib, vb, scrh, lane);
        } }
#undef P0_DECODE
    constexpr long I_C2 = (long)NL * 2 * 2;
    for (long it = gw; it < I_C2; it += NGW) { const long r = it;
        { const int mat = (int)(r >> 1), l = mat >> 1, kv = mat & 1, nb = (int)(r & 1);
            transpose_item(P.in[kv ? I_W2V : I_W2K] + (size_t)l * 64 * 64, 64, wsp<bf16_t>(F, WS_WC2) + (size_t)mat * 64 * 64, 64, 0, nb * 32, scr, lane, IdMap(), IdMap()); }
    }
    const int gt = F.bid * NTHR + F.tid, NGT = F.G * NTHR;
    {
        const float* ws_ = P.in[I_GWS]; bf16_t* wg = wsp<bf16_t>(F, WS_WG);
        for (int i = gt; i < NL * 4 * 128 * 128; i += NGT) { const int s = i & 127, t = (i >> 7) & 127; wg[i] = (s <= t) ? f2bf(ws_[i]) : (bf16_t)0; }
    }
    {
        float* bp = wsp<float>(F, WS_BIN);
        for (int i = gt; i < NL * NP; i += NGT) { const int l = i / NP, c = i % NP, sc = hp_src_col(c); bp[i] = sc >= 0 ? P.in[I_BIN][(size_t)l * NIN + sc] : 0.f; }
    }
    {
        float* cs = wsp<float>(F, WS_CS); const int* pos = (const int*)P.in[I_POS];
        for (int i = gt; i < NT * 8; i += NGT) { const int t = i >> 3, f = i & 7;
            const double ang = (double)pos[t] * P.invf[f];
            const double twopi = 6.283185307179586476925286766559; double r = ang - twopi * rint(ang / twopi);
            const double r2 = r * r; double sn = 0.0, cn = 0.0, term = r;
#pragma unroll 1
            for (int k = 1; k <= 29; k += 2) { sn += term; term *= -r2 / (double)((k + 1) * (k + 2)); }
            term = 1.0;
#pragma unroll 1
            for (int k = 0; k <= 28; k += 2) { cn += term; term *= -r2 / (double)((k + 1) * (k + 2)); }
            cs[(size_t)t * 16 + f] = (float)cn; cs[(size_t)t * 16 + 8 + f] = (float)sn; }
    }
    {
        const f32x4* x4 = (const f32x4*)P.in[I_X]; u32x2* xb = wsp<u32x2>(F, WS_XB);
        for (int i = gt; i < NT * 256; i += NGT) { const f32x4 v = x4[i]; u32x2 w; w.x = pk2(v[0], v[1]); w.y = pk2(v[2], v[3]); xb[i] = w; }
    }
    for (int task = gw; task < NL * 2 * 32; task += NGW) { const int lk = task >> 5, part = task & 31, l = lk >> 1, kv = lk & 1;
        const float* pe = P.in[kv ? I_PEV : I_PEK] + (size_t)l * 2048 + part * 64; const float* w1 = P.in[kv ? I_W1V : I_W1K] + ((size_t)l * 2048 + part * 64) * 64;
        float a = 0.f;
#pragma unroll 16
        for (int k = 0; k < 64; ++k) a += pe[k] * w1[(size_t)k * 64 + lane];
        wsp<float>(F, WS_CB)[task * 64 + lane] = a; }
}

DEV void pb_transpose_unit(Frame F, int unit) {
    frame_refresh(F);
    const int b = unit >> 6, t0 = (unit & 63) * 64; const int tid = F.tid;
    const bf16_t* H = wsp<bf16_t>(F, WS_H); const float* cs = wsp<float>(F, WS_CS);
    const size_t rowb = (size_t)b * SEQ + t0;
    LAS bf16_t* tile = (LAS bf16_t*)F.lds; constexpr int TP = 392;
    LAS unsigned* nmx = (LAS unsigned*)(F.lds + 65536);
    u32x4 rw[2]; f32x4 rc[2], rs[2]; u32x4 vw[6], kw[4];
#pragma unroll
    for (int it = 0; it < 2; ++it) { const int task = tid + it * NTHR, tok = task >> 4, hd = (task >> 3) & 1, ch = task & 7; const size_t row = rowb + tok;
        rw[it] = *(const u32x4*)(H + row * NP + (hd ? HP_KW : HP_KS) + ch * 8);
        const float* c = cs + row * 16 + 4 * (ch & 1); rc[it] = *(const f32x4*)c; rs[it] = *(const f32x4*)(c + 8); }
#pragma unroll
    for (int it = 0; it < 6; ++it) { const int task = tid + it * NTHR, tok = task / 48, ch = task % 48;
        const int scol = ch < 8 ? HP_VS + ch * 8 : (ch < 16 ? HP_VW + (ch - 8) * 8 : HP_FV + (ch - 16) * 8);
        vw[it] = *(const u32x4*)(H + (rowb + tok) * NP + scol); }
    { const int tok = tid >> 3, part = tid & 7;
#pragma unroll
        for (int q = 0; q < 4; ++q) kw[q] = *(const u32x4*)(H + (rowb + tok) * NP + HP_FK + part * 32 + q * 8); }
    if (tid < 4) nmx[tid] = 0u;
#pragma unroll
    for (int it = 0; it < 2; ++it) { const int task = tid + it * NTHR, tok = task >> 4, hd = (task >> 3) & 1, ch = task & 7; const size_t row = rowb + tok;
        u32x4 w = rw[it]; unsigned* wp = (unsigned*)&w;
#pragma unroll
        for (int j = 0; j < 4; ++j) { const float t1 = bflo(wp[j]), t2 = bfhi(wp[j]); const unsigned rot = pk2(t1 * rc[it][j] - t2 * rs[it][j], t2 * rc[it][j] + t1 * rs[it][j]); wp[j] = (ch < 2) ? rot : wp[j]; }
        *(u32x4*)(wsp<bf16_t>(F, WS_KNSA) + row * 128 + hd * 64 + ch * 8) = w; }
#pragma unroll
    for (int it = 0; it < 6; ++it) { const int task = tid + it * NTHR, tok = task / 48, ch = task % 48; const u32x4 w = vw[it];
        *(LAS u32x2*)(tile + tok * TP + ch * 8) = (u32x2){w.x, w.y}; *(LAS u32x2*)(tile + tok * TP + ch * 8 + 4) = (u32x2){w.z, w.w}; }
    __syncthreads();
    { const int part = tid & 7; float ss = 0.f;
#pragma unroll
        for (int q = 0; q < 4; ++q) { const unsigned* wp = (const unsigned*)&kw[q];
#pragma unroll
            for (int j = 0; j < 4; ++j) { const float a = bflo(wp[j]), c = bfhi(wp[j]); ss += a * a + c * c; } }
        ss += __shfl_xor(ss, 1);
        if ((part & 1) == 0) (void)__hip_atomic_fetch_max(nmx + (part >> 1), __float_as_uint(ss), __ATOMIC_RELAXED, __HIP_MEMORY_SCOPE_WORKGROUP); }
    bf16_t* VT = wsp<bf16_t>(F, WS_VT);
#pragma unroll
    for (int it = 0; it < 6; ++it) { const int task = tid + it * NTHR, d = task % 384, sc = task / 384;
        unsigned short v[8];
#pragma unroll
        for (int j = 0; j < 8; ++j) v[j] = tile[(sc * 8 + j) * TP + d];
        u32x4 w; w.x = v[0] | ((unsigned)v[1] << 16); w.y = v[2] | ((unsigned)v[3] << 16); w.z = v[4] | ((unsigned)v[5] << 16); w.w = v[6] | ((unsigned)v[7] << 16);
        *(u32x4*)(VT + ((size_t)b * 384 + d) * SEQ + t0 + sc * 8) = w; }
    __syncthreads();
    if (tid < 4) wsp<float>(F, WS_KN)[((size_t)b * 4 + tid) * 64 + (t0 >> 6)] = sqrtf(__uint_as_float(nmx[tid])) * 1.0001f;
    __syncthreads();
}
DEV void pb_cum_unit(Frame F, int unit) {
    frame_refresh(F);
    const int b = unit >> 2, h = unit & 3, tid = F.tid;
    const float* side = wsp<float>(F, WS_SIDE);
    LAS double* sc = (LAS double*)F.lds;
    double loc[8]; double s = 0.0;
#pragma unroll
    for (int j = 0; j < 8; ++j) { const float x = side[((size_t)b * SEQ + tid * 8 + j) * 16 + 12 + h];
        const float ls = fminf(x, 0.f) - __logf(1.f + __expf(-fabsf(x)));
        s += (double)ls; loc[j] = s; }
    double inc = s;
#pragma unroll
    for (int o = 1; o < 64; o <<= 1) { const double t = __shfl_up(inc, o); if (F.lane >= o) inc += t; }
    if (F.lane == 63) sc[F.wave] = inc;
    __syncthreads();
    double wbase = 0.0;
#pragma unroll
    for (int w = 0; w < 8; ++w) wbase += (w < F.wave) ? sc[w] : 0.0;
    __syncthreads();
    sc[8 + tid] = wbase + inc - s;
    const double base = sc[8 + tid]; float* cum = wsp<float>(F, WS_CUM) + ((size_t)b * 4 + h) * SEQ + tid * 8;
#pragma unroll
    for (int j = 0; j < 8; ++j) cum[j] = (float)((base + loc[j]) * 1.4426950408889634);
    __syncthreads();
}
DEV void pb_conv_unit(Frame F, const Params& P, int l, int unit) {
    frame_refresh(F);
    const int b = unit >> 6, t0 = (unit & 63) * 64, tid = F.tid, lane = F.lane, wave = F.wave;
    const bf16_t* H = wsp<bf16_t>(F, WS_H);
    float w[31]; { const float* cw = P.in[I_CW] + (size_t)l * 31 * 256 + (tid & 255);
#pragma unroll
        for (int j = 0; j < 31; ++j) w[j] = cw[j * 256]; }
    const float bias = P.in[I_CB][l * 256 + (tid & 255)];
    LAS bf16_t* xg = (LAS bf16_t*)F.lds;
    LAS float* cv = (LAS float*)(F.lds + 49152);
    { u32x4 wv[12];
#pragma unroll
        for (int it = 0; it < 12; ++it) { const int task = tid + it * NTHR, r = task >> 6, c4 = (task & 63) * 4; const int t = t0 - 30 + r;
            wv[it] = (task < 94 * 64 && t >= 0) ? *(const u32x4*)(H + ((size_t)b * SEQ + t) * NP + HP_CAB + 2 * c4) : (u32x4){0u, 0u, 0u, 0u}; }
#pragma unroll
        for (int it = 0; it < 12; ++it) { const int task = tid + it * NTHR, r = task >> 6, c4 = (task & 63) * 4;
            if (task < 94 * 64) { const unsigned* wp = (const unsigned*)&wv[it]; float g[4];
#pragma unroll
                for (int j = 0; j < 4; ++j) g[j] = bflo(wp[j]) * sigmoidf_(bfhi(wp[j]));
                *(LAS u32x2*)(xg + r * 256 + c4) = (u32x2){pk2(g[0], g[1]), pk2(g[2], g[3])}; } } }
    __syncthreads();
    { const int c = tid & 255, half = tid >> 8;
        float xw[62];
#pragma unroll
        for (int j = 0; j < 62; ++j) xw[j] = bf2f(xg[(half * 32 + j) * 256 + c]);
#pragma unroll
        for (int tt = 0; tt < 32; ++tt) { float a = bias;
#pragma unroll
            for (int j = 0; j < 31; ++j) a += w[j] * xw[tt + j];
            cv[(half * 32 + tt) * 256 + c] = a; } }
    __syncthreads();
    { const f32x4 gg = *(const f32x4*)(P.in[I_CLNG] + l * 256 + lane * 4), bb = *(const f32x4*)(P.in[I_CLNB] + l * 256 + lane * 4);
        bf16_t* BR = wsp<bf16_t>(F, WS_BR);
#pragma unroll 1
        for (int i = 0; i < 8; ++i) { const int tt = wave * 8 + i; f32x4 v = *(const LAS f32x4*)(cv + tt * 256 + lane * 4);
            const float mean = wave_sum((v[0] + v[1]) + (v[2] + v[3])) * (1.f / 256.f); v = v - mean;
            const float var = wave_sum((v[0] * v[0] + v[1] * v[1]) + (v[2] * v[2] + v[3] * v[3])) * (1.f / 256.f);
            const float rstd = 1.f / sqrtf(var + LN_EPS); v = v * rstd * gg + bb;
#pragma unroll
            for (int j = 0; j < 4; ++j) v[j] = v[j] * sigmoidf_(v[j]);
            u32x2 o; o.x = pk2(v[0], v[1]); o.y = pk2(v[2], v[3]);
            *(u32x2*)(BR + ((size_t)b * SEQ + t0 + tt) * 1024 + 768 + lane * 4) = o; } }
    __syncthreads();
}
DEV void pb_gmlp_unit(Frame F, const Params& P, int l, int unit) {
    frame_refresh(F);
    const int t0 = unit * 128, tid = F.tid, lane = F.lane, wave = F.wave, fr = lane & 15, fq = lane >> 4;
    const bf16_t* H = wsp<bf16_t>(F, WS_H);
    LAS bf16_t* vt = (LAS bf16_t*)F.lds; constexpr int VP = 136;
    { const f32x4 gg = *(const f32x4*)(P.in[I_GLNG] + l * 256 + lane * 4), bb = *(const f32x4*)(P.in[I_GLNB] + l * 256 + lane * 4);
        u32x2 wv[16];
#pragma unroll
        for (int i = 0; i < 16; ++i) wv[i] = *(const u32x2*)(H + (size_t)(t0 + wave * 16 + i) * NP + HP_GV + lane * 4);
#pragma unroll
        for (int i = 0; i < 16; ++i) { const int s = wave * 16 + i; const u32x2 w = wv[i];
            f32x4 v = {gelu_tanh(bflo(w.x)), gelu_tanh(bfhi(w.x)), gelu_tanh(bflo(w.y)), gelu_tanh(bfhi(w.y))};
            const float mean = wave_sum((v[0] + v[1]) + (v[2] + v[3])) * (1.f / 256.f); v = v - mean;
            const float var = wave_sum((v[0] * v[0] + v[1] * v[1]) + (v[2] * v[2] + v[3] * v[3])) * (1.f / 256.f);
            const float rstd = 1.f / sqrtf(var + LN_EPS); v = v * rstd * gg + bb;
#pragma unroll
            for (int j = 0; j < 4; ++j) vt[(lane * 4 + j) * VP + s] = f2bf(v[j]); } }
    __syncthreads();
    { const int g = wave & 3, th = wave >> 2;
        const bf16_t* Wg = wsp<bf16_t>(F, WS_WG) + ((size_t)l * 4 + g) * 128 * 128;
        bf16_t* BR = wsp<bf16_t>(F, WS_BR);
        bf16x8 wf[4][4]; u32x2 uw[4][4]; float bs[4];
#pragma unroll
        for (int tb = 0; tb < 4; ++tb) { const int trow = th * 64 + tb * 16;
#pragma unroll
            for (int ks = 0; ks < 4; ++ks) wf[tb][ks] = (ks * 32 <= trow + 15) ? *(const bf16x8*)(Wg + (size_t)(trow + fr) * 128 + ks * 32 + fq * 8) : (bf16x8){0, 0, 0, 0, 0, 0, 0, 0};
#pragma unroll
            for (int db = 0; db < 4; ++db) uw[tb][db] = *(const u32x2*)(H + (size_t)(t0 + trow + fr) * NP + HP_GU + g * 64 + db * 16 + fq * 4);
            bs[tb] = P.in[I_GBS][((size_t)l * 4 + g) * 128 + trow + fr]; }
#pragma unroll
        for (int tb = 0; tb < 4; ++tb) { const int trow = th * 64 + tb * 16;
            f32x4 acc[4];
#pragma unroll
            for (int db = 0; db < 4; ++db) acc[db] = (f32x4){0.f, 0.f, 0.f, 0.f};
#pragma unroll
            for (int ks = 0; ks < 4; ++ks) if (ks * 32 <= trow + 15) {
#pragma unroll
                for (int db = 0; db < 4; ++db) { const bf16x8 vf = *(const LAS bf16x8*)(vt + (g * 64 + db * 16 + fr) * VP + ks * 32 + fq * 8);
                    acc[db] = mfma16(vf, wf[tb][ks], acc[db]); } }
            const int t = t0 + trow + fr;
#pragma unroll
            for (int db = 0; db < 4; ++db) { const int c = g * 64 + db * 16 + fq * 4; const u32x2 u2 = uw[tb][db]; const float b_ = bs[tb];
                const float o0 = gelu_tanh(bflo(u2.x)) * (acc[db][0] + b_), o1 = gelu_tanh(bfhi(u2.x)) * (acc[db][1] + b_), o2 = gelu_tanh(bflo(u2.y)) * (acc[db][2] + b_), o3 = gelu_tanh(bfhi(u2.y)) * (acc[db][3] + b_);
                u32x2 o; o.x = pk2(o0, o1); o.y = pk2(o2, o3); *(u32x2*)(BR + (size_t)t * 1024 + 512 + c) = o; } } }
    __syncthreads();
}
DEV void pb_compress_unit(Frame F, int l, int unit) {
    frame_refresh(F);
    const int kv = unit & 1, mb = (unit >> 1) & 15, b = unit >> 5; const int tid = F.tid, lane = F.lane, wave = F.wave, fr = lane & 15, fq = lane >> 4;
    const bf16_t* H = wsp<bf16_t>(F, WS_H); const float* cs = wsp<float>(F, WS_CS);
    const bf16_t* W1 = wsp<bf16_t>(F, WS_WC1) + ((size_t)l * 2 + kv) * 64 * 2048; const bf16_t* W2 = wsp<bf16_t>(F, WS_WC2) + ((size_t)l * 2 + kv) * 64 * 64;
    const f32x4 cbv = *(const f32x4*)(wsp<float>(F, WS_CB) + ((size_t)l * 2 + kv) * 32 * 64 + tid * 4);
    LAS float* red = (LAS float*)F.lds;
    LAS bf16_t* h1 = (LAS bf16_t*)(F.lds + 32768);
    f32x4 acc[4];
#pragma unroll
    for (int nb = 0; nb < 4; ++nb) acc[nb] = (f32x4){0.f, 0.f, 0.f, 0.f};
    const int c = mb * 16 + fr;
    { u32x4 aw[8]; f32x4 cco[4], csi[4];
#pragma unroll
        for (int ks_ = 0; ks_ < 8; ++ks_) { const int ks = wave * 8 + ks_; const int j = ks >> 1, dch = (ks & 1) * 32 + fq * 8; int tok = c * 16 + j; tok = tok > SEQ - 1 ? SEQ - 1 : tok;
            const size_t row = (size_t)b * SEQ + tok;
            aw[ks_] = *(const u32x4*)(H + row * NP + (kv ? HP_VC : HP_KC) + dch);
            if ((ks_ & 1) == 0) { const float* cc = cs + row * 16 + ((fq & 1) * 4); cco[ks_ >> 1] = *(const f32x4*)cc; csi[ks_ >> 1] = *(const f32x4*)(cc + 8); } }
#pragma unroll
        for (int hb = 0; hb < 2; ++hb) { bf16x8 bw[4][4];
#pragma unroll
            for (int k4 = 0; k4 < 4; ++k4)
#pragma unroll
                for (int nb = 0; nb < 4; ++nb) bw[k4][nb] = *(const bf16x8*)(W1 + (size_t)(nb * 16 + fr) * 2048 + (wave * 8 + hb * 4 + k4) * 32 + fq * 8);
#pragma unroll
            for (int k4 = 0; k4 < 4; ++k4) { const int ks_ = hb * 4 + k4; u32x4 w = aw[ks_];
                if ((ks_ & 1) == 0) { const bool rp = (kv == 0) && (fq < 2); unsigned* wp = (unsigned*)&w; const f32x4 co = cco[ks_ >> 1], si = csi[ks_ >> 1];
#pragma unroll
                    for (int q = 0; q < 4; ++q) { const float t1 = bflo(wp[q]), t2 = bfhi(wp[q]); const unsigned rot = pk2(t1 * co[q] - t2 * si[q], t2 * co[q] + t1 * si[q]); wp[q] = rp ? rot : wp[q]; } }
                const bf16x8 af = __builtin_bit_cast(bf16x8, w);
#pragma unroll
                for (int nb = 0; nb < 4; ++nb) acc[nb] = mfma16(af, bw[k4][nb], acc[nb]); } } }
#pragma unroll
    for (int nb = 0; nb < 4; ++nb)
#pragma unroll
        for (int i = 0; i < 4; ++i) red[(wave * 16 + fq * 4 + i) * 64 + nb * 16 + fr] = acc[nb][i];
    __syncthreads();
    { LAS float* cbl = (LAS float*)(F.lds + 36864);
        *(LAS f32x4*)(cbl + tid * 4) = cbv;
        __syncthreads();
#pragma unroll
        for (int it = 0; it < 2; ++it) { const int e = tid + it * NTHR, r = e >> 6, n = e & 63; float s = 0.f;
#pragma unroll
            for (int pp = 0; pp < 32; ++pp) s += cbl[pp * 64 + n];
#pragma unroll
            for (int w = 0; w < 8; ++w) s += red[(w * 16 + r) * 64 + n];
            h1[r * 72 + n] = f2bf(gelu_tanh(s)); } }
    __syncthreads();
    if (wave == 0) {
#pragma unroll
        for (int nb = 0; nb < 4; ++nb) { f32x4 o = (f32x4){0.f, 0.f, 0.f, 0.f};
#pragma unroll
            for (int ks = 0; ks < 2; ++ks) { const bf16x8 hf = *(const LAS bf16x8*)(h1 + fr * 72 + ks * 32 + fq * 8); const bf16x8 wf = *(const bf16x8*)(W2 + (size_t)(nb * 16 + fr) * 64 + ks * 32 + fq * 8);
                o = kv ? mfma16(hf, wf, o) : mfma16(wf, hf, o); }
            u32x2 w; w.x = pk2(o[0], o[1]); w.y = pk2(o[2], o[3]);
            if (kv == 0) *(u32x2*)(wsp<bf16_t>(F, WS_KCMP) + ((size_t)b * 256 + mb * 16 + fr) * 64 + nb * 16 + fq * 4) = w;
            else *(u32x2*)(wsp<bf16_t>(F, WS_VCMPT) + ((size_t)b * 64 + nb * 16 + fr) * 256 + mb * 16 + fq * 4) = w; } }
    __syncthreads();
}

constexpr int TILE_B = 9216, AT_KT = 0, AT_VT = 36864, AT_CK = 73728, AT_KC = 0, AT_VC = 36864, AT_XCH = 0, AT_TAB = 32768, AT_FXT = 74752, AT_XST = 77824;
constexpr int KTP = 72, VCP = 264, TABP = 65;
constexpr float QSCALE = 0.125f * LOG2E;
struct FlashSt { float m, l; f32x4 o[4]; };
DEV void flash_init(FlashSt& s) { s.m = -1e30f; s.l = 0.f;
#pragma unroll
    for (int d = 0; d < 4; ++d) s.o[d] = (f32x4){0.f, 0.f, 0.f, 0.f}; }
DEV bf16x8 pack_p(const f32x4& a, const f32x4& b) { u32x4 w; w.x = pk2(a[0], a[1]); w.y = pk2(a[2], a[3]); w.z = pk2(b[0], b[1]); w.w = pk2(b[2], b[3]); return __builtin_bit_cast(bf16x8, w); }
DEV bf16x8 vfrag(const LAS bf16_t* p) { const bf16x4 lo = *(const LAS bf16x4*)p, hi = *(const LAS bf16x4*)(p + 16); return __builtin_shufflevector(lo, hi, 0, 1, 2, 3, 4, 5, 6, 7); }
struct KVFrags { bf16x8 k[4][2]; bf16x8 v[4][2]; };
DEV void load_frags(KVFrags& f, const LAS bf16_t* kt, const LAS bf16_t* vt, int fr, int fq) {
#pragma unroll
    for (int kb = 0; kb < 4; ++kb) { const LAS bf16_t* kp = kt + (16 * kb + fr) * KTP + 8 * fq; f.k[kb][0] = *(const LAS bf16x8*)kp; f.k[kb][1] = *(const LAS bf16x8*)(kp + 32); }
#pragma unroll
    for (int d = 0; d < 4; ++d)
#pragma unroll
        for (int c = 0; c < 2; ++c) f.v[d][c] = vfrag(vt + (16 * d + fr) * KTP + 32 * c + 4 * fq);
}
DEV void qk_frags(f32x4 (&s)[4], const KVFrags& f, const bf16x8 (&qf)[2]) {
#pragma unroll
    for (int kb = 0; kb < 4; ++kb) { f32x4 a = mfma16(f.k[kb][0], qf[0], (f32x4){0.f, 0.f, 0.f, 0.f}); s[kb] = mfma16(f.k[kb][1], qf[1], a); }
}
DEV void flash_update(FlashSt& st, f32x4 (&s)[4], const KVFrags& f, bool on) {
    float mx = fmaxf(fmaxf(fmaxf(s[0][0], s[0][1]), fmaxf(s[0][2], s[0][3])), fmaxf(fmaxf(s[1][0], s[1][1]), fmaxf(s[1][2], s[1][3])));
    mx = fmaxf(mx, fmaxf(fmaxf(fmaxf(s[2][0], s[2][1]), fmaxf(s[2][2], s[2][3])), fmaxf(fmaxf(s[3][0], s[3][1]), fmaxf(s[3][2], s[3][3]))));
    mx = on ? mx : -INFINITY;
    mx = xr_max(mx);
    const float mn = fmaxf(st.m, mx), alpha = fexp2(st.m - mn); st.m = mn;
    const float mref = on ? mn : INFINITY;
    float sum = 0.f;
#pragma unroll
    for (int kb = 0; kb < 4; ++kb)
#pragma unroll
        for (int i = 0; i < 4; ++i) { const float p = fexp2(s[kb][i] - mref); s[kb][i] = p; sum += p; }
    st.l = st.l * alpha + sum;
#pragma unroll
    for (int d = 0; d < 4; ++d) st.o[d] = st.o[d] * alpha;
#pragma unroll
    for (int c = 0; c < 2; ++c) { const bf16x8 pf = pack_p(s[2 * c], s[2 * c + 1]);
#pragma unroll
        for (int d = 0; d < 4; ++d) st.o[d] = mfma16(f.v[d][c], pf, st.o[d]); }
}
DEV float flash_inv_l(const FlashSt& st) { const float l = xr_sum(st.l); return l > 0.f ? 1.f / l : 0.f; }
DEV bf16x8 load_q(const bf16_t* p, const float* c, bool rope, float scale) {
    u32x4 w = *(const u32x4*)p; unsigned* wp = (unsigned*)&w;
    f32x4 co = {1.f, 1.f, 1.f, 1.f}, si = {0.f, 0.f, 0.f, 0.f};
    if (c) { co = *(const f32x4*)c; si = *(const f32x4*)(c + 8); }
#pragma unroll
    for (int j = 0; j < 4; ++j) { const float t1 = bflo(wp[j]), t2 = bfhi(wp[j]);
        const float a = rope ? t1 * co[j] - t2 * si[j] : t1, bq = rope ? t2 * co[j] + t1 * si[j] : t2;
        wp[j] = pk2(a * scale, bq * scale); }
    return __builtin_bit_cast(bf16x8, w);
}
struct TileRegs { u32x4 k, v; };
DEV void tile_load(TileRegs& r, const bf16_t* kbase, size_t kpitch, const bf16_t* vtbase, int key0, int tid) {
    r.k = *(const u32x4*)(kbase + (size_t)(key0 + (tid >> 3)) * kpitch + (tid & 7) * 8);
    r.v = *(const u32x4*)(vtbase + (size_t)(tid >> 3) * SEQ + key0 + (tid & 7) * 8);
}
DEV void tile_store(const TileRegs& r, LAS bf16_t* kt, LAS bf16_t* vt, int tid) {
    *(LAS u32x4*)(kt + (tid >> 3) * KTP + (tid & 7) * 8) = r.k; *(LAS u32x4*)(vt + (tid >> 3) * KTP + (tid & 7) * 8) = r.v;
}

DEV void nsa_unit(Frame F, int b, int qt, int half) {
    frame_refresh(F);
    const int tid = F.tid, lane = F.lane, wave = F.wave, fr = lane & 15, fq = lane >> 4, sq = wave & 1, hp = (wave >> 1) & 1, ks = wave >> 2, head = 2 * hp + ks, qid = wave >> 1;
    const int ql = 32 * half + 16 * sq + fr, tq = qt * 64 + ql, cur = qt; const size_t rowq = (size_t)b * SEQ + tq;
    const bf16_t* H = wsp<bf16_t>(F, WS_H); const float* cs = wsp<float>(F, WS_CS); const float* side = wsp<float>(F, WS_SIDE);
    LAS bf16_t* KT = (LAS bf16_t*)(F.lds + AT_KT); LAS bf16_t* VT = (LAS bf16_t*)(F.lds + AT_VT);
    LAS bf16_t* KC = (LAS bf16_t*)(F.lds + AT_KC); LAS bf16_t* VC = (LAS bf16_t*)(F.lds + AT_VC);
    bf16x8 qf2[2][2], qf[2]; float gate[3];
#pragma unroll
    for (int hh = 0; hh < 2; ++hh)
#pragma unroll
        for (int dc = 0; dc < 2; ++dc) qf2[hh][dc] = load_q(H + rowq * NP + HP_NQ + (2 * hp + hh) * 64 + 32 * dc + 8 * fq, cs + rowq * 16 + 4 * (fq & 1), dc == 0 && fq < 2, QSCALE);
#pragma unroll
    for (int dc = 0; dc < 2; ++dc) qf[dc] = ks ? qf2[1][dc] : qf2[0][dc];
#pragma unroll
    for (int i = 0; i < 3; ++i) gate[i] = sigmoidf_(side[rowq * 16 + head * 3 + i]);
    { const bf16_t* kc = wsp<bf16_t>(F, WS_KCMP) + (size_t)b * 256 * 64; const bf16_t* vc = wsp<bf16_t>(F, WS_VCMPT) + (size_t)b * 64 * 256;
#pragma unroll
        for (int it = 0; it < 4; ++it) { const int id = tid + it * NTHR;
            *(LAS u32x4*)(KC + (id >> 3) * KTP + (id & 7) * 8) = *(const u32x4*)(kc + (size_t)id * 8);
            *(LAS u32x4*)(VC + (id >> 5) * VCP + (id & 31) * 8) = *(const u32x4*)(vc + (size_t)id * 8); } }
    __syncthreads();
    f32x4 res[4]; float imp[16];
    const int nkb = (4 * qt + 2 * half) / 16 + 1;
    const int cl = (tq - 31) >> 4;
    const int srcl = (lane - 16) & 63;
    {
        f32x4 sc[16]; float mx = -1e30f;
#pragma unroll
        for (int kb = 0; kb < 16; ++kb) {
            if (kb < nkb) { const LAS bf16_t* kp = KC + (16 * kb + fr) * KTP + 8 * fq;
                f32x4 a = mfma16(*(const LAS bf16x8*)kp, qf[0], (f32x4){0.f, 0.f, 0.f, 0.f}); a = mfma16(*(const LAS bf16x8*)(kp + 32), qf[1], a);
#pragma unroll
                for (int i = 0; i < 4; ++i) { a[i] = (16 * kb + 4 * fq + i <= cl) ? a[i] : -INFINITY; mx = fmaxf(mx, a[i]); }
                sc[kb] = a; }
            else sc[kb] = (f32x4){-INFINITY, -INFINITY, -INFINITY, -INFINITY}; }
        mx = xr_max(mx);
        float sum = 0.f;
#pragma unroll
        for (int kb = 0; kb < 16; ++kb) if (kb < nkb) {
#pragma unroll
            for (int i = 0; i < 4; ++i) { const float p = fexp2(sc[kb][i] - mx); sc[kb][i] = p; sum += p; } }
        else sc[kb] = (f32x4){0.f, 0.f, 0.f, 0.f};
        sum = xr_sum(sum);
        const float inv = sum > 0.f ? 1.f / sum : 0.f;
        f32x4 o[4];
#pragma unroll
        for (int d = 0; d < 4; ++d) o[d] = (f32x4){0.f, 0.f, 0.f, 0.f};
        float prevx = 0.f;
#pragma unroll
        for (int kb = 0; kb < 16; ++kb) { if (kb < nkb) { sc[kb] = sc[kb] * inv; const float x = __shfl(sc[kb][3], srcl);
                imp[kb] = ((sc[kb][0] + sc[kb][1]) + (sc[kb][2] + sc[kb][3])) + (fq > 0 ? x : prevx); prevx = x; }
            else imp[kb] = 0.f; }
#pragma unroll
        for (int cc = 0; cc < 8; ++cc) if (2 * cc < nkb) { const bf16x8 pf = pack_p(sc[2 * cc], sc[2 * cc + 1]);
#pragma unroll
            for (int d = 0; d < 4; ++d) o[d] = mfma16(vfrag(VC + (16 * d + fr) * VCP + 32 * cc + 4 * fq), pf, o[d]); }
#pragma unroll
        for (int d = 0; d < 4; ++d) res[d] = o[d] * gate[0];
    }
    unsigned mlo, mhi;
    if (cur < 16) { mlo = (2u << cur) - 1u; mhi = 0u; }
    else {
        LAS float* XCH = (LAS float*)(F.lds + AT_XCH); LAS float* TAB = (LAS float*)(F.lds + AT_TAB) + (wave * 16 + fr) * TABP;
        __syncthreads();
#pragma unroll
        for (int kb = 0; kb < 16; ++kb) XCH[(wave * 16 + kb) * 64 + lane] = imp[kb];
        __syncthreads();
#pragma unroll
        for (int kb = 0; kb < 16; ++kb) { const int j = 4 * kb + fq;
            float v = (XCH[((0 + sq) * 16 + kb) * 64 + lane] + XCH[((2 + sq) * 16 + kb) * 64 + lane]) + (XCH[((4 + sq) * 16 + kb) * 64 + lane] + XCH[((6 + sq) * 16 + kb) * 64 + lane]);
            const bool forced = (j == 0) || (j == cur) || (j == cur - 1);
            v = forced ? 1e9f : (j <= cur ? v : -1.f); imp[kb] = v; TAB[j] = v; }
        LDS_WAIT();
        int cnt[4];
#pragma unroll
        for (int k4 = 0; k4 < 4; ++k4) cnt[k4] = 0;
        float myv[4];
#pragma unroll
        for (int k4 = 0; k4 < 4; ++k4) myv[k4] = qid == 0 ? imp[k4] : (qid == 1 ? imp[4 + k4] : (qid == 2 ? imp[8 + k4] : imp[12 + k4]));
#pragma unroll 4
        for (int jj = 0; jj < 64; ++jj) { const float vv = TAB[jj];
#pragma unroll
            for (int k4 = 0; k4 < 4; ++k4) { const int j = 4 * (4 * qid + k4) + fq; cnt[k4] += ((vv > myv[k4]) || (vv == myv[k4] && jj < j)) ? 1 : 0; } }
        mlo = 0u; mhi = 0u;
#pragma unroll
        for (int k4 = 0; k4 < 4; ++k4) { const int j = 4 * (4 * qid + k4) + fq; const unsigned bit = (cnt[k4] < 16 && j <= cur) ? 1u : 0u; if (j < 32) mlo |= bit << (j & 31); else mhi |= bit << (j & 31); }
        mlo = xr_or(mlo); mhi = xr_or(mhi);
        LAS unsigned* MSK = (LAS unsigned*)(F.lds + AT_CK);
        if (fq == 0) { MSK[(wave * 16 + fr) * 2] = mlo; MSK[(wave * 16 + fr) * 2 + 1] = mhi; }
        __syncthreads();
        mlo = (MSK[((0 + sq) * 16 + fr) * 2] | MSK[((2 + sq) * 16 + fr) * 2]) | (MSK[((4 + sq) * 16 + fr) * 2] | MSK[((6 + sq) * 16 + fr) * 2]);
        mhi = (MSK[((0 + sq) * 16 + fr) * 2 + 1] | MSK[((2 + sq) * 16 + fr) * 2 + 1]) | (MSK[((4 + sq) * 16 + fr) * 2 + 1] | MSK[((6 + sq) * 16 + fr) * 2 + 1]);
    }
    __syncthreads();
#pragma unroll 1
    for (int br = 0; br < 2; ++br) {
        const bf16_t* kbase = wsp<bf16_t>(F, WS_KNSA) + (size_t)b * SEQ * 128 + br * 64;
        const bf16_t* vtb = wsp<bf16_t>(F, WS_VT) + ((size_t)b * 384 + br * 64) * SEQ;
        const int j0 = br == 0 ? 0 : (qt > 8 ? qt - 8 : 0);
        const int np = (cur - j0 + 2) >> 1;
        FlashSt st2[2]; flash_init(st2[0]); flash_init(st2[1]);
        TileRegs ra[2], rb[2];
#define NSA_LOADP(R, p) do { _Pragma("unroll") for (int tt_ = 0; tt_ < 2; ++tt_) { const int j_ = j0 + 2 * (p) + tt_; if (j_ <= cur) tile_load(R[tt_], kbase, 128, vtb, j_ * 64, tid); } } while (0)
#define NSA_STOREP(R, p, buf) do { _Pragma("unroll") for (int tt_ = 0; tt_ < 2; ++tt_) { const int j_ = j0 + 2 * (p) + tt_; if (j_ <= cur) tile_store(R[tt_], KT + ((buf) * 2 + tt_) * 64 * KTP, VT + ((buf) * 2 + tt_) * 64 * KTP, tid); } } while (0)
#define NSA_COMPP(p, buf) do { const int j = j0 + 2 * (p) + ks; if (j <= cur) { \
            const LAS bf16_t* kt = KT + ((buf) * 2 + ks) * 64 * KTP; const LAS bf16_t* vt = VT + ((buf) * 2 + ks) * 64 * KTP; \
            const bool on = (br == 0) ? (((j < 32 ? (mlo >> j) : (mhi >> (j - 32))) & 1u) != 0u) : true; \
            if (__any(on)) { KVFrags fg; load_frags(fg, kt, vt, fr, fq); asm volatile("" ::: "memory"); \
                const bool edge = (j == cur) || (br == 1 && j == qt - 8); const int hi = (j == cur) ? ql : 63, lo = (br == 1 && j == qt - 8) ? ql : -1; \
                _Pragma("unroll") for (int hh = 0; hh < 2; ++hh) { f32x4 s[4]; qk_frags(s, fg, qf2[hh]); \
                    if (edge) { _Pragma("unroll") for (int kb = 0; kb < 4; ++kb) _Pragma("unroll") for (int i = 0; i < 4; ++i) { const int kl = 16 * kb + 4 * fq + i; s[kb][i] = (kl <= hi && kl > lo) ? s[kb][i] : -INFINITY; } } \
                    flash_update(st2[hh], s, fg, on); } } } } while (0)
        NSA_LOADP(ra, 0); NSA_LOADP(rb, 1);
#pragma unroll 1
        for (int p = 0; p < np; p += 2) {
            NSA_STOREP(ra, p, 0); __syncthreads(); NSA_LOADP(ra, p + 2); NSA_COMPP(p, 0);
            if (p + 1 < np) { NSA_STOREP(rb, p + 1, 1); __syncthreads(); NSA_LOADP(rb, p + 3); NSA_COMPP(p + 1, 1); }
        }
#undef NSA_LOADP
#undef NSA_STOREP
#undef NSA_COMPP
        { LAS float* XS = (LAS float*)(F.lds + AT_XST) + wave * (18 * 64) + lane;
            XS[0] = ks ? st2[0].m : st2[1].m; XS[64] = ks ? st2[0].l : st2[1].l;
#pragma unroll
            for (int d = 0; d < 4; ++d)
#pragma unroll
                for (int i = 0; i < 4; ++i) XS[(2 + 4 * d + i) * 64] = ks ? st2[0].o[d][i] : st2[1].o[d][i];
            __syncthreads();
            const LAS float* XP = (const LAS float*)(F.lds + AT_XST) + (wave ^ 4) * (18 * 64) + lane;
            FlashSt st; st.m = ks ? st2[1].m : st2[0].m; st.l = ks ? st2[1].l : st2[0].l;
#pragma unroll
            for (int d = 0; d < 4; ++d) st.o[d] = ks ? st2[1].o[d] : st2[0].o[d];
            const float mb = XP[0], lb = XP[64]; const float m = fmaxf(st.m, mb), fa = fexp2(st.m - m), fb = fexp2(mb - m);
            st.l = st.l * fa + lb * fb;
#pragma unroll
            for (int d = 0; d < 4; ++d)
#pragma unroll
                for (int i = 0; i < 4; ++i) st.o[d][i] = st.o[d][i] * fa + XP[(2 + 4 * d + i) * 64] * fb;
            const float sc = flash_inv_l(st) * (br == 0 ? gate[1] : gate[2]);
#pragma unroll
            for (int d = 0; d < 4; ++d) res[d] += st.o[d] * sc; }
        __syncthreads();
    }
    bf16_t* BR = wsp<bf16_t>(F, WS_BR);
#pragma unroll
    for (int d = 0; d < 4; ++d) { u32x2 w; w.x = pk2(res[d][0], res[d][1]); w.y = pk2(res[d][2], res[d][3]);
        *(u32x2*)(BR + rowq * 1024 + head * 64 + 16 * d + 4 * fq) = w; }
}

DEV void fox_unit(Frame F, int b, int h, int qb) {
    frame_refresh(F);
    const int tid = F.tid, lane = F.lane, wave = F.wave, fr = lane & 15, fq = lane >> 4;
    const int q0 = qb * 256, qw = q0 + 32 * wave;
    const bf16_t* H = wsp<bf16_t>(F, WS_H); const float* cum = wsp<float>(F, WS_CUM) + ((size_t)b * 4 + h) * SEQ;
    LAS bf16_t* KT = (LAS bf16_t*)(F.lds + AT_KT); LAS bf16_t* VT = (LAS bf16_t*)(F.lds + AT_VT); LAS float* CK = (LAS float*)(F.lds + AT_CK);
    LAS float* KNP = (LAS float*)(F.lds + AT_FXT); LAS float* CKL = KNP + 64; LAS float* WMIN = KNP + 128; LAS float* WQN = KNP + 136;
    const float cref = cum[q0];
    bf16x8 qf[2][2]; float qn2 = 0.f;
#pragma unroll
    for (int sb = 0; sb < 2; ++sb) { float ss = 0.f;
#pragma unroll
        for (int dc = 0; dc < 2; ++dc) { qf[sb][dc] = load_q(H + ((size_t)b * SEQ + qw + 16 * sb + fr) * NP + HP_FQ + h * 64 + 32 * dc + 8 * fq, nullptr, false, QSCALE);
            const u32x4 w = __builtin_bit_cast(u32x4, qf[sb][dc]); const unsigned* wp = (const unsigned*)&w;
#pragma unroll
            for (int j = 0; j < 4; ++j) { const float a = bflo(wp[j]), c = bfhi(wp[j]); ss += a * a + c * c; } }
        ss = xr_sum(ss); qn2 = fmaxf(qn2, ss); }
#pragma unroll
    for (int o = 1; o < 16; o <<= 1) qn2 = fmaxf(qn2, __shfl_xor(qn2, o));
    if (lane == 0) WQN[wave] = sqrtf(qn2) * 1.0001f;
    if (tid < 64) {
        float kn = wsp<float>(F, WS_KN)[((size_t)b * 4 + h) * 64 + tid];
#pragma unroll
        for (int o = 1; o < 64; o <<= 1) { const float t = __shfl_up(kn, o); if (tid >= o) kn = fmaxf(kn, t); }
        KNP[tid] = kn; CKL[tid] = cum[64 * tid + 63] - cref; }
    const bf16_t* kbase = H + (size_t)b * SEQ * NP + HP_FK + h * 64; const bf16_t* vtb = wsp<bf16_t>(F, WS_VT) + ((size_t)b * 384 + 128 + h * 64) * SEQ;
    FlashSt st[2]; flash_init(st[0]); flash_init(st[1]);
    __syncthreads();
    int np = 2;
    { float qn = WQN[0];
#pragma unroll
        for (int w = 1; w < 8; ++w) qn = fmaxf(qn, WQN[w]);
        const float wk = wsp<float>(F, WS_KN)[((size_t)b * 4 + h) * 64 + 4 * qb + (lane & 3)];
        float kown = fmaxf(wk, __shfl_xor(wk, 1)); kown = fmaxf(kown, __shfl_xor(kown, 2)); kown = __shfl(kown, 0);
        const float thr = -qn * kown - 40.f;
#pragma unroll 1
        for (int Jn = 4 * qb - 1; Jn >= 0; Jn -= 2) { if (qn * KNP[Jn] - CKL[Jn] < thr) break; ++np; } }
    np = __builtin_amdgcn_readfirstlane(np);
#define FOX_TILE(p, tt) ((p) < 2 ? 4 * qb + 2 * (p) + (tt) : 4 * qb - 1 - 2 * ((p) - 2) - (tt))
    TileRegs ra[2], rb[2]; f32x4 cka[2], ckb[2];
#define FOX_LOADP(R, C, p) do { if ((p) < np) { _Pragma("unroll") for (int tt_ = 0; tt_ < 2; ++tt_) { const int j_ = FOX_TILE(p, tt_); if (j_ >= 0) { tile_load(R[tt_], kbase, NP, vtb, j_ * 64, tid); if (tid < 16) C[tt_] = *(const f32x4*)(cum + j_ * 64 + 4 * tid); } } } } while (0)
#define FOX_STOREP(R, C, p, buf) do { _Pragma("unroll") for (int tt_ = 0; tt_ < 2; ++tt_) { const int j_ = FOX_TILE(p, tt_); if (j_ >= 0) { tile_store(R[tt_], KT + ((buf) * 2 + tt_) * 64 * KTP, VT + ((buf) * 2 + tt_) * 64 * KTP, tid); \
            if (tid < 16) *(LAS f32x4*)(CK + ((buf) * 2 + tt_) * 64 + 4 * tid) = C[tt_] - cref; } } } while (0)
#define FOX_COMPP(p, buf) do { _Pragma("unroll") for (int tt_ = 0; tt_ < 2; ++tt_) { const int J = FOX_TILE(p, tt_); const int key0 = 64 * J; if (J >= 0 && key0 <= qw + 31) { \
            const LAS bf16_t* kt = KT + ((buf) * 2 + tt_) * 64 * KTP; const LAS bf16_t* vt = VT + ((buf) * 2 + tt_) * 64 * KTP; const LAS float* ck = CK + ((buf) * 2 + tt_) * 64; \
            KVFrags fg; load_frags(fg, kt, vt, fr, fq); \
            f32x4 dk[4]; _Pragma("unroll") for (int kb = 0; kb < 4; ++kb) dk[kb] = *(const LAS f32x4*)(ck + 16 * kb + 4 * fq); \
            asm volatile("" ::: "memory"); \
            const bool diag = key0 + 63 > qw; \
            _Pragma("unroll") for (int sb = 0; sb < 2; ++sb) { f32x4 s[4]; qk_frags(s, fg, qf[sb]); const int qa = qw + 16 * sb + fr; \
                _Pragma("unroll") for (int kb = 0; kb < 4; ++kb) { s[kb] = s[kb] - dk[kb]; \
                    if (diag) { _Pragma("unroll") for (int i = 0; i < 4; ++i) s[kb][i] = (key0 + 16 * kb + 4 * fq + i <= qa) ? s[kb][i] : -INFINITY; } } \
                flash_update(st[sb], s, fg, true); } } } } while (0)
    FOX_LOADP(ra, cka, 0); FOX_LOADP(rb, ckb, 1);
#pragma unroll 1
    for (int p = 0; p < np; p += 2) {
        FOX_STOREP(ra, cka, p, 0); __syncthreads(); FOX_LOADP(ra, cka, p + 2); FOX_COMPP(p, 0);
        if (p + 1 < np) { FOX_STOREP(rb, ckb, p + 1, 1); __syncthreads(); FOX_LOADP(rb, ckb, p + 3); FOX_COMPP(p + 1, 1); }
    }
#undef FOX_TILE
#undef FOX_LOADP
#undef FOX_STOREP
#undef FOX_COMPP
    bf16_t* BR = wsp<bf16_t>(F, WS_BR);
#pragma unroll
    for (int sb = 0; sb < 2; ++sb) { const float sc = flash_inv_l(st[sb]); const size_t row = (size_t)b * SEQ + qw + 16 * sb + fr;
#pragma unroll
        for (int d = 0; d < 4; ++d) { const f32x4 o = st[sb].o[d] * sc; u32x2 w; w.x = pk2(o[0], o[1]); w.y = pk2(o[2], o[3]);
            *(u32x2*)(BR + row * 1024 + 256 + h * 64 + 16 * d + 4 * fq) = w; } }
    __syncthreads();
}

DEV void ln1_router_phase(Frame F, const Params& P, int l) {
    frame_refresh(F);
    const int tid = F.tid, lane = F.lane, wave = F.wave, fr = lane & 15, fq = lane >> 4;
    LAS float* xs = (LAS float*)F.lds;
    LAS float* part = (LAS float*)(F.lds + 69632);
    constexpr int XP = 1028;
    const bf16_t* mix = wsp<bf16_t>(F, WS_MIX); bf16_t* xb = wsp<bf16_t>(F, WS_XB);
    const float* g1 = P.in[I_LN1G] + (size_t)l * 1024; const float* b1 = P.in[I_LN1B] + (size_t)l * 1024;
    float wf[2][32];
    { const float* wr = P.in[I_WR] + (size_t)l * 1024 * 32 + (size_t)(128 * wave + 32 * fq) * 32 + fr;
#pragma unroll
        for (int s_ = 0; s_ < 32; ++s_) { wf[0][s_] = wr[s_ * 32]; wf[1][s_] = wr[s_ * 32 + 16]; } }
    const float brt = P.in[I_BR][l * 32 + (tid & 31)];
    unsigned* cnt = F.ctl + CW_CNT + l * 32 * 64; int* rowtk = wsp<int>(F, WS_ROWTK); float* tokw = wsp<float>(F, WS_TOKW);
    LAS unsigned* lcnt = (LAS unsigned*)(F.lds + 90112);
    LAS unsigned* lsel = lcnt + 64;
    if (tid < 64) lcnt[tid] = 0u;
    int nsel = 0;
    __syncthreads();
    u32x4 va[2][2], vm[2][2];
    f32x4 gg1[2][2], bb1[2][2];
#pragma unroll
    for (int j = 0; j < 2; ++j)
#pragma unroll
        for (int h = 0; h < 2; ++h) { gg1[j][h] = *(const f32x4*)(g1 + j * 512 + lane * 8 + 4 * h); bb1[j][h] = *(const f32x4*)(b1 + j * 512 + lane * 8 + 4 * h); }
    int unit = F.bid;
    if (unit < NT / 16) {
#pragma unroll
        for (int i = 0; i < 2; ++i)
#pragma unroll
            for (int j = 0; j < 2; ++j) { const size_t o = (size_t)(unit * 16 + wave * 2 + i) * 1024 + j * 512 + lane * 8; va[i][j] = *(const u32x4*)(xb + o); vm[i][j] = *(const u32x4*)(mix + o); } }
#pragma unroll 1
    for (; unit < NT / 16; unit += F.G) {
        const int r0 = unit * 16;
#pragma unroll
        for (int i = 0; i < 2; ++i) { const int r = wave * 2 + i; const size_t row = (size_t)(r0 + r);
            f32x4 v[2][2]; float s = 0.f;
#pragma unroll
            for (int j = 0; j < 2; ++j) { const unsigned* xp_ = (const unsigned*)&va[i][j]; const unsigned* mp_ = (const unsigned*)&vm[i][j];
#pragma unroll
                for (int h = 0; h < 2; ++h) { const f32x4 xa = {bflo(xp_[2 * h]), bfhi(xp_[2 * h]), bflo(xp_[2 * h + 1]), bfhi(xp_[2 * h + 1])}, ma = {bflo(mp_[2 * h]), bfhi(mp_[2 * h]), bflo(mp_[2 * h + 1]), bfhi(mp_[2 * h + 1])};
                    v[j][h] = xa * DN_ALPHA + ma; s += (v[j][h][0] + v[j][h][1]) + (v[j][h][2] + v[j][h][3]); } }
            const float mean = wave_sum(s) * (1.f / 1024.f); float q = 0.f;
#pragma unroll
            for (int j = 0; j < 2; ++j)
#pragma unroll
                for (int h = 0; h < 2; ++h) { v[j][h] = v[j][h] - mean; q += (v[j][h][0] * v[j][h][0] + v[j][h][1] * v[j][h][1]) + (v[j][h][2] * v[j][h][2] + v[j][h][3] * v[j][h][3]); }
            const float rstd = 1.f / sqrtf(wave_sum(q) * (1.f / 1024.f) + LN_EPS);
#pragma unroll
            for (int j = 0; j < 2; ++j) { const f32x4 o0 = v[j][0] * rstd * gg1[j][0] + bb1[j][0], o1 = v[j][1] * rstd * gg1[j][1] + bb1[j][1];
                *(LAS f32x4*)(xs + r * XP + j * 512 + lane * 8) = o0; *(LAS f32x4*)(xs + r * XP + j * 512 + lane * 8 + 4) = o1;
                u32x4 w; w.x = pk2(o0[0], o0[1]); w.y = pk2(o0[2], o0[3]); w.z = pk2(o1[0], o1[1]); w.w = pk2(o1[2], o1[3]); *(u32x4*)(xb + row * 1024 + j * 512 + lane * 8) = w; } }
        { const int un = unit + F.G;
            if (un < NT / 16) {
#pragma unroll
                for (int i = 0; i < 2; ++i)
#pragma unroll
                    for (int j = 0; j < 2; ++j) { const size_t o = (size_t)(un * 16 + wave * 2 + i) * 1024 + j * 512 + lane * 8; va[i][j] = *(const u32x4*)(xb + o); vm[i][j] = *(const u32x4*)(mix + o); } } }
        __syncthreads();
        { f32x4 c0 = (f32x4){0.f, 0.f, 0.f, 0.f}, c1 = c0; const LAS float* xp = xs + fr * XP + 128 * wave + 32 * fq;
#pragma unroll
            for (int s4 = 0; s4 < 8; ++s4) { const f32x4 xa = *(const LAS f32x4*)(xp + 4 * s4);
#pragma unroll
                for (int i = 0; i < 4; ++i) { c0 = __builtin_amdgcn_mfma_f32_16x16x4f32(xa[i], wf[0][4 * s4 + i], c0, 0, 0, 0); c1 = __builtin_amdgcn_mfma_f32_16x16x4f32(xa[i], wf[1][4 * s4 + i], c1, 0, 0, 0); } }
#pragma unroll
            for (int i = 0; i < 4; ++i) { part[(wave * 16 + 4 * fq + i) * 32 + fr] = c0[i]; part[(wave * 16 + 4 * fq + i) * 32 + 16 + fr] = c1[i]; } }
        __syncthreads();
        { const int r = tid >> 5, e = tid & 31; float v = brt;
#pragma unroll
            for (int w = 0; w < 8; ++w) v += part[(w * 16 + r) * 32 + e];
            float bv[4]; int bi[4]; float cur = v;
#define DPP_F(x, ctrl) __builtin_bit_cast(float, __builtin_amdgcn_update_dpp(0, __builtin_bit_cast(int, (x)), (ctrl), 0xf, 0xf, true))
#define DPP_I(x, ctrl) __builtin_amdgcn_update_dpp(0, (x), (ctrl), 0xf, 0xf, true)
#define ARGMAX_STEP(OV, OI) do { const float ov_ = (OV); const int oi_ = (OI); const bool take_ = (ov_ > mv) || (ov_ == mv && oi_ < mi); mv = take_ ? ov_ : mv; mi = take_ ? oi_ : mi; } while (0)
#pragma unroll
            for (int k = 0; k < 4; ++k) { float mv = cur; int mi = e;
                ARGMAX_STEP(DPP_F(mv, 0xB1), DPP_I(mi, 0xB1));
                ARGMAX_STEP(DPP_F(mv, 0x4E), DPP_I(mi, 0x4E));
                ARGMAX_STEP(DPP_F(mv, 0x141), DPP_I(mi, 0x141));
                ARGMAX_STEP(DPP_F(mv, 0x140), DPP_I(mi, 0x140));
                { const auto rv_ = __builtin_amdgcn_permlane16_swap(__float_as_uint(mv), __float_as_uint(mv), false, false); const auto ri_ = __builtin_amdgcn_permlane16_swap((unsigned)mi, (unsigned)mi, false, false);
                    mv = __uint_as_float(rv_[0]); mi = (int)ri_[0]; ARGMAX_STEP(__uint_as_float(rv_[1]), (int)ri_[1]); }
                bv[k] = mv; bi[k] = mi; if (e == mi) cur = -INFINITY; }
#undef DPP_F
#undef DPP_I
#undef ARGMAX_STEP
            if (e < 4) { float ex[4], sum = 0.f;
#pragma unroll
                for (int k = 0; k < 4; ++k) { ex[k] = __expf(bv[k] - bv[0]); sum += ex[k]; }
                const int k = e; const int t = r0 + r; const int ide = k == 0 ? bi[0] : (k == 1 ? bi[1] : (k == 2 ? bi[2] : bi[3])); const float exk = k == 0 ? ex[0] : (k == 1 ? ex[1] : (k == 2 ? ex[2] : ex[3]));
                const unsigned ls = __hip_atomic_fetch_add(lcnt + ide, 1u, __ATOMIC_RELAXED, __HIP_MEMORY_SCOPE_WORKGROUP);
                const int li = nsel + r * 4 + k; lsel[2 * li] = ((unsigned)ide << 24) | ls; lsel[2 * li + 1] = (unsigned)(t * 4 + k); tokw[t * 4 + k] = exk / sum; } }
        nsel += 64;
        __syncthreads();
    }
    if (tid < 32) { const unsigned c = lcnt[tid]; lcnt[32 + tid] = c ? atomicAdd(cnt + tid * 64, c) : 0u; }
    __syncthreads();
    for (int i = tid; i < nsel; i += NTHR) { const unsigned a = lsel[2 * i], tk = lsel[2 * i + 1]; const unsigned e = a >> 24; rowtk[(size_t)e * NT + lcnt[32 + e] + (a & 0xffffffu)] = (int)tk; }
    __syncthreads();
}
DEV void ln2_rows(Frame F, const Params& P, int l) {
    frame_refresh(F);
    const int lane = F.lane; const int gw = F.bid * NWAVES + F.wave, NGW = F.G * NWAVES;
    bf16_t* xb = wsp<bf16_t>(F, WS_XB); const bf16_t* yb = wsp<bf16_t>(F, WS_YBUF); const float* tokw = wsp<float>(F, WS_TOKW);
    const float* g2 = P.in[I_LN2G] + (size_t)l * 1024; const float* b2 = P.in[I_LN2B] + (size_t)l * 1024;
    float* dst = (l == NL - 1) ? P.out : nullptr;
    f32x4 wkn; u32x4 xn[2]; u32x4 yn[2][4];
#define LN2_LOAD(row_) do { wkn = *(const f32x4*)(tokw + (size_t)(row_) * 4); _Pragma("unroll") for (int j = 0; j < 2; ++j) { xn[j] = *(const u32x4*)(xb + (size_t)(row_) * 1024 + j * 512 + lane * 8); \
        _Pragma("unroll") for (int k = 0; k < 4; ++k) yn[j][k] = *(const u32x4*)(yb + ((size_t)(row_) * 4 + k) * 1024 + j * 512 + lane * 8); } } while (0)
    f32x4 gg[2][2], bb[2][2];
#pragma unroll
    for (int j = 0; j < 2; ++j)
#pragma unroll
        for (int h = 0; h < 2; ++h) { gg[j][h] = *(const f32x4*)(g2 + j * 512 + lane * 8 + 4 * h); bb[j][h] = *(const f32x4*)(b2 + j * 512 + lane * 8 + 4 * h); }
    if (gw < NT) LN2_LOAD(gw);
#pragma unroll 1
    for (int row = gw; row < NT; row += NGW) {
        const f32x4 wk = wkn;
        f32x4 v[2][2]; float s = 0.f;
#pragma unroll
        for (int j = 0; j < 2; ++j) { const unsigned* xp = (const unsigned*)&xn[j];
            f32x4 a0 = (f32x4){bflo(xp[0]), bfhi(xp[0]), bflo(xp[1]), bfhi(xp[1])} * DN_ALPHA, a1 = (f32x4){bflo(xp[2]), bfhi(xp[2]), bflo(xp[3]), bfhi(xp[3])} * DN_ALPHA;
#pragma unroll
            for (int k = 0; k < 4; ++k) { const unsigned* yp = (const unsigned*)&yn[j][k]; const float w = wk[k];
                a0[0] += w * bflo(yp[0]); a0[1] += w * bfhi(yp[0]); a0[2] += w * bflo(yp[1]); a0[3] += w * bfhi(yp[1]);
                a1[0] += w * bflo(yp[2]); a1[1] += w * bfhi(yp[2]); a1[2] += w * bflo(yp[3]); a1[3] += w * bfhi(yp[3]); }
            v[j][0] = a0; v[j][1] = a1; s += ((a0[0] + a0[1]) + (a0[2] + a0[3])) + ((a1[0] + a1[1]) + (a1[2] + a1[3])); }
        if (row + NGW < NT) LN2_LOAD(row + NGW);
        const float mean = wave_sum(s) * (1.f / 1024.f); float q = 0.f;
#pragma unroll
        for (int j = 0; j < 2; ++j)
#pragma unroll
            for (int h = 0; h < 2; ++h) { v[j][h] = v[j][h] - mean; q += (v[j][h][0] * v[j][h][0] + v[j][h][1] * v[j][h][1]) + (v[j][h][2] * v[j][h][2] + v[j][h][3] * v[j][h][3]); }
        const float rstd = 1.f / sqrtf(wave_sum(q) * (1.f / 1024.f) + LN_EPS);
#pragma unroll
        for (int j = 0; j < 2; ++j) { const f32x4 o0 = v[j][0] * rstd * gg[j][0] + bb[j][0], o1 = v[j][1] * rstd * gg[j][1] + bb[j][1];
            if (dst) { *(f32x4*)(dst + (size_t)row * 1024 + j * 512 + lane * 8) = o0; *(f32x4*)(dst + (size_t)row * 1024 + j * 512 + lane * 8 + 4) = o1; }
            else { u32x4 w; w.x = pk2(o0[0], o0[1]); w.y = pk2(o0[2], o0[3]); w.z = pk2(o1[0], o1[1]); w.w = pk2(o1[2], o1[3]); *(u32x4*)(xb + (size_t)row * 1024 + j * 512 + lane * 8) = w; } } }
#undef LN2_LOAD
}

constexpr int NPH = 9;
constexpr int N_PHASES = 1 + NL * NPH;
__global__ void __launch_bounds__(NTHR, 2) fwd_kernel(Params P) {
    extern __shared__ __attribute__((aligned(16))) unsigned char lds_raw[];
    Frame F;
    F.lds = (LAS unsigned char*)lds_raw; F.MISC = (volatile LAS unsigned*)(F.lds + MISC_OFF);
    F.tid = threadIdx.x; F.lane = F.tid & 63; F.wave = __builtin_amdgcn_readfirstlane(F.tid >> 6); F.G = gridDim.x; F.bid = blockIdx.x;
    F.ws = P.ws; F.ctl = (unsigned*)(P.ws + WS_CTL);
    for (int u = F.tid; u < 1024; u += NTHR) F.MISC[u] = 0u;
    __syncthreads();
    const int lo = P.ph_lo, hi = P.ph_hi;
    const bool multi = (hi - lo) > 1;
    XcdBarrier bar; bar.bar = F.ctl + CW_BAR; bar.x = 0; bar.st = F.MISC + 8;
    if (multi) bar = xcd_barrier_post(F.ctl + CW_BAR, F.MISC + 8);
#ifndef PHMASK
#define PHMASK 0xFFFF
#endif
#define IN(k) (lo <= (k) && (k) < hi)
#define EN(i) ((PHMASK >> (i)) & 1)
#ifndef DUP_PHASE
#define DUP_PHASE -1
#endif
#define REP(i) for (int rep_ = 0; rep_ < ((DUP_PHASE) == (i) ? 2 : 1); ++rep_)
#define SEAM(k) do { if (IN(k) && IN((k) + 1)) xcd_barrier(bar); } while (0)
#define FILL(k) do { __syncthreads(); if (F.tid == 0) atomicAdd(F.ctl + CW_DONE + (k) * 64, 1u); bg_fill(F, P, F.ctl + CW_DONE + (k) * 64, BG_TOTAL); } while (0)

    if (EN(9) && IN(0)) { REP(9) p0_prologue(F, P); }
    SEAM(0);
#pragma unroll 1
    for (int l = 0; l < NL; ++l) {
        const int pb = 1 + l * NPH;
        if (EN(0) && IN(pb + 0)) REP(0) {
            pg8::Gemm g{wsp<bf16_t>(F, WS_XB), wsp<bf16_t>(F, WS_WIN) + (size_t)l * NP * 1024, 1024, 1024};
            pg8::PlainOrder S; S.init(NT / 256, NP / 256, F.G, F.bid);
            pg8::EpiInProj E{wsp<bf16_t>(F, WS_H), wsp<float>(F, WS_BIN) + (size_t)l * NP, wsp<float>(F, WS_SIDE), wsp<bf16_t>(F, WS_MGT)};
            pg8::gemm_phase<pg8::EpiInProj, pg8::PlainOrder, true>(F.lds, g, S, E);
            FILL(pb + 0);
        }
        SEAM(pb + 0);
        if (EN(1) && IN(pb + 1)) REP(1) {
            unsigned* qctr = F.ctl + CW_QUEUE + l * 64 + 16;
            for (;;) {
                if (F.tid == 0) F.MISC[16] = atomicAdd(qctr, 1u);
                __syncthreads();
                const int L = (int)F.MISC[16];
                __syncthreads();
                if (L >= 528) break;
                if (L < 128) pb_gmlp_unit(F, P, l, L);
                else if (L < 256) pb_compress_unit(F, l, L - 128);
                else if (L < 512) { pb_conv_unit(F, P, l, L - 256); pb_transpose_unit(F, L - 256); }
                else pb_cum_unit(F, L - 512);
            }
        }
        SEAM(pb + 1);
        if (EN(2) && IN(pb + 2)) REP(2) {
            unsigned* qctr = F.ctl + CW_QUEUE + l * 64 + rep_ * 32;
            for (;;) {
                if (F.tid == 0) F.MISC[16] = atomicAdd(qctr, 1u);
                __syncthreads();
                const unsigned L = F.MISC[16];
                __syncthreads();
#ifdef ATT_TWICE
                if (L >= 1536u) break;
                const int Lm = (int)(L % 768u);
#else
                if (L >= 768u) break;
                const int Lm = (int)L;
#endif
                if (Lm < 512) nsa_unit(F, Lm & 3, 63 - (Lm >> 3), (Lm >> 2) & 1);
                else { const int idx = Lm - 512; fox_unit(F, idx & 3, (idx >> 2) & 3, 15 - (idx >> 4)); }
            }
            FILL(pb + 2);
        }
        SEAM(pb + 2);
        if (EN(3) && IN(pb + 3)) REP(3) {
            pg8::Gemm g{wsp<bf16_t>(F, WS_BR), wsp<bf16_t>(F, WS_WBR) + (size_t)l * 4096 * 256, 1024, 256};
            pg8::BrOrder S{F.G, F.bid};
            pg8::EpiBrGate E{wsp<bf16_t>(F, WS_MGT), wsp<bf16_t>(F, WS_GBF)};
            pg8::gemm_phase<pg8::EpiBrGate, pg8::BrOrder, true, true>(F.lds, g, S, E);
        }
        SEAM(pb + 3);
        if (EN(4) && IN(pb + 4)) REP(4) {
            pg8::Gemm g{wsp<bf16_t>(F, WS_GBF), wsp<bf16_t>(F, WS_WO) + (size_t)l * 1024 * 1024, 1024, 1024};
            pg8::PlainOrder S; S.init(NT / 256, 4, F.G, F.bid);
            pg8::EpiBf16Out E{wsp<bf16_t>(F, WS_MIX)};
            pg8::gemm_phase<pg8::EpiBf16Out, pg8::PlainOrder, true>(F.lds, g, S, E);
        }
        SEAM(pb + 4);
        if (EN(5) && IN(pb + 5)) { ln1_router_phase(F, P, l); bg_fill(F, P, nullptr, (long)(l + 1) * BG_PER_LAYER); }
        SEAM(pb + 5);
        if ((EN(6) || EN(7)) && (IN(pb + 6) || IN(pb + 7))) {
            LAS int* tp = (LAS int*)(F.lds + MISC_OFF + 1024);
            if (F.tid == 0) { int run = 0; const unsigned* cnt = F.ctl + CW_CNT + l * 32 * 64;
                for (int e = 0; e < 32; ++e) { const int c = (int)__hip_atomic_load(cnt + e * 64, __ATOMIC_RELAXED, __HIP_MEMORY_SCOPE_AGENT); tp[e] = run; tp[40 + e] = c; run += (c + 255) >> 8; }
                tp[32] = run; }
            __syncthreads();
            LAS unsigned* ul = (LAS unsigned*)(F.lds + MISC_OFF + 1536);
            int ut_ = F.tid; asm volatile("" : "+v"(ut_));
            if (ut_ < 128) { const int m2 = ut_ >> 6, i = ut_ & 63, sh = m2 ? 2 : 3;
                const int x = F.bid & 7, j = F.bid >> 3, W = F.G >> 3;
                const int U = tp[32] << sh, s0 = (x * U) >> 3, s1 = ((x + 1) * U) >> 3, L = s0 + i * W + j;
                unsigned pk = 0xffffffffu;
                if (L < s1) { const int tile = L >> sh, pn = L & ((1 << sh) - 1);
                    int e = (tp[16] <= tile) ? 16 : 0;
                    e += (tp[e + 8] <= tile) ? 8 : 0; e += (tp[e + 4] <= tile) ? 4 : 0; e += (tp[e + 2] <= tile) ? 2 : 0; e += (tp[e + 1] <= tile) ? 1 : 0;
                    const int mt = tile - tp[e], rem = tp[40 + e] - mt * 256, cn = rem < 256 ? rem : 256;
                    pk = (unsigned)pn | ((unsigned)e << 3) | ((unsigned)mt << 8) | ((unsigned)tile << 15) | ((unsigned)(cn - 1) << 24); }
                ul[ut_] = pk; }
            __syncthreads();
            if (EN(6) && IN(pb + 6)) REP(6) {
                pg8::Gemm g{wsp<bf16_t>(F, WS_XB), wsp<bf16_t>(F, WS_W1) + (size_t)l * 32 * 2048 * 1024, 1024, 1024};
                pg8::MoeOrder<1> S{ul, wsp<int>(F, WS_ROWTK)};
                pg8::EpiMoe1 E{wsp<bf16_t>(F, WS_ACT), P.in[I_BE1] + (size_t)l * 32 * 2048};
                pg8::gemm_phase<pg8::EpiMoe1, pg8::MoeOrder<1>, true>(F.lds, g, S, E);
                FILL(pb + 6);
            }
            SEAM(pb + 6);
            if (EN(7) && IN(pb + 7)) REP(7) {
                pg8::Gemm g{wsp<bf16_t>(F, WS_ACT), wsp<bf16_t>(F, WS_W2) + (size_t)l * 32 * 1024 * 1024, 1024, 1024};
                pg8::MoeOrder<2> S{ul + 64, wsp<int>(F, WS_ROWTK)};
                pg8::EpiMoe2 E{wsp<bf16_t>(F, WS_YBUF), P.in[I_BE2] + (size_t)l * 32 * 1024, wsp<int>(F, WS_ROWTK)};
                pg8::gemm_phase<pg8::EpiMoe2, pg8::MoeOrder<2>, true>(F.lds, g, S, E);
                FILL(pb + 7);
            }
        }
        SEAM(pb + 7);
        if (EN(8) && IN(pb + 8)) REP(8) ln2_rows(F, P, l);
        SEAM(pb + 8);
    }
#undef IN
#undef SEAM
}

#ifndef MK_SPLIT
#define MK_SPLIT 0
#endif
extern "C" void kernel_launch(void* const* d_in, const int* in_sizes, int n_in, void* d_out, int out_size, void* d_ws, size_t ws_size, hipStream_t stream) {
    static int grid = 0;
    if (grid == 0) {
        if (n_in != 30 || out_size != NT * 1024 || ws_size < WS_END) { fprintf(stderr, "kernel_launch: unexpected shapes (n_in %d out %d ws %zu need %zu)\n", n_in, out_size, ws_size, (size_t)WS_END); grid = -1; return; }
        int dev = 0, cus = 0, per_cu = 0;
        if (hipGetDevice(&dev) != hipSuccess || hipDeviceGetAttribute(&cus, hipDeviceAttributeMultiprocessorCount, dev) != hipSuccess) { grid = -1; return; }
        if (hipFuncSetAttribute((const void*)fwd_kernel, hipFuncAttributeMaxDynamicSharedMemorySize, LDS_BYTES) != hipSuccess) { fprintf(stderr, "kernel_launch: hipFuncSetAttribute failed\n"); grid = -1; return; }
        if (hipOccupancyMaxActiveBlocksPerMultiprocessor(&per_cu, (const void*)fwd_kernel, NTHR, LDS_BYTES) != hipSuccess || per_cu < 1) fprintf(stderr, "kernel_launch: occupancy query says %d\n", per_cu);
        (void)hipGetLastError();
        grid = cus;
    }
    if (grid < 0) return;
    (void)hipMemsetAsync((char*)d_ws + WS_CTL, 0, CTL_BYTES, stream);
    Params p; memset(&p, 0, sizeof(p));
    for (int i = 0; i < 30; ++i) p.in[i] = (const float*)d_in[i];
    p.out = (float*)d_out; p.ws = (unsigned char*)d_ws;
    for (int i = 0; i < 8; ++i) p.invf[i] = std::pow(500000.0, -(double)i / 8.0);
#if MK_SPLIT
    for (int ph = 0; ph < N_PHASES; ++ph) { p.ph_lo = ph; p.ph_hi = ph + 1; hipLaunchKernelGGL(fwd_kernel, dim3(grid), dim3(NTHR), LDS_BYTES, stream, p); }
#else
    p.ph_lo = 0; p.ph_hi = N_PHASES; hipLaunchKernelGGL(fwd_kernel, dim3(grid), dim3(NTHR), LDS_BYTES, stream, p);
#endif
}
```

```cpp
#include <hip/hip_runtime.h>
#include <cstdio>
#include <cstdint>
#include <cmath>
#include <cstring>

#define DEV __device__ __forceinline__
#define LAS __attribute__((address_space(3)))
#define GAS __attribute__((address_space(1)))

typedef unsigned short bf16_t;
typedef short bf16x8 __attribute__((ext_vector_type(8)));
typedef short bf16x4 __attribute__((ext_vector_type(4)));
typedef float f32x4 __attribute__((ext_vector_type(4)));
typedef float f32x2 __attribute__((ext_vector_type(2)));
typedef unsigned u32x4 __attribute__((ext_vector_type(4)));
typedef unsigned u32x2 __attribute__((ext_vector_type(2)));

constexpr int NB = 4, SEQ = 4096, DM = 1024, NL = 4, NT = NB * SEQ;
constexpr int NIN = 6544, NP = 6656;
constexpr int NE = 32;
constexpr int NWAVES = 8, NTHR = 512;
constexpr float LN_EPS = 1e-5f;
constexpr float DN_ALPHA = 1.6817928305074292f;
constexpr float LOG2E = 1.4426950408889634f;
constexpr int HP_NQ = 0, HP_KC = 256, HP_VC = 320, HP_KS = 384, HP_VS = 448, HP_KW = 512, HP_VW = 576, HP_SP = 640;
constexpr int HP_FQ = 768, HP_FK = 1024, HP_FV = 1280, HP_GU = 1536, HP_GV = 1792, HP_CAB = 2048, HP_MG = 2560;

constexpr size_t al256(size_t x) { return (x + 255) & ~(size_t)255; }
constexpr size_t WS_CTL = 0, CTL_BYTES = 1u << 20;
constexpr size_t WS_WIN = CTL_BYTES;
constexpr size_t WS_BIN = WS_WIN + al256((size_t)NL * NP * 1024 * 2);
constexpr size_t WS_WBR = WS_BIN + al256((size_t)NL * NP * 4);
constexpr size_t WS_WO = WS_WBR + al256((size_t)NL * 4096 * 256 * 2);
constexpr size_t WS_W1 = WS_WO + al256((size_t)NL * 1024 * 1024 * 2);
constexpr size_t WS_W2 = WS_W1 + al256((size_t)NL * 32 * 2048 * 1024 * 2);
constexpr size_t WS_WC1 = WS_W2 + al256((size_t)NL * 32 * 1024 * 1024 * 2);
constexpr size_t WS_WC2 = WS_WC1 + al256((size_t)NL * 2 * 64 * 2048 * 2);
constexpr size_t WS_CB = WS_WC2 + al256((size_t)NL * 2 * 64 * 64 * 2);
constexpr size_t WS_WG = WS_CB + al256((size_t)NL * 2 * 32 * 64 * 4);
constexpr size_t WS_CS = WS_WG + al256((size_t)NL * 4 * 128 * 128 * 2);
constexpr size_t WS_XRES = WS_CS + al256((size_t)NT * 16 * 4);
constexpr size_t WS_XB = WS_XRES + al256((size_t)NT * 1024 * 4);
constexpr size_t WS_H = WS_XB + al256((size_t)NT * 1024 * 2);
constexpr size_t WS_SIDE = WS_H + al256((size_t)NT * NP * 2);
constexpr size_t WS_KNSA = WS_SIDE + al256((size_t)NT * 16 * 4);
constexpr size_t WS_VT = WS_KNSA + al256((size_t)NT * 128 * 2);
constexpr size_t WS_CUM = WS_VT + al256((size_t)NB * 384 * SEQ * 2);
constexpr size_t WS_KCMP = WS_CUM + al256((size_t)NB * 4 * SEQ * 4);
constexpr size_t WS_VCMPT = WS_KCMP + al256((size_t)NB * 256 * 64 * 2);
constexpr size_t WS_BR = WS_VCMPT + al256((size_t)NB * 64 * 256 * 2);
constexpr size_t WS_G32 = WS_BR + al256((size_t)NT * 1024 * 2);
constexpr size_t WS_GBF = WS_G32 + al256((size_t)NT * 1024 * 4);
constexpr size_t WS_MIX = WS_GBF + al256((size_t)NT * 1024 * 2);
constexpr size_t WS_TOKW = WS_MIX + al256((size_t)NT * 1024 * 4);
constexpr size_t WS_ROWTK = WS_TOKW + al256((size_t)NT * 4 * 4);
constexpr int PMAX_TILES = NT * 4 / 256 + NE;
constexpr size_t WS_ACT = WS_ROWTK + al256((size_t)NE * NT * 4);
constexpr size_t WS_YBUF = WS_ACT + al256((size_t)PMAX_TILES * 256 * 1024 * 2);
constexpr size_t WS_MGT = WS_YBUF + al256((size_t)NT * 4 * 1024 * 2);
constexpr size_t WS_KN = WS_MGT + al256((size_t)NT * 4096 * 2);
constexpr size_t WS_END = WS_KN + al256((size_t)NB * 4 * 64 * 4);

constexpr int CW_BAR = 4096;
constexpr int CW_CNT = 32768;
constexpr int CW_QUEUE = 20480;
constexpr int CW_BGQ = 24576;
constexpr int CW_DONE = 28672;

constexpr int RING_BYTES = 131072;
constexpr int MISC_OFF = RING_BYTES;
constexpr int LDS_BYTES = 147456;

DEV float bf2f(bf16_t v) { return __uint_as_float((unsigned)v << 16); }
DEV float bflo(unsigned w) { return __uint_as_float(w << 16); }
DEV float bfhi(unsigned w) { return __uint_as_float(w & 0xffff0000u); }
DEV unsigned pk2(float lo, float hi) { typedef __bf16 b2 __attribute__((ext_vector_type(2))); f32x2 v = {lo, hi}; b2 b = __builtin_convertvector(v, b2); return __builtin_bit_cast(unsigned, b); }
DEV bf16_t f2bf(float f) { return (bf16_t)(pk2(f, 0.f) & 0xffffu); }
DEV float fexp2(float x) { return __builtin_amdgcn_exp2f(x); }
DEV float frcp(float x) { return __builtin_amdgcn_rcpf(x); }
DEV float sigmoidf_(float x) { return frcp(1.f + fexp2(-x * LOG2E)); }
DEV float gelu_tanh(float x) { const float u = 1.5957691216057308f * (x + 0.044715f * x * x * x); return x * frcp(1.f + fexp2(-u * LOG2E)); }
#define WS_DPP(x, ctrl) __builtin_bit_cast(float, __builtin_amdgcn_update_dpp(0, __builtin_bit_cast(int, (x)), (ctrl), 0xf, 0xf, true))
DEV float wave_sum(float v) {
    v += WS_DPP(v, 0xB1); v += WS_DPP(v, 0x4E); v += WS_DPP(v, 0x141); v += WS_DPP(v, 0x140);
    const int vi = __builtin_bit_cast(int, v);
    const float r0 = __builtin_bit_cast(float, __builtin_amdgcn_readlane(vi, 0)), r1 = __builtin_bit_cast(float, __builtin_amdgcn_readlane(vi, 16));
    const float r2 = __builtin_bit_cast(float, __builtin_amdgcn_readlane(vi, 32)), r3 = __builtin_bit_cast(float, __builtin_amdgcn_readlane(vi, 48));
    return (r0 + r1) + (r2 + r3);
}
typedef unsigned u32x2_t __attribute__((ext_vector_type(2)));
DEV float xr_max(float v) {
    { const unsigned u = __float_as_uint(v); const auto r = __builtin_amdgcn_permlane16_swap(u, u, false, false); v = fmaxf(__uint_as_float(r[0]), __uint_as_float(r[1])); }
    { const unsigned u = __float_as_uint(v); const auto r = __builtin_amdgcn_permlane32_swap(u, u, false, false); v = fmaxf(__uint_as_float(r[0]), __uint_as_float(r[1])); }
    return v;
}
DEV float xr_sum(float v) {
    { const unsigned u = __float_as_uint(v); const auto r = __builtin_amdgcn_permlane16_swap(u, u, false, false); v = __uint_as_float(r[0]) + __uint_as_float(r[1]); }
    { const unsigned u = __float_as_uint(v); const auto r = __builtin_amdgcn_permlane32_swap(u, u, false, false); v = __uint_as_float(r[0]) + __uint_as_float(r[1]); }
    return v;
}
DEV unsigned xr_or(unsigned u) {
    { const auto r = __builtin_amdgcn_permlane16_swap(u, u, false, false); u = r[0] | r[1]; }
    { const auto r = __builtin_amdgcn_permlane32_swap(u, u, false, false); u = r[0] | r[1]; }
    return u;
}
DEV f32x4 mfma16(bf16x8 a, bf16x8 b, f32x4 c) { return __builtin_amdgcn_mfma_f32_16x16x32_bf16(a, b, c, 0, 0, 0); }
#define LDS_WAIT() asm volatile("s_waitcnt lgkmcnt(0)" ::: "memory")
#define VM_WAIT() asm volatile("s_waitcnt vmcnt(0)" ::: "memory")

__host__ __device__ __forceinline__ int perm16(int dp) { return dp < 16 ? ((dp & 1) ? 8 + (dp >> 1) : (dp >> 1)) : dp; }
__host__ __device__ __forceinline__ int hp_src_col(int c) {
    if (c < 256) return (c & ~63) + perm16(c & 63);
    if (c < 320) return 256 + perm16(c - 256);
    if (c < 384) return c;
    if (c < 448) return 384 + perm16(c - 384);
    if (c < 512) return c;
    if (c < 576) return 512 + perm16(c - 512);
    if (c < 640) return c;
    if (c < 652) return c;
    if (c < 656) return 1420 + (c - 652);
    if (c < 768) return -1;
    if (c < 1024) return 652 + (c - 768);
    if (c < 1280) return 908 + (c - 1024);
    if (c < 1536) return 1164 + (c - 1280);
    if (c < 1792) return 1424 + (c - 1536);
    if (c < 2048) return 1680 + (c - 1792);
    if (c < 2560) { const int i = c - 2048; return (i & 1) ? 2192 + (i >> 1) : 1936 + (i >> 1); }
    return 2448 + (c - 2560);
}

namespace pg8 {
constexpr int BM = 256, BK = 64, HALF = 128, HTB = HALF * BK * 2, STAGE_BYTES = 8 * HTB, NXCD = 8, WGM = 8;
__host__ __device__ __forceinline__ int lds_byte(int r, int c) { const int st = (r >> 4) * 2 + (c >> 5), rr = r & 15, cc = c & 31, ob = rr * 64 + cc * 2; return st * 1024 + (ob ^ (((ob >> 9) & 1) << 5)); }
__host__ __device__ __forceinline__ void stage_rc(int b, int& R, int& C) { const int st = b / 1024, sb = b % 1024, swz = sb ^ (((sb >> 9) & 1) << 5); R = (st >> 1) * 16 + swz / 64; C = (st & 1) * 32 + (swz % 64) / 2; }
__host__ __device__ __forceinline__ int perm32(int rho) { const int n = rho >> 4, i = rho & 15; return 8 * (i >> 2) + 4 * n + (i & 3); }

struct Unit { int pm, pn, e, mt, cnt; };
constexpr int KROT = 1;
struct Gemm { const bf16_t* A; const bf16_t* Bt; int lda; int K; };

template <class Epi, class Sched, bool ALIGN_EPI, bool HALFN = false>
DEV void gemm_phase(LAS unsigned char* lds, const Gemm g, const Sched& S, const Epi& E) {
    int tid_ = threadIdx.x; asm volatile("" : "+v"(tid_));
    const int tid = tid_, wid = __builtin_amdgcn_readfirstlane(tid >> 6), lane = tid & 63, wr = wid >> 2, wc = wid & 3, fr = lane & 15, fq = lane >> 4;
    const int K = g.K, nt = K / BK;
#define PG8_KOF(t_, r_) ((size_t)((t_) + (r_) - (((t_) + (r_)) >= nt ? nt : 0)) * kstep)
    unsigned voffA[2], voffB[2];
#pragma unroll
    for (int i = 0; i < 2; ++i) { int R, C; stage_rc(tid * 16 + i * 8192, R, C); int Rb = Epi::PERM ? ((R & ~31) + perm32(R & 31)) : R;
        if constexpr (Epi::PAIR16) Rb = 16 * (Rb >> 3) + (Rb & 7);
        voffA[i] = (unsigned)(R * g.lda + C) * 2u; voffB[i] = (unsigned)(Rb * K + C) * 2u; }
    const unsigned hstepA = (unsigned)HALF * (unsigned)g.lda * 2u;
    const size_t kstep = (size_t)(BK * 2);
    const size_t hstepB = (size_t)(Epi::PAIR16 ? 8 : HALF) * K * 2;
    unsigned voffG[2];
#pragma unroll
    for (int i = 0; i < 2; ++i) { const unsigned off = (unsigned)tid * 16u + (unsigned)i * 8192u; voffG[i] = (off >> 8) * 512u + (off & 255u); }
    constexpr size_t GPIECE = 64 * 512;
    const unsigned ldsw = (unsigned)wid * 1024u;
    const int aoff = lds_byte(wr * 64 + fr, fq * 8), boff = lds_byte(wc * 32 + fr, fq * 8);
    const char* const Abase = (const char*)g.A;
#define PG8_SA(b, h) (((b) * 2 + (h)) * HTB)
#define PG8_SB(b, h) ((4 + (b) * 2 + (h)) * HTB)
#define PG8_STAGE_B(bufoff, gbase, voff) do { _Pragma("unroll") for (int _i = 0; _i < 2; ++_i) \
        __builtin_amdgcn_global_load_lds((const unsigned*)((const char*)(gbase) + (voff)[_i]), (LAS unsigned*)(lds + (bufoff) + ldsw + _i * 8192), 16, 0, 0); } while (0)
#define PG8_STAGE_B1(bufoff, gbase, gatep) do { if constexpr (HALFN) PG8_STAGE_B(bufoff, gatep, voffG); else PG8_STAGE_B(bufoff, (gbase) + hstepB, voffB); } while (0)
#define PG8_STAGE_A(bufoff, koff, offs) do { _Pragma("unroll") for (int _i = 0; _i < 2; ++_i) { \
        if constexpr (Sched::GATHER) __builtin_amdgcn_global_load_lds((const unsigned*)(Abase + (size_t)(koff) + (offs)[_i]), (LAS unsigned*)(lds + (bufoff) + ldsw + _i * 8192), 16, 0, 0); \
        else __builtin_amdgcn_global_load_lds((const unsigned*)(Abase + ((size_t)(koff) + (size_t)__builtin_amdgcn_readfirstlane((offs)[_i])) + voffA[_i]), (LAS unsigned*)(lds + (bufoff) + ldsw + _i * 8192), 16, 0, 0); } } while (0)
#define PG8_LDA(dst, b, h) do { _Pragma("unroll") for (int m = 0; m < 4; ++m) _Pragma("unroll") for (int k = 0; k < 2; ++k) dst[m][k] = *(const LAS bf16x8*)(lds + PG8_SA(b, h) + aoff + m * 2048 + k * 1024); } while (0)
#define PG8_LDB(dst, b, h) do { _Pragma("unroll") for (int n = 0; n < 2; ++n) _Pragma("unroll") for (int k = 0; k < 2; ++k) dst[n][k] = *(const LAS bf16x8*)(lds + PG8_SB(b, h) + boff + n * 2048 + k * 1024); } while (0)
#define PG8_MMA(ai, bj, At, Bt) do { __builtin_amdgcn_s_setprio(1); _Pragma("unroll") for (int m = 0; m < 4; ++m) _Pragma("unroll") for (int n = 0; n < 2; ++n) _Pragma("unroll") for (int k = 0; k < 2; ++k) \
        acc[ai][bj][m][n] = __builtin_amdgcn_mfma_f32_16x16x32_bf16(Bt[n][k], At[m][k], acc[ai][bj][m][n], 0, 0, 0); __builtin_amdgcn_s_setprio(0); } while (0)
#define PG8_WAIT_V(n) asm volatile("s_waitcnt vmcnt(" #n ")" ::: "memory")
#define PG8_WAIT_L(n) asm volatile("s_waitcnt lgkmcnt(" #n ")" ::: "memory")
#define PG8_BAR __builtin_amdgcn_s_barrier()
#define PG8_SCHED __builtin_amdgcn_sched_barrier(0)
#define PG8_MKOFF(dst, u) do { if constexpr (Sched::GATHER) { const unsigned _ao = S.aoff(u); _Pragma("unroll") for (int _h = 0; _h < 2; ++_h) _Pragma("unroll") for (int _i = 0; _i < 2; ++_i) { \
        int _R, _C; stage_rc(tid * 16 + _i * 8192, _R, _C); dst[_h][_i] = _ao + (S.arow(u, _h * HALF + _R) * (unsigned)g.lda + (unsigned)_C) * 2u; } } \
    else { const unsigned _ub = S.aoff(u) + S.arow(u, 0) * (unsigned)g.lda * 2u; _Pragma("unroll") for (int _h = 0; _h < 2; ++_h) _Pragma("unroll") for (int _i = 0; _i < 2; ++_i) dst[_h][_i] = _ub + (unsigned)_h * hstepA; } } while (0)
    Unit cur, nxt; int ui = 0;
    if (!S.next(0, cur)) return;
    f32x4 acc[2][2][4][2];
#pragma unroll
    for (int a = 0; a < 2; ++a)
#pragma unroll
        for (int b = 0; b < 2; ++b)
#pragma unroll
            for (int m = 0; m < 4; ++m)
#pragma unroll
                for (int n = 0; n < 2; ++n) acc[a][b][m][n] = (f32x4){0.f, 0.f, 0.f, 0.f};
    bf16x8 At[4][2], B0[2][2], B1[2][2];
    unsigned oc[2][2], on[2][2];
    PG8_MKOFF(oc, cur);
    const char* cB = (const char*)g.Bt + S.boff(cur);
    const char* cG = E.gate_base(cur);
    int rc = 0; if constexpr (Sched::ROT) rc = S.rot(cur);
    { const size_t k0 = PG8_KOF(0, rc);
    PG8_STAGE_B(PG8_SB(0, 0), cB + k0, voffB); PG8_STAGE_B1(PG8_SB(0, 1), cB + k0, cG); PG8_STAGE_A(PG8_SA(0, 0), k0, oc[0]); PG8_STAGE_A(PG8_SA(0, 1), k0, oc[1]); }
    if (wr == 1) PG8_BAR;
    PG8_WAIT_V(2); PG8_BAR;
    { const size_t k1 = PG8_KOF(1, rc);
    PG8_STAGE_B(PG8_SB(1, 0), cB + k1, voffB); PG8_STAGE_A(PG8_SA(1, 0), k1, oc[0]); PG8_STAGE_B1(PG8_SB(1, 1), cB + k1, cG + GPIECE); }
    PG8_WAIT_V(6); PG8_BAR;
    typename Epi::Pre pre;
    for (;;) {
        const bool has_next = S.next(ui + 1, nxt);
        const char* nB = cB; const char* nG = cG;
        int rn = 0; if constexpr (Sched::ROT) { if (has_next) rn = S.rot(nxt); }
        LAS int* const idxb = (LAS int*)(lds + STAGE_BYTES + 2048) + ((ui + 1) & 1) * 256;
        if (has_next) { nB = (const char*)g.Bt + S.boff(nxt); nG = E.gate_base(nxt);
            if constexpr (Sched::GATHER) { if (wid < 4) __builtin_amdgcn_global_load_lds((const unsigned*)(S.idx_ptr(nxt) + tid), (LAS unsigned*)(idxb + wid * 64), 4, 0, 0); }
            else PG8_MKOFF(on, nxt); }
        else {
#pragma unroll
            for (int h = 0; h < 2; ++h)
#pragma unroll
                for (int i = 0; i < 2; ++i) on[h][i] = oc[h][i];
        }
#pragma unroll 1
        for (int t = 0; t < nt; t += 2) {
            const bool last = (t == nt - 2);
            const size_t k1 = PG8_KOF(t + 1, rc);
            const size_t k2 = last ? PG8_KOF(0, rn) : PG8_KOF(t + 2, rc), k3 = last ? PG8_KOF(1, rn) : PG8_KOF(t + 3, rc);
            if constexpr (Sched::GATHER) { if (last && has_next) {
                const unsigned ao_ = S.aoff(nxt);
#pragma unroll
                for (int h = 0; h < 2; ++h)
#pragma unroll
                    for (int i = 0; i < 2; ++i) { int R_, C_; stage_rc(tid * 16 + i * 8192, R_, C_); const int r_ = h * HALF + R_; const int ix_ = idxb[r_];
                        on[h][i] = ao_ + (S.arow_from(nxt, r_, ix_) * (unsigned)g.lda + (unsigned)C_) * 2u; } } }
            unsigned o2[2][2]; const unsigned lastm = last ? 0xffffffffu : 0u;
#pragma unroll
            for (int h = 0; h < 2; ++h)
#pragma unroll
                for (int i = 0; i < 2; ++i) o2[h][i] = oc[h][i] ^ ((oc[h][i] ^ on[h][i]) & lastm);
            const char* b2 = (last ? nB : cB) + k2; const char* b3 = (last ? nB : cB) + k3;
            const char* g2 = last ? nG : cG + (size_t)(t + 2) * GPIECE; const char* g3 = g2 + GPIECE;
            PG8_LDB(B0, 0, 0); if constexpr (!HALFN) PG8_LDB(B1, 0, 1); else { if (wr == 0) E.gate_read(pre, lds + PG8_SB(0, 1), t >> 1, wc, fr, fq); } PG8_SCHED; PG8_LDA(At, 0, 0); PG8_STAGE_A(PG8_SA(1, 1), k1, oc[1]);
            PG8_WAIT_V(8); PG8_WAIT_L(0); PG8_BAR; PG8_MMA(0, 0, At, B0); if constexpr (!HALFN) PG8_MMA(0, 1, At, B1); PG8_BAR; PG8_SCHED;
            PG8_LDA(At, 0, 1); PG8_STAGE_B(PG8_SB(0, 0), b2, voffB); PG8_STAGE_B1(PG8_SB(0, 1), b2, g2); PG8_STAGE_A(PG8_SA(0, 0), k2, o2[0]);
            PG8_WAIT_V(8); PG8_WAIT_L(0); PG8_BAR; PG8_MMA(1, 0, At, B0); if constexpr (!HALFN) PG8_MMA(1, 1, At, B1); PG8_BAR; PG8_SCHED;
            PG8_LDB(B0, 1, 0); if constexpr (!HALFN) PG8_LDB(B1, 1, 1); else { if (wr == 1) E.gate_read(pre, lds + PG8_SB(1, 1), t >> 1, wc, fr, fq); } PG8_SCHED; PG8_LDA(At, 1, 0); PG8_STAGE_A(PG8_SA(0, 1), k2, o2[1]);
            PG8_WAIT_V(8); PG8_WAIT_L(0); PG8_BAR; PG8_MMA(0, 0, At, B0); if constexpr (!HALFN) PG8_MMA(0, 1, At, B1); PG8_BAR; PG8_SCHED;
            PG8_LDA(At, 1, 1); PG8_STAGE_B(PG8_SB(1, 0), b3, voffB); PG8_STAGE_B1(PG8_SB(1, 1), b3, g3); PG8_STAGE_A(PG8_SA(1, 0), k3, o2[0]);
            PG8_WAIT_V(8); PG8_WAIT_L(0); PG8_BAR; PG8_MMA(1, 0, At, B0); if constexpr (!HALFN) PG8_MMA(1, 1, At, B1); PG8_BAR; PG8_SCHED;
        }
        if constexpr (ALIGN_EPI) { if (wr == 0) PG8_BAR; }
        if constexpr (HALFN) E.fold(acc, pre, cur, wr, wc, fr, fq); else E(acc, cur, wr, wc, fr, fq);
        if (!has_next) break;
#pragma unroll
        for (int a = 0; a < 2; ++a)
#pragma unroll
            for (int b = 0; b < 2; ++b)
#pragma unroll
                for (int m = 0; m < 4; ++m)
#pragma unroll
                    for (int n = 0; n < 2; ++n) { if (!HALFN || b == 0) acc[a][b][m][n] = (f32x4){0.f, 0.f, 0.f, 0.f}; }
        cur = nxt; cB = nB; cG = nG; ++ui; rc = rn;
#pragma unroll
        for (int h = 0; h < 2; ++h)
#pragma unroll
            for (int i = 0; i < 2; ++i) oc[h][i] = on[h][i];
        if constexpr (ALIGN_EPI) { if (wr == 1) PG8_BAR; }
    }
    PG8_WAIT_V(0);
    if constexpr (!ALIGN_EPI) { if (wr == 0) PG8_BAR; }
    PG8_BAR;
#undef PG8_SA
#undef PG8_SB
#undef PG8_STAGE_A
#undef PG8_STAGE_B1
#undef PG8_STAGE_B
#undef PG8_LDA
#undef PG8_LDB
#undef PG8_MMA
#undef PG8_WAIT_V
#undef PG8_WAIT_L
#undef PG8_BAR
#undef PG8_SCHED
#undef PG8_MKOFF
#undef PG8_KOF
}

struct StaticOrder {
    int nM, nN, nwg, G, c;
    DEV void init(int nM_, int nN_, int G_, int c_) { nM = nM_; nN = nN_; nwg = nM * nN; G = G_; c = c_; }
    DEV bool next(int i, Unit& u) const {
        const long L = (long)i * G + c; if (L >= nwg) return false;
        int wgid = (int)L; { const int q = nwg / NXCD, r = nwg % NXCD, xcd = wgid % NXCD, off = wgid / NXCD; wgid = (xcd < r ? xcd * (q + 1) : r * (q + 1) + (xcd - r) * q) + off; }
        const int nig = WGM * nN, gid = wgid / nig, fm = gid * WGM, gsz = (nM - fm) < WGM ? (nM - fm) : WGM;
        u.pm = fm + ((wgid % nig) % gsz); u.pn = (wgid % nig) / gsz; u.e = 0; u.mt = 0; u.cnt = 256; return true;
    }
};
}

#define XB_TMO      128
#define XB_XCNT(j)  (256  + 64 * (j))
#define XB_XSUB(j)  (1280 + 64 * (j))
#define XB_XGEN(j)  (2304 + 64 * (j))
#define XB_TOP      3328
#define XB_TOPGEN   3392
#define XCD_BAR_WORDS 3456
#define XB_SPIN_CAP (1u << 20)
DEV unsigned xb_ld(unsigned* p)              { return __hip_atomic_load(p, __ATOMIC_RELAXED, __HIP_MEMORY_SCOPE_AGENT); }
DEV unsigned xb_add(unsigned* p, unsigned v) { return __hip_atomic_fetch_add(p, v, __ATOMIC_RELAXED, __HIP_MEMORY_SCOPE_AGENT); }
DEV unsigned xb_xcc_id() { return (unsigned)__builtin_amdgcn_s_getreg((3 << 11) | 20) & 0xFu; }
#define XB_SPIN(cond, bar) do { unsigned _sp = 0; while (cond) { __builtin_amdgcn_s_sleep(1); \
    if ((++_sp & 255u) == 0u) { if (xb_ld(&(bar)[XB_TMO])) break; if (_sp > XB_SPIN_CAP) { atomicAdd(&(bar)[XB_TMO], 1u); break; } } } } while (0)
struct XcdBarrier { unsigned* bar; unsigned x; volatile LAS unsigned* st; };
DEV XcdBarrier xcd_barrier_post(unsigned* bar, volatile LAS unsigned* st) {
    XcdBarrier b; b.bar = bar; b.x = xb_xcc_id(); b.st = st;
    if (threadIdx.x == 0) (void)xb_add(&bar[XB_XCNT(b.x)], 1u);
    return b;
}
DEV void xcd_barrier_complete(unsigned* bar, unsigned x, unsigned& nloc, unsigned& nx) {
    const unsigned G = gridDim.x * gridDim.y * gridDim.z;
    unsigned sum, cnt, mine, sp = 0u;
    for (;;) {
        sum = 0u; cnt = 0u; mine = 0u;
#pragma unroll
        for (unsigned j = 0; j < 16; ++j) { const unsigned c = xb_ld(&bar[XB_XCNT(j)]); sum += c; cnt += (c > 0u) ? 1u : 0u; mine = (j == x) ? c : mine; }
        if (sum == G) break;
        __builtin_amdgcn_s_sleep(1);
        if ((++sp & 255u) == 0u) { if (xb_ld(&bar[XB_TMO])) break; if (sp > XB_SPIN_CAP) { atomicAdd(&bar[XB_TMO], 1u); break; } }
    }
    nloc = mine > 0u ? mine : 1u; nx = cnt > 0u ? cnt : 1u;
}
DEV void xcd_barrier(const XcdBarrier& b) {
    asm volatile("s_waitcnt vmcnt(0)" ::: "memory");
    __syncthreads();
    if (threadIdx.x == 0) {
        unsigned* bar = b.bar;
        __builtin_amdgcn_s_waitcnt(0);
        unsigned nloc = b.st[0], nx = b.st[1];
        if (nloc == 0u) { xcd_barrier_complete(bar, b.x, nloc, nx); b.st[0] = nloc; b.st[1] = nx; }
        const unsigned old = xb_add(&bar[XB_XSUB(b.x)], 1u);
        const unsigned gen = old / nloc;
        if (old + 1u == (gen + 1u) * nloc) {
            __builtin_amdgcn_fence(__ATOMIC_RELEASE, "agent");
            asm volatile("s_waitcnt vmcnt(0)" ::: "memory");
            const unsigned og = xb_add(&bar[XB_TOP], 1u);
            const unsigned tg = og / nx;
            if (og + 1u == (tg + 1u) * nx) xb_add(&bar[XB_TOPGEN], 1u);
            else XB_SPIN(xb_ld(&bar[XB_TOPGEN]) == tg, bar);
            __builtin_amdgcn_fence(__ATOMIC_ACQUIRE, "agent");
            xb_add(&bar[XB_XGEN(b.x)], 1u);
            asm volatile("s_waitcnt vmcnt(0)" ::: "memory");
        } else {
            XB_SPIN(xb_ld(&bar[XB_XGEN(b.x)]) == gen, bar);
            __builtin_amdgcn_fence(__ATOMIC_ACQUIRE, "agent");
            asm volatile("s_waitcnt vmcnt(0)" ::: "memory");
        }
    }
    __syncthreads();
}

struct Params {
    const float* in[30];
    float* out;
    unsigned char* ws;
    int ph_lo, ph_hi;
    double invf[8];
};
enum { I_X = 0, I_POS, I_WIN, I_BIN, I_PEK, I_PEV, I_W1K, I_W2K, I_W1V, I_W2V, I_GLNG, I_GLNB, I_GWS, I_GBS, I_CW, I_CB, I_CLNG, I_CLNB,
       I_WBR, I_WO, I_LN1G, I_LN1B, I_WR, I_BR, I_WE1, I_BE1, I_WE2, I_BE2, I_LN2G, I_LN2B };

namespace pg8 {
struct EpiInProj {
    struct Pre {};
    static constexpr bool PAIR16 = false;
    DEV const char* gate_base(const Unit&) const { return nullptr; }
    static constexpr bool PERM = true;
    bf16_t* H; const float* bias; float* side; bf16_t* MGT;
    DEV void operator()(const f32x4 (&acc)[2][2][4][2], const Unit& u, int wr, int wc, int fr, int fq) const {
        const int row0 = u.pm * BM + wr * 64 + fr, col0 = u.pn * BM + wc * 32 + 8 * fq;
        f32x4 bv[2][2];
#pragma unroll
        for (int bj = 0; bj < 2; ++bj)
#pragma unroll
            for (int n = 0; n < 2; ++n) bv[bj][n] = *(const f32x4*)(bias + col0 + bj * HALF + 4 * n);
        if (u.pn >= 10) {
            bf16_t* tile = MGT + ((size_t)u.pm * 16 + (u.pn - 10)) * 65536 + (wr * 64 + fr) * 256 + wc * 32 + 8 * fq;
#pragma unroll
            for (int ai = 0; ai < 2; ++ai)
#pragma unroll
                for (int m = 0; m < 4; ++m)
#pragma unroll
                    for (int bj = 0; bj < 2; ++bj) { const f32x4 v0 = acc[ai][bj][m][0] + bv[bj][0], v1 = acc[ai][bj][m][1] + bv[bj][1];
                        u32x4 w; w.x = pk2(sigmoidf_(v0[0]), sigmoidf_(v0[1])); w.y = pk2(sigmoidf_(v0[2]), sigmoidf_(v0[3])); w.z = pk2(sigmoidf_(v1[0]), sigmoidf_(v1[1])); w.w = pk2(sigmoidf_(v1[2]), sigmoidf_(v1[3]));
                        *(u32x4*)(tile + (ai * HALF + m * 16) * 256 + bj * HALF) = w; }
            return; }
        const bool special = (u.pn == 2) && (wc == 0) && (fq < 2);
#pragma unroll
        for (int ai = 0; ai < 2; ++ai)
#pragma unroll
            for (int m = 0; m < 4; ++m) { const int row = row0 + ai * HALF + m * 16; bf16_t* rowp = H + (size_t)row * NP + col0;
#pragma unroll
                for (int bj = 0; bj < 2; ++bj) { const f32x4 v0 = acc[ai][bj][m][0] + bv[bj][0], v1 = acc[ai][bj][m][1] + bv[bj][1];
                    u32x4 w; w.x = pk2(v0[0], v0[1]); w.y = pk2(v0[2], v0[3]); w.z = pk2(v1[0], v1[1]); w.w = pk2(v1[2], v1[3]);
                    *(u32x4*)(rowp + bj * HALF) = w;
                    if (bj == 1 && special) { float* sp = side + (size_t)row * 16 + 8 * fq; *(f32x4*)sp = v0; *(f32x4*)(sp + 4) = v1; } } }
    }
};
struct EpiBrGate {
    static constexpr bool PERM = true;
    struct Pre { u32x4 g[2][4]; };
    static constexpr bool PAIR16 = false;
    const bf16_t* MGT; bf16_t* GBF;
    DEV const char* gate_base(const Unit& u) const { return (const char*)(MGT + ((size_t)u.pm * 16 + u.e * 4 + (u.pn >> 1)) * 65536 + (u.pn & 1) * 128); }
    DEV void gate_read(Pre& p, const LAS unsigned char* slot, int idx, int wc, int fr, int fq) const {
        const LAS unsigned char* q = slot + fr * 256 + (wc * 32 + 8 * fq) * 2;
        if (idx == 0) {
#pragma unroll
            for (int m = 0; m < 4; ++m) p.g[0][m] = *(const LAS u32x4*)(q + m * 16 * 256); }
        else {
#pragma unroll
            for (int m = 0; m < 4; ++m) p.g[1][m] = *(const LAS u32x4*)(q + m * 16 * 256); }
    }
    DEV void fold(f32x4 (&acc)[2][2][4][2], const Pre& p, const Unit& u, int wr, int wc, int fr, int fq) const {
        const int n = u.e;
#pragma unroll
        for (int ai = 0; ai < 2; ++ai)
#pragma unroll
            for (int m = 0; m < 4; ++m) { const u32x4 g = p.g[ai][m]; const f32x4 a0 = acc[ai][0][m][0], a1 = acc[ai][0][m][1];
                f32x4 t0, t1;
                t0[0] = a0[0] * bflo(g.x); t0[1] = a0[1] * bfhi(g.x); t0[2] = a0[2] * bflo(g.y); t0[3] = a0[3] * bfhi(g.y);
                t1[0] = a1[0] * bflo(g.z); t1[1] = a1[1] * bfhi(g.z); t1[2] = a1[2] * bflo(g.w); t1[3] = a1[3] * bfhi(g.w);
                if (n == 0) { acc[ai][1][m][0] = t0; acc[ai][1][m][1] = t1; } else { acc[ai][1][m][0] += t0; acc[ai][1][m][1] += t1; } }
        if (n == 3) { const int row0 = u.pm * BM + wr * 64 + fr, col0 = u.pn * HALF + wc * 32 + 8 * fq;
#pragma unroll
            for (int ai = 0; ai < 2; ++ai)
#pragma unroll
                for (int m = 0; m < 4; ++m) { const f32x4 v0 = acc[ai][1][m][0], v1 = acc[ai][1][m][1];
                    u32x4 w; w.x = pk2(v0[0], v0[1]); w.y = pk2(v0[2], v0[3]); w.z = pk2(v1[0], v1[1]); w.w = pk2(v1[2], v1[3]);
                    *(u32x4*)(GBF + (size_t)(row0 + ai * HALF + m * 16) * 1024 + col0) = w; } }
    }
};
struct BrOrder {
    static constexpr bool GATHER = false;
    static constexpr bool ROT = false;
    int G, c;
    DEV bool next(int i, Unit& u) const { const int x = c & 7, q = (c >> 3) + (i >> 2) * (G >> 3); if (q >= 64 || (G & 7)) { if (!(G & 7)) return false; const int tile = c + (i >> 2) * G; if (tile >= 512) return false; u.pm = tile >> 3; u.pn = tile & 7; }
        else { u.pm = x + 8 * (q >> 3); u.pn = q & 7; }
        u.e = i & 3; u.mt = 0; u.cnt = 256; return true; }
    DEV size_t boff(const Unit& u) const { return (size_t)(u.e * 1024 + u.pn * 128) * 256 * 2; }
    DEV unsigned aoff(const Unit& u) const { return (unsigned)(u.e * 256 * 2); }
    DEV unsigned arow(const Unit& u, int r) const { return (unsigned)(u.pm * BM + r); }
};
struct PlainOrder : StaticOrder {
    static constexpr bool GATHER = false;
    static constexpr bool ROT = true;
    DEV int rot(const Unit& u) const { return ((u.pm + 2 * u.pn) & 7) * KROT; }
    DEV size_t boff(const Unit& u) const { return (size_t)u.pn * 256 * 1024 * 2; }
    DEV unsigned aoff(const Unit&) const { return 0u; }
    DEV unsigned arow(const Unit& u, int r) const { return (unsigned)(u.pm * BM + r); }
};
struct EpiBf16Out {
    struct Pre {};
    static constexpr bool PAIR16 = false;
    DEV const char* gate_base(const Unit&) const { return nullptr; }
    static constexpr bool PERM = true;
    bf16_t* C;
    DEV void operator()(const f32x4 (&acc)[2][2][4][2], const Unit& u, int wr, int wc, int fr, int fq) const {
        const int row0 = u.pm * BM + wr * 64 + fr, col0 = u.pn * BM + wc * 32 + 8 * fq;
#pragma unroll
        for (int ai = 0; ai < 2; ++ai)
#pragma unroll
            for (int m = 0; m < 4; ++m) { bf16_t* rowp = C + (size_t)(row0 + ai * HALF + m * 16) * 1024 + col0;
#pragma unroll
                for (int bj = 0; bj < 2; ++bj) { const f32x4 v0 = acc[ai][bj][m][0], v1 = acc[ai][bj][m][1];
                    u32x4 w; w.x = pk2(v0[0], v0[1]); w.y = pk2(v0[2], v0[3]); w.z = pk2(v1[0], v1[1]); w.w = pk2(v1[2], v1[3]); *(u32x4*)(rowp + bj * HALF) = w; } }
    }
};
template <int MODE> struct MoeOrder {
    static constexpr bool GATHER = (MODE == 1);
    static constexpr bool ROT = true;
    DEV int rot(const Unit& u) const { return (MODE == 1 ? u.pn : 2 * u.pn) * KROT; }
    const LAS unsigned* ul;
    const int* rowtk;
    DEV bool next(int i, Unit& u) const {
        const unsigned p = (unsigned)__builtin_amdgcn_readfirstlane((int)ul[i]); if (p == 0xffffffffu) return false;
        u.pn = (int)(p & 7u); u.e = (int)((p >> 3) & 31u); u.mt = (int)((p >> 8) & 127u); u.pm = (int)((p >> 15) & 511u); u.cnt = (int)(p >> 24) + 1; return true;
    }
    DEV size_t boff(const Unit& u) const { return MODE == 1 ? ((size_t)u.e * 2048 + u.pn * 256) * 1024 * 2 : ((size_t)u.e * 1024 + u.pn * 256) * 1024 * 2; }
    DEV unsigned aoff(const Unit&) const { return 0u; }
    DEV unsigned arow(const Unit& u, int r) const {
        if (MODE == 2) return (unsigned)(u.pm * 256 + r);
        return r < u.cnt ? (unsigned)(rowtk[(size_t)u.e * NT + u.mt * 256 + r] >> 2) : 0u;
    }
    DEV const int* idx_ptr(const Unit& u) const { return rowtk + (size_t)u.e * NT + u.mt * 256; }
    DEV unsigned arow_from(const Unit& u, int r, int ix) const { return r < u.cnt ? (unsigned)(ix >> 2) : 0u; }
};
struct EpiMoe1 {
    struct Pre {};
    DEV const char* gate_base(const Unit&) const { return nullptr; }
    static constexpr bool PERM = true, PAIR16 = true;
    bf16_t* ACT; const float* b1;
    DEV void operator()(const f32x4 (&acc)[2][2][4][2], const Unit& u, int wr, int wc, int fr, int fq) const {
        const int row0 = u.pm * BM + wr * 64 + fr, q = 4 * wc + fq, hcol0 = u.pn * BM + 16 * q;
        const float* bp = b1 + (size_t)u.e * 2048 + hcol0;
        f32x4 bv[2][2];
#pragma unroll
        for (int bj = 0; bj < 2; ++bj)
#pragma unroll
            for (int n = 0; n < 2; ++n) bv[bj][n] = *(const f32x4*)(bp + 8 * bj + 4 * n);
#pragma unroll
        for (int ai = 0; ai < 2; ++ai)
#pragma unroll
            for (int m = 0; m < 4; ++m) { bf16_t* rowp = ACT + (size_t)(row0 + ai * HALF + m * 16) * 1024 + (hcol0 >> 1);
                float o[8];
#pragma unroll
                for (int bj = 0; bj < 2; ++bj) { const f32x4 v0 = acc[ai][bj][m][0] + bv[bj][0], v1 = acc[ai][bj][m][1] + bv[bj][1];
#pragma unroll
                    for (int j = 0; j < 4; ++j) { const float hg = j < 2 ? v0[2 * j] : v1[2 * j - 4], hl = j < 2 ? v0[2 * j + 1] : v1[2 * j - 3];
                        const float glu = fminf(hg, 7.f), lin = fminf(fmaxf(hl, -7.f), 7.f); o[4 * bj + j] = glu * sigmoidf_(1.702f * glu) * (lin + 1.f); } }
                u32x4 w; w.x = pk2(o[0], o[1]); w.y = pk2(o[2], o[3]); w.z = pk2(o[4], o[5]); w.w = pk2(o[6], o[7]); *(u32x4*)rowp = w; }
    }
};
struct EpiMoe2 {
    struct Pre {};
    static constexpr bool PAIR16 = false;
    DEV const char* gate_base(const Unit&) const { return nullptr; }
    static constexpr bool PERM = true;
    bf16_t* Y; const float* b2; const int* rowtk;
    DEV void operator()(const f32x4 (&acc)[2][2][4][2], const Unit& u, int wr, int wc, int fr, int fq) const {
        const int col0 = u.pn * BM + wc * 32 + 8 * fq;
        const float* bp = b2 + (size_t)u.e * 1024 + col0;
        f32x4 bv[2][2];
#pragma unroll
        for (int bj = 0; bj < 2; ++bj)
#pragma unroll
            for (int n = 0; n < 2; ++n) bv[bj][n] = *(const f32x4*)(bp + bj * HALF + 4 * n);
        const int* rt = rowtk + (size_t)u.e * NT + u.mt * 256 + wr * 64 + fr;
        int dst[2][4];
#pragma unroll
        for (int ai = 0; ai < 2; ++ai)
#pragma unroll
            for (int m = 0; m < 4; ++m) dst[ai][m] = rt[ai * HALF + m * 16];
        asm volatile("" :: "v"(bv[0][0]), "v"(bv[0][1]), "v"(bv[1][0]), "v"(bv[1][1]), "v"(dst[0][0]), "v"(dst[0][1]), "v"(dst[0][2]), "v"(dst[0][3]), "v"(dst[1][0]), "v"(dst[1][1]), "v"(dst[1][2]), "v"(dst[1][3]));
#pragma unroll
        for (int ai = 0; ai < 2; ++ai)
#pragma unroll
            for (int m = 0; m < 4; ++m) { const int r = ai * HALF + wr * 64 + m * 16 + fr;
                if (r < u.cnt) { bf16_t* rowp = Y + (size_t)dst[ai][m] * 1024 + col0;
#pragma unroll
                    for (int bj = 0; bj < 2; ++bj) { const f32x4 v0 = acc[ai][bj][m][0] + bv[bj][0], v1 = acc[ai][bj][m][1] + bv[bj][1];
                        u32x4 w; w.x = pk2(v0[0], v0[1]); w.y = pk2(v0[2], v0[3]); w.z = pk2(v1[0], v1[1]); w.w = pk2(v1[2], v1[3]); *(u32x4*)(rowp + bj * HALF) = w; } } }
    }
};
}

struct Frame {
    LAS unsigned char* lds;
    volatile LAS unsigned* MISC;
    unsigned* ctl;
    unsigned char* ws;
    int tid, lane, wave, G, bid;
};
template <class T> DEV T* wsp(const Frame& F, size_t off) { return (T*)(F.ws + off); }
DEV void frame_refresh(Frame& F) {
    int t_ = threadIdx.x; asm volatile("" : "+v"(t_)); F.tid = t_; F.lane = t_ & 63; F.wave = __builtin_amdgcn_readfirstlane(t_ >> 6);
    unsigned long long w_ = (unsigned long long)F.ws; asm volatile("" : "+s"(w_)); F.ws = (unsigned char*)(GAS unsigned char*)w_; F.ctl = (unsigned*)F.ws;
}

struct IdMap { DEV int operator()(int i) const { return i; } };
struct HpColMap { DEV int operator()(int c) const { return hp_src_col(c); } };
struct CmpRowMap { DEV int operator()(int k) const { return (k & ~63) + perm16(k & 63); } };
template <class RM, class CM>
DEV void transpose_item(const float* W, int ldw, bf16_t* WT, int ldt, int k0, int n0, LAS float* scr, int lane, RM rm, CM cm) {
    const int nn = lane & 31; const int sc = cm(n0 + nn);
#pragma unroll 8
    for (int i = 0; i < 32; ++i) { const int kk = 2 * i + (lane >> 5); scr[kk * 33 + nn] = sc >= 0 ? W[(size_t)rm(k0 + kk) * ldw + sc] : 0.f; }
    LDS_WAIT(); asm volatile("" ::: "memory");
    const int c = lane & 7;
#pragma unroll
    for (int j = 0; j < 4; ++j) { const int n = (lane >> 3) + 8 * j; const LAS float* s = scr + (8 * c) * 33 + n;
        u32x4 o; o.x = pk2(s[0 * 33], s[1 * 33]); o.y = pk2(s[2 * 33], s[3 * 33]); o.z = pk2(s[4 * 33], s[5 * 33]); o.w = pk2(s[6 * 33], s[7 * 33]);
        *(u32x4*)(WT + (size_t)(n0 + n) * ldt + k0 + 8 * c) = o; }
    LDS_WAIT(); asm volatile("" ::: "memory");
}
struct TItem { const float* W; bf16_t* WT; int ldw, ldt, k0, n0, rmap; };
DEV void titem_load(const TItem& it, f32x4 (&v)[16], int lane) {
    const int nq = lane & 15, kr = lane >> 4;
    if (it.rmap == 2) { const int n = it.n0 + 4 * nq; const int c0 = hp_src_col(n), c1 = hp_src_col(n + 1), c2 = hp_src_col(n + 2), c3 = hp_src_col(n + 3);
        const bool quad = (c0 >= 0) && (c1 == c0 + 1) && (c2 == c0 + 2) && (c3 == c0 + 3);
#pragma unroll
        for (int i = 0; i < 16; ++i) { const float* rp = it.W + (size_t)(it.k0 + 4 * i + kr) * it.ldw;
            if (quad) v[i] = __builtin_nontemporal_load((const f32x4*)(rp + c0));
            else v[i] = (f32x4){c0 >= 0 ? rp[c0] : 0.f, c1 >= 0 ? rp[c1] : 0.f, c2 >= 0 ? rp[c2] : 0.f, c3 >= 0 ? rp[c3] : 0.f}; }
        return; }
#pragma unroll
    for (int i = 0; i < 16; ++i) { int k = it.k0 + 4 * i + kr; if (it.rmap) k = (k & ~63) + perm16(k & 63); v[i] = __builtin_nontemporal_load((const f32x4*)(it.W + (size_t)k * it.ldw + it.n0 + 4 * nq)); }
}
DEV void titem_store(const TItem& it, const f32x4 (&v)[16], LAS bf16_t* scr, int lane) {
    const int nq = lane & 15, kr = lane >> 4; constexpr int SP = 66;
#pragma unroll
    for (int i = 0; i < 16; ++i) { LAS unsigned* d = (LAS unsigned*)(scr + (4 * i + kr) * SP + 4 * nq); d[0] = pk2(v[i][0], v[i][1]); d[1] = pk2(v[i][2], v[i][3]); }
    LDS_WAIT(); asm volatile("" ::: "memory");
    const int c = lane & 7;
#pragma unroll
    for (int j = 0; j < 8; ++j) { const int n = (lane >> 3) + 8 * j; const LAS bf16_t* sp = scr + (8 * c) * SP + n;
        u32x4 o; o.x = sp[0] | ((unsigned)sp[SP] << 16); o.y = sp[2 * SP] | ((unsigned)sp[3 * SP] << 16); o.z = sp[4 * SP] | ((unsigned)sp[5 * SP] << 16); o.w = sp[6 * SP] | ((unsigned)sp[7 * SP] << 16);
        __builtin_nontemporal_store(o, (u32x4*)(it.WT + (size_t)(it.n0 + n) * it.ldt + it.k0 + 8 * c)); }
    LDS_WAIT(); asm volatile("" ::: "memory");
}
constexpr long BG_PER_LAYER = 32L * 512 + 32L * 256, BG_TOTAL = NL * BG_PER_LAYER;
DEV void bg_item(const Frame& F, const Params& P, long idx, LAS bf16_t* scr, int lane) {
    const int l = (int)(idx / BG_PER_LAYER); long r = idx - (long)l * BG_PER_LAYER; TItem it;
    if (r < 32L * 512) { const int mat = l * 32 + (int)(r >> 9), q = (int)(r & 511); it = TItem{P.in[I_WE1] + (size_t)mat * 1024 * 2048, wsp<bf16_t>(F, WS_W1) + (size_t)mat * 2048 * 1024, 2048, 1024, (q >> 5) * 64, (q & 31) * 64, 0}; }
    else { r -= 32L * 512; const int mat = l * 32 + (int)(r >> 8), q = (int)(r & 255); it = TItem{P.in[I_WE2] + (size_t)mat * 1024 * 1024, wsp<bf16_t>(F, WS_W2) + (size_t)mat * 1024 * 1024, 1024, 1024, (q >> 4) * 64, (q & 15) * 64, 0}; }
    f32x4 v[16]; titem_load(it, v, lane); titem_store(it, v, scr, lane);
}
constexpr int BG_CHUNK = 8, BG_FILL_STRIDE = 4;
DEV void bg_fill(Frame F, const Params& P, unsigned* done, long limit) {
    frame_refresh(F);
    unsigned* head = F.ctl + CW_BGQ; LAS bf16_t* scr = (LAS bf16_t*)(F.lds + F.wave * 16384); const int lane = F.lane;
    if (done && (F.wave % BG_FILL_STRIDE) != 0) return;
#pragma unroll 1
    for (;;) {
        if (done) { if ((unsigned)__builtin_amdgcn_readfirstlane(__hip_atomic_load(done, __ATOMIC_RELAXED, __HIP_MEMORY_SCOPE_AGENT)) >= (unsigned)F.G) break; }
        else { if ((long)(unsigned)__builtin_amdgcn_readfirstlane(__hip_atomic_load(head, __ATOMIC_RELAXED, __HIP_MEMORY_SCOPE_AGENT)) >= limit) break; }
        unsigned base = 0u; if (lane == 0) base = atomicAdd(head, (unsigned)BG_CHUNK);
        base = (unsigned)__builtin_amdgcn_readfirstlane(base);
        if ((long)base >= BG_TOTAL) break;
#pragma unroll 1
        for (int i = 0; i < BG_CHUNK; ++i) if ((long)base + i < BG_TOTAL) bg_item(F, P, (long)base + i, scr, lane);
    }
}
DEV void p0_prologue(Frame F, const Params& P) {
    frame_refresh(F);
    LAS float* scr = (LAS float*)(F.lds + F.wave * 16384);
    const int gw = F.bid * NWAVES + F.wave, NGW = F.G * NWAVES, lane = F.lane;
    LAS bf16_t* scrh = (LAS bf16_t*)scr;
    constexpr long I_E1 = 0, I_E2 = 0, I_BRI = (long)NL * 4 * 64, I_OI = (long)NL * 256, I_C1 = (long)NL * 2 * 32;
    constexpr long I_IN64 = (long)NL * 16 * 104;
    constexpr long N64 = I_E1 + I_E2 + I_BRI + I_OI + I_C1 + I_IN64;
#define P0_DECODE(it, r_) do { long r = (r_); \
        if (r < I_E1) { const int mat = (int)(r >> 9), q = (int)(r & 511); it = TItem{P.in[I_WE1] + (size_t)mat * 1024 * 2048, wsp<bf16_t>(F, WS_W1) + (size_t)mat * 2048 * 1024, 2048, 1024, (q >> 5) * 64, (q & 31) * 64, 0}; break; } \
        r -= I_E1; \
        if (r < I_E2) { const int mat = (int)(r >> 8), q = (int)(r & 255); it = TItem{P.in[I_WE2] + (size_t)mat * 1024 * 1024, wsp<bf16_t>(F, WS_W2) + (size_t)mat * 1024 * 1024, 1024, 1024, (q >> 4) * 64, (q & 15) * 64, 0}; break; } \
        r -= I_E2; \
        if (r < I_BRI) { const int mat = (int)(r >> 6), q = (int)(r & 63); it = TItem{P.in[I_WBR] + (size_t)mat * 256 * 1024, wsp<bf16_t>(F, WS_WBR) + (size_t)mat * 1024 * 256, 1024, 256, (q >> 4) * 64, (q & 15) * 64, 0}; break; } \
        r -= I_BRI; \
        if (r < I_OI) { const int l_ = (int)(r >> 8), q = (int)(r & 255); it = TItem{P.in[I_WO] + (size_t)l_ * 1024 * 1024, wsp<bf16_t>(F, WS_WO) + (size_t)l_ * 1024 * 1024, 1024, 1024, (q >> 4) * 64, (q & 15) * 64, 0}; break; } \
        r -= I_OI; \
        if (r < I_C1) { const int mat = (int)(r >> 5), l_ = mat >> 1, kv = mat & 1; it = TItem{P.in[kv ? I_W1V : I_W1K] + (size_t)l_ * 2048 * 64, wsp<bf16_t>(F, WS_WC1) + (size_t)mat * 64 * 2048, 64, 2048, (int)(r & 31) * 64, 0, kv == 0 ? 1 : 0}; break; } \
        r -= I_C1; \
        { const int l_ = (int)(r / (16 * 104)), q = (int)(r % (16 * 104)); it = TItem{P.in[I_WIN] + (size_t)l_ * 1024 * NIN, wsp<bf16_t>(F, WS_WIN) + (size_t)l_ * NP * 1024, NIN, 1024, (q / 104) * 64, (q % 104) * 64, 2}; } } while (0)
    { f32x4 va[16], vb[16]; TItem ia, ib; long it = gw;
        if (it < N64) { P0_DECODE(ia, it); titem_load(ia, va, lane); }
#pragma unroll 1
        for (; it < N64; it += 2 * (long)NGW) {
            const long i2 = it + NGW, i3 = it + 2 * (long)NGW;
            if (i2 < N64) { P0_DECODE(ib, i2); titem_load(ib, vb, lane); }
            titem_store(ia, va, scrh, lane);
            if (i3 < N64) { P0_DECODE(ia, i3); titem_load(ia, va, lane); }
            if (i2 < N64) titem_store(ib, vb, scrh, lane);
        } }
#undef P0_DECODE
    constexpr long I_C2 = (long)NL * 2 * 2;
    for (long it = gw; it < I_C2; it += NGW) { const long r = it;
        { const int mat = (int)(r >> 1), l = mat >> 1, kv = mat & 1, nb = (int)(r & 1);
            transpose_item(P.in[kv ? I_W2V : I_W2K] + (size_t)l * 64 * 64, 64, wsp<bf16_t>(F, WS_WC2) + (size_t)mat * 64 * 64, 64, 0, nb * 32, scr, lane, IdMap(), IdMap()); }
    }
    const int gt = F.bid * NTHR + F.tid, NGT = F.G * NTHR;
    {
        const float* ws_ = P.in[I_GWS]; bf16_t* wg = wsp<bf16_t>(F, WS_WG);
        for (int i = gt; i < NL * 4 * 128 * 128; i += NGT) { const int s = i & 127, t = (i >> 7) & 127; wg[i] = (s <= t) ? f2bf(ws_[i]) : (bf16_t)0; }
    }
    {
        float* bp = wsp<float>(F, WS_BIN);
        for (int i = gt; i < NL * NP; i += NGT) { const int l = i / NP, c = i % NP, sc = hp_src_col(c); bp[i] = sc >= 0 ? P.in[I_BIN][(size_t)l * NIN + sc] : 0.f; }
    }
    {
        float* cs = wsp<float>(F, WS_CS); const int* pos = (const int*)P.in[I_POS];
        for (int i = gt; i < NT * 8; i += NGT) { const int t = i >> 3, f = i & 7;
            const double ang = (double)pos[t] * P.invf[f];
            const double twopi = 6.283185307179586476925286766559; double r = ang - twopi * rint(ang / twopi);
            const double r2 = r * r; double sn = 0.0, cn = 0.0, term = r;
#pragma unroll 1
            for (int k = 1; k <= 29; k += 2) { sn += term; term *= -r2 / (double)((k + 1) * (k + 2)); }
            term = 1.0;
#pragma unroll 1
            for (int k = 0; k <= 28; k += 2) { cn += term; term *= -r2 / (double)((k + 1) * (k + 2)); }
            cs[(size_t)t * 16 + f] = (float)cn; cs[(size_t)t * 16 + 8 + f] = (float)sn; }
    }
    {
        const f32x4* x4 = (const f32x4*)P.in[I_X]; u32x2* xb = wsp<u32x2>(F, WS_XB);
        for (int i = gt; i < NT * 256; i += NGT) { const f32x4 v = x4[i]; u32x2 w; w.x = pk2(v[0], v[1]); w.y = pk2(v[2], v[3]); xb[i] = w; }
    }
    for (int task = gw; task < NL * 2 * 32; task += NGW) { const int lk = task >> 5, part = task & 31, l = lk >> 1, kv = lk & 1;
        const float* pe = P.in[kv ? I_PEV : I_PEK] + (size_t)l * 2048 + part * 64; const float* w1 = P.in[kv ? I_W1V : I_W1K] + ((size_t)l * 2048 + part * 64) * 64;
        float a = 0.f;
#pragma unroll 16
        for (int k = 0; k < 64; ++k) a += pe[k] * w1[(size_t)k * 64 + lane];
        wsp<float>(F, WS_CB)[task * 64 + lane] = a; }
}

DEV void pb_transpose_unit(Frame F, int unit) {
    frame_refresh(F);
    const int b = unit >> 6, t0 = (unit & 63) * 64; const int tid = F.tid;
    const bf16_t* H = wsp<bf16_t>(F, WS_H); const float* cs = wsp<float>(F, WS_CS);
    const size_t rowb = (size_t)b * SEQ + t0;
    LAS bf16_t* tile = (LAS bf16_t*)F.lds; constexpr int TP = 392;
    LAS unsigned* nmx = (LAS unsigned*)(F.lds + 65536);
    u32x4 rw[2]; f32x4 rc[2], rs[2]; u32x4 vw[6], kw[4];
#pragma unroll
    for (int it = 0; it < 2; ++it) { const int task = tid + it * NTHR, tok = task >> 4, hd = (task >> 3) & 1, ch = task & 7; const size_t row = rowb + tok;
        rw[it] = *(const u32x4*)(H + row * NP + (hd ? HP_KW : HP_KS) + ch * 8);
        const float* c = cs + row * 16 + 4 * (ch & 1); rc[it] = *(const f32x4*)c; rs[it] = *(const f32x4*)(c + 8); }
#pragma unroll
    for (int it = 0; it < 6; ++it) { const int task = tid + it * NTHR, tok = task / 48, ch = task % 48;
        const int scol = ch < 8 ? HP_VS + ch * 8 : (ch < 16 ? HP_VW + (ch - 8) * 8 : HP_FV + (ch - 16) * 8);
        vw[it] = *(const u32x4*)(H + (rowb + tok) * NP + scol); }
    { const int tok = tid >> 3, part = tid & 7;
#pragma unroll
        for (int q = 0; q < 4; ++q) kw[q] = *(const u32x4*)(H + (rowb + tok) * NP + HP_FK + part * 32 + q * 8); }
    if (tid < 4) nmx[tid] = 0u;
#pragma unroll
    for (int it = 0; it < 2; ++it) { const int task = tid + it * NTHR, tok = task >> 4, hd = (task >> 3) & 1, ch = task & 7; const size_t row = rowb + tok;
        u32x4 w = rw[it]; unsigned* wp = (unsigned*)&w;
#pragma unroll
        for (int j = 0; j < 4; ++j) { const float t1 = bflo(wp[j]), t2 = bfhi(wp[j]); const unsigned rot = pk2(t1 * rc[it][j] - t2 * rs[it][j], t2 * rc[it][j] + t1 * rs[it][j]); wp[j] = (ch < 2) ? rot : wp[j]; }
        *(u32x4*)(wsp<bf16_t>(F, WS_KNSA) + row * 128 + hd * 64 + ch * 8) = w; }
#pragma unroll
    for (int it = 0; it < 6; ++it) { const int task = tid + it * NTHR, tok = task / 48, ch = task % 48; const u32x4 w = vw[it];
        *(LAS u32x2*)(tile + tok * TP + ch * 8) = (u32x2){w.x, w.y}; *(LAS u32x2*)(tile + tok * TP + ch * 8 + 4) = (u32x2){w.z, w.w}; }
    __syncthreads();
    { const int part = tid & 7; float ss = 0.f;
#pragma unroll
        for (int q = 0; q < 4; ++q) { const unsigned* wp = (const unsigned*)&kw[q];
#pragma unroll
            for (int j = 0; j < 4; ++j) { const float a = bflo(wp[j]), c = bfhi(wp[j]); ss += a * a + c * c; } }
        ss += __shfl_xor(ss, 1);
        if ((part & 1) == 0) (void)__hip_atomic_fetch_max(nmx + (part >> 1), __float_as_uint(ss), __ATOMIC_RELAXED, __HIP_MEMORY_SCOPE_WORKGROUP); }
    bf16_t* VT = wsp<bf16_t>(F, WS_VT);
#pragma unroll
    for (int it = 0; it < 6; ++it) { const int task = tid + it * NTHR, d = task % 384, sc = task / 384;
        unsigned short v[8];
#pragma unroll
        for (int j = 0; j < 8; ++j) v[j] = tile[(sc * 8 + j) * TP + d];
        u32x4 w; w.x = v[0] | ((unsigned)v[1] << 16); w.y = v[2] | ((unsigned)v[3] << 16); w.z = v[4] | ((unsigned)v[5] << 16); w.w = v[6] | ((unsigned)v[7] << 16);
        *(u32x4*)(VT + ((size_t)b * 384 + d) * SEQ + t0 + sc * 8) = w; }
    __syncthreads();
    if (tid < 4) wsp<float>(F, WS_KN)[((size_t)b * 4 + tid) * 64 + (t0 >> 6)] = sqrtf(__uint_as_float(nmx[tid])) * 1.0001f;
    __syncthreads();
}
DEV void pb_cum_unit(Frame F, int unit) {
    frame_refresh(F);
    const int b = unit >> 2, h = unit & 3, tid = F.tid;
    const float* side = wsp<float>(F, WS_SIDE);
    LAS double* sc = (LAS double*)F.lds;
    double loc[8]; double s = 0.0;
#pragma unroll
    for (int j = 0; j < 8; ++j) { const float x = side[((size_t)b * SEQ + tid * 8 + j) * 16 + 12 + h];
        const float ls = fminf(x, 0.f) - __logf(1.f + __expf(-fabsf(x)));
        s += (double)ls; loc[j] = s; }
    double inc = s;
#pragma unroll
    for (int o = 1; o < 64; o <<= 1) { const double t = __shfl_up(inc, o); if (F.lane >= o) inc += t; }
    if (F.lane == 63) sc[F.wave] = inc;
    __syncthreads();
    double wbase = 0.0;
#pragma unroll
    for (int w = 0; w < 8; ++w) wbase += (w < F.wave) ? sc[w] : 0.0;
    __syncthreads();
    sc[8 + tid] = wbase + inc - s;
    const double base = sc[8 + tid]; float* cum = wsp<float>(F, WS_CUM) + ((size_t)b * 4 + h) * SEQ + tid * 8;
#pragma unroll
    for (int j = 0; j < 8; ++j) cum[j] = (float)((base + loc[j]) * 1.4426950408889634);
    __syncthreads();
}
DEV void pb_conv_unit(Frame F, const Params& P, int l, int unit) {
    frame_refresh(F);
    const int b = unit >> 6, t0 = (unit & 63) * 64, tid = F.tid, lane = F.lane, wave = F.wave;
    const bf16_t* H = wsp<bf16_t>(F, WS_H);
    float w[31]; { const float* cw = P.in[I_CW] + (size_t)l * 31 * 256 + (tid & 255);
#pragma unroll
        for (int j = 0; j < 31; ++j) w[j] = cw[j * 256]; }
    const float bias = P.in[I_CB][l * 256 + (tid & 255)];
    LAS bf16_t* xg = (LAS bf16_t*)F.lds;
    LAS float* cv = (LAS float*)(F.lds + 49152);
    { u32x4 wv[12];
#pragma unroll
        for (int it = 0; it < 12; ++it) { const int task = tid + it * NTHR, r = task >> 6, c4 = (task & 63) * 4; const int t = t0 - 30 + r;
            wv[it] = (task < 94 * 64 && t >= 0) ? *(const u32x4*)(H + ((size_t)b * SEQ + t) * NP + HP_CAB + 2 * c4) : (u32x4){0u, 0u, 0u, 0u}; }
#pragma unroll
        for (int it = 0; it < 12; ++it) { const int task = tid + it * NTHR, r = task >> 6, c4 = (task & 63) * 4;
            if (task < 94 * 64) { const unsigned* wp = (const unsigned*)&wv[it]; float g[4];
#pragma unroll
                for (int j = 0; j < 4; ++j) g[j] = bflo(wp[j]) * sigmoidf_(bfhi(wp[j]));
                *(LAS u32x2*)(xg + r * 256 + c4) = (u32x2){pk2(g[0], g[1]), pk2(g[2], g[3])}; } } }
    __syncthreads();
    { const int c = tid & 255, half = tid >> 8;
        float xw[62];
#pragma unroll
        for (int j = 0; j < 62; ++j) xw[j] = bf2f(xg[(half * 32 + j) * 256 + c]);
#pragma unroll
        for (int tt = 0; tt < 32; ++tt) { float a = bias;
#pragma unroll
            for (int j = 0; j < 31; ++j) a += w[j] * xw[tt + j];
            cv[(half * 32 + tt) * 256 + c] = a; } }
    __syncthreads();
    { const f32x4 gg = *(const f32x4*)(P.in[I_CLNG] + l * 256 + lane * 4), bb = *(const f32x4*)(P.in[I_CLNB] + l * 256 + lane * 4);
        bf16_t* BR = wsp<bf16_t>(F, WS_BR);
#pragma unroll 1
        for (int i = 0; i < 8; ++i) { const int tt = wave * 8 + i; f32x4 v = *(const LAS f32x4*)(cv + tt * 256 + lane * 4);
            const float mean = wave_sum((v[0] + v[1]) + (v[2] + v[3])) * (1.f / 256.f); v = v - mean;
            const float var = wave_sum((v[0] * v[0] + v[1] * v[1]) + (v[2] * v[2] + v[3] * v[3])) * (1.f / 256.f);
            const float rstd = 1.f / sqrtf(var + LN_EPS); v = v * rstd * gg + bb;
#pragma unroll
            for (int j = 0; j < 4; ++j) v[j] = v[j] * sigmoidf_(v[j]);
            u32x2 o; o.x = pk2(v[0], v[1]); o.y = pk2(v[2], v[3]);
            *(u32x2*)(BR + ((size_t)b * SEQ + t0 + tt) * 1024 + 768 + lane * 4) = o; } }
    __syncthreads();
}
DEV void pb_gmlp_unit(Frame F, const Params& P, int l, int unit) {
    frame_refresh(F);
    const int t0 = unit * 128, tid = F.tid, lane = F.lane, wave = F.wave, fr = lane & 15, fq = lane >> 4;
    const bf16_t* H = wsp<bf16_t>(F, WS_H);
    LAS bf16_t* vt = (LAS bf16_t*)F.lds; constexpr int VP = 136;
    { const f32x4 gg = *(const f32x4*)(P.in[I_GLNG] + l * 256 + lane * 4), bb = *(const f32x4*)(P.in[I_GLNB] + l * 256 + lane * 4);
        u32x2 wv[16];
#pragma unroll
        for (int i = 0; i < 16; ++i) wv[i] = *(const u32x2*)(H + (size_t)(t0 + wave * 16 + i) * NP + HP_GV + lane * 4);
#pragma unroll
        for (int i = 0; i < 16; ++i) { const int s = wave * 16 + i; const u32x2 w = wv[i];
            f32x4 v = {gelu_tanh(bflo(w.x)), gelu_tanh(bfhi(w.x)), gelu_tanh(bflo(w.y)), gelu_tanh(bfhi(w.y))};
            const float mean = wave_sum((v[0] + v[1]) + (v[2] + v[3])) * (1.f / 256.f); v = v - mean;
            const float var = wave_sum((v[0] * v[0] + v[1] * v[1]) + (v[2] * v[2] + v[3] * v[3])) * (1.f / 256.f);
            const float rstd = 1.f / sqrtf(var + LN_EPS); v = v * rstd * gg + bb;
#pragma unroll
            for (int j = 0; j < 4; ++j) vt[(lane * 4 + j) * VP + s] = f2bf(v[j]); } }
    __syncthreads();
    { const int g = wave & 3, th = wave >> 2;
        const bf16_t* Wg = wsp<bf16_t>(F, WS_WG) + ((size_t)l * 4 + g) * 128 * 128;
        bf16_t* BR = wsp<bf16_t>(F, WS_BR);
        bf16x8 wf[4][4]; u32x2 uw[4][4]; float bs[4];
#pragma unroll
        for (int tb = 0; tb < 4; ++tb) { const int trow = th * 64 + tb * 16;
#pragma unroll
            for (int ks = 0; ks < 4; ++ks) wf[tb][ks] = (ks * 32 <= trow + 15) ? *(const bf16x8*)(Wg + (size_t)(trow + fr) * 128 + ks * 32 + fq * 8) : (bf16x8){0, 0, 0, 0, 0, 0, 0, 0};
#pragma unroll
            for (int db = 0; db < 4; ++db) uw[tb][db] = *(const u32x2*)(H + (size_t)(t0 + trow + fr) * NP + HP_GU + g * 64 + db * 16 + fq * 4);
            bs[tb] = P.in[I_GBS][((size_t)l * 4 + g) * 128 + trow + fr]; }
#pragma unroll
        for (int tb = 0; tb < 4; ++tb) { const int trow = th * 64 + tb * 16;
            f32x4 acc[4];
#pragma unroll
            for (int db = 0; db < 4; ++db) acc[db] = (f32x4){0.f, 0.f, 0.f, 0.f};
#pragma unroll
            for (int ks = 0; ks < 4; ++ks) if (ks * 32 <= trow + 15) {
#pragma unroll
                for (int db = 0; db < 4; ++db) { const bf16x8 vf = *(const LAS bf16x8*)(vt + (g * 64 + db * 16 + fr) * VP + ks * 32 + fq * 8);
                    acc[db] = mfma16(vf, wf[tb][ks], acc[db]); } }
            const int t = t0 + trow + fr;
#pragma unroll
            for (int db = 0; db < 4; ++db) { const int c = g * 64 + db * 16 + fq * 4; const u32x2 u2 = uw[tb][db]; const float b_ = bs[tb];
                const float o0 = gelu_tanh(bflo(u2.x)) * (acc[db][0] + b_), o1 = gelu_tanh(bfhi(u2.x)) * (acc[db][1] + b_), o2 = gelu_tanh(bflo(u2.y)) * (acc[db][2] + b_), o3 = gelu_tanh(bfhi(u2.y)) * (acc[db][3] + b_);
                u32x2 o; o.x = pk2(o0, o1); o.y = pk2(o2, o3); *(u32x2*)(BR + (size_t)t * 1024 + 512 + c) = o; } } }
    __syncthreads();
}
DEV void pb_compress_unit(Frame F, int l, int unit) {
    frame_refresh(F);
    const int kv = unit & 1, mb = (unit >> 1) & 15, b = unit >> 5; const int tid = F.tid, lane = F.lane, wave = F.wave, fr = lane & 15, fq = lane >> 4;
    const bf16_t* H = wsp<bf16_t>(F, WS_H); const float* cs = wsp<float>(F, WS_CS);
    const bf16_t* W1 = wsp<bf16_t>(F, WS_WC1) + ((size_t)l * 2 + kv) * 64 * 2048; const bf16_t* W2 = wsp<bf16_t>(F, WS_WC2) + ((size_t)l * 2 + kv) * 64 * 64;
    const f32x4 cbv = *(const f32x4*)(wsp<float>(F, WS_CB) + ((size_t)l * 2 + kv) * 32 * 64 + tid * 4);
    LAS float* red = (LAS float*)F.lds;
    LAS bf16_t* h1 = (LAS bf16_t*)(F.lds + 32768);
    f32x4 acc[4];
#pragma unroll
    for (int nb = 0; nb < 4; ++nb) acc[nb] = (f32x4){0.f, 0.f, 0.f, 0.f};
    const int c = mb * 16 + fr;
    { u32x4 aw[8]; f32x4 cco[4], csi[4];
#pragma unroll
        for (int ks_ = 0; ks_ < 8; ++ks_) { const int ks = wave * 8 + ks_; const int j = ks >> 1, dch = (ks & 1) * 32 + fq * 8; int tok = c * 16 + j; tok = tok > SEQ - 1 ? SEQ - 1 : tok;
            const size_t row = (size_t)b * SEQ + tok;
            aw[ks_] = *(const u32x4*)(H + row * NP + (kv ? HP_VC : HP_KC) + dch);
            if ((ks_ & 1) == 0) { const float* cc = cs + row * 16 + ((fq & 1) * 4); cco[ks_ >> 1] = *(const f32x4*)cc; csi[ks_ >> 1] = *(const f32x4*)(cc + 8); } }
#pragma unroll
        for (int hb = 0; hb < 2; ++hb) { bf16x8 bw[4][4];
#pragma unroll
            for (int k4 = 0; k4 < 4; ++k4)
#pragma unroll
                for (int nb = 0; nb < 4; ++nb) bw[k4][nb] = *(const bf16x8*)(W1 + (size_t)(nb * 16 + fr) * 2048 + (wave * 8 + hb * 4 + k4) * 32 + fq * 8);
#pragma unroll
            for (int k4 = 0; k4 < 4; ++k4) { const int ks_ = hb * 4 + k4; u32x4 w = aw[ks_];
                if ((ks_ & 1) == 0) { const bool rp = (kv == 0) && (fq < 2); unsigned* wp = (unsigned*)&w; const f32x4 co = cco[ks_ >> 1], si = csi[ks_ >> 1];
#pragma unroll
                    for (int q = 0; q < 4; ++q) { const float t1 = bflo(wp[q]), t2 = bfhi(wp[q]); const unsigned rot = pk2(t1 * co[q] - t2 * si[q], t2 * co[q] + t1 * si[q]); wp[q] = rp ? rot : wp[q]; } }
                const bf16x8 af = __builtin_bit_cast(bf16x8, w);
#pragma unroll
                for (int nb = 0; nb < 4; ++nb) acc[nb] = mfma16(af, bw[k4][nb], acc[nb]); } } }
#pragma unroll
    for (int nb = 0; nb < 4; ++nb)
#pragma unroll
        for (int i = 0; i < 4; ++i) red[(wave * 16 + fq * 4 + i) * 64 + nb * 16 + fr] = acc[nb][i];
    __syncthreads();
    { LAS float* cbl = (LAS float*)(F.lds + 36864);
        *(LAS f32x4*)(cbl + tid * 4) = cbv;
        __syncthreads();
#pragma unroll
        for (int it = 0; it < 2; ++it) { const int e = tid + it * NTHR, r = e >> 6, n = e & 63; float s = 0.f;
#pragma unroll
            for (int pp = 0; pp < 32; ++pp) s += cbl[pp * 64 + n];
#pragma unroll
            for (int w = 0; w < 8; ++w) s += red[(w * 16 + r) * 64 + n];
            h1[r * 72 + n] = f2bf(gelu_tanh(s)); } }
    __syncthreads();
    if (wave == 0) {
#pragma unroll
        for (int nb = 0; nb < 4; ++nb) { f32x4 o = (f32x4){0.f, 0.f, 0.f, 0.f};
#pragma unroll
            for (int ks = 0; ks < 2; ++ks) { const bf16x8 hf = *(const LAS bf16x8*)(h1 + fr * 72 + ks * 32 + fq * 8); const bf16x8 wf = *(const bf16x8*)(W2 + (size_t)(nb * 16 + fr) * 64 + ks * 32 + fq * 8);
                o = kv ? mfma16(hf, wf, o) : mfma16(wf, hf, o); }
            u32x2 w; w.x = pk2(o[0], o[1]); w.y = pk2(o[2], o[3]);
            if (kv == 0) *(u32x2*)(wsp<bf16_t>(F, WS_KCMP) + ((size_t)b * 256 + mb * 16 + fr) * 64 + nb * 16 + fq * 4) = w;
            else *(u32x2*)(wsp<bf16_t>(F, WS_VCMPT) + ((size_t)b * 64 + nb * 16 + fr) * 256 + mb * 16 + fq * 4) = w; } }
    __syncthreads();
}

constexpr int TILE_B = 9216, AT_KT = 0, AT_VT = 36864, AT_CK = 73728, AT_KC = 0, AT_VC = 36864, AT_XCH = 0, AT_TAB = 32768, AT_FXT = 74752, AT_XST = 77824;
constexpr int KTP = 72, VCP = 264, TABP = 65;
constexpr float QSCALE = 0.125f * LOG2E;
struct FlashSt { float m, l; f32x4 o[4]; };
DEV void flash_init(FlashSt& s) { s.m = -1e30f; s.l = 0.f;
#pragma unroll
    for (int d = 0; d < 4; ++d) s.o[d] = (f32x4){0.f, 0.f, 0.f, 0.f}; }
DEV bf16x8 pack_p(const f32x4& a, const f32x4& b) { u32x4 w; w.x = pk2(a[0], a[1]); w.y = pk2(a[2], a[3]); w.z = pk2(b[0], b[1]); w.w = pk2(b[2], b[3]); return __builtin_bit_cast(bf16x8, w); }
DEV bf16x8 vfrag(const LAS bf16_t* p) { const bf16x4 lo = *(const LAS bf16x4*)p, hi = *(const LAS bf16x4*)(p + 16); return __builtin_shufflevector(lo, hi, 0, 1, 2, 3, 4, 5, 6, 7); }
struct KVFrags { bf16x8 k[4][2]; bf16x8 v[4][2]; };
DEV void load_frags(KVFrags& f, const LAS bf16_t* kt, const LAS bf16_t* vt, int fr, int fq) {
#pragma unroll
    for (int kb = 0; kb < 4; ++kb) { const LAS bf16_t* kp = kt + (16 * kb + fr) * KTP + 8 * fq; f.k[kb][0] = *(const LAS bf16x8*)kp; f.k[kb][1] = *(const LAS bf16x8*)(kp + 32); }
#pragma unroll
    for (int d = 0; d < 4; ++d)
#pragma unroll
        for (int c = 0; c < 2; ++c) f.v[d][c] = vfrag(vt + (16 * d + fr) * KTP + 32 * c + 4 * fq);
}
DEV void qk_frags(f32x4 (&s)[4], const KVFrags& f, const bf16x8 (&qf)[2]) {
#pragma unroll
    for (int kb = 0; kb < 4; ++kb) { f32x4 a = mfma16(f.k[kb][0], qf[0], (f32x4){0.f, 0.f, 0.f, 0.f}); s[kb] = mfma16(f.k[kb][1], qf[1], a); }
}
DEV void flash_update(FlashSt& st, f32x4 (&s)[4], const KVFrags& f, bool on) {
    float mx = fmaxf(fmaxf(fmaxf(s[0][0], s[0][1]), fmaxf(s[0][2], s[0][3])), fmaxf(fmaxf(s[1][0], s[1][1]), fmaxf(s[1][2], s[1][3])));
    mx = fmaxf(mx, fmaxf(fmaxf(fmaxf(s[2][0], s[2][1]), fmaxf(s[2][2], s[2][3])), fmaxf(fmaxf(s[3][0], s[3][1]), fmaxf(s[3][2], s[3][3]))));
    mx = on ? mx : -INFINITY;
    mx = xr_max(mx);
    const float mn = fmaxf(st.m, mx), alpha = fexp2(st.m - mn); st.m = mn;
    const float mref = on ? mn : INFINITY;
    float sum = 0.f;
#pragma unroll
    for (int kb = 0; kb < 4; ++kb)
#pragma unroll
        for (int i = 0; i < 4; ++i) { const float p = fexp2(s[kb][i] - mref); s[kb][i] = p; sum += p; }
    st.l = st.l * alpha + sum;
#pragma unroll
    for (int d = 0; d < 4; ++d) st.o[d] = st.o[d] * alpha;
#pragma unroll
    for (int c = 0; c < 2; ++c) { const bf16x8 pf = pack_p(s[2 * c], s[2 * c + 1]);
#pragma unroll
        for (int d = 0; d < 4; ++d) st.o[d] = mfma16(f.v[d][c], pf, st.o[d]); }
}
DEV float flash_inv_l(const FlashSt& st) { const float l = xr_sum(st.l); return l > 0.f ? 1.f / l : 0.f; }
DEV bf16x8 load_q(const bf16_t* p, const float* c, bool rope, float scale) {
    u32x4 w = *(const u32x4*)p; unsigned* wp = (unsigned*)&w;
    f32x4 co = {1.f, 1.f, 1.f, 1.f}, si = {0.f, 0.f, 0.f, 0.f};
    if (c) { co = *(const f32x4*)c; si = *(const f32x4*)(c + 8); }
#pragma unroll
    for (int j = 0; j < 4; ++j) { const float t1 = bflo(wp[j]), t2 = bfhi(wp[j]);
        const float a = rope ? t1 * co[j] - t2 * si[j] : t1, bq = rope ? t2 * co[j] + t1 * si[j] : t2;
        wp[j] = pk2(a * scale, bq * scale); }
    return __builtin_bit_cast(bf16x8, w);
}
struct TileRegs { u32x4 k, v; };
DEV void tile_load(TileRegs& r, const bf16_t* kbase, size_t kpitch, const bf16_t* vtbase, int key0, int tid) {
    r.k = *(const u32x4*)(kbase + (size_t)(key0 + (tid >> 3)) * kpitch + (tid & 7) * 8);
    r.v = *(const u32x4*)(vtbase + (size_t)(tid >> 3) * SEQ + key0 + (tid & 7) * 8);
}
DEV void tile_store(const TileRegs& r, LAS bf16_t* kt, LAS bf16_t* vt, int tid) {
    *(LAS u32x4*)(kt + (tid >> 3) * KTP + (tid & 7) * 8) = r.k; *(LAS u32x4*)(vt + (tid >> 3) * KTP + (tid & 7) * 8) = r.v;
}

DEV void nsa_unit(Frame F, int b, int qt, int half) {
    frame_refresh(F);
    const int tid = F.tid, lane = F.lane, wave = F.wave, fr = lane & 15, fq = lane >> 4, sq = wave & 1, hp = (wave >> 1) & 1, ks = wave >> 2, head = 2 * hp + ks, qid = wave >> 1;
    const int ql = 32 * half + 16 * sq + fr, tq = qt * 64 + ql, cur = qt; const size_t rowq = (size_t)b * SEQ + tq;
    const bf16_t* H = wsp<bf16_t>(F, WS_H); const float* cs = wsp<float>(F, WS_CS); const float* side = wsp<float>(F, WS_SIDE);
    LAS bf16_t* KT = (LAS bf16_t*)(F.lds + AT_KT); LAS bf16_t* VT = (LAS bf16_t*)(F.lds + AT_VT);
    LAS bf16_t* KC = (LAS bf16_t*)(F.lds + AT_KC); LAS bf16_t* VC = (LAS bf16_t*)(F.lds + AT_VC);
    bf16x8 qf2[2][2], qf[2]; float gate[3];
#pragma unroll
    for (int hh = 0; hh < 2; ++hh)
#pragma unroll
        for (int dc = 0; dc < 2; ++dc) qf2[hh][dc] = load_q(H + rowq * NP + HP_NQ + (2 * hp + hh) * 64 + 32 * dc + 8 * fq, cs + rowq * 16 + 4 * (fq & 1), dc == 0 && fq < 2, QSCALE);
#pragma unroll
    for (int dc = 0; dc < 2; ++dc) qf[dc] = ks ? qf2[1][dc] : qf2[0][dc];
#pragma unroll
    for (int i = 0; i < 3; ++i) gate[i] = sigmoidf_(side[rowq * 16 + head * 3 + i]);
    { const bf16_t* kc = wsp<bf16_t>(F, WS_KCMP) + (size_t)b * 256 * 64; const bf16_t* vc = wsp<bf16_t>(F, WS_VCMPT) + (size_t)b * 64 * 256;
#pragma unroll
        for (int it = 0; it < 4; ++it) { const int id = tid + it * NTHR;
            *(LAS u32x4*)(KC + (id >> 3) * KTP + (id & 7) * 8) = *(const u32x4*)(kc + (size_t)id * 8);
            *(LAS u32x4*)(VC + (id >> 5) * VCP + (id & 31) * 8) = *(const u32x4*)(vc + (size_t)id * 8); } }
    __syncthreads();
    f32x4 res[4]; float imp[16];
    const int nkb = (4 * qt + 2 * half) / 16 + 1;
    const int cl = (tq - 31) >> 4;
    const int srcl = (lane - 16) & 63;
    {
        f32x4 sc[16]; float mx = -1e30f;
#pragma unroll
        for (int kb = 0; kb < 16; ++kb) {
            if (kb < nkb) { const LAS bf16_t* kp = KC + (16 * kb + fr) * KTP + 8 * fq;
                f32x4 a = mfma16(*(const LAS bf16x8*)kp, qf[0], (f32x4){0.f, 0.f, 0.f, 0.f}); a = mfma16(*(const LAS bf16x8*)(kp + 32), qf[1], a);
#pragma unroll
                for (int i = 0; i < 4; ++i) { a[i] = (16 * kb + 4 * fq + i <= cl) ? a[i] : -INFINITY; mx = fmaxf(mx, a[i]); }
                sc[kb] = a; }
            else sc[kb] = (f32x4){-INFINITY, -INFINITY, -INFINITY, -INFINITY}; }
        mx = xr_max(mx);
        float sum = 0.f;
#pragma unroll
        for (int kb = 0; kb < 16; ++kb) if (kb < nkb) {
#pragma unroll
            for (int i = 0; i < 4; ++i) { const float p = fexp2(sc[kb][i] - mx); sc[kb][i] = p; sum += p; } }
        else sc[kb] = (f32x4){0.f, 0.f, 0.f, 0.f};
        sum = xr_sum(sum);
        const float inv = sum > 0.f ? 1.f / sum : 0.f;
        f32x4 o[4];
#pragma unroll
        for (int d = 0; d < 4; ++d) o[d] = (f32x4){0.f, 0.f, 0.f, 0.f};
        float prevx = 0.f;
#pragma unroll
        for (int kb = 0; kb < 16; ++kb) { if (kb < nkb) { sc[kb] = sc[kb] * inv; const float x = __shfl(sc[kb][3], srcl);
                imp[kb] = ((sc[kb][0] + sc[kb][1]) + (sc[kb][2] + sc[kb][3])) + (fq > 0 ? x : prevx); prevx = x; }
            else imp[kb] = 0.f; }
#pragma unroll
        for (int cc = 0; cc < 8; ++cc) if (2 * cc < nkb) { const bf16x8 pf = pack_p(sc[2 * cc], sc[2 * cc + 1]);
#pragma unroll
            for (int d = 0; d < 4; ++d) o[d] = mfma16(vfrag(VC + (16 * d + fr) * VCP + 32 * cc + 4 * fq), pf, o[d]); }
#pragma unroll
        for (int d = 0; d < 4; ++d) res[d] = o[d] * gate[0];
    }
    unsigned mlo, mhi;
    if (cur < 16) { mlo = (2u << cur) - 1u; mhi = 0u; }
    else {
        LAS float* XCH = (LAS float*)(F.lds + AT_XCH); LAS float* TAB = (LAS float*)(F.lds + AT_TAB) + (wave * 16 + fr) * TABP;
        __syncthreads();
#pragma unroll
        for (int kb = 0; kb < 16; ++kb) XCH[(wave * 16 + kb) * 64 + lane] = imp[kb];
        __syncthreads();
#pragma unroll
        for (int kb = 0; kb < 16; ++kb) { const int j = 4 * kb + fq;
            float v = (XCH[((0 + sq) * 16 + kb) * 64 + lane] + XCH[((2 + sq) * 16 + kb) * 64 + lane]) + (XCH[((4 + sq) * 16 + kb) * 64 + lane] + XCH[((6 + sq) * 16 + kb) * 64 + lane]);
            const bool forced = (j == 0) || (j == cur) || (j == cur - 1);
            v = forced ? 1e9f : (j <= cur ? v : -1.f); imp[kb] = v; TAB[j] = v; }
        LDS_WAIT();
        int cnt[4];
#pragma unroll
        for (int k4 = 0; k4 < 4; ++k4) cnt[k4] = 0;
        float myv[4];
#pragma unroll
        for (int k4 = 0; k4 < 4; ++k4) myv[k4] = qid == 0 ? imp[k4] : (qid == 1 ? imp[4 + k4] : (qid == 2 ? imp[8 + k4] : imp[12 + k4]));
#pragma unroll 4
        for (int jj = 0; jj < 64; ++jj) { const float vv = TAB[jj];
#pragma unroll
            for (int k4 = 0; k4 < 4; ++k4) { const int j = 4 * (4 * qid + k4) + fq; cnt[k4] += ((vv > myv[k4]) || (vv == myv[k4] && jj < j)) ? 1 : 0; } }
        mlo = 0u; mhi = 0u;
#pragma unroll
        for (int k4 = 0; k4 < 4; ++k4) { const int j = 4 * (4 * qid + k4) + fq; const unsigned bit = (cnt[k4] < 16 && j <= cur) ? 1u : 0u; if (j < 32) mlo |= bit << (j & 31); else mhi |= bit << (j & 31); }
        mlo = xr_or(mlo); mhi = xr_or(mhi);
        LAS unsigned* MSK = (LAS unsigned*)(F.lds + AT_CK);
        if (fq == 0) { MSK[(wave * 16 + fr) * 2] = mlo; MSK[(wave * 16 + fr) * 2 + 1] = mhi; }
        __syncthreads();
        mlo = (MSK[((0 + sq) * 16 + fr) * 2] | MSK[((2 + sq) * 16 + fr) * 2]) | (MSK[((4 + sq) * 16 + fr) * 2] | MSK[((6 + sq) * 16 + fr) * 2]);
        mhi = (MSK[((0 + sq) * 16 + fr) * 2 + 1] | MSK[((2 + sq) * 16 + fr) * 2 + 1]) | (MSK[((4 + sq) * 16 + fr) * 2 + 1] | MSK[((6 + sq) * 16 + fr) * 2 + 1]);
    }
    __syncthreads();
#pragma unroll 1
    for (int br = 0; br < 2; ++br) {
        const bf16_t* kbase = wsp<bf16_t>(F, WS_KNSA) + (size_t)b * SEQ * 128 + br * 64;
        const bf16_t* vtb = wsp<bf16_t>(F, WS_VT) + ((size_t)b * 384 + br * 64) * SEQ;
        const int j0 = br == 0 ? 0 : (qt > 8 ? qt - 8 : 0);
        const int np = (cur - j0 + 2) >> 1;
        FlashSt st2[2]; flash_init(st2[0]); flash_init(st2[1]);
        TileRegs ra[2], rb[2];
#define NSA_LOADP(R, p) do { _Pragma("unroll") for (int tt_ = 0; tt_ < 2; ++tt_) { const int j_ = j0 + 2 * (p) + tt_; if (j_ <= cur) tile_load(R[tt_], kbase, 128, vtb, j_ * 64, tid); } } while (0)
#define NSA_STOREP(R, p, buf) do { _Pragma("unroll") for (int tt_ = 0; tt_ < 2; ++tt_) { const int j_ = j0 + 2 * (p) + tt_; if (j_ <= cur) tile_store(R[tt_], KT + ((buf) * 2 + tt_) * 64 * KTP, VT + ((buf) * 2 + tt_) * 64 * KTP, tid); } } while (0)
#define NSA_COMPP(p, buf) do { const int j = j0 + 2 * (p) + ks; if (j <= cur) { \
            const LAS bf16_t* kt = KT + ((buf) * 2 + ks) * 64 * KTP; const LAS bf16_t* vt = VT + ((buf) * 2 + ks) * 64 * KTP; \
            const bool on = (br == 0) ? (((j < 32 ? (mlo >> j) : (mhi >> (j - 32))) & 1u) != 0u) : true; \
            if (__any(on)) { KVFrags fg; load_frags(fg, kt, vt, fr, fq); asm volatile("" ::: "memory"); \
                const bool edge = (j == cur) || (br == 1 && j == qt - 8); const int hi = (j == cur) ? ql : 63, lo = (br == 1 && j == qt - 8) ? ql : -1; \
                _Pragma("unroll") for (int hh = 0; hh < 2; ++hh) { f32x4 s[4]; qk_frags(s, fg, qf2[hh]); \
                    if (edge) { _Pragma("unroll") for (int kb = 0; kb < 4; ++kb) _Pragma("unroll") for (int i = 0; i < 4; ++i) { const int kl = 16 * kb + 4 * fq + i; s[kb][i] = (kl <= hi && kl > lo) ? s[kb][i] : -INFINITY; } } \
                    flash_update(st2[hh], s, fg, on); } } } } while (0)
        NSA_LOADP(ra, 0); NSA_LOADP(rb, 1);
#pragma unroll 1
        for (int p = 0; p < np; p += 2) {
            NSA_STOREP(ra, p, 0); __syncthreads(); NSA_LOADP(ra, p + 2); NSA_COMPP(p, 0);
            if (p + 1 < np) { NSA_STOREP(rb, p + 1, 1); __syncthreads(); NSA_LOADP(rb, p + 3); NSA_COMPP(p + 1, 1); }
        }
#undef NSA_LOADP
#undef NSA_STOREP
#undef NSA_COMPP
        { LAS float* XS = (LAS float*)(F.lds + AT_XST) + wave * (18 * 64) + lane;
            XS[0] = ks ? st2[0].m : st2[1].m; XS[64] = ks ? st2[0].l : st2[1].l;
#pragma unroll
            for (int d = 0; d < 4; ++d)
#pragma unroll
                for (int i = 0; i < 4; ++i) XS[(2 + 4 * d + i) * 64] = ks ? st2[0].o[d][i] : st2[1].o[d][i];
            __syncthreads();
            const LAS float* XP = (const LAS float*)(F.lds + AT_XST) + (wave ^ 4) * (18 * 64) + lane;
            FlashSt st; st.m = ks ? st2[1].m : st2[0].m; st.l = ks ? st2[1].l : st2[0].l;
#pragma unroll
            for (int d = 0; d < 4; ++d) st.o[d] = ks ? st2[1].o[d] : st2[0].o[d];
            const float mb = XP[0], lb = XP[64]; const float m = fmaxf(st.m, mb), fa = fexp2(st.m - m), fb = fexp2(mb - m);
            st.l = st.l * fa + lb * fb;
#pragma unroll
            for (int d = 0; d < 4; ++d)
#pragma unroll
                for (int i = 0; i < 4; ++i) st.o[d][i] = st.o[d][i] * fa + XP[(2 + 4 * d + i) * 64] * fb;
            const float sc = flash_inv_l(st) * (br == 0 ? gate[1] : gate[2]);
#pragma unroll
            for (int d = 0; d < 4; ++d) res[d] += st.o[d] * sc; }
        __syncthreads();
    }
    bf16_t* BR = wsp<bf16_t>(F, WS_BR);
#pragma unroll
    for (int d = 0; d < 4; ++d) { u32x2 w; w.x = pk2(res[d][0], res[d][1]); w.y = pk2(res[d][2], res[d][3]);
        *(u32x2*)(BR + rowq * 1024 + head * 64 + 16 * d + 4 * fq) = w; }
}

DEV void fox_unit(Frame F, int b, int h, int qb) {
    frame_refresh(F);
    const int tid = F.tid, lane = F.lane, wave = F.wave, fr = lane & 15, fq = lane >> 4;
    const int q0 = qb * 256, qw = q0 + 32 * wave;
    const bf16_t* H = wsp<bf16_t>(F, WS_H); const float* cum = wsp<float>(F, WS_CUM) + ((size_t)b * 4 + h) * SEQ;
    LAS bf16_t* KT = (LAS bf16_t*)(F.lds + AT_KT); LAS bf16_t* VT = (LAS bf16_t*)(F.lds + AT_VT); LAS float* CK = (LAS float*)(F.lds + AT_CK);
    LAS float* KNP = (LAS float*)(F.lds + AT_FXT); LAS float* CKL = KNP + 64; LAS float* WMIN = KNP + 128; LAS float* WQN = KNP + 136;
    const float cref = cum[q0];
    bf16x8 qf[2][2]; float qn2 = 0.f;
#pragma unroll
    for (int sb = 0; sb < 2; ++sb) { float ss = 0.f;
#pragma unroll
        for (int dc = 0; dc < 2; ++dc) { qf[sb][dc] = load_q(H + ((size_t)b * SEQ + qw + 16 * sb + fr) * NP + HP_FQ + h * 64 + 32 * dc + 8 * fq, nullptr, false, QSCALE);
            const u32x4 w = __builtin_bit_cast(u32x4, qf[sb][dc]); const unsigned* wp = (const unsigned*)&w;
#pragma unroll
            for (int j = 0; j < 4; ++j) { const float a = bflo(wp[j]), c = bfhi(wp[j]); ss += a * a + c * c; } }
        ss = xr_sum(ss); qn2 = fmaxf(qn2, ss); }
#pragma unroll
    for (int o = 1; o < 16; o <<= 1) qn2 = fmaxf(qn2, __shfl_xor(qn2, o));
    if (lane == 0) WQN[wave] = sqrtf(qn2) * 1.0001f;
    if (tid < 64) {
        float kn = wsp<float>(F, WS_KN)[((size_t)b * 4 + h) * 64 + tid];
#pragma unroll
        for (int o = 1; o < 64; o <<= 1) { const float t = __shfl_up(kn, o); if (tid >= o) kn = fmaxf(kn, t); }
        KNP[tid] = kn; CKL[tid] = cum[64 * tid + 63] - cref; }
    const bf16_t* kbase = H + (size_t)b * SEQ * NP + HP_FK + h * 64; const bf16_t* vtb = wsp<bf16_t>(F, WS_VT) + ((size_t)b * 384 + 128 + h * 64) * SEQ;
    FlashSt st[2]; flash_init(st[0]); flash_init(st[1]);
    __syncthreads();
    int np = 2;
    { float qn = WQN[0];
#pragma unroll
        for (int w = 1; w < 8; ++w) qn = fmaxf(qn, WQN[w]);
        const float wk = wsp<float>(F, WS_KN)[((size_t)b * 4 + h) * 64 + 4 * qb + (lane & 3)];
        float kown = fmaxf(wk, __shfl_xor(wk, 1)); kown = fmaxf(kown, __shfl_xor(kown, 2)); kown = __shfl(kown, 0);
        const float thr = -qn * kown - 40.f;
#pragma unroll 1
        for (int Jn = 4 * qb - 1; Jn >= 0; Jn -= 2) { if (qn * KNP[Jn] - CKL[Jn] < thr) break; ++np; } }
    np = __builtin_amdgcn_readfirstlane(np);
#define FOX_TILE(p, tt) ((p) < 2 ? 4 * qb + 2 * (p) + (tt) : 4 * qb - 1 - 2 * ((p) - 2) - (tt))
    TileRegs ra[2], rb[2]; f32x4 cka[2], ckb[2];
#define FOX_LOADP(R, C, p) do { if ((p) < np) { _Pragma("unroll") for (int tt_ = 0; tt_ < 2; ++tt_) { const int j_ = FOX_TILE(p, tt_); if (j_ >= 0) { tile_load(R[tt_], kbase, NP, vtb, j_ * 64, tid); if (tid < 16) C[tt_] = *(const f32x4*)(cum + j_ * 64 + 4 * tid); } } } } while (0)
#define FOX_STOREP(R, C, p, buf) do { _Pragma("unroll") for (int tt_ = 0; tt_ < 2; ++tt_) { const int j_ = FOX_TILE(p, tt_); if (j_ >= 0) { tile_store(R[tt_], KT + ((buf) * 2 + tt_) * 64 * KTP, VT + ((buf) * 2 + tt_) * 64 * KTP, tid); \
            if (tid < 16) *(LAS f32x4*)(CK + ((buf) * 2 + tt_) * 64 + 4 * tid) = C[tt_] - cref; } } } while (0)
#define FOX_COMPP(p, buf) do { _Pragma("unroll") for (int tt_ = 0; tt_ < 2; ++tt_) { const int J = FOX_TILE(p, tt_); const int key0 = 64 * J; if (J >= 0 && key0 <= qw + 31) { \
            const LAS bf16_t* kt = KT + ((buf) * 2 + tt_) * 64 * KTP; const LAS bf16_t* vt = VT + ((buf) * 2 + tt_) * 64 * KTP; const LAS float* ck = CK + ((buf) * 2 + tt_) * 64; \
            KVFrags fg; load_frags(fg, kt, vt, fr, fq); \
            f32x4 dk[4]; _Pragma("unroll") for (int kb = 0; kb < 4; ++kb) dk[kb] = *(const LAS f32x4*)(ck + 16 * kb + 4 * fq); \
            asm volatile("" ::: "memory"); \
            const bool diag = key0 + 63 > qw; \
            _Pragma("unroll") for (int sb = 0; sb < 2; ++sb) { f32x4 s[4]; qk_frags(s, fg, qf[sb]); const int qa = qw + 16 * sb + fr; \
                _Pragma("unroll") for (int kb = 0; kb < 4; ++kb) { s[kb] = s[kb] - dk[kb]; \
                    if (diag) { _Pragma("unroll") for (int i = 0; i < 4; ++i) s[kb][i] = (key0 + 16 * kb + 4 * fq + i <= qa) ? s[kb][i] : -INFINITY; } } \
                flash_update(st[sb], s, fg, true); } } } } while (0)
    FOX_LOADP(ra, cka, 0); FOX_LOADP(rb, ckb, 1);
#pragma unroll 1
    for (int p = 0; p < np; p += 2) {
        FOX_STOREP(ra, cka, p, 0); __syncthreads(); FOX_LOADP(ra, cka, p + 2); FOX_COMPP(p, 0);
        if (p + 1 < np) { FOX_STOREP(rb, ckb, p + 1, 1); __syncthreads(); FOX_LOADP(rb, ckb, p + 3); FOX_COMPP(p + 1, 1); }
    }
#undef FOX_TILE
#undef FOX_LOADP
#undef FOX_STOREP
#undef FOX_COMPP
    bf16_t* BR = wsp<bf16_t>(F, WS_BR);
#pragma unroll
    for (int sb = 0; sb < 2; ++sb) { const float sc = flash_inv_l(st[sb]); const size_t row = (size_t)b * SEQ + qw + 16 * sb + fr;
#pragma unroll
        for (int d = 0; d < 4; ++d) { const f32x4 o = st[sb].o[d] * sc; u32x2 w; w.x = pk2(o[0], o[1]); w.y = pk2(o[2], o[3]);
            *(u32x2*)(BR + row * 1024 + 256 + h * 64 + 16 * d + 4 * fq) = w; } }
    __syncthreads();
}

DEV void ln1_router_phase(Frame F, const Params& P, int l) {
    frame_refresh(F);
    const int tid = F.tid, lane = F.lane, wave = F.wave, fr = lane & 15, fq = lane >> 4;
    LAS float* xs = (LAS float*)F.lds;
    LAS float* part = (LAS float*)(F.lds + 69632);
    constexpr int XP = 1028;
    const bf16_t* mix = wsp<bf16_t>(F, WS_MIX); bf16_t* xb = wsp<bf16_t>(F, WS_XB);
    const float* g1 = P.in[I_LN1G] + (size_t)l * 1024; const float* b1 = P.in[I_LN1B] + (size_t)l * 1024;
    float wf[2][32];
    { const float* wr = P.in[I_WR] + (size_t)l * 1024 * 32 + (size_t)(128 * wave + 32 * fq) * 32 + fr;
#pragma unroll
        for (int s_ = 0; s_ < 32; ++s_) { wf[0][s_] = wr[s_ * 32]; wf[1][s_] = wr[s_ * 32 + 16]; } }
    const float brt = P.in[I_BR][l * 32 + (tid & 31)];
    unsigned* cnt = F.ctl + CW_CNT + l * 32 * 64; int* rowtk = wsp<int>(F, WS_ROWTK); float* tokw = wsp<float>(F, WS_TOKW);
    LAS unsigned* lcnt = (LAS unsigned*)(F.lds + 90112);
    LAS unsigned* lsel = lcnt + 64;
    if (tid < 64) lcnt[tid] = 0u;
    int nsel = 0;
    __syncthreads();
    u32x4 va[2][2], vm[2][2];
    f32x4 gg1[2][2], bb1[2][2];
#pragma unroll
    for (int j = 0; j < 2; ++j)
#pragma unroll
        for (int h = 0; h < 2; ++h) { gg1[j][h] = *(const f32x4*)(g1 + j * 512 + lane * 8 + 4 * h); bb1[j][h] = *(const f32x4*)(b1 + j * 512 + lane * 8 + 4 * h); }
    int unit = F.bid;
    if (unit < NT / 16) {
#pragma unroll
        for (int i = 0; i < 2; ++i)
#pragma unroll
            for (int j = 0; j < 2; ++j) { const size_t o = (size_t)(unit * 16 + wave * 2 + i) * 1024 + j * 512 + lane * 8; va[i][j] = *(const u32x4*)(xb + o); vm[i][j] = *(const u32x4*)(mix + o); } }
#pragma unroll 1
    for (; unit < NT / 16; unit += F.G) {
        const int r0 = unit * 16;
#pragma unroll
        for (int i = 0; i < 2; ++i) { const int r = wave * 2 + i; const size_t row = (size_t)(r0 + r);
            f32x4 v[2][2]; float s = 0.f;
#pragma unroll
            for (int j = 0; j < 2; ++j) { const unsigned* xp_ = (const unsigned*)&va[i][j]; const unsigned* mp_ = (const unsigned*)&vm[i][j];
#pragma unroll
                for (int h = 0; h < 2; ++h) { const f32x4 xa = {bflo(xp_[2 * h]), bfhi(xp_[2 * h]), bflo(xp_[2 * h + 1]), bfhi(xp_[2 * h + 1])}, ma = {bflo(mp_[2 * h]), bfhi(mp_[2 * h]), bflo(mp_[2 * h + 1]), bfhi(mp_[2 * h + 1])};
                    v[j][h] = xa * DN_ALPHA + ma; s += (v[j][h][0] + v[j][h][1]) + (v[j][h][2] + v[j][h][3]); } }
            const float mean = wave_sum(s) * (1.f / 1024.f); float q = 0.f;
#pragma unroll
            for (int j = 0; j < 2; ++j)
#pragma unroll
                for (int h = 0; h < 2; ++h) { v[j][h] = v[j][h] - mean; q += (v[j][h][0] * v[j][h][0] + v[j][h][1] * v[j][h][1]) + (v[j][h][2] * v[j][h][2] + v[j][h][3] * v[j][h][3]); }
            const float rstd = 1.f / sqrtf(wave_sum(q) * (1.f / 1024.f) + LN_EPS);
#pragma unroll
            for (int j = 0; j < 2; ++j) { const f32x4 o0 = v[j][0] * rstd * gg1[j][0] + bb1[j][0], o1 = v[j][1] * rstd * gg1[j][1] + bb1[j][1];
                *(LAS f32x4*)(xs + r * XP + j * 512 + lane * 8) = o0; *(LAS f32x4*)(xs + r * XP + j * 512 + lane * 8 + 4) = o1;
                u32x4 w; w.x = pk2(o0[0], o0[1]); w.y = pk2(o0[2], o0[3]); w.z = pk2(o1[0], o1[1]); w.w = pk2(o1[2], o1[3]); *(u32x4*)(xb + row * 1024 + j * 512 + lane * 8) = w; } }
        { const int un = unit + F.G;
            if (un < NT / 16) {
#pragma unroll
                for (int i = 0; i < 2; ++i)
#pragma unroll
                    for (int j = 0; j < 2; ++j) { const size_t o = (size_t)(un * 16 + wave * 2 + i) * 1024 + j * 512 + lane * 8; va[i][j] = *(const u32x4*)(xb + o); vm[i][j] = *(const u32x4*)(mix + o); } } }
        __syncthreads();
        { f32x4 c0 = (f32x4){0.f, 0.f, 0.f, 0.f}, c1 = c0; const LAS float* xp = xs + fr * XP + 128 * wave + 32 * fq;
#pragma unroll
            for (int s4 = 0; s4 < 8; ++s4) { const f32x4 xa = *(const LAS f32x4*)(xp + 4 * s4);
#pragma unroll
                for (int i = 0; i < 4; ++i) { c0 = __builtin_amdgcn_mfma_f32_16x16x4f32(xa[i], wf[0][4 * s4 + i], c0, 0, 0, 0); c1 = __builtin_amdgcn_mfma_f32_16x16x4f32(xa[i], wf[1][4 * s4 + i], c1, 0, 0, 0); } }
#pragma unroll
            for (int i = 0; i < 4; ++i) { part[(wave * 16 + 4 * fq + i) * 32 + fr] = c0[i]; part[(wave * 16 + 4 * fq + i) * 32 + 16 + fr] = c1[i]; } }
        __syncthreads();
        { const int r = tid >> 5, e = tid & 31; float v = brt;
#pragma unroll
            for (int w = 0; w < 8; ++w) v += part[(w * 16 + r) * 32 + e];
            float bv[4]; int bi[4]; float cur = v;
#define DPP_F(x, ctrl) __builtin_bit_cast(float, __builtin_amdgcn_update_dpp(0, __builtin_bit_cast(int, (x)), (ctrl), 0xf, 0xf, true))
#define DPP_I(x, ctrl) __builtin_amdgcn_update_dpp(0, (x), (ctrl), 0xf, 0xf, true)
#define ARGMAX_STEP(OV, OI) do { const float ov_ = (OV); const int oi_ = (OI); const bool take_ = (ov_ > mv) || (ov_ == mv && oi_ < mi); mv = take_ ? ov_ : mv; mi = take_ ? oi_ : mi; } while (0)
#pragma unroll
            for (int k = 0; k < 4; ++k) { float mv = cur; int mi = e;
                ARGMAX_STEP(DPP_F(mv, 0xB1), DPP_I(mi, 0xB1));
                ARGMAX_STEP(DPP_F(mv, 0x4E), DPP_I(mi, 0x4E));
                ARGMAX_STEP(DPP_F(mv, 0x141), DPP_I(mi, 0x141));
                ARGMAX_STEP(DPP_F(mv, 0x140), DPP_I(mi, 0x140));
                { const auto rv_ = __builtin_amdgcn_permlane16_swap(__float_as_uint(mv), __float_as_uint(mv), false, false); const auto ri_ = __builtin_amdgcn_permlane16_swap((unsigned)mi, (unsigned)mi, false, false);
                    mv = __uint_as_float(rv_[0]); mi = (int)ri_[0]; ARGMAX_STEP(__uint_as_float(rv_[1]), (int)ri_[1]); }
                bv[k] = mv; bi[k] = mi; if (e == mi) cur = -INFINITY; }
#undef DPP_F
#undef DPP_I
#undef ARGMAX_STEP
            if (e < 4) { float ex[4], sum = 0.f;
#pragma unroll
                for (int k = 0; k < 4; ++k) { ex[k] = __expf(bv[k] - bv[0]); sum += ex[k]; }
                const int k = e; const int t = r0 + r; const int ide = k == 0 ? bi[0] : (k == 1 ? bi[1] : (k == 2 ? bi[2] : bi[3])); const float exk = k == 0 ? ex[0] : (k == 1 ? ex[1] : (k == 2 ? ex[2] : ex[3]));
                const unsigned ls = __hip_atomic_fetch_add(lcnt + ide, 1u, __ATOMIC_RELAXED, __HIP_MEMORY_SCOPE_WORKGROUP);
                const int li = nsel + r * 4 + k; lsel[2 * li] = ((unsigned)ide << 24) | ls; lsel[2 * li + 1] = (unsigned)(t * 4 + k); tokw[t * 4 + k] = exk / sum; } }
        nsel += 64;
        __syncthreads();
    }
    if (tid < 32) { const unsigned c = lcnt[tid]; lcnt[32 + tid] = c ? atomicAdd(cnt + tid * 64, c) : 0u; }
    __syncthreads();
    for (int i = tid; i < nsel; i += NTHR) { const unsigned a = lsel[2 * i], tk = lsel[2 * i + 1]; const unsigned e = a >> 24; rowtk[(size_t)e * NT + lcnt[32 + e] + (a & 0xffffffu)] = (int)tk; }
    __syncthreads();
}
DEV void ln2_rows(Frame F, const Params& P, int l) {
    frame_refresh(F);
    const int lane = F.lane; const int gw = F.bid * NWAVES + F.wave, NGW = F.G * NWAVES;
    bf16_t* xb = wsp<bf16_t>(F, WS_XB); const bf16_t* yb = wsp<bf16_t>(F, WS_YBUF); const float* tokw = wsp<float>(F, WS_TOKW);
    const float* g2 = P.in[I_LN2G] + (size_t)l * 1024; const float* b2 = P.in[I_LN2B] + (size_t)l * 1024;
    float* dst = (l == NL - 1) ? P.out : nullptr;
    f32x4 wkn; u32x4 xn[2]; u32x4 yn[2][4];
#define LN2_LOAD(row_) do { wkn = *(const f32x4*)(tokw + (size_t)(row_) * 4); _Pragma("unroll") for (int j = 0; j < 2; ++j) { xn[j] = *(const u32x4*)(xb + (size_t)(row_) * 1024 + j * 512 + lane * 8); \
        _Pragma("unroll") for (int k = 0; k < 4; ++k) yn[j][k] = *(const u32x4*)(yb + ((size_t)(row_) * 4 + k) * 1024 + j * 512 + lane * 8); } } while (0)
    f32x4 gg[2][2], bb[2][2];
#pragma unroll
    for (int j = 0; j < 2; ++j)
#pragma unroll
        for (int h = 0; h < 2; ++h) { gg[j][h] = *(const f32x4*)(g2 + j * 512 + lane * 8 + 4 * h); bb[j][h] = *(const f32x4*)(b2 + j * 512 + lane * 8 + 4 * h); }
    if (gw < NT) LN2_LOAD(gw);
#pragma unroll 1
    for (int row = gw; row < NT; row += NGW) {
        const f32x4 wk = wkn;
        f32x4 v[2][2]; float s = 0.f;
#pragma unroll
        for (int j = 0; j < 2; ++j) { const unsigned* xp = (const unsigned*)&xn[j];
            f32x4 a0 = (f32x4){bflo(xp[0]), bfhi(xp[0]), bflo(xp[1]), bfhi(xp[1])} * DN_ALPHA, a1 = (f32x4){bflo(xp[2]), bfhi(xp[2]), bflo(xp[3]), bfhi(xp[3])} * DN_ALPHA;
#pragma unroll
            for (int k = 0; k < 4; ++k) { const unsigned* yp = (const unsigned*)&yn[j][k]; const float w = wk[k];
                a0[0] += w * bflo(yp[0]); a0[1] += w * bfhi(yp[0]); a0[2] += w * bflo(yp[1]); a0[3] += w * bfhi(yp[1]);
                a1[0] += w * bflo(yp[2]); a1[1] += w * bfhi(yp[2]); a1[2] += w * bflo(yp[3]); a1[3] += w * bfhi(yp[3]); }
            v[j][0] = a0; v[j][1] = a1; s += ((a0[0] + a0[1]) + (a0[2] + a0[3])) + ((a1[0] + a1[1]) + (a1[2] + a1[3])); }
        if (row + NGW < NT) LN2_LOAD(row + NGW);
        const float mean = wave_sum(s) * (1.f / 1024.f); float q = 0.f;
#pragma unroll
        for (int j = 0; j < 2; ++j)
#pragma unroll
            for (int h = 0; h < 2; ++h) { v[j][h] = v[j][h] - mean; q += (v[j][h][0] * v[j][h][0] + v[j][h][1] * v[j][h][1]) + (v[j][h][2] * v[j][h][2] + v[j][h][3] * v[j][h][3]); }
        const float rstd = 1.f / sqrtf(wave_sum(q) * (1.f / 1024.f) + LN_EPS);
#pragma unroll
        for (int j = 0; j < 2; ++j) { const f32x4 o0 = v[j][0] * rstd * gg[j][0] + bb[j][0], o1 = v[j][1] * rstd * gg[j][1] + bb[j][1];
            if (dst) { *(f32x4*)(dst + (size_t)row * 1024 + j * 512 + lane * 8) = o0; *(f32x4*)(dst + (size_t)row * 1024 + j * 512 + lane * 8 + 4) = o1; }
            else { u32x4 w; w.x = pk2(o0[0], o0[1]); w.y = pk2(o0[2], o0[3]); w.z = pk2(o1[0], o1[1]); w.w = pk2(o1[2], o1[3]); *(u32x4*)(xb + (size_t)row * 1024 + j * 512 + lane * 8) = w; } } }
#undef LN2_LOAD
}

constexpr int NPH = 9;
constexpr int N_PHASES = 1 + NL * NPH;
__global__ void __launch_bounds__(NTHR, 2) fwd_kernel(Params P) {
    extern __shared__ __attribute__((aligned(16))) unsigned char lds_raw[];
    Frame F;
    F.lds = (LAS unsigned char*)lds_raw; F.MISC = (volatile LAS unsigned*)(F.lds + MISC_OFF);
    F.tid = threadIdx.x; F.lane = F.tid & 63; F.wave = __builtin_amdgcn_readfirstlane(F.tid >> 6); F.G = gridDim.x; F.bid = blockIdx.x;
    F.ws = P.ws; F.ctl = (unsigned*)(P.ws + WS_CTL);
    for (int u = F.tid; u < 1024; u += NTHR) F.MISC[u] = 0u;
    __syncthreads();
    const int lo = P.ph_lo, hi = P.ph_hi;
    const bool multi = (hi - lo) > 1;
    XcdBarrier bar; bar.bar = F.ctl + CW_BAR; bar.x = 0; bar.st = F.MISC + 8;
    if (multi) bar = xcd_barrier_post(F.ctl + CW_BAR, F.MISC + 8);
#ifndef PHMASK
#define PHMASK 0xFFFF
#endif
#define IN(k) (lo <= (k) && (k) < hi)
#define EN(i) ((PHMASK >> (i)) & 1)
#ifndef DUP_PHASE
#define DUP_PHASE -1
#endif
#define REP(i) for (int rep_ = 0; rep_ < ((DUP_PHASE) == (i) ? 2 : 1); ++rep_)
#define SEAM(k) do { if (IN(k) && IN((k) + 1)) xcd_barrier(bar); } while (0)
#define FILL(k) do { __syncthreads(); if (F.tid == 0) atomicAdd(F.ctl + CW_DONE + (k) * 64, 1u); bg_fill(F, P, F.ctl + CW_DONE + (k) * 64, BG_TOTAL); } while (0)

    if (EN(9) && IN(0)) { REP(9) p0_prologue(F, P); }
    SEAM(0);
#pragma unroll 1
    for (int l = 0; l < NL; ++l) {
        const int pb = 1 + l * NPH;
        if (EN(0) && IN(pb + 0)) REP(0) {
            pg8::Gemm g{wsp<bf16_t>(F, WS_XB), wsp<bf16_t>(F, WS_WIN) + (size_t)l * NP * 1024, 1024, 1024};
            pg8::PlainOrder S; S.init(NT / 256, NP / 256, F.G, F.bid);
            pg8::EpiInProj E{wsp<bf16_t>(F, WS_H), wsp<float>(F, WS_BIN) + (size_t)l * NP, wsp<float>(F, WS_SIDE), wsp<bf16_t>(F, WS_MGT)};
            pg8::gemm_phase<pg8::EpiInProj, pg8::PlainOrder, true>(F.lds, g, S, E);
            FILL(pb + 0);
        }
        SEAM(pb + 0);
        if (EN(1) && IN(pb + 1)) REP(1) {
            unsigned* qctr = F.ctl + CW_QUEUE + l * 64 + 16;
            for (;;) {
                if (F.tid == 0) F.MISC[16] = atomicAdd(qctr, 1u);
                __syncthreads();
                const int L = (int)F.MISC[16];
                __syncthreads();
                if (L >= 528) break;
                if (L < 128) pb_gmlp_unit(F, P, l, L);
                else if (L < 256) pb_compress_unit(F, l, L - 128);
                else if (L < 512) { pb_conv_unit(F, P, l, L - 256); pb_transpose_unit(F, L - 256); }
                else pb_cum_unit(F, L - 512);
            }
        }
        SEAM(pb + 1);
        if (EN(2) && IN(pb + 2)) REP(2) {
            unsigned* qctr = F.ctl + CW_QUEUE + l * 64 + rep_ * 32;
            for (;;) {
                if (F.tid == 0) F.MISC[16] = atomicAdd(qctr, 1u);
                __syncthreads();
                const unsigned L = F.MISC[16];
                __syncthreads();
#ifdef ATT_TWICE
                if (L >= 1536u) break;
                const int Lm = (int)(L % 768u);
#else
                if (L >= 768u) break;
                const int Lm = (int)L;
#endif
                if (Lm < 512) nsa_unit(F, Lm & 3, 63 - (Lm >> 3), (Lm >> 2) & 1);
                else { const int idx = Lm - 512; fox_unit(F, idx & 3, (idx >> 2) & 3, 15 - (idx >> 4)); }
            }
            FILL(pb + 2);
        }
        SEAM(pb + 2);
        if (EN(3) && IN(pb + 3)) REP(3) {
            pg8::Gemm g{wsp<bf16_t>(F, WS_BR), wsp<bf16_t>(F, WS_WBR) + (size_t)l * 4096 * 256, 1024, 256};
            pg8::BrOrder S{F.G, F.bid};
            pg8::EpiBrGate E{wsp<bf16_t>(F, WS_MGT), wsp<bf16_t>(F, WS_GBF)};
            pg8::gemm_phase<pg8::EpiBrGate, pg8::BrOrder, true, true>(F.lds, g, S, E);
        }
        SEAM(pb + 3);
        if (EN(4) && IN(pb + 4)) REP(4) {
            pg8::Gemm g{wsp<bf16_t>(F, WS_GBF), wsp<bf16_t>(F, WS_WO) + (size_t)l * 1024 * 1024, 1024, 1024};
            pg8::PlainOrder S; S.init(NT / 256, 4, F.G, F.bid);
            pg8::EpiBf16Out E{wsp<bf16_t>(F, WS_MIX)};
            pg8::gemm_phase<pg8::EpiBf16Out, pg8::PlainOrder, true>(F.lds, g, S, E);
        }
        SEAM(pb + 4);
        if (EN(5) && IN(pb + 5)) { ln1_router_phase(F, P, l); bg_fill(F, P, nullptr, (long)(l + 1) * BG_PER_LAYER); }
        SEAM(pb + 5);
        if ((EN(6) || EN(7)) && (IN(pb + 6) || IN(pb + 7))) {
            LAS int* tp = (LAS int*)(F.lds + MISC_OFF + 1024);
            if (F.tid == 0) { int run = 0; const unsigned* cnt = F.ctl + CW_CNT + l * 32 * 64;
                for (int e = 0; e < 32; ++e) { const int c = (int)__hip_atomic_load(cnt + e * 64, __ATOMIC_RELAXED, __HIP_MEMORY_SCOPE_AGENT); tp[e] = run; tp[40 + e] = c; run += (c + 255) >> 8; }
                tp[32] = run; }
            __syncthreads();
            LAS unsigned* ul = (LAS unsigned*)(F.lds + MISC_OFF + 1536);
            int ut_ = F.tid; asm volatile("" : "+v"(ut_));
            if (ut_ < 128) { const int m2 = ut_ >> 6, i = ut_ & 63, sh = m2 ? 2 : 3;
                const int x = F.bid & 7, j = F.bid >> 3, W = F.G >> 3;
                const int U = tp[32] << sh, s0 = (x * U) >> 3, s1 = ((x + 1) * U) >> 3, L = s0 + i * W + j;
                unsigned pk = 0xffffffffu;
                if (L < s1) { const int tile = L >> sh, pn = L & ((1 << sh) - 1);
                    int e = (tp[16] <= tile) ? 16 : 0;
                    e += (tp[e + 8] <= tile) ? 8 : 0; e += (tp[e + 4] <= tile) ? 4 : 0; e += (tp[e + 2] <= tile) ? 2 : 0; e += (tp[e + 1] <= tile) ? 1 : 0;
                    const int mt = tile - tp[e], rem = tp[40 + e] - mt * 256, cn = rem < 256 ? rem : 256;
                    pk = (unsigned)pn | ((unsigned)e << 3) | ((unsigned)mt << 8) | ((unsigned)tile << 15) | ((unsigned)(cn - 1) << 24); }
                ul[ut_] = pk; }
            __syncthreads();
            if (EN(6) && IN(pb + 6)) REP(6) {
                pg8::Gemm g{wsp<bf16_t>(F, WS_XB), wsp<bf16_t>(F, WS_W1) + (size_t)l * 32 * 2048 * 1024, 1024, 1024};
                pg8::MoeOrder<1> S{ul, wsp<int>(F, WS_ROWTK)};
                pg8::EpiMoe1 E{wsp<bf16_t>(F, WS_ACT), P.in[I_BE1] + (size_t)l * 32 * 2048};
                pg8::gemm_phase<pg8::EpiMoe1, pg8::MoeOrder<1>, true>(F.lds, g, S, E);
                FILL(pb + 6);
            }
            SEAM(pb + 6);
            if (EN(7) && IN(pb + 7)) REP(7) {
                pg8::Gemm g{wsp<bf16_t>(F, WS_ACT), wsp<bf16_t>(F, WS_W2) + (size_t)l * 32 * 1024 * 1024, 1024, 1024};
                pg8::MoeOrder<2> S{ul + 64, wsp<int>(F, WS_ROWTK)};
                pg8::EpiMoe2 E{wsp<bf16_t>(F, WS_YBUF), P.in[I_BE2] + (size_t)l * 32 * 1024, wsp<int>(F, WS_ROWTK)};
                pg8::gemm_phase<pg8::EpiMoe2, pg8::MoeOrder<2>, true>(F.lds, g, S, E);
                FILL(pb + 7);
            }
        }
        SEAM(pb + 7);
        if (EN(8) && IN(pb + 8)) REP(8) ln2_rows(F, P, l);
        SEAM(pb + 8);
    }
#undef IN
#undef SEAM
}

#ifndef MK_SPLIT
#define MK_SPLIT 0
#endif
extern "C" void kernel_launch(void* const* d_in, const int* in_sizes, int n_in, void* d_out, int out_size, void* d_ws, size_t ws_size, hipStream_t stream) {
    static int grid = 0;
    if (grid == 0) {
        if (n_in != 30 || out_size != NT * 1024 || ws_size < WS_END) { fprintf(stderr, "kernel_launch: unexpected shapes (n_in %d out %d ws %zu need %zu)\n", n_in, out_size, ws_size, (size_t)WS_END); grid = -1; return; }
        int dev = 0, cus = 0, per_cu = 0;
        if (hipGetDevice(&dev) != hipSuccess || hipDeviceGetAttribute(&cus, hipDeviceAttributeMultiprocessorCount, dev) != hipSuccess) { grid = -1; return; }
        if (hipFuncSetAttribute((const void*)fwd_kernel, hipFuncAttributeMaxDynamicSharedMemorySize, LDS_BYTES) != hipSuccess) { fprintf(stderr, "kernel_launch: hipFuncSetAttribute failed\n"); grid = -1; return; }
        if (hipOccupancyMaxActiveBlocksPerMultiprocessor(&per_cu, (const void*)fwd_kernel, NTHR, LDS_BYTES) != hipSuccess || per_cu < 1) fprintf(stderr, "kernel_launch: occupancy query says %d\n", per_cu);
        (void)hipGetLastError();
        grid = cus;
    }
    if (grid < 0) return;
    (void)hipMemsetAsync((char*)d_ws + WS_CTL, 0, CTL_BYTES, stream);
    Params p; memset(&p, 0, sizeof(p));
    for (int i = 0; i < 30; ++i) p.in[i] = (const float*)d_in[i];
    p.out = (float*)d_out; p.ws = (unsigned char*)d_ws;
    for (int i = 0; i < 8; ++i) p.invf[i] = std::pow(500000.0, -(double)i / 8.0);
#if MK_SPLIT
    for (int ph = 0; ph < N_PHASES; ++ph) { p.ph_lo = ph; p.ph_hi = ph + 1; hipLaunchKernelGGL(fwd_kernel, dim3(grid), dim3(NTHR), LDS_BYTES, stream, p); }
#else
    p.ph_lo = 0; p.ph_hi = N_PHASES; hipLaunchKernelGGL(fwd_kernel, dim3(grid), dim3(NTHR), LDS_BYTES, stream, p);
#endif
}
```

```cpp
#include <hip/hip_runtime.h>
#include <cstdio>
#include <cstdint>
#include <cmath>
#include <cstring>

#define DEV __device__ __forceinline__
#define LAS __attribute__((address_space(3)))
#define GAS __attribute__((address_space(1)))

typedef unsigned short bf16_t;
typedef short bf16x8 __attribute__((ext_vector_type(8)));
typedef short bf16x4 __attribute__((ext_vector_type(4)));
typedef float f32x4 __attribute__((ext_vector_type(4)));
typedef float f32x2 __attribute__((ext_vector_type(2)));
typedef unsigned u32x4 __attribute__((ext_vector_type(4)));
typedef unsigned u32x2 __attribute__((ext_vector_type(2)));

constexpr int NB = 4, SEQ = 4096, DM = 1024, NL = 4, NT = NB * SEQ;
constexpr int NIN = 6544, NP = 6656;
constexpr int NE = 32;
constexpr int NWAVES = 8, NTHR = 512;
constexpr float LN_EPS = 1e-5f;
constexpr float DN_ALPHA = 1.6817928305074292f;
constexpr float LOG2E = 1.4426950408889634f;
constexpr int HP_NQ = 0, HP_KC = 256, HP_VC = 320, HP_KS = 384, HP_VS = 448, HP_KW = 512, HP_VW = 576, HP_SP = 640;
constexpr int HP_FQ = 768, HP_FK = 1024, HP_FV = 1280, HP_GU = 1536, HP_GV = 1792, HP_CAB = 2048, HP_MG = 2560;

constexpr size_t al256(size_t x) { return (x + 255) & ~(size_t)255; }
constexpr size_t WS_CTL = 0, CTL_BYTES = 1u << 20;
constexpr size_t WS_WIN = CTL_BYTES;
constexpr size_t WS_BIN = WS_WIN + al256((size_t)NL * NP * 1024 * 2);
constexpr size_t WS_WBR = WS_BIN + al256((size_t)NL * NP * 4);
constexpr size_t WS_WO = WS_WBR + al256((size_t)NL * 4096 * 256 * 2);
constexpr size_t WS_W1 = WS_WO + al256((size_t)NL * 1024 * 1024 * 2);
constexpr size_t WS_W2 = WS_W1 + al256((size_t)NL * 32 * 2048 * 1024 * 2);
constexpr size_t WS_WC1 = WS_W2 + al256((size_t)NL * 32 * 1024 * 1024 * 2);
constexpr size_t WS_WC2 = WS_WC1 + al256((size_t)NL * 2 * 64 * 2048 * 2);
constexpr size_t WS_CB = WS_WC2 + al256((size_t)NL * 2 * 64 * 64 * 2);
constexpr size_t WS_WG = WS_CB + al256((size_t)NL * 2 * 32 * 64 * 4);
constexpr size_t WS_CS = WS_WG + al256((size_t)NL * 4 * 128 * 128 * 2);
constexpr size_t WS_XRES = WS_CS + al256((size_t)NT * 16 * 4);
constexpr size_t WS_XB = WS_XRES + al256((size_t)NT * 1024 * 4);
constexpr size_t WS_H = WS_XB + al256((size_t)NT * 1024 * 2);
constexpr size_t WS_SIDE = WS_H + al256((size_t)NT * NP * 2);
constexpr size_t WS_KNSA = WS_SIDE + al256((size_t)NT * 16 * 4);
constexpr size_t WS_VT = WS_KNSA + al256((size_t)NT * 128 * 2);
constexpr size_t WS_CUM = WS_VT + al256((size_t)NB * 384 * SEQ * 2);
constexpr size_t WS_KCMP = WS_CUM + al256((size_t)NB * 4 * SEQ * 4);
constexpr size_t WS_VCMPT = WS_KCMP + al256((size_t)NB * 256 * 64 * 2);
constexpr size_t WS_BR = WS_VCMPT + al256((size_t)NB * 64 * 256 * 2);
constexpr size_t WS_G32 = WS_BR + al256((size_t)NT * 1024 * 2);
constexpr size_t WS_GBF = WS_G32 + al256((size_t)NT * 1024 * 4);
constexpr size_t WS_MIX = WS_GBF + al256((size_t)NT * 1024 * 2);
constexpr size_t WS_TOKW = WS_MIX + al256((size_t)NT * 1024 * 4);
constexpr size_t WS_ROWTK = WS_TOKW + al256((size_t)NT * 4 * 4);
constexpr int PMAX_TILES = NT * 4 / 256 + NE;
constexpr size_t WS_ACT = WS_ROWTK + al256((size_t)NE * NT * 4);
constexpr size_t WS_YBUF = WS_ACT + al256((size_t)PMAX_TILES * 256 * 1024 * 2);
constexpr size_t WS_MGT = WS_YBUF + al256((size_t)NT * 4 * 1024 * 2);
constexpr size_t WS_KN = WS_MGT + al256((size_t)NT * 4096 * 2);
constexpr size_t WS_END = WS_KN + al256((size_t)NB * 4 * 64 * 4);

constexpr int CW_BAR = 4096;
constexpr int CW_CNT = 32768;
constexpr int CW_QUEUE = 20480;
constexpr int CW_BGQ = 24576;
constexpr int CW_DONE = 28672;

constexpr int RING_BYTES = 131072;
constexpr int MISC_OFF = RING_BYTES;
constexpr int LDS_BYTES = 147456;

DEV float bf2f(bf16_t v) { return __uint_as_float((unsigned)v << 16); }
DEV float bflo(unsigned w) { return __uint_as_float(w << 16); }
DEV float bfhi(unsigned w) { return __uint_as_float(w & 0xffff0000u); }
DEV unsigned pk2(float lo, float hi) { typedef __bf16 b2 __attribute__((ext_vector_type(2))); f32x2 v = {lo, hi}; b2 b = __builtin_convertvector(v, b2); return __builtin_bit_cast(unsigned, b); }
DEV bf16_t f2bf(float f) { return (bf16_t)(pk2(f, 0.f) & 0xffffu); }
DEV float fexp2(float x) { return __builtin_amdgcn_exp2f(x); }
DEV float frcp(float x) { return __builtin_amdgcn_rcpf(x); }
DEV float sigmoidf_(float x) { return frcp(1.f + fexp2(-x * LOG2E)); }
DEV float gelu_tanh(float x) { const float u = 1.5957691216057308f * (x + 0.044715f * x * x * x); return x * frcp(1.f + fexp2(-u * LOG2E)); }
#define WS_DPP(x, ctrl) __builtin_bit_cast(float, __builtin_amdgcn_update_dpp(0, __builtin_bit_cast(int, (x)), (ctrl), 0xf, 0xf, true))
DEV float wave_sum(float v) {
    v += WS_DPP(v, 0xB1); v += WS_DPP(v, 0x4E); v += WS_DPP(v, 0x141); v += WS_DPP(v, 0x140);
    const int vi = __builtin_bit_cast(int, v);
    const float r0 = __builtin_bit_cast(float, __builtin_amdgcn_readlane(vi, 0)), r1 = __builtin_bit_cast(float, __builtin_amdgcn_readlane(vi, 16));
    const float r2 = __builtin_bit_cast(float, __builtin_amdgcn_readlane(vi, 32)), r3 = __builtin_bit_cast(float, __builtin_amdgcn_readlane(vi, 48));
    return (r0 + r1) + (r2 + r3);
}
typedef unsigned u32x2_t __attribute__((ext_vector_type(2)));
DEV float xr_max(float v) {
    { const unsigned u = __float_as_uint(v); const auto r = __builtin_amdgcn_permlane16_swap(u, u, false, false); v = fmaxf(__uint_as_float(r[0]), __uint_as_float(r[1])); }
    { const unsigned u = __float_as_uint(v); const auto r = __builtin_amdgcn_permlane32_swap(u, u, false, false); v = fmaxf(__uint_as_float(r[0]), __uint_as_float(r[1])); }
    return v;
}
DEV float xr_sum(float v) {
    { const unsigned u = __float_as_uint(v); const auto r = __builtin_amdgcn_permlane16_swap(u, u, false, false); v = __uint_as_float(r[0]) + __uint_as_float(r[1]); }
    { const unsigned u = __float_as_uint(v); const auto r = __builtin_amdgcn_permlane32_swap(u, u, false, false); v = __uint_as_float(r[0]) + __uint_as_float(r[1]); }
    return v;
}
DEV unsigned xr_or(unsigned u) {
    { const auto r = __builtin_amdgcn_permlane16_swap(u, u, false, false); u = r[0] | r[1]; }
    { const auto r = __builtin_amdgcn_permlane32_swap(u, u, false, false); u = r[0] | r[1]; }
    return u;
}
DEV f32x4 mfma16(bf16x8 a, bf16x8 b, f32x4 c) { return __builtin_amdgcn_mfma_f32_16x16x32_bf16(a, b, c, 0, 0, 0); }
#define LDS_WAIT() asm volatile("s_waitcnt lgkmcnt(0)" ::: "memory")
#define VM_WAIT() asm volatile("s_waitcnt vmcnt(0)" ::: "memory")

__host__ __device__ __forceinline__ int perm16(int dp) { return dp < 16 ? ((dp & 1) ? 8 + (dp >> 1) : (dp >> 1)) : dp; }
__host__ __device__ __forceinline__ int hp_src_col(int c) {
    if (c < 256) return (c & ~63) + perm16(c & 63);
    if (c < 320) return 256 + perm16(c - 256);
    if (c < 384) return c;
    if (c < 448) return 384 + perm16(c - 384);
    if (c < 512) return c;
    if (c < 576) return 512 + perm16(c - 512);
    if (c < 640) return c;
    if (c < 652) return c;
    if (c < 656) return 1420 + (c - 652);
    if (c < 768) return -1;
    if (c < 1024) return 652 + (c - 768);
    if (c < 1280) return 908 + (c - 1024);
    if (c < 1536) return 1164 + (c - 1280);
    if (c < 1792) return 1424 + (c - 1536);
    if (c < 2048) return 1680 + (c - 1792);
    if (c < 2560) { const int i = c - 2048; return (i & 1) ? 2192 + (i >> 1) : 1936 + (i >> 1); }
    return 2448 + (c - 2560);
}

namespace pg8 {
constexpr int BM = 256, BK = 64, HALF = 128, HTB = HALF * BK * 2, STAGE_BYTES = 8 * HTB, NXCD = 8, WGM = 8;
__host__ __device__ __forceinline__ int lds_byte(int r, int c) { const int st = (r >> 4) * 2 + (c >> 5), rr = r & 15, cc = c & 31, ob = rr * 64 + cc * 2; return st * 1024 + (ob ^ (((ob >> 9) & 1) << 5)); }
__host__ __device__ __forceinline__ void stage_rc(int b, int& R, int& C) { const int st = b / 1024, sb = b % 1024, swz = sb ^ (((sb >> 9) & 1) << 5); R = (st >> 1) * 16 + swz / 64; C = (st & 1) * 32 + (swz % 64) / 2; }
__host__ __device__ __forceinline__ int perm32(int rho) { const int n = rho >> 4, i = rho & 15; return 8 * (i >> 2) + 4 * n + (i & 3); }

struct Unit { int pm, pn, e, mt, cnt; };
constexpr int KROT = 1;
struct Gemm { const bf16_t* A; const bf16_t* Bt; int lda; int K; };

template <class Epi, class Sched, bool ALIGN_EPI, bool HALFN = false>
DEV void gemm_phase(LAS unsigned char* lds, const Gemm g, const Sched& S, const Epi& E) {
    int tid_ = threadIdx.x; asm volatile("" : "+v"(tid_));
    const int tid = tid_, wid = __builtin_amdgcn_readfirstlane(tid >> 6), lane = tid & 63, wr = wid >> 2, wc = wid & 3, fr = lane & 15, fq = lane >> 4;
    const int K = g.K, nt = K / BK;
#define PG8_KOF(t_, r_) ((size_t)((t_) + (r_) - (((t_) + (r_)) >= nt ? nt : 0)) * kstep)
    unsigned voffA[2], voffB[2];
#pragma unroll
    for (int i = 0; i < 2; ++i) { int R, C; stage_rc(tid * 16 + i * 8192, R, C); int Rb = Epi::PERM ? ((R & ~31) + perm32(R & 31)) : R;
        if constexpr (Epi::PAIR16) Rb = 16 * (Rb >> 3) + (Rb & 7);
        voffA[i] = (unsigned)(R * g.lda + C) * 2u; voffB[i] = (unsigned)(Rb * K + C) * 2u; }
    const unsigned hstepA = (unsigned)HALF * (unsigned)g.lda * 2u;
    const size_t kstep = (size_t)(BK * 2);
    const size_t hstepB = (size_t)(Epi::PAIR16 ? 8 : HALF) * K * 2;
    unsigned voffG[2];
#pragma unroll
    for (int i = 0; i < 2; ++i) { const unsigned off = (unsigned)tid * 16u + (unsigned)i * 8192u; voffG[i] = (off >> 8) * 512u + (off & 255u); }
    constexpr size_t GPIECE = 64 * 512;
    const unsigned ldsw = (unsigned)wid * 1024u;
    const int aoff = lds_byte(wr * 64 + fr, fq * 8), boff = lds_byte(wc * 32 + fr, fq * 8);
    const char* const Abase = (const char*)g.A;
#define PG8_SA(b, h) (((b) * 2 + (h)) * HTB)
#define PG8_SB(b, h) ((4 + (b) * 2 + (h)) * HTB)
#define PG8_STAGE_B(bufoff, gbase, voff) do { _Pragma("unroll") for (int _i = 0; _i < 2; ++_i) \
        __builtin_amdgcn_global_load_lds((const unsigned*)((const char*)(gbase) + (voff)[_i]), (LAS unsigned*)(lds + (bufoff) + ldsw + _i * 8192), 16, 0, 0); } while (0)
#define PG8_STAGE_B1(bufoff, gbase, gatep) do { if constexpr (HALFN) PG8_STAGE_B(bufoff, gatep, voffG); else PG8_STAGE_B(bufoff, (gbase) + hstepB, voffB); } while (0)
#define PG8_STAGE_A(bufoff, koff, offs) do { _Pragma("unroll") for (int _i = 0; _i < 2; ++_i) { \
        if constexpr (Sched::GATHER) __builtin_amdgcn_global_load_lds((const unsigned*)(Abase + (size_t)(koff) + (offs)[_i]), (LAS unsigned*)(lds + (bufoff) + ldsw + _i * 8192), 16, 0, 0); \
        else __builtin_amdgcn_global_load_lds((const unsigned*)(Abase + ((size_t)(koff) + (size_t)__builtin_amdgcn_readfirstlane((offs)[_i])) + voffA[_i]), (LAS unsigned*)(lds + (bufoff) + ldsw + _i * 8192), 16, 0, 0); } } while (0)
#define PG8_LDA(dst, b, h) do { _Pragma("unroll") for (int m = 0; m < 4; ++m) _Pragma("unroll") for (int k = 0; k < 2; ++k) dst[m][k] = *(const LAS bf16x8*)(lds + PG8_SA(b, h) + aoff + m * 2048 + k * 1024); } while (0)
#define PG8_LDB(dst, b, h) do { _Pragma("unroll") for (int n = 0; n < 2; ++n) _Pragma("unroll") for (int k = 0; k < 2; ++k) dst[n][k] = *(const LAS bf16x8*)(lds + PG8_SB(b, h) + boff + n * 2048 + k * 1024); } while (0)
#define PG8_MMA(ai, bj, At, Bt) do { __builtin_amdgcn_s_setprio(1); _Pragma("unroll") for (int m = 0; m < 4; ++m) _Pragma("unroll") for (int n = 0; n < 2; ++n) _Pragma("unroll") for (int k = 0; k < 2; ++k) \
        acc[ai][bj][m][n] = __builtin_amdgcn_mfma_f32_16x16x32_bf16(Bt[n][k], At[m][k], acc[ai][bj][m][n], 0, 0, 0); __builtin_amdgcn_s_setprio(0); } while (0)
#define PG8_WAIT_V(n) asm volatile("s_waitcnt vmcnt(" #n ")" ::: "memory")
#define PG8_WAIT_L(n) asm volatile("s_waitcnt lgkmcnt(" #n ")" ::: "memory")
#define PG8_BAR __builtin_amdgcn_s_barrier()
#define PG8_SCHED __builtin_amdgcn_sched_barrier(0)
#define PG8_MKOFF(dst, u) do { if constexpr (Sched::GATHER) { const unsigned _ao = S.aoff(u); _Pragma("unroll") for (int _h = 0; _h < 2; ++_h) _Pragma("unroll") for (int _i = 0; _i < 2; ++_i) { \
        int _R, _C; stage_rc(tid * 16 + _i * 8192, _R, _C); dst[_h][_i] = _ao + (S.arow(u, _h * HALF + _R) * (unsigned)g.lda + (unsigned)_C) * 2u; } } \
    else { const unsigned _ub = S.aoff(u) + S.arow(u, 0) * (unsigned)g.lda * 2u; _Pragma("unroll") for (int _h = 0; _h < 2; ++_h) _Pragma("unroll") for (int _i = 0; _i < 2; ++_i) dst[_h][_i] = _ub + (unsigned)_h * hstepA; } } while (0)
    Unit cur, nxt; int ui = 0;
    if (!S.next(0, cur)) return;
    f32x4 acc[2][2][4][2];
#pragma unroll
    for (int a = 0; a < 2; ++a)
#pragma unroll
        for (int b = 0; b < 2; ++b)
#pragma unroll
            for (int m = 0; m < 4; ++m)
#pragma unroll
                for (int n = 0; n < 2; ++n) acc[a][b][m][n] = (f32x4){0.f, 0.f, 0.f, 0.f};
    bf16x8 At[4][2], B0[2][2], B1[2][2];
    unsigned oc[2][2], on[2][2];
    PG8_MKOFF(oc, cur);
    const char* cB = (const char*)g.Bt + S.boff(cur);
    const char* cG = E.gate_base(cur);
    int rc = 0; if constexpr (Sched::ROT) rc = S.rot(cur);
    { const size_t k0 = PG8_KOF(0, rc);
    PG8_STAGE_B(PG8_SB(0, 0), cB + k0, voffB); PG8_STAGE_B1(PG8_SB(0, 1), cB + k0, cG); PG8_STAGE_A(PG8_SA(0, 0), k0, oc[0]); PG8_STAGE_A(PG8_SA(0, 1), k0, oc[1]); }
    if (wr == 1) PG8_BAR;
    PG8_WAIT_V(2); PG8_BAR;
    { const size_t k1 = PG8_KOF(1, rc);
    PG8_STAGE_B(PG8_SB(1, 0), cB + k1, voffB); PG8_STAGE_A(PG8_SA(1, 0), k1, oc[0]); PG8_STAGE_B1(PG8_SB(1, 1), cB + k1, cG + GPIECE); }
    PG8_WAIT_V(6); PG8_BAR;
    typename Epi::Pre pre;
    for (;;) {
        const bool has_next = S.next(ui + 1, nxt);
        const char* nB = cB; const char* nG = cG;
        int rn = 0; if constexpr (Sched::ROT) { if (has_next) rn = S.rot(nxt); }
        LAS int* const idxb = (LAS int*)(lds + STAGE_BYTES + 2048) + ((ui + 1) & 1) * 256;
        if (has_next) { nB = (const char*)g.Bt + S.boff(nxt); nG = E.gate_base(nxt);
            if constexpr (Sched::GATHER) { if (wid < 4) __builtin_amdgcn_global_load_lds((const unsigned*)(S.idx_ptr(nxt) + tid), (LAS unsigned*)(idxb + wid * 64), 4, 0, 0); }
            else PG8_MKOFF(on, nxt); }
        else {
#pragma unroll
            for (int h = 0; h < 2; ++h)
#pragma unroll
                for (int i = 0; i < 2; ++i) on[h][i] = oc[h][i];
        }
#pragma unroll 1
        for (int t = 0; t < nt; t += 2) {
            const bool last = (t == nt - 2);
            const size_t k1 = PG8_KOF(t + 1, rc);
            const size_t k2 = last ? PG8_KOF(0, rn) : PG8_KOF(t + 2, rc), k3 = last ? PG8_KOF(1, rn) : PG8_KOF(t + 3, rc);
            if constexpr (Sched::GATHER) { if (last && has_next) {
                const unsigned ao_ = S.aoff(nxt);
#pragma unroll
                for (int h = 0; h < 2; ++h)
#pragma unroll
                    for (int i = 0; i < 2; ++i) { int R_, C_; stage_rc(tid * 16 + i * 8192, R_, C_); const int r_ = h * HALF + R_; const int ix_ = idxb[r_];
                        on[h][i] = ao_ + (S.arow_from(nxt, r_, ix_) * (unsigned)g.lda + (unsigned)C_) * 2u; } } }
            unsigned o2[2][2]; const unsigned lastm = last ? 0xffffffffu : 0u;
#pragma unroll
            for (int h = 0; h < 2; ++h)
#pragma unroll
                for (int i = 0; i < 2; ++i) o2[h][i] = oc[h][i] ^ ((oc[h][i] ^ on[h][i]) & lastm);
            const char* b2 = (last ? nB : cB) + k2; const char* b3 = (last ? nB : cB) + k3;
            const char* g2 = last ? nG : cG + (size_t)(t + 2) * GPIECE; const char* g3 = g2 + GPIECE;
            PG8_LDB(B0, 0, 0); if constexpr (!HALFN) PG8_LDB(B1, 0, 1); else { if (wr == 0) E.gate_read(pre, lds + PG8_SB(0, 1), t >> 1, wc, fr, fq); } PG8_SCHED; PG8_LDA(At, 0, 0); PG8_STAGE_A(PG8_SA(1, 1), k1, oc[1]);
            PG8_WAIT_V(8); PG8_WAIT_L(0); PG8_BAR; PG8_MMA(0, 0, At, B0); if constexpr (!HALFN) PG8_MMA(0, 1, At, B1); PG8_BAR; PG8_SCHED;
            PG8_LDA(At, 0, 1); PG8_STAGE_B(PG8_SB(0, 0), b2, voffB); PG8_STAGE_B1(PG8_SB(0, 1), b2, g2); PG8_STAGE_A(PG8_SA(0, 0), k2, o2[0]);
            PG8_WAIT_V(8); PG8_WAIT_L(0); PG8_BAR; PG8_MMA(1, 0, At, B0); if constexpr (!HALFN) PG8_MMA(1, 1, At, B1); PG8_BAR; PG8_SCHED;
            PG8_LDB(B0, 1, 0); if constexpr (!HALFN) PG8_LDB(B1, 1, 1); else { if (wr == 1) E.gate_read(pre, lds + PG8_SB(1, 1), t >> 1, wc, fr, fq); } PG8_SCHED; PG8_LDA(At, 1, 0); PG8_STAGE_A(PG8_SA(0, 1), k2, o2[1]);
            PG8_WAIT_V(8); PG8_WAIT_L(0); PG8_BAR; PG8_MMA(0, 0, At, B0); if constexpr (!HALFN) PG8_MMA(0, 1, At, B1); PG8_BAR; PG8_SCHED;
            PG8_LDA(At, 1, 1); PG8_STAGE_B(PG8_SB(1, 0), b3, voffB); PG8_STAGE_B1(PG8_SB(1, 1), b3, g3); PG8_STAGE_A(PG8_SA(1, 0), k3, o2[0]);
            PG8_WAIT_V(8); PG8_WAIT_L(0); PG8_BAR; PG8_MMA(1, 0, At, B0); if constexpr (!HALFN) PG8_MMA(1, 1, At, B1); PG8_BAR; PG8_SCHED;
        }
        if constexpr (ALIGN_EPI) { if (wr == 0) PG8_BAR; }
        if constexpr (HALFN) E.fold(acc, pre, cur, wr, wc, fr, fq); else E(acc, cur, wr, wc, fr, fq);
        if (!has_next) break;
#pragma unroll
        for (int a = 0; a < 2; ++a)
#pragma unroll
            for (int b = 0; b < 2; ++b)
#pragma unroll
                for (int m = 0; m < 4; ++m)
#pragma unroll
                    for (int n = 0; n < 2; ++n) { if (!HALFN || b == 0) acc[a][b][m][n] = (f32x4){0.f, 0.f, 0.f, 0.f}; }
        cur = nxt; cB = nB; cG = nG; ++ui; rc = rn;
#pragma unroll
        for (int h = 0; h < 2; ++h)
#pragma unroll
            for (int i = 0; i < 2; ++i) oc[h][i] = on[h][i];
        if constexpr (ALIGN_EPI) { if (wr == 1) PG8_BAR; }
    }
    PG8_WAIT_V(0);
    if constexpr (!ALIGN_EPI) { if (wr == 0) PG8_BAR; }
    PG8_BAR;
#undef PG8_SA
#undef PG8_SB
#undef PG8_STAGE_A
#undef PG8_STAGE_B1
#undef PG8_STAGE_B
#undef PG8_LDA
#undef PG8_LDB
#undef PG8_MMA
#undef PG8_WAIT_V
#undef PG8_WAIT_L
#undef PG8_BAR
#undef PG8_SCHED
#undef PG8_MKOFF
#undef PG8_KOF
}

struct StaticOrder {
    int nM, nN, nwg, G, c;
    DEV void init(int nM_, int nN_, int G_, int c_) { nM = nM_; nN = nN_; nwg = nM * nN; G = G_; c = c_; }
    DEV bool next(int i, Unit& u) const {
        const long L = (long)i * G + c; if (L >= nwg) return false;
        int wgid = (int)L; { const int q = nwg / NXCD, r = nwg % NXCD, xcd = wgid % NXCD, off = wgid / NXCD; wgid = (xcd < r ? xcd * (q + 1) : r * (q + 1) + (xcd - r) * q) + off; }
        const int nig = WGM * nN, gid = wgid / nig, fm = gid * WGM, gsz = (nM - fm) < WGM ? (nM - fm) : WGM;
        u.pm = fm + ((wgid % nig) % gsz); u.pn = (wgid % nig) / gsz; u.e = 0; u.mt = 0; u.cnt = 256; return true;
    }
};
}

#define XB_TMO      128
#define XB_XCNT(j)  (256  + 64 * (j))
#define XB_XSUB(j)  (1280 + 64 * (j))
#define XB_XGEN(j)  (2304 + 64 * (j))
#define XB_TOP      3328
#define XB_TOPGEN   3392
#define XCD_BAR_WORDS 3456
#define XB_SPIN_CAP (1u << 20)
DEV unsigned xb_ld(unsigned* p)              { return __hip_atomic_load(p, __ATOMIC_RELAXED, __HIP_MEMORY_SCOPE_AGENT); }
DEV unsigned xb_add(unsigned* p, unsigned v) { return __hip_atomic_fetch_add(p, v, __ATOMIC_RELAXED, __HIP_MEMORY_SCOPE_AGENT); }
DEV unsigned xb_xcc_id() { return (unsigned)__builtin_amdgcn_s_getreg((3 << 11) | 20) & 0xFu; }
#define XB_SPIN(cond, bar) do { unsigned _sp = 0; while (cond) { __builtin_amdgcn_s_sleep(1); \
    if ((++_sp & 255u) == 0u) { if (xb_ld(&(bar)[XB_TMO])) break; if (_sp > XB_SPIN_CAP) { atomicAdd(&(bar)[XB_TMO], 1u); break; } } } } while (0)
struct XcdBarrier { unsigned* bar; unsigned x; volatile LAS unsigned* st; };
DEV XcdBarrier xcd_barrier_post(unsigned* bar, volatile LAS unsigned* st) {
    XcdBarrier b; b.bar = bar; b.x = xb_xcc_id(); b.st = st;
    if (threadIdx.x == 0) (void)xb_add(&bar[XB_XCNT(b.x)], 1u);
    return b;
}
DEV void xcd_barrier_complete(unsigned* bar, unsigned x, unsigned& nloc, unsigned& nx) {
    const unsigned G = gridDim.x * gridDim.y * gridDim.z;
    unsigned sum, cnt, mine, sp = 0u;
    for (;;) {
        sum = 0u; cnt = 0u; mine = 0u;
#pragma unroll
        for (unsigned j = 0; j < 16; ++j) { const unsigned c = xb_ld(&bar[XB_XCNT(j)]); sum += c; cnt += (c > 0u) ? 1u : 0u; mine = (j == x) ? c : mine; }
        if (sum == G) break;
        __builtin_amdgcn_s_sleep(1);
        if ((++sp & 255u) == 0u) { if (xb_ld(&bar[XB_TMO])) break; if (sp > XB_SPIN_CAP) { atomicAdd(&bar[XB_TMO], 1u); break; } }
    }
    nloc = mine > 0u ? mine : 1u; nx = cnt > 0u ? cnt : 1u;
}
DEV void xcd_barrier(const XcdBarrier& b) {
    asm volatile("s_waitcnt vmcnt(0)" ::: "memory");
    __syncthreads();
    if (threadIdx.x == 0) {
        unsigned* bar = b.bar;
        __builtin_amdgcn_s_waitcnt(0);
        unsigned nloc = b.st[0], nx = b.st[1];
        if (nloc == 0u) { xcd_barrier_complete(bar, b.x, nloc, nx); b.st[0] = nloc; b.st[1] = nx; }
        const unsigned old = xb_add(&bar[XB_XSUB(b.x)], 1u);
        const unsigned gen = old / nloc;
        if (old + 1u == (gen + 1u) * nloc) {
            __builtin_amdgcn_fence(__ATOMIC_RELEASE, "agent");
            asm volatile("s_waitcnt vmcnt(0)" ::: "memory");
            const unsigned og = xb_add(&bar[XB_TOP], 1u);
            const unsigned tg = og / nx;
            if (og + 1u == (tg + 1u) * nx) xb_add(&bar[XB_TOPGEN], 1u);
            else XB_SPIN(xb_ld(&bar[XB_TOPGEN]) == tg, bar);
            __builtin_amdgcn_fence(__ATOMIC_ACQUIRE, "agent");
            xb_add(&bar[XB_XGEN(b.x)], 1u);
            asm volatile("s_waitcnt vmcnt(0)" ::: "memory");
        } else {
            XB_SPIN(xb_ld(&bar[XB_XGEN(b.x)]) == gen, bar);
            __builtin_amdgcn_fence(__ATOMIC_ACQUIRE, "agent");
            asm volatile("s_waitcnt vmcnt(0)" ::: "memory");
        }
    }
    __syncthreads();
}

struct Params {
    const float* in[30];
    float* out;
    unsigned char* ws;
    int ph_lo, ph_hi;
    double invf[8];
};
enum { I_X = 0, I_POS, I_WIN, I_BIN, I_PEK, I_PEV, I_W1K, I_W2K, I_W1V, I_W2V, I_GLNG, I_GLNB, I_GWS, I_GBS, I_CW, I_CB, I_CLNG, I_CLNB,
       I_WBR, I_WO, I_LN1G, I_LN1B, I_WR, I_BR, I_WE1, I_BE1, I_WE2, I_BE2, I_LN2G, I_LN2B };

namespace pg8 {
struct EpiInProj {
    struct Pre {};
    static constexpr bool PAIR16 = false;
    DEV const char* gate_base(const Unit&) const { return nullptr; }
    static constexpr bool PERM = true;
    bf16_t* H; const float* bias; float* side; bf16_t* MGT;
    DEV void operator()(const f32x4 (&acc)[2][2][4][2], const Unit& u, int wr, int wc, int fr, int fq) const {
        const int row0 = u.pm * BM + wr * 64 + fr, col0 = u.pn * BM + wc * 32 + 8 * fq;
        f32x4 bv[2][2];
#pragma unroll
        for (int bj = 0; bj < 2; ++bj)
#pragma unroll
            for (int n = 0; n < 2; ++n) bv[bj][n] = *(const f32x4*)(bias + col0 + bj * HALF + 4 * n);
        if (u.pn >= 10) {
            bf16_t* tile = MGT + ((size_t)u.pm * 16 + (u.pn - 10)) * 65536 + (wr * 64 + fr) * 256 + wc * 32 + 8 * fq;
#pragma unroll
            for (int ai = 0; ai < 2; ++ai)
#pragma unroll
                for (int m = 0; m < 4; ++m)
#pragma unroll
                    for (int bj = 0; bj < 2; ++bj) { const f32x4 v0 = acc[ai][bj][m][0] + bv[bj][0], v1 = acc[ai][bj][m][1] + bv[bj][1];
                        u32x4 w; w.x = pk2(sigmoidf_(v0[0]), sigmoidf_(v0[1])); w.y = pk2(sigmoidf_(v0[2]), sigmoidf_(v0[3])); w.z = pk2(sigmoidf_(v1[0]), sigmoidf_(v1[1])); w.w = pk2(sigmoidf_(v1[2]), sigmoidf_(v1[3]));
                        *(u32x4*)(tile + (ai * HALF + m * 16) * 256 + bj * HALF) = w; }
            return; }
        const bool special = (u.pn == 2) && (wc == 0) && (fq < 2);
#pragma unroll
        for (int ai = 0; ai < 2; ++ai)
#pragma unroll
            for (int m = 0; m < 4; ++m) { const int row = row0 + ai * HALF + m * 16; bf16_t* rowp = H + (size_t)row * NP + col0;
#pragma unroll
                for (int bj = 0; bj < 2; ++bj) { const f32x4 v0 = acc[ai][bj][m][0] + bv[bj][0], v1 = acc[ai][bj][m][1] + bv[bj][1];
                    u32x4 w; w.x = pk2(v0[0], v0[1]); w.y = pk2(v0[2], v0[3]); w.z = pk2(v1[0], v1[1]); w.w = pk2(v1[2], v1[3]);
                    *(u32x4*)(rowp + bj * HALF) = w;
                    if (bj == 1 && special) { float* sp = side + (size_t)row * 16 + 8 * fq; *(f32x4*)sp = v0; *(f32x4*)(sp + 4) = v1; } } }
    }
};
struct EpiBrGate {
    static constexpr bool PERM = true;
    struct Pre { u32x4 g[2][4]; };
    static constexpr bool PAIR16 = false;
    const bf16_t* MGT; bf16_t* GBF;
    DEV const char* gate_base(const Unit& u) const { return (const char*)(MGT + ((size_t)u.pm * 16 + u.e * 4 + (u.pn >> 1)) * 65536 + (u.pn & 1) * 128); }
    DEV void gate_read(Pre& p, const LAS unsigned char* slot, int idx, int wc, int fr, int fq) const {
        const LAS unsigned char* q = slot + fr * 256 + (wc * 32 + 8 * fq) * 2;
        if (idx == 0) {
#pragma unroll
            for (int m = 0; m < 4; ++m) p.g[0][m] = *(const LAS u32x4*)(q + m * 16 * 256); }
        else {
#pragma unroll
            for (int m = 0; m < 4; ++m) p.g[1][m] = *(const LAS u32x4*)(q + m * 16 * 256); }
    }
    DEV void fold(f32x4 (&acc)[2][2][4][2], const Pre& p, const Unit& u, int wr, int wc, int fr, int fq) const {
        const int n = u.e;
#pragma unroll
        for (int ai = 0; ai < 2; ++ai)
#pragma unroll
            for (int m = 0; m < 4; ++m) { const u32x4 g = p.g[ai][m]; const f32x4 a0 = acc[ai][0][m][0], a1 = acc[ai][0][m][1];
                f32x4 t0, t1;
                t0[0] = a0[0] * bflo(g.x); t0[1] = a0[1] * bfhi(g.x); t0[2] = a0[2] * bflo(g.y); t0[3] = a0[3] * bfhi(g.y);
                t1[0] = a1[0] * bflo(g.z); t1[1] = a1[1] * bfhi(g.z); t1[2] = a1[2] * bflo(g.w); t1[3] = a1[3] * bfhi(g.w);
                if (n == 0) { acc[ai][1][m][0] = t0; acc[ai][1][m][1] = t1; } else { acc[ai][1][m][0] += t0; acc[ai][1][m][1] += t1; } }
        if (n == 3) { const int row0 = u.pm * BM + wr * 64 + fr, col0 = u.pn * HALF + wc * 32 + 8 * fq;
#pragma unroll
            for (int ai = 0; ai < 2; ++ai)
#pragma unroll
                for (int m = 0; m < 4; ++m) { const f32x4 v0 = acc[ai][1][m][0], v1 = acc[ai][1][m][1];
                    u32x4 w; w.x = pk2(v0[0], v0[1]); w.y = pk2(v0[2], v0[3]); w.z = pk2(v1[0], v1[1]); w.w = pk2(v1[2], v1[3]);
                    *(u32x4*)(GBF + (size_t)(row0 + ai * HALF + m * 16) * 1024 + col0) = w; } }
    }
};
struct BrOrder {
    static constexpr bool GATHER = false;
    static constexpr bool ROT = false;
    int G, c;
    DEV bool next(int i, Unit& u) const { const int x = c & 7, q = (c >> 3) + (i >> 2) * (G >> 3); if (q >= 64 || (G & 7)) { if (!(G & 7)) return false; const int tile = c + (i >> 2) * G; if (tile >= 512) return false; u.pm = tile >> 3; u.pn = tile & 7; }
        else { u.pm = x + 8 * (q >> 3); u.pn = q & 7; }
        u.e = i & 3; u.mt = 0; u.cnt = 256; return true; }
    DEV size_t boff(const Unit& u) const { return (size_t)(u.e * 1024 + u.pn * 128) * 256 * 2; }
    DEV unsigned aoff(const Unit& u) const { return (unsigned)(u.e * 256 * 2); }
    DEV unsigned arow(const Unit& u, int r) const { return (unsigned)(u.pm * BM + r); }
};
struct PlainOrder : StaticOrder {
    static constexpr bool GATHER = false;
    static constexpr bool ROT = true;
    DEV int rot(const Unit& u) const { return ((2 * u.pm + u.pn) & 7) * KROT; }
    DEV size_t boff(const Unit& u) const { return (size_t)u.pn * 256 * 1024 * 2; }
    DEV unsigned aoff(const Unit&) const { return 0u; }
    DEV unsigned arow(const Unit& u, int r) const { return (unsigned)(u.pm * BM + r); }
};
struct EpiBf16Out {
    struct Pre {};
    static constexpr bool PAIR16 = false;
    DEV const char* gate_base(const Unit&) const { return nullptr; }
    static constexpr bool PERM = true;
    bf16_t* C;
    DEV void operator()(const f32x4 (&acc)[2][2][4][2], const Unit& u, int wr, int wc, int fr, int fq) const {
        const int row0 = u.pm * BM + wr * 64 + fr, col0 = u.pn * BM + wc * 32 + 8 * fq;
#pragma unroll
        for (int ai = 0; ai < 2; ++ai)
#pragma unroll
            for (int m = 0; m < 4; ++m) { bf16_t* rowp = C + (size_t)(row0 + ai * HALF + m * 16) * 1024 + col0;
#pragma unroll
                for (int bj = 0; bj < 2; ++bj) { const f32x4 v0 = acc[ai][bj][m][0], v1 = acc[ai][bj][m][1];
                    u32x4 w; w.x = pk2(v0[0], v0[1]); w.y = pk2(v0[2], v0[3]); w.z = pk2(v1[0], v1[1]); w.w = pk2(v1[2], v1[3]); *(u32x4*)(rowp + bj * HALF) = w; } }
    }
};
template <int MODE> struct MoeOrder {
    static constexpr bool GATHER = (MODE == 1);
    static constexpr bool ROT = true;
    DEV int rot(const Unit& u) const { return u.pn * KROT; }
    const LAS unsigned* ul;
    const int* rowtk;
    DEV bool next(int i, Unit& u) const {
        const unsigned p = (unsigned)__builtin_amdgcn_readfirstlane((int)ul[i]); if (p == 0xffffffffu) return false;
        u.pn = (int)(p & 7u); u.e = (int)((p >> 3) & 31u); u.mt = (int)((p >> 8) & 127u); u.pm = (int)((p >> 15) & 511u); u.cnt = (int)(p >> 24) + 1; return true;
    }
    DEV size_t boff(const Unit& u) const { return MODE == 1 ? ((size_t)u.e * 2048 + u.pn * 256) * 1024 * 2 : ((size_t)u.e * 1024 + u.pn * 256) * 1024 * 2; }
    DEV unsigned aoff(const Unit&) const { return 0u; }
    DEV unsigned arow(const Unit& u, int r) const {
        if (MODE == 2) return (unsigned)(u.pm * 256 + r);
        return r < u.cnt ? (unsigned)(rowtk[(size_t)u.e * NT + u.mt * 256 + r] >> 2) : 0u;
    }
    DEV const int* idx_ptr(const Unit& u) const { return rowtk + (size_t)u.e * NT + u.mt * 256; }
    DEV unsigned arow_from(const Unit& u, int r, int ix) const { return r < u.cnt ? (unsigned)(ix >> 2) : 0u; }
};
struct EpiMoe1 {
    struct Pre {};
    DEV const char* gate_base(const Unit&) const { return nullptr; }
    static constexpr bool PERM = true, PAIR16 = true;
    bf16_t* ACT; const float* b1;
    DEV void operator()(const f32x4 (&acc)[2][2][4][2], const Unit& u, int wr, int wc, int fr, int fq) const {
        const int row0 = u.pm * BM + wr * 64 + fr, q = 4 * wc + fq, hcol0 = u.pn * BM + 16 * q;
        const float* bp = b1 + (size_t)u.e * 2048 + hcol0;
        f32x4 bv[2][2];
#pragma unroll
        for (int bj = 0; bj < 2; ++bj)
#pragma unroll
            for (int n = 0; n < 2; ++n) bv[bj][n] = *(const f32x4*)(bp + 8 * bj + 4 * n);
#pragma unroll
        for (int ai = 0; ai < 2; ++ai)
#pragma unroll
            for (int m = 0; m < 4; ++m) { bf16_t* rowp = ACT + (size_t)(row0 + ai * HALF + m * 16) * 1024 + (hcol0 >> 1);
                float o[8];
#pragma unroll
                for (int bj = 0; bj < 2; ++bj) { const f32x4 v0 = acc[ai][bj][m][0] + bv[bj][0], v1 = acc[ai][bj][m][1] + bv[bj][1];
#pragma unroll
                    for (int j = 0; j < 4; ++j) { const float hg = j < 2 ? v0[2 * j] : v1[2 * j - 4], hl = j < 2 ? v0[2 * j + 1] : v1[2 * j - 3];
                        const float glu = fminf(hg, 7.f), lin = fminf(fmaxf(hl, -7.f), 7.f); o[4 * bj + j] = glu * sigmoidf_(1.702f * glu) * (lin + 1.f); } }
                u32x4 w; w.x = pk2(o[0], o[1]); w.y = pk2(o[2], o[3]); w.z = pk2(o[4], o[5]); w.w = pk2(o[6], o[7]); *(u32x4*)rowp = w; }
    }
};
struct EpiMoe2 {
    struct Pre {};
    static constexpr bool PAIR16 = false;
    DEV const char* gate_base(const Unit&) const { return nullptr; }
    static constexpr bool PERM = true;
    bf16_t* Y; const float* b2; const int* rowtk;
    DEV void operator()(const f32x4 (&acc)[2][2][4][2], const Unit& u, int wr, int wc, int fr, int fq) const {
        const int col0 = u.pn * BM + wc * 32 + 8 * fq;
        const float* bp = b2 + (size_t)u.e * 1024 + col0;
        f32x4 bv[2][2];
#pragma unroll
        for (int bj = 0; bj < 2; ++bj)
#pragma unroll
            for (int n = 0; n < 2; ++n) bv[bj][n] = *(const f32x4*)(bp + bj * HALF + 4 * n);
        const int* rt = rowtk + (size_t)u.e * NT + u.mt * 256 + wr * 64 + fr;
        int dst[2][4];
#pragma unroll
        for (int ai = 0; ai < 2; ++ai)
#pragma unroll
            for (int m = 0; m < 4; ++m) dst[ai][m] = rt[ai * HALF + m * 16];
        asm volatile("" :: "v"(bv[0][0]), "v"(bv[0][1]), "v"(bv[1][0]), "v"(bv[1][1]), "v"(dst[0][0]), "v"(dst[0][1]), "v"(dst[0][2]), "v"(dst[0][3]), "v"(dst[1][0]), "v"(dst[1][1]), "v"(dst[1][2]), "v"(dst[1][3]));
#pragma unroll
        for (int ai = 0; ai < 2; ++ai)
#pragma unroll
            for (int m = 0; m < 4; ++m) { const int r = ai * HALF + wr * 64 + m * 16 + fr;
                if (r < u.cnt) { bf16_t* rowp = Y + (size_t)dst[ai][m] * 1024 + col0;
#pragma unroll
                    for (int bj = 0; bj < 2; ++bj) { const f32x4 v0 = acc[ai][bj][m][0] + bv[bj][0], v1 = acc[ai][bj][m][1] + bv[bj][1];
                        u32x4 w; w.x = pk2(v0[0], v0[1]); w.y = pk2(v0[2], v0[3]); w.z = pk2(v1[0], v1[1]); w.w = pk2(v1[2], v1[3]); *(u32x4*)(rowp + bj * HALF) = w; } } }
    }
};
}

struct Frame {
    LAS unsigned char* lds;
    volatile LAS unsigned* MISC;
    unsigned* ctl;
    unsigned char* ws;
    int tid, lane, wave, G, bid;
};
template <class T> DEV T* wsp(const Frame& F, size_t off) { return (T*)(F.ws + off); }
DEV void frame_refresh(Frame& F) {
    int t_ = threadIdx.x; asm volatile("" : "+v"(t_)); F.tid = t_; F.lane = t_ & 63; F.wave = __builtin_amdgcn_readfirstlane(t_ >> 6);
    unsigned long long w_ = (unsigned long long)F.ws; asm volatile("" : "+s"(w_)); F.ws = (unsigned char*)(GAS unsigned char*)w_; F.ctl = (unsigned*)F.ws;
}

struct IdMap { DEV int operator()(int i) const { return i; } };
struct HpColMap { DEV int operator()(int c) const { return hp_src_col(c); } };
struct CmpRowMap { DEV int operator()(int k) const { return (k & ~63) + perm16(k & 63); } };
template <class RM, class CM>
DEV void transpose_item(const float* W, int ldw, bf16_t* WT, int ldt, int k0, int n0, LAS float* scr, int lane, RM rm, CM cm) {
    const int nn = lane & 31; const int sc = cm(n0 + nn);
#pragma unroll 8
    for (int i = 0; i < 32; ++i) { const int kk = 2 * i + (lane >> 5); scr[kk * 33 + nn] = sc >= 0 ? W[(size_t)rm(k0 + kk) * ldw + sc] : 0.f; }
    LDS_WAIT(); asm volatile("" ::: "memory");
    const int c = lane & 7;
#pragma unroll
    for (int j = 0; j < 4; ++j) { const int n = (lane >> 3) + 8 * j; const LAS float* s = scr + (8 * c) * 33 + n;
        u32x4 o; o.x = pk2(s[0 * 33], s[1 * 33]); o.y = pk2(s[2 * 33], s[3 * 33]); o.z = pk2(s[4 * 33], s[5 * 33]); o.w = pk2(s[6 * 33], s[7 * 33]);
        *(u32x4*)(WT + (size_t)(n0 + n) * ldt + k0 + 8 * c) = o; }
    LDS_WAIT(); asm volatile("" ::: "memory");
}
struct TItem { const float* W; bf16_t* WT; int ldw, ldt, k0, n0, rmap; };
DEV void titem_load(const TItem& it, f32x4 (&v)[16], int lane) {
    const int nq = lane & 15, kr = lane >> 4;
    if (it.rmap == 2) { const int n = it.n0 + 4 * nq; const int c0 = hp_src_col(n), c1 = hp_src_col(n + 1), c2 = hp_src_col(n + 2), c3 = hp_src_col(n + 3);
        const bool quad = (c0 >= 0) && (c1 == c0 + 1) && (c2 == c0 + 2) && (c3 == c0 + 3);
#pragma unroll
        for (int i = 0; i < 16; ++i) { const float* rp = it.W + (size_t)(it.k0 + 4 * i + kr) * it.ldw;
            if (quad) v[i] = __builtin_nontemporal_load((const f32x4*)(rp + c0));
            else v[i] = (f32x4){c0 >= 0 ? rp[c0] : 0.f, c1 >= 0 ? rp[c1] : 0.f, c2 >= 0 ? rp[c2] : 0.f, c3 >= 0 ? rp[c3] : 0.f}; }
        return; }
#pragma unroll
    for (int i = 0; i < 16; ++i) { int k = it.k0 + 4 * i + kr; if (it.rmap) k = (k & ~63) + perm16(k & 63); v[i] = __builtin_nontemporal_load((const f32x4*)(it.W + (size_t)k * it.ldw + it.n0 + 4 * nq)); }
}
DEV void titem_store(const TItem& it, const f32x4 (&v)[16], LAS bf16_t* scr, int lane) {
    const int nq = lane & 15, kr = lane >> 4; constexpr int SP = 66;
#pragma unroll
    for (int i = 0; i < 16; ++i) { LAS unsigned* d = (LAS unsigned*)(scr + (4 * i + kr) * SP + 4 * nq); d[0] = pk2(v[i][0], v[i][1]); d[1] = pk2(v[i][2], v[i][3]); }
    LDS_WAIT(); asm volatile("" ::: "memory");
    const int c = lane & 7;
#pragma unroll
    for (int j = 0; j < 8; ++j) { const int n = (lane >> 3) + 8 * j; const LAS bf16_t* sp = scr + (8 * c) * SP + n;
        u32x4 o; o.x = sp[0] | ((unsigned)sp[SP] << 16); o.y = sp[2 * SP] | ((unsigned)sp[3 * SP] << 16); o.z = sp[4 * SP] | ((unsigned)sp[5 * SP] << 16); o.w = sp[6 * SP] | ((unsigned)sp[7 * SP] << 16);
        __builtin_nontemporal_store(o, (u32x4*)(it.WT + (size_t)(it.n0 + n) * it.ldt + it.k0 + 8 * c)); }
    LDS_WAIT(); asm volatile("" ::: "memory");
}
constexpr long BG_PER_LAYER = 32L * 512 + 32L * 256, BG_TOTAL = NL * BG_PER_LAYER;
DEV void bg_item(const Frame& F, const Params& P, long idx, LAS bf16_t* scr, int lane) {
    const int l = (int)(idx / BG_PER_LAYER); long r = idx - (long)l * BG_PER_LAYER; TItem it;
    if (r < 32L * 512) { const int mat = l * 32 + (int)(r >> 9), q = (int)(r & 511); it = TItem{P.in[I_WE1] + (size_t)mat * 1024 * 2048, wsp<bf16_t>(F, WS_W1) + (size_t)mat * 2048 * 1024, 2048, 1024, (q >> 5) * 64, (q & 31) * 64, 0}; }
    else { r -= 32L * 512; const int mat = l * 32 + (int)(r >> 8), q = (int)(r & 255); it = TItem{P.in[I_WE2] + (size_t)mat * 1024 * 1024, wsp<bf16_t>(F, WS_W2) + (size_t)mat * 1024 * 1024, 1024, 1024, (q >> 4) * 64, (q & 15) * 64, 0}; }
    f32x4 v[16]; titem_load(it, v, lane); titem_store(it, v, scr, lane);
}
constexpr int BG_CHUNK = 8, BG_FILL_STRIDE = 4;
DEV void bg_fill(Frame F, const Params& P, unsigned* done, long limit) {
    frame_refresh(F);
    unsigned* head = F.ctl + CW_BGQ; LAS bf16_t* scr = (LAS bf16_t*)(F.lds + F.wave * 16384); const int lane = F.lane;
    if (done && (F.wave % BG_FILL_STRIDE) != 0) return;
#pragma unroll 1
    for (;;) {
        if (done) { if ((unsigned)__builtin_amdgcn_readfirstlane(__hip_atomic_load(done, __ATOMIC_RELAXED, __HIP_MEMORY_SCOPE_AGENT)) >= (unsigned)F.G) break; }
        else { if ((long)(unsigned)__builtin_amdgcn_readfirstlane(__hip_atomic_load(head, __ATOMIC_RELAXED, __HIP_MEMORY_SCOPE_AGENT)) >= limit) break; }
        unsigned base = 0u; if (lane == 0) base = atomicAdd(head, (unsigned)BG_CHUNK);
        base = (unsigned)__builtin_amdgcn_readfirstlane(base);
        if ((long)base >= BG_TOTAL) break;
#pragma unroll 1
        for (int i = 0; i < BG_CHUNK; ++i) if ((long)base + i < BG_TOTAL) bg_item(F, P, (long)base + i, scr, lane);
    }
}
DEV void p0_prologue(Frame F, const Params& P) {
    frame_refresh(F);
    LAS float* scr = (LAS float*)(F.lds + F.wave * 16384);
    const int gw = F.bid * NWAVES + F.wave, NGW = F.G * NWAVES, lane = F.lane;
    LAS bf16_t* scrh = (LAS bf16_t*)scr;
    constexpr long I_E1 = 0, I_E2 = 0, I_BRI = (long)NL * 4 * 64, I_OI = (long)NL * 256, I_C1 = (long)NL * 2 * 32;
    constexpr long I_IN64 = (long)NL * 16 * 104;
    constexpr long N64 = I_E1 + I_E2 + I_BRI + I_OI + I_C1 + I_IN64;
#define P0_DECODE(it, r_) do { long r = (r_); \
        if (r < I_E1) { const int mat = (int)(r >> 9), q = (int)(r & 511); it = TItem{P.in[I_WE1] + (size_t)mat * 1024 * 2048, wsp<bf16_t>(F, WS_W1) + (size_t)mat * 2048 * 1024, 2048, 1024, (q >> 5) * 64, (q & 31) * 64, 0}; break; } \
        r -= I_E1; \
        if (r < I_E2) { const int mat = (int)(r >> 8), q = (int)(r & 255); it = TItem{P.in[I_WE2] + (size_t)mat * 1024 * 1024, wsp<bf16_t>(F, WS_W2) + (size_t)mat * 1024 * 1024, 1024, 1024, (q >> 4) * 64, (q & 15) * 64, 0}; break; } \
        r -= I_E2; \
        if (r < I_BRI) { const int mat = (int)(r >> 6), q = (int)(r & 63); it = TItem{P.in[I_WBR] + (size_t)mat * 256 * 1024, wsp<bf16_t>(F, WS_WBR) + (size_t)mat * 1024 * 256, 1024, 256, (q >> 4) * 64, (q & 15) * 64, 0}; break; } \
        r -= I_BRI; \
        if (r < I_OI) { const int l_ = (int)(r >> 8), q = (int)(r & 255); it = TItem{P.in[I_WO] + (size_t)l_ * 1024 * 1024, wsp<bf16_t>(F, WS_WO) + (size_t)l_ * 1024 * 1024, 1024, 1024, (q >> 4) * 64, (q & 15) * 64, 0}; break; } \
        r -= I_OI; \
        if (r < I_C1) { const int mat = (int)(r >> 5), l_ = mat >> 1, kv = mat & 1; it = TItem{P.in[kv ? I_W1V : I_W1K] + (size_t)l_ * 2048 * 64, wsp<bf16_t>(F, WS_WC1) + (size_t)mat * 64 * 2048, 64, 2048, (int)(r & 31) * 64, 0, kv == 0 ? 1 : 0}; break; } \
        r -= I_C1; \
        { const int l_ = (int)(r / (16 * 104)), q = (int)(r % (16 * 104)); it = TItem{P.in[I_WIN] + (size_t)l_ * 1024 * NIN, wsp<bf16_t>(F, WS_WIN) + (size_t)l_ * NP * 1024, NIN, 1024, (q / 104) * 64, (q % 104) * 64, 2}; } } while (0)
    { f32x4 va[16], vb[16]; TItem ia, ib; long it = gw;
        if (it < N64) { P0_DECODE(ia, it); titem_load(ia, va, lane); }
#pragma unroll 1
        for (; it < N64; it += 2 * (long)NGW) {
            const long i2 = it + NGW, i3 = it + 2 * (long)NGW;
            if (i2 < N64) { P0_DECODE(ib, i2); titem_load(ib, vb, lane); }
            titem_store(ia, va, scrh, lane);
            if (i3 < N64) { P0_DECODE(ia, i3); titem_load(ia, va, lane); }
            if (i2 < N64) titem_store(ib, vb, scrh, lane);
        } }
#undef P0_DECODE
    constexpr long I_C2 = (long)NL * 2 * 2;
    for (long it = gw; it < I_C2; it += NGW) { const long r = it;
        { const int mat = (int)(r >> 1), l = mat >> 1, kv = mat & 1, nb = (int)(r & 1);
            transpose_item(P.in[kv ? I_W2V : I_W2K] + (size_t)l * 64 * 64, 64, wsp<bf16_t>(F, WS_WC2) + (size_t)mat * 64 * 64, 64, 0, nb * 32, scr, lane, IdMap(), IdMap()); }
    }
    const int gt = F.bid * NTHR + F.tid, NGT = F.G * NTHR;
    {
        const float* ws_ = P.in[I_GWS]; bf16_t* wg = wsp<bf16_t>(F, WS_WG);
        for (int i = gt; i < NL * 4 * 128 * 128; i += NGT) { const int s = i & 127, t = (i >> 7) & 127; wg[i] = (s <= t) ? f2bf(ws_[i]) : (bf16_t)0; }
    }
    {
        float* bp = wsp<float>(F, WS_BIN);
        for (int i = gt; i < NL * NP; i += NGT) { const int l = i / NP, c = i % NP, sc = hp_src_col(c); bp[i] = sc >= 0 ? P.in[I_BIN][(size_t)l * NIN + sc] : 0.f; }
    }
    {
        float* cs = wsp<float>(F, WS_CS); const int* pos = (const int*)P.in[I_POS];
        for (int i = gt; i < NT * 8; i += NGT) { const int t = i >> 3, f = i & 7;
            const double ang = (double)pos[t] * P.invf[f];
            const double twopi = 6.283185307179586476925286766559; double r = ang - twopi * rint(ang / twopi);
            const double r2 = r * r; double sn = 0.0, cn = 0.0, term = r;
#pragma unroll 1
            for (int k = 1; k <= 29; k += 2) { sn += term; term *= -r2 / (double)((k + 1) * (k + 2)); }
            term = 1.0;
#pragma unroll 1
            for (int k = 0; k <= 28; k += 2) { cn += term; term *= -r2 / (double)((k + 1) * (k + 2)); }
            cs[(size_t)t * 16 + f] = (float)cn; cs[(size_t)t * 16 + 8 + f] = (float)sn; }
    }
    {
        const f32x4* x4 = (const f32x4*)P.in[I_X]; u32x2* xb = wsp<u32x2>(F, WS_XB);
        for (int i = gt; i < NT * 256; i += NGT) { const f32x4 v = x4[i]; u32x2 w; w.x = pk2(v[0], v[1]); w.y = pk2(v[2], v[3]); xb[i] = w; }
    }
    for (int task = gw; task < NL * 2 * 32; task += NGW) { const int lk = task >> 5, part = task & 31, l = lk >> 1, kv = lk & 1;
        const float* pe = P.in[kv ? I_PEV : I_PEK] + (size_t)l * 2048 + part * 64; const float* w1 = P.in[kv ? I_W1V : I_W1K] + ((size_t)l * 2048 + part * 64) * 64;
        float a = 0.f;
#pragma unroll 16
        for (int k = 0; k < 64; ++k) a += pe[k] * w1[(size_t)k * 64 + lane];
        wsp<float>(F, WS_CB)[task * 64 + lane] = a; }
}

DEV void pb_transpose_unit(Frame F, int unit) {
    frame_refresh(F);
    const int b = unit >> 6, t0 = (unit & 63) * 64; const int tid = F.tid;
    const bf16_t* H = wsp<bf16_t>(F, WS_H); const float* cs = wsp<float>(F, WS_CS);
    const size_t rowb = (size_t)b * SEQ + t0;
    LAS bf16_t* tile = (LAS bf16_t*)F.lds; constexpr int TP = 392;
    LAS unsigned* nmx = (LAS unsigned*)(F.lds + 65536);
    u32x4 rw[2]; f32x4 rc[2], rs[2]; u32x4 vw[6], kw[4];
#pragma unroll
    for (int it = 0; it < 2; ++it) { const int task = tid + it * NTHR, tok = task >> 4, hd = (task >> 3) & 1, ch = task & 7; const size_t row = rowb + tok;
        rw[it] = *(const u32x4*)(H + row * NP + (hd ? HP_KW : HP_KS) + ch * 8);
        const float* c = cs + row * 16 + 4 * (ch & 1); rc[it] = *(const f32x4*)c; rs[it] = *(const f32x4*)(c + 8); }
#pragma unroll
    for (int it = 0; it < 6; ++it) { const int task = tid + it * NTHR, tok = task / 48, ch = task % 48;
        const int scol = ch < 8 ? HP_VS + ch * 8 : (ch < 16 ? HP_VW + (ch - 8) * 8 : HP_FV + (ch - 16) * 8);
        vw[it] = *(const u32x4*)(H + (rowb + tok) * NP + scol); }
    { const int tok = tid >> 3, part = tid & 7;
#pragma unroll
        for (int q = 0; q < 4; ++q) kw[q] = *(const u32x4*)(H + (rowb + tok) * NP + HP_FK + part * 32 + q * 8); }
    if (tid < 4) nmx[tid] = 0u;
#pragma unroll
    for (int it = 0; it < 2; ++it) { const int task = tid + it * NTHR, tok = task >> 4, hd = (task >> 3) & 1, ch = task & 7; const size_t row = rowb + tok;
        u32x4 w = rw[it]; unsigned* wp = (unsigned*)&w;
#pragma unroll
        for (int j = 0; j < 4; ++j) { const float t1 = bflo(wp[j]), t2 = bfhi(wp[j]); const unsigned rot = pk2(t1 * rc[it][j] - t2 * rs[it][j], t2 * rc[it][j] + t1 * rs[it][j]); wp[j] = (ch < 2) ? rot : wp[j]; }
        *(u32x4*)(wsp<bf16_t>(F, WS_KNSA) + row * 128 + hd * 64 + ch * 8) = w; }
#pragma unroll
    for (int it = 0; it < 6; ++it) { const int task = tid + it * NTHR, tok = task / 48, ch = task % 48; const u32x4 w = vw[it];
        *(LAS u32x2*)(tile + tok * TP + ch * 8) = (u32x2){w.x, w.y}; *(LAS u32x2*)(tile + tok * TP + ch * 8 + 4) = (u32x2){w.z, w.w}; }
    __syncthreads();
    { const int part = tid & 7; float ss = 0.f;
#pragma unroll
        for (int q = 0; q < 4; ++q) { const unsigned* wp = (const unsigned*)&kw[q];
#pragma unroll
            for (int j = 0; j < 4; ++j) { const float a = bflo(wp[j]), c = bfhi(wp[j]); ss += a * a + c * c; } }
        ss += __shfl_xor(ss, 1);
        if ((part & 1) == 0) (void)__hip_atomic_fetch_max(nmx + (part >> 1), __float_as_uint(ss), __ATOMIC_RELAXED, __HIP_MEMORY_SCOPE_WORKGROUP); }
    bf16_t* VT = wsp<bf16_t>(F, WS_VT);
#pragma unroll
    for (int it = 0; it < 6; ++it) { const int task = tid + it * NTHR, d = task % 384, sc = task / 384;
        unsigned short v[8];
#pragma unroll
        for (int j = 0; j < 8; ++j) v[j] = tile[(sc * 8 + j) * TP + d];
        u32x4 w; w.x = v[0] | ((unsigned)v[1] << 16); w.y = v[2] | ((unsigned)v[3] << 16); w.z = v[4] | ((unsigned)v[5] << 16); w.w = v[6] | ((unsigned)v[7] << 16);
        *(u32x4*)(VT + ((size_t)b * 384 + d) * SEQ + t0 + sc * 8) = w; }
    __syncthreads();
    if (tid < 4) wsp<float>(F, WS_KN)[((size_t)b * 4 + tid) * 64 + (t0 >> 6)] = sqrtf(__uint_as_float(nmx[tid])) * 1.0001f;
    __syncthreads();
}
DEV void pb_cum_unit(Frame F, int unit) {
    frame_refresh(F);
    const int b = unit >> 2, h = unit & 3, tid = F.tid;
    const float* side = wsp<float>(F, WS_SIDE);
    LAS double* sc = (LAS double*)F.lds;
    double loc[8]; double s = 0.0;
#pragma unroll
    for (int j = 0; j < 8; ++j) { const float x = side[((size_t)b * SEQ + tid * 8 + j) * 16 + 12 + h];
        const float ls = fminf(x, 0.f) - __logf(1.f + __expf(-fabsf(x)));
        s += (double)ls; loc[j] = s; }
    double inc = s;
#pragma unroll
    for (int o = 1; o < 64; o <<= 1) { const double t = __shfl_up(inc, o); if (F.lane >= o) inc += t; }
    if (F.lane == 63) sc[F.wave] = inc;
    __syncthreads();
    double wbase = 0.0;
#pragma unroll
    for (int w = 0; w < 8; ++w) wbase += (w < F.wave) ? sc[w] : 0.0;
    __syncthreads();
    sc[8 + tid] = wbase + inc - s;
    const double base = sc[8 + tid]; float* cum = wsp<float>(F, WS_CUM) + ((size_t)b * 4 + h) * SEQ + tid * 8;
#pragma unroll
    for (int j = 0; j < 8; ++j) cum[j] = (float)((base + loc[j]) * 1.4426950408889634);
    __syncthreads();
}
DEV void pb_conv_unit(Frame F, const Params& P, int l, int unit) {
    frame_refresh(F);
    const int b = unit >> 6, t0 = (unit & 63) * 64, tid = F.tid, lane = F.lane, wave = F.wave;
    const bf16_t* H = wsp<bf16_t>(F, WS_H);
    float w[31]; { const float* cw = P.in[I_CW] + (size_t)l * 31 * 256 + (tid & 255);
#pragma unroll
        for (int j = 0; j < 31; ++j) w[j] = cw[j * 256]; }
    const float bias = P.in[I_CB][l * 256 + (tid & 255)];
    LAS bf16_t* xg = (LAS bf16_t*)F.lds;
    LAS float* cv = (LAS float*)(F.lds + 49152);
    { u32x4 wv[12];
#pragma unroll
        for (int it = 0; it < 12; ++it) { const int task = tid + it * NTHR, r = task >> 6, c4 = (task & 63) * 4; const int t = t0 - 30 + r;
            wv[it] = (task < 94 * 64 && t >= 0) ? *(const u32x4*)(H + ((size_t)b * SEQ + t) * NP + HP_CAB + 2 * c4) : (u32x4){0u, 0u, 0u, 0u}; }
#pragma unroll
        for (int it = 0; it < 12; ++it) { const int task = tid + it * NTHR, r = task >> 6, c4 = (task & 63) * 4;
            if (task < 94 * 64) { const unsigned* wp = (const unsigned*)&wv[it]; float g[4];
#pragma unroll
                for (int j = 0; j < 4; ++j) g[j] = bflo(wp[j]) * sigmoidf_(bfhi(wp[j]));
                *(LAS u32x2*)(xg + r * 256 + c4) = (u32x2){pk2(g[0], g[1]), pk2(g[2], g[3])}; } } }
    __syncthreads();
    { const int c = tid & 255, half = tid >> 8;
        float xw[62];
#pragma unroll
        for (int j = 0; j < 62; ++j) xw[j] = bf2f(xg[(half * 32 + j) * 256 + c]);
#pragma unroll
        for (int tt = 0; tt < 32; ++tt) { float a = bias;
#pragma unroll
            for (int j = 0; j < 31; ++j) a += w[j] * xw[tt + j];
            cv[(half * 32 + tt) * 256 + c] = a; } }
    __syncthreads();
    { const f32x4 gg = *(const f32x4*)(P.in[I_CLNG] + l * 256 + lane * 4), bb = *(const f32x4*)(P.in[I_CLNB] + l * 256 + lane * 4);
        bf16_t* BR = wsp<bf16_t>(F, WS_BR);
#pragma unroll 1
        for (int i = 0; i < 8; ++i) { const int tt = wave * 8 + i; f32x4 v = *(const LAS f32x4*)(cv + tt * 256 + lane * 4);
            const float mean = wave_sum((v[0] + v[1]) + (v[2] + v[3])) * (1.f / 256.f); v = v - mean;
            const float var = wave_sum((v[0] * v[0] + v[1] * v[1]) + (v[2] * v[2] + v[3] * v[3])) * (1.f / 256.f);
            const float rstd = 1.f / sqrtf(var + LN_EPS); v = v * rstd * gg + bb;
#pragma unroll
            for (int j = 0; j < 4; ++j) v[j] = v[j] * sigmoidf_(v[j]);
            u32x2 o; o.x = pk2(v[0], v[1]); o.y = pk2(v[2], v[3]);
            *(u32x2*)(BR + ((size_t)b * SEQ + t0 + tt) * 1024 + 768 + lane * 4) = o; } }
    __syncthreads();
}
DEV void pb_gmlp_unit(Frame F, const Params& P, int l, int unit) {
    frame_refresh(F);
    const int t0 = unit * 128, tid = F.tid, lane = F.lane, wave = F.wave, fr = lane & 15, fq = lane >> 4;
    const bf16_t* H = wsp<bf16_t>(F, WS_H);
    LAS bf16_t* vt = (LAS bf16_t*)F.lds; constexpr int VP = 136;
    { const f32x4 gg = *(const f32x4*)(P.in[I_GLNG] + l * 256 + lane * 4), bb = *(const f32x4*)(P.in[I_GLNB] + l * 256 + lane * 4);
        u32x2 wv[16];
#pragma unroll
        for (int i = 0; i < 16; ++i) wv[i] = *(const u32x2*)(H + (size_t)(t0 + wave * 16 + i) * NP + HP_GV + lane * 4);
#pragma unroll
        for (int i = 0; i < 16; ++i) { const int s = wave * 16 + i; const u32x2 w = wv[i];
            f32x4 v = {gelu_tanh(bflo(w.x)), gelu_tanh(bfhi(w.x)), gelu_tanh(bflo(w.y)), gelu_tanh(bfhi(w.y))};
            const float mean = wave_sum((v[0] + v[1]) + (v[2] + v[3])) * (1.f / 256.f); v = v - mean;
            const float var = wave_sum((v[0] * v[0] + v[1] * v[1]) + (v[2] * v[2] + v[3] * v[3])) * (1.f / 256.f);
            const float rstd = 1.f / sqrtf(var + LN_EPS); v = v * rstd * gg + bb;
#pragma unroll
            for (int j = 0; j < 4; ++j) vt[(lane * 4 + j) * VP + s] = f2bf(v[j]); } }
    __syncthreads();
    { const int g = wave & 3, th = wave >> 2;
        const bf16_t* Wg = wsp<bf16_t>(F, WS_WG) + ((size_t)l * 4 + g) * 128 * 128;
        bf16_t* BR = wsp<bf16_t>(F, WS_BR);
        bf16x8 wf[4][4]; u32x2 uw[4][4]; float bs[4];
#pragma unroll
        for (int tb = 0; tb < 4; ++tb) { const int trow = th * 64 + tb * 16;
#pragma unroll
            for (int ks = 0; ks < 4; ++ks) wf[tb][ks] = (ks * 32 <= trow + 15) ? *(const bf16x8*)(Wg + (size_t)(trow + fr) * 128 + ks * 32 + fq * 8) : (bf16x8){0, 0, 0, 0, 0, 0, 0, 0};
#pragma unroll
            for (int db = 0; db < 4; ++db) uw[tb][db] = *(const u32x2*)(H + (size_t)(t0 + trow + fr) * NP + HP_GU + g * 64 + db * 16 + fq * 4);
            bs[tb] = P.in[I_GBS][((size_t)l * 4 + g) * 128 + trow + fr]; }
#pragma unroll
        for (int tb = 0; tb < 4; ++tb) { const int trow = th * 64 + tb * 16;
            f32x4 acc[4];
#pragma unroll
            for (int db = 0; db < 4; ++db) acc[db] = (f32x4){0.f, 0.f, 0.f, 0.f};
#pragma unroll
            for (int ks = 0; ks < 4; ++ks) if (ks * 32 <= trow + 15) {
#pragma unroll
                for (int db = 0; db < 4; ++db) { const bf16x8 vf = *(const LAS bf16x8*)(vt + (g * 64 + db * 16 + fr) * VP + ks * 32 + fq * 8);
                    acc[db] = mfma16(vf, wf[tb][ks], acc[db]); } }
            const int t = t0 + trow + fr;
#pragma unroll
            for (int db = 0; db < 4; ++db) { const int c = g * 64 + db * 16 + fq * 4; const u32x2 u2 = uw[tb][db]; const float b_ = bs[tb];
                const float o0 = gelu_tanh(bflo(u2.x)) * (acc[db][0] + b_), o1 = gelu_tanh(bfhi(u2.x)) * (acc[db][1] + b_), o2 = gelu_tanh(bflo(u2.y)) * (acc[db][2] + b_), o3 = gelu_tanh(bfhi(u2.y)) * (acc[db][3] + b_);
                u32x2 o; o.x = pk2(o0, o1); o.y = pk2(o2, o3); *(u32x2*)(BR + (size_t)t * 1024 + 512 + c) = o; } } }
    __syncthreads();
}
DEV void pb_compress_unit(Frame F, int l, int unit) {
    frame_refresh(F);
    const int kv = unit & 1, mb = (unit >> 1) & 15, b = unit >> 5; const int tid = F.tid, lane = F.lane, wave = F.wave, fr = lane & 15, fq = lane >> 4;
    const bf16_t* H = wsp<bf16_t>(F, WS_H); const float* cs = wsp<float>(F, WS_CS);
    const bf16_t* W1 = wsp<bf16_t>(F, WS_WC1) + ((size_t)l * 2 + kv) * 64 * 2048; const bf16_t* W2 = wsp<bf16_t>(F, WS_WC2) + ((size_t)l * 2 + kv) * 64 * 64;
    const f32x4 cbv = *(const f32x4*)(wsp<float>(F, WS_CB) + ((size_t)l * 2 + kv) * 32 * 64 + tid * 4);
    LAS float* red = (LAS float*)F.lds;
    LAS bf16_t* h1 = (LAS bf16_t*)(F.lds + 32768);
    f32x4 acc[4];
#pragma unroll
    for (int nb = 0; nb < 4; ++nb) acc[nb] = (f32x4){0.f, 0.f, 0.f, 0.f};
    const int c = mb * 16 + fr;
    { u32x4 aw[8]; f32x4 cco[4], csi[4];
#pragma unroll
        for (int ks_ = 0; ks_ < 8; ++ks_) { const int ks = wave * 8 + ks_; const int j = ks >> 1, dch = (ks & 1) * 32 + fq * 8; int tok = c * 16 + j; tok = tok > SEQ - 1 ? SEQ - 1 : tok;
            const size_t row = (size_t)b * SEQ + tok;
            aw[ks_] = *(const u32x4*)(H + row * NP + (kv ? HP_VC : HP_KC) + dch);
            if ((ks_ & 1) == 0) { const float* cc = cs + row * 16 + ((fq & 1) * 4); cco[ks_ >> 1] = *(const f32x4*)cc; csi[ks_ >> 1] = *(const f32x4*)(cc + 8); } }
#pragma unroll
        for (int hb = 0; hb < 2; ++hb) { bf16x8 bw[4][4];
#pragma unroll
            for (int k4 = 0; k4 < 4; ++k4)
#pragma unroll
                for (int nb = 0; nb < 4; ++nb) bw[k4][nb] = *(const bf16x8*)(W1 + (size_t)(nb * 16 + fr) * 2048 + (wave * 8 + hb * 4 + k4) * 32 + fq * 8);
#pragma unroll
            for (int k4 = 0; k4 < 4; ++k4) { const int ks_ = hb * 4 + k4; u32x4 w = aw[ks_];
                if ((ks_ & 1) == 0) { const bool rp = (kv == 0) && (fq < 2); unsigned* wp = (unsigned*)&w; const f32x4 co = cco[ks_ >> 1], si = csi[ks_ >> 1];
#pragma unroll
                    for (int q = 0; q < 4; ++q) { const float t1 = bflo(wp[q]), t2 = bfhi(wp[q]); const unsigned rot = pk2(t1 * co[q] - t2 * si[q], t2 * co[q] + t1 * si[q]); wp[q] = rp ? rot : wp[q]; } }
                const bf16x8 af = __builtin_bit_cast(bf16x8, w);
#pragma unroll
                for (int nb = 0; nb < 4; ++nb) acc[nb] = mfma16(af, bw[k4][nb], acc[nb]); } } }
#pragma unroll
    for (int nb = 0; nb < 4; ++nb)
#pragma unroll
        for (int i = 0; i < 4; ++i) red[(wave * 16 + fq * 4 + i) * 64 + nb * 16 + fr] = acc[nb][i];
    __syncthreads();
    { LAS float* cbl = (LAS float*)(F.lds + 36864);
        *(LAS f32x4*)(cbl + tid * 4) = cbv;
        __syncthreads();
#pragma unroll
        for (int it = 0; it < 2; ++it) { const int e = tid + it * NTHR, r = e >> 6, n = e & 63; float s = 0.f;
#pragma unroll
            for (int pp = 0; pp < 32; ++pp) s += cbl[pp * 64 + n];
#pragma unroll
            for (int w = 0; w < 8; ++w) s += red[(w * 16 + r) * 64 + n];
            h1[r * 72 + n] = f2bf(gelu_tanh(s)); } }
    __syncthreads();
    if (wave == 0) {
#pragma unroll
        for (int nb = 0; nb < 4; ++nb) { f32x4 o = (f32x4){0.f, 0.f, 0.f, 0.f};
#pragma unroll
            for (int ks = 0; ks < 2; ++ks) { const bf16x8 hf = *(const LAS bf16x8*)(h1 + fr * 72 + ks * 32 + fq * 8); const bf16x8 wf = *(const bf16x8*)(W2 + (size_t)(nb * 16 + fr) * 64 + ks * 32 + fq * 8);
                o = kv ? mfma16(hf, wf, o) : mfma16(wf, hf, o); }
            u32x2 w; w.x = pk2(o[0], o[1]); w.y = pk2(o[2], o[3]);
            if (kv == 0) *(u32x2*)(wsp<bf16_t>(F, WS_KCMP) + ((size_t)b * 256 + mb * 16 + fr) * 64 + nb * 16 + fq * 4) = w;
            else *(u32x2*)(wsp<bf16_t>(F, WS_VCMPT) + ((size_t)b * 64 + nb * 16 + fr) * 256 + mb * 16 + fq * 4) = w; } }
    __syncthreads();
}

constexpr int TILE_B = 9216, AT_KT = 0, AT_VT = 36864, AT_CK = 73728, AT_KC = 0, AT_VC = 36864, AT_XCH = 0, AT_TAB = 32768, AT_FXT = 74752, AT_XST = 77824;
constexpr int KTP = 72, VCP = 264, TABP = 65;
constexpr float QSCALE = 0.125f * LOG2E;
struct FlashSt { float m, l; f32x4 o[4]; };
DEV void flash_init(FlashSt& s) { s.m = -1e30f; s.l = 0.f;
#pragma unroll
    for (int d = 0; d < 4; ++d) s.o[d] = (f32x4){0.f, 0.f, 0.f, 0.f}; }
DEV bf16x8 pack_p(const f32x4& a, const f32x4& b) { u32x4 w; w.x = pk2(a[0], a[1]); w.y = pk2(a[2], a[3]); w.z = pk2(b[0], b[1]); w.w = pk2(b[2], b[3]); return __builtin_bit_cast(bf16x8, w); }
DEV bf16x8 vfrag(const LAS bf16_t* p) { const bf16x4 lo = *(const LAS bf16x4*)p, hi = *(const LAS bf16x4*)(p + 16); return __builtin_shufflevector(lo, hi, 0, 1, 2, 3, 4, 5, 6, 7); }
struct KVFrags { bf16x8 k[4][2]; bf16x8 v[4][2]; };
DEV void load_frags(KVFrags& f, const LAS bf16_t* kt, const LAS bf16_t* vt, int fr, int fq) {
#pragma unroll
    for (int kb = 0; kb < 4; ++kb) { const LAS bf16_t* kp = kt + (16 * kb + fr) * KTP + 8 * fq; f.k[kb][0] = *(const LAS bf16x8*)kp; f.k[kb][1] = *(const LAS bf16x8*)(kp + 32); }
#pragma unroll
    for (int d = 0; d < 4; ++d)
#pragma unroll
        for (int c = 0; c < 2; ++c) f.v[d][c] = vfrag(vt + (16 * d + fr) * KTP + 32 * c + 4 * fq);
}
DEV void qk_frags(f32x4 (&s)[4], const KVFrags& f, const bf16x8 (&qf)[2]) {
#pragma unroll
    for (int kb = 0; kb < 4; ++kb) { f32x4 a = mfma16(f.k[kb][0], qf[0], (f32x4){0.f, 0.f, 0.f, 0.f}); s[kb] = mfma16(f.k[kb][1], qf[1], a); }
}
DEV void flash_update(FlashSt& st, f32x4 (&s)[4], const KVFrags& f, bool on) {
    float mx = fmaxf(fmaxf(fmaxf(s[0][0], s[0][1]), fmaxf(s[0][2], s[0][3])), fmaxf(fmaxf(s[1][0], s[1][1]), fmaxf(s[1][2], s[1][3])));
    mx = fmaxf(mx, fmaxf(fmaxf(fmaxf(s[2][0], s[2][1]), fmaxf(s[2][2], s[2][3])), fmaxf(fmaxf(s[3][0], s[3][1]), fmaxf(s[3][2], s[3][3]))));
    mx = on ? mx : -INFINITY;
    mx = xr_max(mx);
    const float mn = fmaxf(st.m, mx), alpha = fexp2(st.m - mn); st.m = mn;
    const float mref = on ? mn : INFINITY;
    float sum = 0.f;
#pragma unroll
    for (int kb = 0; kb < 4; ++kb)
#pragma unroll
        for (int i = 0; i < 4; ++i) { const float p = fexp2(s[kb][i] - mref); s[kb][i] = p; sum += p; }
    st.l = st.l * alpha + sum;
#pragma unroll
    for (int d = 0; d < 4; ++d) st.o[d] = st.o[d] * alpha;
#pragma unroll
    for (int c = 0; c < 2; ++c) { const bf16x8 pf = pack_p(s[2 * c], s[2 * c + 1]);
#pragma unroll
        for (int d = 0; d < 4; ++d) st.o[d] = mfma16(f.v[d][c], pf, st.o[d]); }
}
DEV float flash_inv_l(const FlashSt& st) { const float l = xr_sum(st.l); return l > 0.f ? 1.f / l : 0.f; }
DEV bf16x8 load_q(const bf16_t* p, const float* c, bool rope, float scale) {
    u32x4 w = *(const u32x4*)p; unsigned* wp = (unsigned*)&w;
    f32x4 co = {1.f, 1.f, 1.f, 1.f}, si = {0.f, 0.f, 0.f, 0.f};
    if (c) { co = *(const f32x4*)c; si = *(const f32x4*)(c + 8); }
#pragma unroll
    for (int j = 0; j < 4; ++j) { const float t1 = bflo(wp[j]), t2 = bfhi(wp[j]);
        const float a = rope ? t1 * co[j] - t2 * si[j] : t1, bq = rope ? t2 * co[j] + t1 * si[j] : t2;
        wp[j] = pk2(a * scale, bq * scale); }
    return __builtin_bit_cast(bf16x8, w);
}
struct TileRegs { u32x4 k, v; };
DEV void tile_load(TileRegs& r, const bf16_t* kbase, size_t kpitch, const bf16_t* vtbase, int key0, int tid) {
    r.k = *(const u32x4*)(kbase + (size_t)(key0 + (tid >> 3)) * kpitch + (tid & 7) * 8);
    r.v = *(const u32x4*)(vtbase + (size_t)(tid >> 3) * SEQ + key0 + (tid & 7) * 8);
}
DEV void tile_store(const TileRegs& r, LAS bf16_t* kt, LAS bf16_t* vt, int tid) {
    *(LAS u32x4*)(kt + (tid >> 3) * KTP + (tid & 7) * 8) = r.k; *(LAS u32x4*)(vt + (tid >> 3) * KTP + (tid & 7) * 8) = r.v;
}

DEV void nsa_unit(Frame F, int b, int qt, int half) {
    frame_refresh(F);
    const int tid = F.tid, lane = F.lane, wave = F.wave, fr = lane & 15, fq = lane >> 4, sq = wave & 1, hp = (wave >> 1) & 1, ks = wave >> 2, head = 2 * hp + ks, qid = wave >> 1;
    const int ql = 32 * half + 16 * sq + fr, tq = qt * 64 + ql, cur = qt; const size_t rowq = (size_t)b * SEQ + tq;
    const bf16_t* H = wsp<bf16_t>(F, WS_H); const float* cs = wsp<float>(F, WS_CS); const float* side = wsp<float>(F, WS_SIDE);
    LAS bf16_t* KT = (LAS bf16_t*)(F.lds + AT_KT); LAS bf16_t* VT = (LAS bf16_t*)(F.lds + AT_VT);
    LAS bf16_t* KC = (LAS bf16_t*)(F.lds + AT_KC); LAS bf16_t* VC = (LAS bf16_t*)(F.lds + AT_VC);
    bf16x8 qf2[2][2], qf[2]; float gate[3];
#pragma unroll
    for (int hh = 0; hh < 2; ++hh)
#pragma unroll
        for (int dc = 0; dc < 2; ++dc) qf2[hh][dc] = load_q(H + rowq * NP + HP_NQ + (2 * hp + hh) * 64 + 32 * dc + 8 * fq, cs + rowq * 16 + 4 * (fq & 1), dc == 0 && fq < 2, QSCALE);
#pragma unroll
    for (int dc = 0; dc < 2; ++dc) qf[dc] = ks ? qf2[1][dc] : qf2[0][dc];
#pragma unroll
    for (int i = 0; i < 3; ++i) gate[i] = sigmoidf_(side[rowq * 16 + head * 3 + i]);
    { const bf16_t* kc = wsp<bf16_t>(F, WS_KCMP) + (size_t)b * 256 * 64; const bf16_t* vc = wsp<bf16_t>(F, WS_VCMPT) + (size_t)b * 64 * 256;
#pragma unroll
        for (int it = 0; it < 4; ++it) { const int id = tid + it * NTHR;
            *(LAS u32x4*)(KC + (id >> 3) * KTP + (id & 7) * 8) = *(const u32x4*)(kc + (size_t)id * 8);
            *(LAS u32x4*)(VC + (id >> 5) * VCP + (id & 31) * 8) = *(const u32x4*)(vc + (size_t)id * 8); } }
    __syncthreads();
    f32x4 res[4]; float imp[16];
    const int nkb = (4 * qt + 2 * half) / 16 + 1;
    const int cl = (tq - 31) >> 4;
    const int srcl = (lane - 16) & 63;
    {
        f32x4 sc[16]; float mx = -1e30f;
#pragma unroll
        for (int kb = 0; kb < 16; ++kb) {
            if (kb < nkb) { const LAS bf16_t* kp = KC + (16 * kb + fr) * KTP + 8 * fq;
                f32x4 a = mfma16(*(const LAS bf16x8*)kp, qf[0], (f32x4){0.f, 0.f, 0.f, 0.f}); a = mfma16(*(const LAS bf16x8*)(kp + 32), qf[1], a);
#pragma unroll
                for (int i = 0; i < 4; ++i) { a[i] = (16 * kb + 4 * fq + i <= cl) ? a[i] : -INFINITY; mx = fmaxf(mx, a[i]); }
                sc[kb] = a; }
            else sc[kb] = (f32x4){-INFINITY, -INFINITY, -INFINITY, -INFINITY}; }
        mx = xr_max(mx);
        float sum = 0.f;
#pragma unroll
        for (int kb = 0; kb < 16; ++kb) if (kb < nkb) {
#pragma unroll
            for (int i = 0; i < 4; ++i) { const float p = fexp2(sc[kb][i] - mx); sc[kb][i] = p; sum += p; } }
        else sc[kb] = (f32x4){0.f, 0.f, 0.f, 0.f};
        sum = xr_sum(sum);
        const float inv = sum > 0.f ? 1.f / sum : 0.f;
        f32x4 o[4];
#pragma unroll
        for (int d = 0; d < 4; ++d) o[d] = (f32x4){0.f, 0.f, 0.f, 0.f};
        float prevx = 0.f;
#pragma unroll
        for (int kb = 0; kb < 16; ++kb) { if (kb < nkb) { sc[kb] = sc[kb] * inv; const float x = __shfl(sc[kb][3], srcl);
                imp[kb] = ((sc[kb][0] + sc[kb][1]) + (sc[kb][2] + sc[kb][3])) + (fq > 0 ? x : prevx); prevx = x; }
            else imp[kb] = 0.f; }
#pragma unroll
        for (int cc = 0; cc < 8; ++cc) if (2 * cc < nkb) { const bf16x8 pf = pack_p(sc[2 * cc], sc[2 * cc + 1]);
#pragma unroll
            for (int d = 0; d < 4; ++d) o[d] = mfma16(vfrag(VC + (16 * d + fr) * VCP + 32 * cc + 4 * fq), pf, o[d]); }
#pragma unroll
        for (int d = 0; d < 4; ++d) res[d] = o[d] * gate[0];
    }
    unsigned mlo, mhi;
    if (cur < 16) { mlo = (2u << cur) - 1u; mhi = 0u; }
    else {
        LAS float* XCH = (LAS float*)(F.lds + AT_XCH); LAS float* TAB = (LAS float*)(F.lds + AT_TAB) + (wave * 16 + fr) * TABP;
        __syncthreads();
#pragma unroll
        for (int kb = 0; kb < 16; ++kb) XCH[(wave * 16 + kb) * 64 + lane] = imp[kb];
        __syncthreads();
#pragma unroll
        for (int kb = 0; kb < 16; ++kb) { const int j = 4 * kb + fq;
            float v = (XCH[((0 + sq) * 16 + kb) * 64 + lane] + XCH[((2 + sq) * 16 + kb) * 64 + lane]) + (XCH[((4 + sq) * 16 + kb) * 64 + lane] + XCH[((6 + sq) * 16 + kb) * 64 + lane]);
            const bool forced = (j == 0) || (j == cur) || (j == cur - 1);
            v = forced ? 1e9f : (j <= cur ? v : -1.f); imp[kb] = v; TAB[j] = v; }
        LDS_WAIT();
        int cnt[4];
#pragma unroll
        for (int k4 = 0; k4 < 4; ++k4) cnt[k4] = 0;
        float myv[4];
#pragma unroll
        for (int k4 = 0; k4 < 4; ++k4) myv[k4] = qid == 0 ? imp[k4] : (qid == 1 ? imp[4 + k4] : (qid == 2 ? imp[8 + k4] : imp[12 + k4]));
#pragma unroll 4
        for (int jj = 0; jj < 64; ++jj) { const float vv = TAB[jj];
#pragma unroll
            for (int k4 = 0; k4 < 4; ++k4) { const int j = 4 * (4 * qid + k4) + fq; cnt[k4] += ((vv > myv[k4]) || (vv == myv[k4] && jj < j)) ? 1 : 0; } }
        mlo = 0u; mhi = 0u;
#pragma unroll
        for (int k4 = 0; k4 < 4; ++k4) { const int j = 4 * (4 * qid + k4) + fq; const unsigned bit = (cnt[k4] < 16 && j <= cur) ? 1u : 0u; if (j < 32) mlo |= bit << (j & 31); else mhi |= bit << (j & 31); }
        mlo = xr_or(mlo); mhi = xr_or(mhi);
        LAS unsigned* MSK = (LAS unsigned*)(F.lds + AT_CK);
        if (fq == 0) { MSK[(wave * 16 + fr) * 2] = mlo; MSK[(wave * 16 + fr) * 2 + 1] = mhi; }
        __syncthreads();
        mlo = (MSK[((0 + sq) * 16 + fr) * 2] | MSK[((2 + sq) * 16 + fr) * 2]) | (MSK[((4 + sq) * 16 + fr) * 2] | MSK[((6 + sq) * 16 + fr) * 2]);
        mhi = (MSK[((0 + sq) * 16 + fr) * 2 + 1] | MSK[((2 + sq) * 16 + fr) * 2 + 1]) | (MSK[((4 + sq) * 16 + fr) * 2 + 1] | MSK[((6 + sq) * 16 + fr) * 2 + 1]);
    }
    __syncthreads();
#pragma unroll 1
    for (int br = 0; br < 2; ++br) {
        const bf16_t* kbase = wsp<bf16_t>(F, WS_KNSA) + (size_t)b * SEQ * 128 + br * 64;
        const bf16_t* vtb = wsp<bf16_t>(F, WS_VT) + ((size_t)b * 384 + br * 64) * SEQ;
        const int j0 = br == 0 ? 0 : (qt > 8 ? qt - 8 : 0);
        const int np = (cur - j0 + 2) >> 1;
        FlashSt st2[2]; flash_init(st2[0]); flash_init(st2[1]);
        TileRegs ra[2], rb[2];
#define NSA_LOADP(R, p) do { _Pragma("unroll") for (int tt_ = 0; tt_ < 2; ++tt_) { const int j_ = j0 + 2 * (p) + tt_; if (j_ <= cur) tile_load(R[tt_], kbase, 128, vtb, j_ * 64, tid); } } while (0)
#define NSA_STOREP(R, p, buf) do { _Pragma("unroll") for (int tt_ = 0; tt_ < 2; ++tt_) { const int j_ = j0 + 2 * (p) + tt_; if (j_ <= cur) tile_store(R[tt_], KT + ((buf) * 2 + tt_) * 64 * KTP, VT + ((buf) * 2 + tt_) * 64 * KTP, tid); } } while (0)
#define NSA_COMPP(p, buf) do { const int j = j0 + 2 * (p) + ks; if (j <= cur) { \
            const LAS bf16_t* kt = KT + ((buf) * 2 + ks) * 64 * KTP; const LAS bf16_t* vt = VT + ((buf) * 2 + ks) * 64 * KTP; \
            const bool on = (br == 0) ? (((j < 32 ? (mlo >> j) : (mhi >> (j - 32))) & 1u) != 0u) : true; \
            if (__any(on)) { KVFrags fg; load_frags(fg, kt, vt, fr, fq); asm volatile("" ::: "memory"); \
                const bool edge = (j == cur) || (br == 1 && j == qt - 8); const int hi = (j == cur) ? ql : 63, lo = (br == 1 && j == qt - 8) ? ql : -1; \
                _Pragma("unroll") for (int hh = 0; hh < 2; ++hh) { f32x4 s[4]; qk_frags(s, fg, qf2[hh]); \
                    if (edge) { _Pragma("unroll") for (int kb = 0; kb < 4; ++kb) _Pragma("unroll") for (int i = 0; i < 4; ++i) { const int kl = 16 * kb + 4 * fq + i; s[kb][i] = (kl <= hi && kl > lo) ? s[kb][i] : -INFINITY; } } \
                    flash_update(st2[hh], s, fg, on); } } } } while (0)
        NSA_LOADP(ra, 0); NSA_LOADP(rb, 1);
#pragma unroll 1
        for (int p = 0; p < np; p += 2) {
            NSA_STOREP(ra, p, 0); __syncthreads(); NSA_LOADP(ra, p + 2); NSA_COMPP(p, 0);
            if (p + 1 < np) { NSA_STOREP(rb, p + 1, 1); __syncthreads(); NSA_LOADP(rb, p + 3); NSA_COMPP(p + 1, 1); }
        }
#undef NSA_LOADP
#undef NSA_STOREP
#undef NSA_COMPP
        { LAS float* XS = (LAS float*)(F.lds + AT_XST) + wave * (18 * 64) + lane;
            XS[0] = ks ? st2[0].m : st2[1].m; XS[64] = ks ? st2[0].l : st2[1].l;
#pragma unroll
            for (int d = 0; d < 4; ++d)
#pragma unroll
                for (int i = 0; i < 4; ++i) XS[(2 + 4 * d + i) * 64] = ks ? st2[0].o[d][i] : st2[1].o[d][i];
            __syncthreads();
            const LAS float* XP = (const LAS float*)(F.lds + AT_XST) + (wave ^ 4) * (18 * 64) + lane;
            FlashSt st; st.m = ks ? st2[1].m : st2[0].m; st.l = ks ? st2[1].l : st2[0].l;
#pragma unroll
            for (int d = 0; d < 4; ++d) st.o[d] = ks ? st2[1].o[d] : st2[0].o[d];
            const float mb = XP[0], lb = XP[64]; const float m = fmaxf(st.m, mb), fa = fexp2(st.m - m), fb = fexp2(mb - m);
            st.l = st.l * fa + lb * fb;
#pragma unroll
            for (int d = 0; d < 4; ++d)
#pragma unroll
                for (int i = 0; i < 4; ++i) st.o[d][i] = st.o[d][i] * fa + XP[(2 + 4 * d + i) * 64] * fb;
            const float sc = flash_inv_l(st) * (br == 0 ? gate[1] : gate[2]);
#pragma unroll
            for (int d = 0; d < 4; ++d) res[d] += st.o[d] * sc; }
        __syncthreads();
    }
    bf16_t* BR = wsp<bf16_t>(F, WS_BR);
#pragma unroll
    for (int d = 0; d < 4; ++d) { u32x2 w; w.x = pk2(res[d][0], res[d][1]); w.y = pk2(res[d][2], res[d][3]);
        *(u32x2*)(BR + rowq * 1024 + head * 64 + 16 * d + 4 * fq) = w; }
}

DEV void fox_unit(Frame F, int b, int h, int qb) {
    frame_refresh(F);
    const int tid = F.tid, lane = F.lane, wave = F.wave, fr = lane & 15, fq = lane >> 4;
    const int q0 = qb * 256, qw = q0 + 32 * wave;
    const bf16_t* H = wsp<bf16_t>(F, WS_H); const float* cum = wsp<float>(F, WS_CUM) + ((size_t)b * 4 + h) * SEQ;
    LAS bf16_t* KT = (LAS bf16_t*)(F.lds + AT_KT); LAS bf16_t* VT = (LAS bf16_t*)(F.lds + AT_VT); LAS float* CK = (LAS float*)(F.lds + AT_CK);
    LAS float* KNP = (LAS float*)(F.lds + AT_FXT); LAS float* CKL = KNP + 64; LAS float* WMIN = KNP + 128; LAS float* WQN = KNP + 136;
    const float cref = cum[q0];
    bf16x8 qf[2][2]; float qn2 = 0.f;
#pragma unroll
    for (int sb = 0; sb < 2; ++sb) { float ss = 0.f;
#pragma unroll
        for (int dc = 0; dc < 2; ++dc) { qf[sb][dc] = load_q(H + ((size_t)b * SEQ + qw + 16 * sb + fr) * NP + HP_FQ + h * 64 + 32 * dc + 8 * fq, nullptr, false, QSCALE);
            const u32x4 w = __builtin_bit_cast(u32x4, qf[sb][dc]); const unsigned* wp = (const unsigned*)&w;
#pragma unroll
            for (int j = 0; j < 4; ++j) { const float a = bflo(wp[j]), c = bfhi(wp[j]); ss += a * a + c * c; } }
        ss = xr_sum(ss); qn2 = fmaxf(qn2, ss); }
#pragma unroll
    for (int o = 1; o < 16; o <<= 1) qn2 = fmaxf(qn2, __shfl_xor(qn2, o));
    if (lane == 0) WQN[wave] = sqrtf(qn2) * 1.0001f;
    if (tid < 64) {
        float kn = wsp<float>(F, WS_KN)[((size_t)b * 4 + h) * 64 + tid];
#pragma unroll
        for (int o = 1; o < 64; o <<= 1) { const float t = __shfl_up(kn, o); if (tid >= o) kn = fmaxf(kn, t); }
        KNP[tid] = kn; CKL[tid] = cum[64 * tid + 63] - cref; }
    const bf16_t* kbase = H + (size_t)b * SEQ * NP + HP_FK + h * 64; const bf16_t* vtb = wsp<bf16_t>(F, WS_VT) + ((size_t)b * 384 + 128 + h * 64) * SEQ;
    FlashSt st[2]; flash_init(st[0]); flash_init(st[1]);
    __syncthreads();
    int np = 2;
    { float qn = WQN[0];
#pragma unroll
        for (int w = 1; w < 8; ++w) qn = fmaxf(qn, WQN[w]);
        const float wk = wsp<float>(F, WS_KN)[((size_t)b * 4 + h) * 64 + 4 * qb + (lane & 3)];
        float kown = fmaxf(wk, __shfl_xor(wk, 1)); kown = fmaxf(kown, __shfl_xor(kown, 2)); kown = __shfl(kown, 0);
        const float thr = -qn * kown - 40.f;
#pragma unroll 1
        for (int Jn = 4 * qb - 1; Jn >= 0; Jn -= 2) { if (qn * KNP[Jn] - CKL[Jn] < thr) break; ++np; } }
    np = __builtin_amdgcn_readfirstlane(np);
#define FOX_TILE(p, tt) ((p) < 2 ? 4 * qb + 2 * (p) + (tt) : 4 * qb - 1 - 2 * ((p) - 2) - (tt))
    TileRegs ra[2], rb[2]; f32x4 cka[2], ckb[2];
#define FOX_LOADP(R, C, p) do { if ((p) < np) { _Pragma("unroll") for (int tt_ = 0; tt_ < 2; ++tt_) { const int j_ = FOX_TILE(p, tt_); if (j_ >= 0) { tile_load(R[tt_], kbase, NP, vtb, j_ * 64, tid); if (tid < 16) C[tt_] = *(const f32x4*)(cum + j_ * 64 + 4 * tid); } } } } while (0)
#define FOX_STOREP(R, C, p, buf) do { _Pragma("unroll") for (int tt_ = 0; tt_ < 2; ++tt_) { const int j_ = FOX_TILE(p, tt_); if (j_ >= 0) { tile_store(R[tt_], KT + ((buf) * 2 + tt_) * 64 * KTP, VT + ((buf) * 2 + tt_) * 64 * KTP, tid); \
            if (tid < 16) *(LAS f32x4*)(CK + ((buf) * 2 + tt_) * 64 + 4 * tid) = C[tt_] - cref; } } } while (0)
#define FOX_COMPP(p, buf) do { _Pragma("unroll") for (int tt_ = 0; tt_ < 2; ++tt_) { const int J = FOX_TILE(p, tt_); const int key0 = 64 * J; if (J >= 0 && key0 <= qw + 31) { \
            const LAS bf16_t* kt = KT + ((buf) * 2 + tt_) * 64 * KTP; const LAS bf16_t* vt = VT + ((buf) * 2 + tt_) * 64 * KTP; const LAS float* ck = CK + ((buf) * 2 + tt_) * 64; \
            KVFrags fg; load_frags(fg, kt, vt, fr, fq); \
            f32x4 dk[4]; _Pragma("unroll") for (int kb = 0; kb < 4; ++kb) dk[kb] = *(const LAS f32x4*)(ck + 16 * kb + 4 * fq); \
            asm volatile("" ::: "memory"); \
            const bool diag = key0 + 63 > qw; \
            _Pragma("unroll") for (int sb = 0; sb < 2; ++sb) { f32x4 s[4]; qk_frags(s, fg, qf[sb]); const int qa = qw + 16 * sb + fr; \
                _Pragma("unroll") for (int kb = 0; kb < 4; ++kb) { s[kb] = s[kb] - dk[kb]; \
                    if (diag) { _Pragma("unroll") for (int i = 0; i < 4; ++i) s[kb][i] = (key0 + 16 * kb + 4 * fq + i <= qa) ? s[kb][i] : -INFINITY; } } \
                flash_update(st[sb], s, fg, true); } } } } while (0)
    FOX_LOADP(ra, cka, 0); FOX_LOADP(rb, ckb, 1);
#pragma unroll 1
    for (int p = 0; p < np; p += 2) {
        FOX_STOREP(ra, cka, p, 0); __syncthreads(); FOX_LOADP(ra, cka, p + 2); FOX_COMPP(p, 0);
        if (p + 1 < np) { FOX_STOREP(rb, ckb, p + 1, 1); __syncthreads(); FOX_LOADP(rb, ckb, p + 3); FOX_COMPP(p + 1, 1); }
    }
#undef FOX_TILE
#undef FOX_LOADP
#undef FOX_STOREP
#undef FOX_COMPP
    bf16_t* BR = wsp<bf16_t>(F, WS_BR);
#pragma unroll
    for (int sb = 0; sb < 2; ++sb) { const float sc = flash_inv_l(st[sb]); const size_t row = (size_t)b * SEQ + qw + 16 * sb + fr;
#pragma unroll
        for (int d = 0; d < 4; ++d) { const f32x4 o = st[sb].o[d] * sc; u32x2 w; w.x = pk2(o[0], o[1]); w.y = pk2(o[2], o[3]);
            *(u32x2*)(BR + row * 1024 + 256 + h * 64 + 16 * d + 4 * fq) = w; } }
    __syncthreads();
}

DEV void ln1_router_phase(Frame F, const Params& P, int l) {
    frame_refresh(F);
    const int tid = F.tid, lane = F.lane, wave = F.wave, fr = lane & 15, fq = lane >> 4;
    LAS float* xs = (LAS float*)F.lds;
    LAS float* part = (LAS float*)(F.lds + 69632);
    constexpr int XP = 1028;
    const bf16_t* mix = wsp<bf16_t>(F, WS_MIX); bf16_t* xb = wsp<bf16_t>(F, WS_XB);
    const float* g1 = P.in[I_LN1G] + (size_t)l * 1024; const float* b1 = P.in[I_LN1B] + (size_t)l * 1024;
    float wf[2][32];
    { const float* wr = P.in[I_WR] + (size_t)l * 1024 * 32 + (size_t)(128 * wave + 32 * fq) * 32 + fr;
#pragma unroll
        for (int s_ = 0; s_ < 32; ++s_) { wf[0][s_] = wr[s_ * 32]; wf[1][s_] = wr[s_ * 32 + 16]; } }
    const float brt = P.in[I_BR][l * 32 + (tid & 31)];
    unsigned* cnt = F.ctl + CW_CNT + l * 32 * 64; int* rowtk = wsp<int>(F, WS_ROWTK); float* tokw = wsp<float>(F, WS_TOKW);
    LAS unsigned* lcnt = (LAS unsigned*)(F.lds + 90112);
    LAS unsigned* lsel = lcnt + 64;
    if (tid < 64) lcnt[tid] = 0u;
    int nsel = 0;
    __syncthreads();
    u32x4 va[2][2], vm[2][2];
    f32x4 gg1[2][2], bb1[2][2];
#pragma unroll
    for (int j = 0; j < 2; ++j)
#pragma unroll
        for (int h = 0; h < 2; ++h) { gg1[j][h] = *(const f32x4*)(g1 + j * 512 + lane * 8 + 4 * h); bb1[j][h] = *(const f32x4*)(b1 + j * 512 + lane * 8 + 4 * h); }
    int unit = F.bid;
    if (unit < NT / 16) {
#pragma unroll
        for (int i = 0; i < 2; ++i)
#pragma unroll
            for (int j = 0; j < 2; ++j) { const size_t o = (size_t)(unit * 16 + wave * 2 + i) * 1024 + j * 512 + lane * 8; va[i][j] = *(const u32x4*)(xb + o); vm[i][j] = *(const u32x4*)(mix + o); } }
#pragma unroll 1
    for (; unit < NT / 16; unit += F.G) {
        const int r0 = unit * 16;
#pragma unroll
        for (int i = 0; i < 2; ++i) { const int r = wave * 2 + i; const size_t row = (size_t)(r0 + r);
            f32x4 v[2][2]; float s = 0.f;
#pragma unroll
            for (int j = 0; j < 2; ++j) { const unsigned* xp_ = (const unsigned*)&va[i][j]; const unsigned* mp_ = (const unsigned*)&vm[i][j];
#pragma unroll
                for (int h = 0; h < 2; ++h) { const f32x4 xa = {bflo(xp_[2 * h]), bfhi(xp_[2 * h]), bflo(xp_[2 * h + 1]), bfhi(xp_[2 * h + 1])}, ma = {bflo(mp_[2 * h]), bfhi(mp_[2 * h]), bflo(mp_[2 * h + 1]), bfhi(mp_[2 * h + 1])};
                    v[j][h] = xa * DN_ALPHA + ma; s += (v[j][h][0] + v[j][h][1]) + (v[j][h][2] + v[j][h][3]); } }
            const float mean = wave_sum(s) * (1.f / 1024.f); float q = 0.f;
#pragma unroll
            for (int j = 0; j < 2; ++j)
#pragma unroll
                for (int h = 0; h < 2; ++h) { v[j][h] = v[j][h] - mean; q += (v[j][h][0] * v[j][h][0] + v[j][h][1] * v[j][h][1]) + (v[j][h][2] * v[j][h][2] + v[j][h][3] * v[j][h][3]); }
            const float rstd = 1.f / sqrtf(wave_sum(q) * (1.f / 1024.f) + LN_EPS);
#pragma unroll
            for (int j = 0; j < 2; ++j) { const f32x4 o0 = v[j][0] * rstd * gg1[j][0] + bb1[j][0], o1 = v[j][1] * rstd * gg1[j][1] + bb1[j][1];
                *(LAS f32x4*)(xs + r * XP + j * 512 + lane * 8) = o0; *(LAS f32x4*)(xs + r * XP + j * 512 + lane * 8 + 4) = o1;
                u32x4 w; w.x = pk2(o0[0], o0[1]); w.y = pk2(o0[2], o0[3]); w.z = pk2(o1[0], o1[1]); w.w = pk2(o1[2], o1[3]); *(u32x4*)(xb + row * 1024 + j * 512 + lane * 8) = w; } }
        { const int un = unit + F.G;
            if (un < NT / 16) {
#pragma unroll
                for (int i = 0; i < 2; ++i)
#pragma unroll
                    for (int j = 0; j < 2; ++j) { const size_t o = (size_t)(un * 16 + wave * 2 + i) * 1024 + j * 512 + lane * 8; va[i][j] = *(const u32x4*)(xb + o); vm[i][j] = *(const u32x4*)(mix + o); } } }
        __syncthreads();
        { f32x4 c0 = (f32x4){0.f, 0.f, 0.f, 0.f}, c1 = c0; const LAS float* xp = xs + fr * XP + 128 * wave + 32 * fq;
#pragma unroll
            for (int s4 = 0; s4 < 8; ++s4) { const f32x4 xa = *(const LAS f32x4*)(xp + 4 * s4);
#pragma unroll
                for (int i = 0; i < 4; ++i) { c0 = __builtin_amdgcn_mfma_f32_16x16x4f32(xa[i], wf[0][4 * s4 + i], c0, 0, 0, 0); c1 = __builtin_amdgcn_mfma_f32_16x16x4f32(xa[i], wf[1][4 * s4 + i], c1, 0, 0, 0); } }
#pragma unroll
            for (int i = 0; i < 4; ++i) { part[(wave * 16 + 4 * fq + i) * 32 + fr] = c0[i]; part[(wave * 16 + 4 * fq + i) * 32 + 16 + fr] = c1[i]; } }
        __syncthreads();
        { const int r = tid >> 5, e = tid & 31; float v = brt;
#pragma unroll
            for (int w = 0; w < 8; ++w) v += part[(w * 16 + r) * 32 + e];
            float bv[4]; int bi[4]; float cur = v;
#define DPP_F(x, ctrl) __builtin_bit_cast(float, __builtin_amdgcn_update_dpp(0, __builtin_bit_cast(int, (x)), (ctrl), 0xf, 0xf, true))
#define DPP_I(x, ctrl) __builtin_amdgcn_update_dpp(0, (x), (ctrl), 0xf, 0xf, true)
#define ARGMAX_STEP(OV, OI) do { const float ov_ = (OV); const int oi_ = (OI); const bool take_ = (ov_ > mv) || (ov_ == mv && oi_ < mi); mv = take_ ? ov_ : mv; mi = take_ ? oi_ : mi; } while (0)
#pragma unroll
            for (int k = 0; k < 4; ++k) { float mv = cur; int mi = e;
                ARGMAX_STEP(DPP_F(mv, 0xB1), DPP_I(mi, 0xB1));
                ARGMAX_STEP(DPP_F(mv, 0x4E), DPP_I(mi, 0x4E));
                ARGMAX_STEP(DPP_F(mv, 0x141), DPP_I(mi, 0x141));
                ARGMAX_STEP(DPP_F(mv, 0x140), DPP_I(mi, 0x140));
                { const auto rv_ = __builtin_amdgcn_permlane16_swap(__float_as_uint(mv), __float_as_uint(mv), false, false); const auto ri_ = __builtin_amdgcn_permlane16_swap((unsigned)mi, (unsigned)mi, false, false);
                    mv = __uint_as_float(rv_[0]); mi = (int)ri_[0]; ARGMAX_STEP(__uint_as_float(rv_[1]), (int)ri_[1]); }
                bv[k] = mv; bi[k] = mi; if (e == mi) cur = -INFINITY; }
#undef DPP_F
#undef DPP_I
#undef ARGMAX_STEP
            if (e < 4) { float ex[4], sum = 0.f;
#pragma unroll
                for (int k = 0; k < 4; ++k) { ex[k] = __expf(bv[k] - bv[0]); sum += ex[k]; }
                const int k = e; const int t = r0 + r; const int ide = k == 0 ? bi[0] : (k == 1 ? bi[1] : (k == 2 ? bi[2] : bi[3])); const float exk = k == 0 ? ex[0] : (k == 1 ? ex[1] : (k == 2 ? ex[2] : ex[3]));
                const unsigned ls = __hip_atomic_fetch_add(lcnt + ide, 1u, __ATOMIC_RELAXED, __HIP_MEMORY_SCOPE_WORKGROUP);
                const int li = nsel + r * 4 + k; lsel[2 * li] = ((unsigned)ide << 24) | ls; lsel[2 * li + 1] = (unsigned)(t * 4 + k); tokw[t * 4 + k] = exk / sum; } }
        nsel += 64;
        __syncthreads();
    }
    if (tid < 32) { const unsigned c = lcnt[tid]; lcnt[32 + tid] = c ? atomicAdd(cnt + tid * 64, c) : 0u; }
    __syncthreads();
    for (int i = tid; i < nsel; i += NTHR) { const unsigned a = lsel[2 * i], tk = lsel[2 * i + 1]; const unsigned e = a >> 24; rowtk[(size_t)e * NT + lcnt[32 + e] + (a & 0xffffffu)] = (int)tk; }
    __syncthreads();
}
DEV void ln2_rows(Frame F, const Params& P, int l) {
    frame_refresh(F);
    const int lane = F.lane; const int gw = F.bid * NWAVES + F.wave, NGW = F.G * NWAVES;
    bf16_t* xb = wsp<bf16_t>(F, WS_XB); const bf16_t* yb = wsp<bf16_t>(F, WS_YBUF); const float* tokw = wsp<float>(F, WS_TOKW);
    const float* g2 = P.in[I_LN2G] + (size_t)l * 1024; const float* b2 = P.in[I_LN2B] + (size_t)l * 1024;
    float* dst = (l == NL - 1) ? P.out : nullptr;
    f32x4 wkn; u32x4 xn[2]; u32x4 yn[2][4];
#define LN2_LOAD(row_) do { wkn = *(const f32x4*)(tokw + (size_t)(row_) * 4); _Pragma("unroll") for (int j = 0; j < 2; ++j) { xn[j] = *(const u32x4*)(xb + (size_t)(row_) * 1024 + j * 512 + lane * 8); \
        _Pragma("unroll") for (int k = 0; k < 4; ++k) yn[j][k] = *(const u32x4*)(yb + ((size_t)(row_) * 4 + k) * 1024 + j * 512 + lane * 8); } } while (0)
    f32x4 gg[2][2], bb[2][2];
#pragma unroll
    for (int j = 0; j < 2; ++j)
#pragma unroll
        for (int h = 0; h < 2; ++h) { gg[j][h] = *(const f32x4*)(g2 + j * 512 + lane * 8 + 4 * h); bb[j][h] = *(const f32x4*)(b2 + j * 512 + lane * 8 + 4 * h); }
    if (gw < NT) LN2_LOAD(gw);
#pragma unroll 1
    for (int row = gw; row < NT; row += NGW) {
        const f32x4 wk = wkn;
        f32x4 v[2][2]; float s = 0.f;
#pragma unroll
        for (int j = 0; j < 2; ++j) { const unsigned* xp = (const unsigned*)&xn[j];
            f32x4 a0 = (f32x4){bflo(xp[0]), bfhi(xp[0]), bflo(xp[1]), bfhi(xp[1])} * DN_ALPHA, a1 = (f32x4){bflo(xp[2]), bfhi(xp[2]), bflo(xp[3]), bfhi(xp[3])} * DN_ALPHA;
#pragma unroll
            for (int k = 0; k < 4; ++k) { const unsigned* yp = (const unsigned*)&yn[j][k]; const float w = wk[k];
                a0[0] += w * bflo(yp[0]); a0[1] += w * bfhi(yp[0]); a0[2] += w * bflo(yp[1]); a0[3] += w * bfhi(yp[1]);
                a1[0] += w * bflo(yp[2]); a1[1] += w * bfhi(yp[2]); a1[2] += w * bflo(yp[3]); a1[3] += w * bfhi(yp[3]); }
            v[j][0] = a0; v[j][1] = a1; s += ((a0[0] + a0[1]) + (a0[2] + a0[3])) + ((a1[0] + a1[1]) + (a1[2] + a1[3])); }
        if (row + NGW < NT) LN2_LOAD(row + NGW);
        const float mean = wave_sum(s) * (1.f / 1024.f); float q = 0.f;
#pragma unroll
        for (int j = 0; j < 2; ++j)
#pragma unroll
            for (int h = 0; h < 2; ++h) { v[j][h] = v[j][h] - mean; q += (v[j][h][0] * v[j][h][0] + v[j][h][1] * v[j][h][1]) + (v[j][h][2] * v[j][h][2] + v[j][h][3] * v[j][h][3]); }
        const float rstd = 1.f / sqrtf(wave_sum(q) * (1.f / 1024.f) + LN_EPS);
#pragma unroll
        for (int j = 0; j < 2; ++j) { const f32x4 o0 = v[j][0] * rstd * gg[j][0] + bb[j][0], o1 = v[j][1] * rstd * gg[j][1] + bb[j][1];
            if (dst) { *(f32x4*)(dst + (size_t)row * 1024 + j * 512 + lane * 8) = o0; *(f32x4*)(dst + (size_t)row * 1024 + j * 512 + lane * 8 + 4) = o1; }
            else { u32x4 w; w.x = pk2(o0[0], o0[1]); w.y = pk2(o0[2], o0[3]); w.z = pk2(o1[0], o1[1]); w.w = pk2(o1[2], o1[3]); *(u32x4*)(xb + (size_t)row * 1024 + j * 512 + lane * 8) = w; } } }
#undef LN2_LOAD
}

constexpr int NPH = 9;
constexpr int N_PHASES = 1 + NL * NPH;
__global__ void __launch_bounds__(NTHR, 2) fwd_kernel(Params P) {
    extern __shared__ __attribute__((aligned(16))) unsigned char lds_raw[];
    Frame F;
    F.lds = (LAS unsigned char*)lds_raw; F.MISC = (volatile LAS unsigned*)(F.lds + MISC_OFF);
    F.tid = threadIdx.x; F.lane = F.tid & 63; F.wave = __builtin_amdgcn_readfirstlane(F.tid >> 6); F.G = gridDim.x; F.bid = blockIdx.x;
    F.ws = P.ws; F.ctl = (unsigned*)(P.ws + WS_CTL);
    for (int u = F.tid; u < 1024; u += NTHR) F.MISC[u] = 0u;
    __syncthreads();
    const int lo = P.ph_lo, hi = P.ph_hi;
    const bool multi = (hi - lo) > 1;
    XcdBarrier bar; bar.bar = F.ctl + CW_BAR; bar.x = 0; bar.st = F.MISC + 8;
    if (multi) bar = xcd_barrier_post(F.ctl + CW_BAR, F.MISC + 8);
#ifndef PHMASK
#define PHMASK 0xFFFF
#endif
#define IN(k) (lo <= (k) && (k) < hi)
#define EN(i) ((PHMASK >> (i)) & 1)
#ifndef DUP_PHASE
#define DUP_PHASE -1
#endif
#define REP(i) for (int rep_ = 0; rep_ < ((DUP_PHASE) == (i) ? 2 : 1); ++rep_)
#define SEAM(k) do { if (IN(k) && IN((k) + 1)) xcd_barrier(bar); } while (0)
#define FILL(k) do { __syncthreads(); if (F.tid == 0) atomicAdd(F.ctl + CW_DONE + (k) * 64, 1u); bg_fill(F, P, F.ctl + CW_DONE + (k) * 64, BG_TOTAL); } while (0)

    if (EN(9) && IN(0)) { REP(9) p0_prologue(F, P); }
    SEAM(0);
#pragma unroll 1
    for (int l = 0; l < NL; ++l) {
        const int pb = 1 + l * NPH;
        if (EN(0) && IN(pb + 0)) REP(0) {
            pg8::Gemm g{wsp<bf16_t>(F, WS_XB), wsp<bf16_t>(F, WS_WIN) + (size_t)l * NP * 1024, 1024, 1024};
            pg8::PlainOrder S; S.init(NT / 256, NP / 256, F.G, F.bid);
            pg8::EpiInProj E{wsp<bf16_t>(F, WS_H), wsp<float>(F, WS_BIN) + (size_t)l * NP, wsp<float>(F, WS_SIDE), wsp<bf16_t>(F, WS_MGT)};
            pg8::gemm_phase<pg8::EpiInProj, pg8::PlainOrder, true>(F.lds, g, S, E);
            FILL(pb + 0);
        }
        SEAM(pb + 0);
        if (EN(1) && IN(pb + 1)) REP(1) {
            unsigned* qctr = F.ctl + CW_QUEUE + l * 64 + 16;
            for (;;) {
                if (F.tid == 0) F.MISC[16] = atomicAdd(qctr, 1u);
                __syncthreads();
                const int L = (int)F.MISC[16];
                __syncthreads();
                if (L >= 528) break;
                if (L < 128) pb_gmlp_unit(F, P, l, L);
                else if (L < 256) pb_compress_unit(F, l, L - 128);
                else if (L < 512) { pb_conv_unit(F, P, l, L - 256); pb_transpose_unit(F, L - 256); }
                else pb_cum_unit(F, L - 512);
            }
        }
        SEAM(pb + 1);
        if (EN(2) && IN(pb + 2)) REP(2) {
            unsigned* qctr = F.ctl + CW_QUEUE + l * 64 + rep_ * 32;
            for (;;) {
                if (F.tid == 0) F.MISC[16] = atomicAdd(qctr, 1u);
                __syncthreads();
                const unsigned L = F.MISC[16];
                __syncthreads();
#ifdef ATT_TWICE
                if (L >= 1536u) break;
                const int Lm = (int)(L % 768u);
#else
                if (L >= 768u) break;
                const int Lm = (int)L;
#endif
                if (Lm < 512) nsa_unit(F, Lm & 3, 63 - (Lm >> 3), (Lm >> 2) & 1);
                else { const int idx = Lm - 512; fox_unit(F, idx & 3, (idx >> 2) & 3, 15 - (idx >> 4)); }
            }
            FILL(pb + 2);
        }
        SEAM(pb + 2);
        if (EN(3) && IN(pb + 3)) REP(3) {
            pg8::Gemm g{wsp<bf16_t>(F, WS_BR), wsp<bf16_t>(F, WS_WBR) + (size_t)l * 4096 * 256, 1024, 256};
            pg8::BrOrder S{F.G, F.bid};
            pg8::EpiBrGate E{wsp<bf16_t>(F, WS_MGT), wsp<bf16_t>(F, WS_GBF)};
            pg8::gemm_phase<pg8::EpiBrGate, pg8::BrOrder, true, true>(F.lds, g, S, E);
        }
        SEAM(pb + 3);
        if (EN(4) && IN(pb + 4)) REP(4) {
            pg8::Gemm g{wsp<bf16_t>(F, WS_GBF), wsp<bf16_t>(F, WS_WO) + (size_t)l * 1024 * 1024, 1024, 1024};
            pg8::PlainOrder S; S.init(NT / 256, 4, F.G, F.bid);
            pg8::EpiBf16Out E{wsp<bf16_t>(F, WS_MIX)};
            pg8::gemm_phase<pg8::EpiBf16Out, pg8::PlainOrder, true>(F.lds, g, S, E);
        }
        SEAM(pb + 4);
        if (EN(5) && IN(pb + 5)) { ln1_router_phase(F, P, l); bg_fill(F, P, nullptr, (long)(l + 1) * BG_PER_LAYER); }
        SEAM(pb + 5);
        if ((EN(6) || EN(7)) && (IN(pb + 6) || IN(pb + 7))) {
            LAS int* tp = (LAS int*)(F.lds + MISC_OFF + 1024);
            if (F.tid == 0) { int run = 0; const unsigned* cnt = F.ctl + CW_CNT + l * 32 * 64;
                for (int e = 0; e < 32; ++e) { const int c = (int)__hip_atomic_load(cnt + e * 64, __ATOMIC_RELAXED, __HIP_MEMORY_SCOPE_AGENT); tp[e] = run; tp[40 + e] = c; run += (c + 255) >> 8; }
                tp[32] = run; }
            __syncthreads();
            LAS unsigned* ul = (LAS unsigned*)(F.lds + MISC_OFF + 1536);
            int ut_ = F.tid; asm volatile("" : "+v"(ut_));
            if (ut_ < 128) { const int m2 = ut_ >> 6, i = ut_ & 63, sh = m2 ? 2 : 3;
                const int x = F.bid & 7, j = F.bid >> 3, W = F.G >> 3;
                const int U = tp[32] << sh, s0 = (x * U) >> 3, s1 = ((x + 1) * U) >> 3, L = s0 + i * W + j;
                unsigned pk = 0xffffffffu;
                if (L < s1) { const int tile = L >> sh, pn = L & ((1 << sh) - 1);
                    int e = (tp[16] <= tile) ? 16 : 0;
                    e += (tp[e + 8] <= tile) ? 8 : 0; e += (tp[e + 4] <= tile) ? 4 : 0; e += (tp[e + 2] <= tile) ? 2 : 0; e += (tp[e + 1] <= tile) ? 1 : 0;
                    const int mt = tile - tp[e], rem = tp[40 + e] - mt * 256, cn = rem < 256 ? rem : 256;
                    pk = (unsigned)pn | ((unsigned)e << 3) | ((unsigned)mt << 8) | ((unsigned)tile << 15) | ((unsigned)(cn - 1) << 24); }
                ul[ut_] = pk; }
            __syncthreads();
            if (EN(6) && IN(pb + 6)) REP(6) {
                pg8::Gemm g{wsp<bf16_t>(F, WS_XB), wsp<bf16_t>(F, WS_W1) + (size_t)l * 32 * 2048 * 1024, 1024, 1024};
                pg8::MoeOrder<1> S{ul, wsp<int>(F, WS_ROWTK)};
                pg8::EpiMoe1 E{wsp<bf16_t>(F, WS_ACT), P.in[I_BE1] + (size_t)l * 32 * 2048};
                pg8::gemm_phase<pg8::EpiMoe1, pg8::MoeOrder<1>, true>(F.lds, g, S, E);
                FILL(pb + 6);
            }
            SEAM(pb + 6);
            if (EN(7) && IN(pb + 7)) REP(7) {
                pg8::Gemm g{wsp<bf16_t>(F, WS_ACT), wsp<bf16_t>(F, WS_W2) + (size_t)l * 32 * 1024 * 1024, 1024, 1024};
                pg8::MoeOrder<2> S{ul + 64, wsp<int>(F, WS_ROWTK)};
                pg8::EpiMoe2 E{wsp<bf16_t>(F, WS_YBUF), P.in[I_BE2] + (size_t)l * 32 * 1024, wsp<int>(F, WS_ROWTK)};
                pg8::gemm_phase<pg8::EpiMoe2, pg8::MoeOrder<2>, true>(F.lds, g, S, E);
                FILL(pb + 7);
            }
        }
        SEAM(pb + 7);
        if (EN(8) && IN(pb + 8)) REP(8) ln2_rows(F, P, l);
        SEAM(pb + 8);
    }
#undef IN
#undef SEAM
}

#ifndef MK_SPLIT
#define MK_SPLIT 0
#endif
extern "C" void kernel_launch(void* const* d_in, const int* in_sizes, int n_in, void* d_out, int out_size, void* d_ws, size_t ws_size, hipStream_t stream) {
    static int grid = 0;
    if (grid == 0) {
        if (n_in != 30 || out_size != NT * 1024 || ws_size < WS_END) { fprintf(stderr, "kernel_launch: unexpected shapes (n_in %d out %d ws %zu need %zu)\n", n_in, out_size, ws_size, (size_t)WS_END); grid = -1; return; }
        int dev = 0, cus = 0, per_cu = 0;
        if (hipGetDevice(&dev) != hipSuccess || hipDeviceGetAttribute(&cus, hipDeviceAttributeMultiprocessorCount, dev) != hipSuccess) { grid = -1; return; }
        if (hipFuncSetAttribute((const void*)fwd_kernel, hipFuncAttributeMaxDynamicSharedMemorySize, LDS_BYTES) != hipSuccess) { fprintf(stderr, "kernel_launch: hipFuncSetAttribute failed\n"); grid = -1; return; }
        if (hipOccupancyMaxActiveBlocksPerMultiprocessor(&per_cu, (const void*)fwd_kernel, NTHR, LDS_BYTES) != hipSuccess || per_cu < 1) fprintf(stderr, "kernel_launch: occupancy query says %d\n", per_cu);
        (void)hipGetLastError();
        grid = cus;
    }
    if (grid < 0) return;
    (void)hipMemsetAsync((char*)d_ws + WS_CTL, 0, CTL_BYTES, stream);
    Params p; memset(&p, 0, sizeof(p));
    for (int i = 0; i < 30; ++i) p.in[i] = (const float*)d_in[i];
    p.out = (float*)d_out; p.ws = (unsigned char*)d_ws;
    for (int i = 0; i < 8; ++i) p.invf[i] = std::pow(500000.0, -(double)i / 8.0);
#if MK_SPLIT
    for (int ph = 0; ph < N_PHASES; ++ph) { p.ph_lo = ph; p.ph_hi = ph + 1; hipLaunchKernelGGL(fwd_kernel, dim3(grid), dim3(NTHR), LDS_BYTES, stream, p); }
#else
    p.ph_lo = 0; p.ph_hi = N_PHASES; hipLaunchKernelGGL(fwd_kernel, dim3(grid), dim3(NTHR), LDS_BYTES, stream, p);
#endif
}
```

```cpp
#include <hip/hip_runtime.h>
#include <cstdio>
#include <cstdint>
#include <cmath>
#include <cstring>

#define DEV __device__ __forceinline__
#define LAS __attribute__((address_space(3)))
#define GAS __attribute__((address_space(1)))

typedef unsigned short bf16_t;
typedef short bf16x8 __attribute__((ext_vector_type(8)));
typedef short bf16x4 __attribute__((ext_vector_type(4)));
typedef float f32x4 __attribute__((ext_vector_type(4)));
typedef float f32x2 __attribute__((ext_vector_type(2)));
typedef unsigned u32x4 __attribute__((ext_vector_type(4)));
typedef unsigned u32x2 __attribute__((ext_vector_type(2)));

constexpr int NB = 4, SEQ = 4096, DM = 1024, NL = 4, NT = NB * SEQ;
constexpr int NIN = 6544, NP = 6656;
constexpr int NE = 32;
constexpr int NWAVES = 8, NTHR = 512;
constexpr float LN_EPS = 1e-5f;
constexpr float DN_ALPHA = 1.6817928305074292f;
constexpr float LOG2E = 1.4426950408889634f;
constexpr int HP_NQ = 0, HP_KC = 256, HP_VC = 320, HP_KS = 384, HP_VS = 448, HP_KW = 512, HP_VW = 576, HP_SP = 640;
constexpr int HP_FQ = 768, HP_FK = 1024, HP_FV = 1280, HP_GU = 1536, HP_GV = 1792, HP_CAB = 2048, HP_MG = 2560;

constexpr size_t al256(size_t x) { return (x + 255) & ~(size_t)255; }
constexpr size_t WS_CTL = 0, CTL_BYTES = 1u << 20;
constexpr size_t WS_WIN = CTL_BYTES;
constexpr size_t WS_BIN = WS_WIN + al256((size_t)NL * NP * 1024 * 2);
constexpr size_t WS_WBR = WS_BIN + al256((size_t)NL * NP * 4);
constexpr size_t WS_WO = WS_WBR + al256((size_t)NL * 4096 * 256 * 2);
constexpr size_t WS_W1 = WS_WO + al256((size_t)NL * 1024 * 1024 * 2);
constexpr size_t WS_W2 = WS_W1 + al256((size_t)NL * 32 * 2048 * 1024 * 2);
constexpr size_t WS_WC1 = WS_W2 + al256((size_t)NL * 32 * 1024 * 1024 * 2);
constexpr size_t WS_WC2 = WS_WC1 + al256((size_t)NL * 2 * 64 * 2048 * 2);
constexpr size_t WS_CB = WS_WC2 + al256((size_t)NL * 2 * 64 * 64 * 2);
constexpr size_t WS_WG = WS_CB + al256((size_t)NL * 2 * 32 * 64 * 4);
constexpr size_t WS_CS = WS_WG + al256((size_t)NL * 4 * 128 * 128 * 2);
constexpr size_t WS_XRES = WS_CS + al256((size_t)NT * 16 * 4);
constexpr size_t WS_XB = WS_XRES + al256((size_t)NT * 1024 * 4);
constexpr size_t WS_H = WS_XB + al256((size_t)NT * 1024 * 2);
constexpr size_t WS_SIDE = WS_H + al256((size_t)NT * NP * 2);
constexpr size_t WS_KNSA = WS_SIDE + al256((size_t)NT * 16 * 4);
constexpr size_t WS_VT = WS_KNSA + al256((size_t)NT * 128 * 2);
constexpr size_t WS_CUM = WS_VT + al256((size_t)NB * 384 * SEQ * 2);
constexpr size_t WS_KCMP = WS_CUM + al256((size_t)NB * 4 * SEQ * 4);
constexpr size_t WS_VCMPT = WS_KCMP + al256((size_t)NB * 256 * 64 * 2);
constexpr size_t WS_BR = WS_VCMPT + al256((size_t)NB * 64 * 256 * 2);
constexpr size_t WS_G32 = WS_BR + al256((size_t)NT * 1024 * 2);
constexpr size_t WS_GBF = WS_G32 + al256((size_t)NT * 1024 * 4);
constexpr size_t WS_MIX = WS_GBF + al256((size_t)NT * 1024 * 2);
constexpr size_t WS_TOKW = WS_MIX + al256((size_t)NT * 1024 * 4);
constexpr size_t WS_ROWTK = WS_TOKW + al256((size_t)NT * 4 * 4);
constexpr int PMAX_TILES = NT * 4 / 256 + NE;
constexpr size_t WS_ACT = WS_ROWTK + al256((size_t)NE * NT * 4);
constexpr size_t WS_YBUF = WS_ACT + al256((size_t)PMAX_TILES * 256 * 1024 * 2);
constexpr size_t WS_MGT = WS_YBUF + al256((size_t)NT * 4 * 1024 * 2);
constexpr size_t WS_KN = WS_MGT + al256((size_t)NT * 4096 * 2);
constexpr size_t WS_END = WS_KN + al256((size_t)NB * 4 * 64 * 4);

constexpr int CW_BAR = 4096;
constexpr int CW_CNT = 32768;
constexpr int CW_QUEUE = 20480;
constexpr int CW_BGQ = 24576;
constexpr int CW_DONE = 28672;

constexpr int RING_BYTES = 131072;
constexpr int MISC_OFF = RING_BYTES;
constexpr int LDS_BYTES = 147456;

DEV float bf2f(bf16_t v) { return __uint_as_float((unsigned)v << 16); }
DEV float bflo(unsigned w) { return __uint_as_float(w << 16); }
DEV float bfhi(unsigned w) { return __uint_as_float(w & 0xffff0000u); }
DEV unsigned pk2(float lo, float hi) { typedef __bf16 b2 __attribute__((ext_vector_type(2))); f32x2 v = {lo, hi}; b2 b = __builtin_convertvector(v, b2); return __builtin_bit_cast(unsigned, b); }
DEV bf16_t f2bf(float f) { return (bf16_t)(pk2(f, 0.f) & 0xffffu); }
DEV float fexp2(float x) { return __builtin_amdgcn_exp2f(x); }
DEV float frcp(float x) { return __builtin_amdgcn_rcpf(x); }
DEV float sigmoidf_(float x) { return frcp(1.f + fexp2(-x * LOG2E)); }
DEV float gelu_tanh(float x) { const float u = 1.5957691216057308f * (x + 0.044715f * x * x * x); return x * frcp(1.f + fexp2(-u * LOG2E)); }
#define WS_DPP(x, ctrl) __builtin_bit_cast(float, __builtin_amdgcn_update_dpp(0, __builtin_bit_cast(int, (x)), (ctrl), 0xf, 0xf, true))
DEV float wave_sum(float v) {
    v += WS_DPP(v, 0xB1); v += WS_DPP(v, 0x4E); v += WS_DPP(v, 0x141); v += WS_DPP(v, 0x140);
    const int vi = __builtin_bit_cast(int, v);
    const float r0 = __builtin_bit_cast(float, __builtin_amdgcn_readlane(vi, 0)), r1 = __builtin_bit_cast(float, __builtin_amdgcn_readlane(vi, 16));
    const float r2 = __builtin_bit_cast(float, __builtin_amdgcn_readlane(vi, 32)), r3 = __builtin_bit_cast(float, __builtin_amdgcn_readlane(vi, 48));
    return (r0 + r1) + (r2 + r3);
}
typedef unsigned u32x2_t __attribute__((ext_vector_type(2)));
DEV float xr_max(float v) {
    { const unsigned u = __float_as_uint(v); const auto r = __builtin_amdgcn_permlane16_swap(u, u, false, false); v = fmaxf(__uint_as_float(r[0]), __uint_as_float(r[1])); }
    { const unsigned u = __float_as_uint(v); const auto r = __builtin_amdgcn_permlane32_swap(u, u, false, false); v = fmaxf(__uint_as_float(r[0]), __uint_as_float(r[1])); }
    return v;
}
DEV float xr_sum(float v) {
    { const unsigned u = __float_as_uint(v); const auto r = __builtin_amdgcn_permlane16_swap(u, u, false, false); v = __uint_as_float(r[0]) + __uint_as_float(r[1]); }
    { const unsigned u = __float_as_uint(v); const auto r = __builtin_amdgcn_permlane32_swap(u, u, false, false); v = __uint_as_float(r[0]) + __uint_as_float(r[1]); }
    return v;
}
DEV unsigned xr_or(unsigned u) {
    { const auto r = __builtin_amdgcn_permlane16_swap(u, u, false, false); u = r[0] | r[1]; }
    { const auto r = __builtin_amdgcn_permlane32_swap(u, u, false, false); u = r[0] | r[1]; }
    return u;
}
DEV f32x4 mfma16(bf16x8 a, bf16x8 b, f32x4 c) { return __builtin_amdgcn_mfma_f32_16x16x32_bf16(a, b, c, 0, 0, 0); }
#define LDS_WAIT() asm volatile("s_waitcnt lgkmcnt(0)" ::: "memory")
#define VM_WAIT() asm volatile("s_waitcnt vmcnt(0)" ::: "memory")

__host__ __device__ __forceinline__ int perm16(int dp) { return dp < 16 ? ((dp & 1) ? 8 + (dp >> 1) : (dp >> 1)) : dp; }
__host__ __device__ __forceinline__ int hp_src_col(int c) {
    if (c < 256) return (c & ~63) + perm16(c & 63);
    if (c < 320) return 256 + perm16(c - 256);
    if (c < 384) return c;
    if (c < 448) return 384 + perm16(c - 384);
    if (c < 512) return c;
    if (c < 576) return 512 + perm16(c - 512);
    if (c < 640) return c;
    if (c < 652) return c;
    if (c < 656) return 1420 + (c - 652);
    if (c < 768) return -1;
    if (c < 1024) return 652 + (c - 768);
    if (c < 1280) return 908 + (c - 1024);
    if (c < 1536) return 1164 + (c - 1280);
    if (c < 1792) return 1424 + (c - 1536);
    if (c < 2048) return 1680 + (c - 1792);
    if (c < 2560) { const int i = c - 2048; return (i & 1) ? 2192 + (i >> 1) : 1936 + (i >> 1); }
    return 2448 + (c - 2560);
}

namespace pg8 {
constexpr int BM = 256, BK = 64, HALF = 128, HTB = HALF * BK * 2, STAGE_BYTES = 8 * HTB, NXCD = 8, WGM = 8;
__host__ __device__ __forceinline__ int lds_byte(int r, int c) { const int st = (r >> 4) * 2 + (c >> 5), rr = r & 15, cc = c & 31, ob = rr * 64 + cc * 2; return st * 1024 + (ob ^ (((ob >> 9) & 1) << 5)); }
__host__ __device__ __forceinline__ void stage_rc(int b, int& R, int& C) { const int st = b / 1024, sb = b % 1024, swz = sb ^ (((sb >> 9) & 1) << 5); R = (st >> 1) * 16 + swz / 64; C = (st & 1) * 32 + (swz % 64) / 2; }
__host__ __device__ __forceinline__ int perm32(int rho) { const int n = rho >> 4, i = rho & 15; return 8 * (i >> 2) + 4 * n + (i & 3); }

struct Unit { int pm, pn, e, mt, cnt; };
constexpr int KROT = 1;
struct Gemm { const bf16_t* A; const bf16_t* Bt; int lda; int K; };

template <class Epi, class Sched, bool ALIGN_EPI, bool HALFN = false>
DEV void gemm_phase(LAS unsigned char* lds, const Gemm g, const Sched& S, const Epi& E) {
    int tid_ = threadIdx.x; asm volatile("" : "+v"(tid_));
    const int tid = tid_, wid = __builtin_amdgcn_readfirstlane(tid >> 6), lane = tid & 63, wr = wid >> 2, wc = wid & 3, fr = lane & 15, fq = lane >> 4;
    const int K = g.K, nt = K / BK;
#define PG8_KOF(t_, r_) ((size_t)((t_) + (r_) - (((t_) + (r_)) >= nt ? nt : 0)) * kstep)
    unsigned voffA[2], voffB[2];
#pragma unroll
    for (int i = 0; i < 2; ++i) { int R, C; stage_rc(tid * 16 + i * 8192, R, C); int Rb = Epi::PERM ? ((R & ~31) + perm32(R & 31)) : R;
        if constexpr (Epi::PAIR16) Rb = 16 * (Rb >> 3) + (Rb & 7);
        voffA[i] = (unsigned)(R * g.lda + C) * 2u; voffB[i] = (unsigned)(Rb * K + C) * 2u; }
    const unsigned hstepA = (unsigned)HALF * (unsigned)g.lda * 2u;
    const size_t kstep = (size_t)(BK * 2);
    const size_t hstepB = (size_t)(Epi::PAIR16 ? 8 : HALF) * K * 2;
    unsigned voffG[2];
#pragma unroll
    for (int i = 0; i < 2; ++i) { const unsigned off = (unsigned)tid * 16u + (unsigned)i * 8192u; voffG[i] = (off >> 8) * 512u + (off & 255u); }
    constexpr size_t GPIECE = 64 * 512;
    const unsigned ldsw = (unsigned)wid * 1024u;
    const int aoff = lds_byte(wr * 64 + fr, fq * 8), boff = lds_byte(wc * 32 + fr, fq * 8);
    const char* const Abase = (const char*)g.A;
#define PG8_SA(b, h) (((b) * 2 + (h)) * HTB)
#define PG8_SB(b, h) ((4 + (b) * 2 + (h)) * HTB)
#define PG8_STAGE_B(bufoff, gbase, voff) do { _Pragma("unroll") for (int _i = 0; _i < 2; ++_i) \
        __builtin_amdgcn_global_load_lds((const unsigned*)((const char*)(gbase) + (voff)[_i]), (LAS unsigned*)(lds + (bufoff) + ldsw + _i * 8192), 16, 0, 0); } while (0)
#define PG8_STAGE_B1(bufoff, gbase, gatep) do { if constexpr (HALFN) PG8_STAGE_B(bufoff, gatep, voffG); else PG8_STAGE_B(bufoff, (gbase) + hstepB, voffB); } while (0)
#define PG8_STAGE_A(bufoff, koff, offs) do { _Pragma("unroll") for (int _i = 0; _i < 2; ++_i) { \
        if constexpr (Sched::GATHER) __builtin_amdgcn_global_load_lds((const unsigned*)(Abase + (size_t)(koff) + (offs)[_i]), (LAS unsigned*)(lds + (bufoff) + ldsw + _i * 8192), 16, 0, 0); \
        else __builtin_amdgcn_global_load_lds((const unsigned*)(Abase + ((size_t)(koff) + (size_t)__builtin_amdgcn_readfirstlane((offs)[_i])) + voffA[_i]), (LAS unsigned*)(lds + (bufoff) + ldsw + _i * 8192), 16, 0, 0); } } while (0)
#define PG8_LDA(dst, b, h) do { _Pragma("unroll") for (int m = 0; m < 4; ++m) _Pragma("unroll") for (int k = 0; k < 2; ++k) dst[m][k] = *(const LAS bf16x8*)(lds + PG8_SA(b, h) + aoff + m * 2048 + k * 1024); } while (0)
#define PG8_LDB(dst, b, h) do { _Pragma("unroll") for (int n = 0; n < 2; ++n) _Pragma("unroll") for (int k = 0; k < 2; ++k) dst[n][k] = *(const LAS bf16x8*)(lds + PG8_SB(b, h) + boff + n * 2048 + k * 1024); } while (0)
#define PG8_MMA(ai, bj, At, Bt) do { __builtin_amdgcn_s_setprio(1); _Pragma("unroll") for (int m = 0; m < 4; ++m) _Pragma("unroll") for (int n = 0; n < 2; ++n) _Pragma("unroll") for (int k = 0; k < 2; ++k) \
        acc[ai][bj][m][n] = __builtin_amdgcn_mfma_f32_16x16x32_bf16(Bt[n][k], At[m][k], acc[ai][bj][m][n], 0, 0, 0); __builtin_amdgcn_s_setprio(0); } while (0)
#define PG8_WAIT_V(n) asm volatile("s_waitcnt vmcnt(" #n ")" ::: "memory")
#define PG8_WAIT_L(n) asm volatile("s_waitcnt lgkmcnt(" #n ")" ::: "memory")
#define PG8_BAR __builtin_amdgcn_s_barrier()
#define PG8_SCHED __builtin_amdgcn_sched_barrier(0)
#define PG8_MKOFF(dst, u) do { if constexpr (Sched::GATHER) { const unsigned _ao = S.aoff(u); _Pragma("unroll") for (int _h = 0; _h < 2; ++_h) _Pragma("unroll") for (int _i = 0; _i < 2; ++_i) { \
        int _R, _C; stage_rc(tid * 16 + _i * 8192, _R, _C); dst[_h][_i] = _ao + (S.arow(u, _h * HALF + _R) * (unsigned)g.lda + (unsigned)_C) * 2u; } } \
    else { const unsigned _ub = S.aoff(u) + S.arow(u, 0) * (unsigned)g.lda * 2u; _Pragma("unroll") for (int _h = 0; _h < 2; ++_h) _Pragma("unroll") for (int _i = 0; _i < 2; ++_i) dst[_h][_i] = _ub + (unsigned)_h * hstepA; } } while (0)
    Unit cur, nxt; int ui = 0;
    if (!S.next(0, cur)) return;
    f32x4 acc[2][2][4][2];
#pragma unroll
    for (int a = 0; a < 2; ++a)
#pragma unroll
        for (int b = 0; b < 2; ++b)
#pragma unroll
            for (int m = 0; m < 4; ++m)
#pragma unroll
                for (int n = 0; n < 2; ++n) acc[a][b][m][n] = (f32x4){0.f, 0.f, 0.f, 0.f};
    bf16x8 At[4][2], B0[2][2], B1[2][2];
    unsigned oc[2][2], on[2][2];
    PG8_MKOFF(oc, cur);
    const char* cB = (const char*)g.Bt + S.boff(cur);
    const char* cG = E.gate_base(cur);
    int rc = 0; if constexpr (Sched::ROT) rc = S.rot(cur);
    { const size_t k0 = PG8_KOF(0, rc);
    PG8_STAGE_B(PG8_SB(0, 0), cB + k0, voffB); PG8_STAGE_B1(PG8_SB(0, 1), cB + k0, cG); PG8_STAGE_A(PG8_SA(0, 0), k0, oc[0]); PG8_STAGE_A(PG8_SA(0, 1), k0, oc[1]); }
    if (wr == 1) PG8_BAR;
    PG8_WAIT_V(2); PG8_BAR;
    { const size_t k1 = PG8_KOF(1, rc);
    PG8_STAGE_B(PG8_SB(1, 0), cB + k1, voffB); PG8_STAGE_A(PG8_SA(1, 0), k1, oc[0]); PG8_STAGE_B1(PG8_SB(1, 1), cB + k1, cG + GPIECE); }
    PG8_WAIT_V(6); PG8_BAR;
    typename Epi::Pre pre;
    for (;;) {
        const bool has_next = S.next(ui + 1, nxt);
        const char* nB = cB; const char* nG = cG;
        int rn = 0; if constexpr (Sched::ROT) { if (has_next) rn = S.rot(nxt); }
        LAS int* const idxb = (LAS int*)(lds + STAGE_BYTES + 2048) + ((ui + 1) & 1) * 256;
        if (has_next) { nB = (const char*)g.Bt + S.boff(nxt); nG = E.gate_base(nxt);
            if constexpr (Sched::GATHER) { if (wid < 4) __builtin_amdgcn_global_load_lds((const unsigned*)(S.idx_ptr(nxt) + tid), (LAS unsigned*)(idxb + wid * 64), 4, 0, 0); }
            else PG8_MKOFF(on, nxt); }
        else {
#pragma unroll
            for (int h = 0; h < 2; ++h)
#pragma unroll
                for (int i = 0; i < 2; ++i) on[h][i] = oc[h][i];
        }
#pragma unroll 1
        for (int t = 0; t < nt; t += 2) {
            const bool last = (t == nt - 2);
            const bool nowait = Epi::DRAINS && (t == 0) && (ui > 0);
            const size_t k1 = PG8_KOF(t + 1, rc);
            const size_t k2 = last ? PG8_KOF(0, rn) : PG8_KOF(t + 2, rc), k3 = last ? PG8_KOF(1, rn) : PG8_KOF(t + 3, rc);
            if constexpr (Sched::GATHER) { if (last && has_next) {
                const unsigned ao_ = S.aoff(nxt);
#pragma unroll
                for (int h = 0; h < 2; ++h)
#pragma unroll
                    for (int i = 0; i < 2; ++i) { int R_, C_; stage_rc(tid * 16 + i * 8192, R_, C_); const int r_ = h * HALF + R_; const int ix_ = idxb[r_];
                        on[h][i] = ao_ + (S.arow_from(nxt, r_, ix_) * (unsigned)g.lda + (unsigned)C_) * 2u; } } }
            unsigned o2[2][2]; const unsigned lastm = last ? 0xffffffffu : 0u;
#pragma unroll
            for (int h = 0; h < 2; ++h)
#pragma unroll
                for (int i = 0; i < 2; ++i) o2[h][i] = oc[h][i] ^ ((oc[h][i] ^ on[h][i]) & lastm);
            const char* b2 = (last ? nB : cB) + k2; const char* b3 = (last ? nB : cB) + k3;
            const char* g2 = last ? nG : cG + (size_t)(t + 2) * GPIECE; const char* g3 = g2 + GPIECE;
            PG8_LDB(B0, 0, 0); if constexpr (!HALFN) PG8_LDB(B1, 0, 1); else { if (wr == 0) E.gate_read(pre, lds + PG8_SB(0, 1), t >> 1, wc, fr, fq); } PG8_SCHED; PG8_LDA(At, 0, 0); PG8_STAGE_A(PG8_SA(1, 1), k1, oc[1]);
            if (!nowait) PG8_WAIT_V(8); PG8_WAIT_L(0); PG8_BAR; PG8_MMA(0, 0, At, B0); if constexpr (!HALFN) PG8_MMA(0, 1, At, B1); PG8_BAR; PG8_SCHED;
            PG8_LDA(At, 0, 1); PG8_STAGE_B(PG8_SB(0, 0), b2, voffB); PG8_STAGE_B1(PG8_SB(0, 1), b2, g2); PG8_STAGE_A(PG8_SA(0, 0), k2, o2[0]);
            if (!nowait) PG8_WAIT_V(8); PG8_WAIT_L(0); PG8_BAR; PG8_MMA(1, 0, At, B0); if constexpr (!HALFN) PG8_MMA(1, 1, At, B1); PG8_BAR; PG8_SCHED;
            PG8_LDB(B0, 1, 0); if constexpr (!HALFN) PG8_LDB(B1, 1, 1); else { if (wr == 1) E.gate_read(pre, lds + PG8_SB(1, 1), t >> 1, wc, fr, fq); } PG8_SCHED; PG8_LDA(At, 1, 0); PG8_STAGE_A(PG8_SA(0, 1), k2, o2[1]);
            PG8_WAIT_V(8); PG8_WAIT_L(0); PG8_BAR; PG8_MMA(0, 0, At, B0); if constexpr (!HALFN) PG8_MMA(0, 1, At, B1); PG8_BAR; PG8_SCHED;
            PG8_LDA(At, 1, 1); PG8_STAGE_B(PG8_SB(1, 0), b3, voffB); PG8_STAGE_B1(PG8_SB(1, 1), b3, g3); PG8_STAGE_A(PG8_SA(1, 0), k3, o2[0]);
            PG8_WAIT_V(8); PG8_WAIT_L(0); PG8_BAR; PG8_MMA(1, 0, At, B0); if constexpr (!HALFN) PG8_MMA(1, 1, At, B1); PG8_BAR; PG8_SCHED;
        }
        if constexpr (ALIGN_EPI) { if (wr == 0) PG8_BAR; }
        if constexpr (HALFN) E.fold(acc, pre, cur, wr, wc, fr, fq); else E(acc, cur, wr, wc, fr, fq);
        if (!has_next) break;
#pragma unroll
        for (int a = 0; a < 2; ++a)
#pragma unroll
            for (int b = 0; b < 2; ++b)
#pragma unroll
                for (int m = 0; m < 4; ++m)
#pragma unroll
                    for (int n = 0; n < 2; ++n) { if (!HALFN || b == 0) acc[a][b][m][n] = (f32x4){0.f, 0.f, 0.f, 0.f}; }
        cur = nxt; cB = nB; cG = nG; ++ui; rc = rn;
#pragma unroll
        for (int h = 0; h < 2; ++h)
#pragma unroll
            for (int i = 0; i < 2; ++i) oc[h][i] = on[h][i];
        if constexpr (ALIGN_EPI) { if (wr == 1) PG8_BAR; }
    }
    PG8_WAIT_V(0);
    if constexpr (!ALIGN_EPI) { if (wr == 0) PG8_BAR; }
    PG8_BAR;
#undef PG8_SA
#undef PG8_SB
#undef PG8_STAGE_A
#undef PG8_STAGE_B1
#undef PG8_STAGE_B
#undef PG8_LDA
#undef PG8_LDB
#undef PG8_MMA
#undef PG8_WAIT_V
#undef PG8_WAIT_L
#undef PG8_BAR
#undef PG8_SCHED
#undef PG8_MKOFF
#undef PG8_KOF
}

struct StaticOrder {
    int nM, nN, nwg, G, c;
    DEV void init(int nM_, int nN_, int G_, int c_) { nM = nM_; nN = nN_; nwg = nM * nN; G = G_; c = c_; }
    DEV bool next(int i, Unit& u) const {
        const long L = (long)i * G + c; if (L >= nwg) return false;
        int wgid = (int)L; { const int q = nwg / NXCD, r = nwg % NXCD, xcd = wgid % NXCD, off = wgid / NXCD; wgid = (xcd < r ? xcd * (q + 1) : r * (q + 1) + (xcd - r) * q) + off; }
        const int nig = WGM * nN, gid = wgid / nig, fm = gid * WGM, gsz = (nM - fm) < WGM ? (nM - fm) : WGM;
        u.pm = fm + ((wgid % nig) % gsz); u.pn = (wgid % nig) / gsz; u.e = 0; u.mt = 0; u.cnt = 256; return true;
    }
};
}

#define XB_TMO      128
#define XB_XCNT(j)  (256  + 64 * (j))
#define XB_XSUB(j)  (1280 + 64 * (j))
#define XB_XGEN(j)  (2304 + 64 * (j))
#define XB_TOP      3328
#define XB_TOPGEN   3392
#define XCD_BAR_WORDS 3456
#define XB_SPIN_CAP (1u << 20)
DEV unsigned xb_ld(unsigned* p)              { return __hip_atomic_load(p, __ATOMIC_RELAXED, __HIP_MEMORY_SCOPE_AGENT); }
DEV unsigned xb_add(unsigned* p, unsigned v) { return __hip_atomic_fetch_add(p, v, __ATOMIC_RELAXED, __HIP_MEMORY_SCOPE_AGENT); }
DEV unsigned xb_xcc_id() { return (unsigned)__builtin_amdgcn_s_getreg((3 << 11) | 20) & 0xFu; }
#define XB_SPIN(cond, bar) do { unsigned _sp = 0; while (cond) { __builtin_amdgcn_s_sleep(1); \
    if ((++_sp & 255u) == 0u) { if (xb_ld(&(bar)[XB_TMO])) break; if (_sp > XB_SPIN_CAP) { atomicAdd(&(bar)[XB_TMO], 1u); break; } } } } while (0)
struct XcdBarrier { unsigned* bar; unsigned x; volatile LAS unsigned* st; };
DEV XcdBarrier xcd_barrier_post(unsigned* bar, volatile LAS unsigned* st) {
    XcdBarrier b; b.bar = bar; b.x = xb_xcc_id(); b.st = st;
    if (threadIdx.x == 0) (void)xb_add(&bar[XB_XCNT(b.x)], 1u);
    return b;
}
DEV void xcd_barrier_complete(unsigned* bar, unsigned x, unsigned& nloc, unsigned& nx) {
    const unsigned G = gridDim.x * gridDim.y * gridDim.z;
    unsigned sum, cnt, mine, sp = 0u;
    for (;;) {
        sum = 0u; cnt = 0u; mine = 0u;
#pragma unroll
        for (unsigned j = 0; j < 16; ++j) { const unsigned c = xb_ld(&bar[XB_XCNT(j)]); sum += c; cnt += (c > 0u) ? 1u : 0u; mine = (j == x) ? c : mine; }
        if (sum == G) break;
        __builtin_amdgcn_s_sleep(1);
        if ((++sp & 255u) == 0u) { if (xb_ld(&bar[XB_TMO])) break; if (sp > XB_SPIN_CAP) { atomicAdd(&bar[XB_TMO], 1u); break; } }
    }
    nloc = mine > 0u ? mine : 1u; nx = cnt > 0u ? cnt : 1u;
}
DEV void xcd_barrier(const XcdBarrier& b) {
    asm volatile("s_waitcnt vmcnt(0)" ::: "memory");
    __syncthreads();
    if (threadIdx.x == 0) {
        unsigned* bar = b.bar;
        __builtin_amdgcn_s_waitcnt(0);
        unsigned nloc = b.st[0], nx = b.st[1];
        if (nloc == 0u) { xcd_barrier_complete(bar, b.x, nloc, nx); b.st[0] = nloc; b.st[1] = nx; }
        const unsigned old = xb_add(&bar[XB_XSUB(b.x)], 1u);
        const unsigned gen = old / nloc;
        if (old + 1u == (gen + 1u) * nloc) {
            __builtin_amdgcn_fence(__ATOMIC_RELEASE, "agent");
            asm volatile("s_waitcnt vmcnt(0)" ::: "memory");
            const unsigned og = xb_add(&bar[XB_TOP], 1u);
            const unsigned tg = og / nx;
            if (og + 1u == (tg + 1u) * nx) xb_add(&bar[XB_TOPGEN], 1u);
            else XB_SPIN(xb_ld(&bar[XB_TOPGEN]) == tg, bar);
            __builtin_amdgcn_fence(__ATOMIC_ACQUIRE, "agent");
            xb_add(&bar[XB_XGEN(b.x)], 1u);
            asm volatile("s_waitcnt vmcnt(0)" ::: "memory");
        } else {
            XB_SPIN(xb_ld(&bar[XB_XGEN(b.x)]) == gen, bar);
            __builtin_amdgcn_fence(__ATOMIC_ACQUIRE, "agent");
            asm volatile("s_waitcnt vmcnt(0)" ::: "memory");
        }
    }
    __syncthreads();
}

struct Params {
    const float* in[30];
    float* out;
    unsigned char* ws;
    int ph_lo, ph_hi;
    double invf[8];
};
enum { I_X = 0, I_POS, I_WIN, I_BIN, I_PEK, I_PEV, I_W1K, I_W2K, I_W1V, I_W2V, I_GLNG, I_GLNB, I_GWS, I_GBS, I_CW, I_CB, I_CLNG, I_CLNB,
       I_WBR, I_WO, I_LN1G, I_LN1B, I_WR, I_BR, I_WE1, I_BE1, I_WE2, I_BE2, I_LN2G, I_LN2B };

namespace pg8 {
struct EpiInProj {
    struct Pre {};
    static constexpr bool PAIR16 = false, DRAINS = true;
    DEV const char* gate_base(const Unit&) const { return nullptr; }
    static constexpr bool PERM = true;
    bf16_t* H; const float* bias; float* side; bf16_t* MGT;
    DEV void operator()(const f32x4 (&acc)[2][2][4][2], const Unit& u, int wr, int wc, int fr, int fq) const {
        const int row0 = u.pm * BM + wr * 64 + fr, col0 = u.pn * BM + wc * 32 + 8 * fq;
        f32x4 bv[2][2];
#pragma unroll
        for (int bj = 0; bj < 2; ++bj)
#pragma unroll
            for (int n = 0; n < 2; ++n) bv[bj][n] = *(const f32x4*)(bias + col0 + bj * HALF + 4 * n);
        asm volatile("" :: "v"(bv[0][0]), "v"(bv[0][1]), "v"(bv[1][0]), "v"(bv[1][1]));
        if (u.pn >= 10) {
            bf16_t* tile = MGT + ((size_t)u.pm * 16 + (u.pn - 10)) * 65536 + (wr * 64 + fr) * 256 + wc * 32 + 8 * fq;
#pragma unroll
            for (int ai = 0; ai < 2; ++ai)
#pragma unroll
                for (int m = 0; m < 4; ++m)
#pragma unroll
                    for (int bj = 0; bj < 2; ++bj) { const f32x4 v0 = acc[ai][bj][m][0] + bv[bj][0], v1 = acc[ai][bj][m][1] + bv[bj][1];
                        u32x4 w; w.x = pk2(sigmoidf_(v0[0]), sigmoidf_(v0[1])); w.y = pk2(sigmoidf_(v0[2]), sigmoidf_(v0[3])); w.z = pk2(sigmoidf_(v1[0]), sigmoidf_(v1[1])); w.w = pk2(sigmoidf_(v1[2]), sigmoidf_(v1[3]));
                        *(u32x4*)(tile + (ai * HALF + m * 16) * 256 + bj * HALF) = w; }
            return; }
        const bool special = (u.pn == 2) && (wc == 0) && (fq < 2);
#pragma unroll
        for (int ai = 0; ai < 2; ++ai)
#pragma unroll
            for (int m = 0; m < 4; ++m) { const int row = row0 + ai * HALF + m * 16; bf16_t* rowp = H + (size_t)row * NP + col0;
#pragma unroll
                for (int bj = 0; bj < 2; ++bj) { const f32x4 v0 = acc[ai][bj][m][0] + bv[bj][0], v1 = acc[ai][bj][m][1] + bv[bj][1];
                    u32x4 w; w.x = pk2(v0[0], v0[1]); w.y = pk2(v0[2], v0[3]); w.z = pk2(v1[0], v1[1]); w.w = pk2(v1[2], v1[3]);
                    *(u32x4*)(rowp + bj * HALF) = w;
                    if (bj == 1 && special) { float* sp = side + (size_t)row * 16 + 8 * fq; *(f32x4*)sp = v0; *(f32x4*)(sp + 4) = v1; } } }
    }
};
struct EpiBrGate {
    static constexpr bool PERM = true;
    struct Pre { u32x4 g[2][4]; };
    static constexpr bool PAIR16 = false, DRAINS = false;
    const bf16_t* MGT; bf16_t* GBF;
    DEV const char* gate_base(const Unit& u) const { return (const char*)(MGT + ((size_t)u.pm * 16 + u.e * 4 + (u.pn >> 1)) * 65536 + (u.pn & 1) * 128); }
    DEV void gate_read(Pre& p, const LAS unsigned char* slot, int idx, int wc, int fr, int fq) const {
        const LAS unsigned char* q = slot + fr * 256 + (wc * 32 + 8 * fq) * 2;
        if (idx == 0) {
#pragma unroll
            for (int m = 0; m < 4; ++m) p.g[0][m] = *(const LAS u32x4*)(q + m * 16 * 256); }
        else {
#pragma unroll
            for (int m = 0; m < 4; ++m) p.g[1][m] = *(const LAS u32x4*)(q + m * 16 * 256); }
    }
    DEV void fold(f32x4 (&acc)[2][2][4][2], const Pre& p, const Unit& u, int wr, int wc, int fr, int fq) const {
        const int n = u.e;
#pragma unroll
        for (int ai = 0; ai < 2; ++ai)
#pragma unroll
            for (int m = 0; m < 4; ++m) { const u32x4 g = p.g[ai][m]; const f32x4 a0 = acc[ai][0][m][0], a1 = acc[ai][0][m][1];
                f32x4 t0, t1;
                t0[0] = a0[0] * bflo(g.x); t0[1] = a0[1] * bfhi(g.x); t0[2] = a0[2] * bflo(g.y); t0[3] = a0[3] * bfhi(g.y);
                t1[0] = a1[0] * bflo(g.z); t1[1] = a1[1] * bfhi(g.z); t1[2] = a1[2] * bflo(g.w); t1[3] = a1[3] * bfhi(g.w);
                if (n == 0) { acc[ai][1][m][0] = t0; acc[ai][1][m][1] = t1; } else { acc[ai][1][m][0] += t0; acc[ai][1][m][1] += t1; } }
        if (n == 3) { const int row0 = u.pm * BM + wr * 64 + fr, col0 = u.pn * HALF + wc * 32 + 8 * fq;
#pragma unroll
            for (int ai = 0; ai < 2; ++ai)
#pragma unroll
                for (int m = 0; m < 4; ++m) { const f32x4 v0 = acc[ai][1][m][0], v1 = acc[ai][1][m][1];
                    u32x4 w; w.x = pk2(v0[0], v0[1]); w.y = pk2(v0[2], v0[3]); w.z = pk2(v1[0], v1[1]); w.w = pk2(v1[2], v1[3]);
                    *(u32x4*)(GBF + (size_t)(row0 + ai * HALF + m * 16) * 1024 + col0) = w; } }
    }
};
struct BrOrder {
    static constexpr bool GATHER = false;
    static constexpr bool ROT = false;
    int G, c;
    DEV bool next(int i, Unit& u) const { const int x = c & 7, q = (c >> 3) + (i >> 2) * (G >> 3); if (q >= 64 || (G & 7)) { if (!(G & 7)) return false; const int tile = c + (i >> 2) * G; if (tile >= 512) return false; u.pm = tile >> 3; u.pn = tile & 7; }
        else { u.pm = x + 8 * (q >> 3); u.pn = q & 7; }
        u.e = i & 3; u.mt = 0; u.cnt = 256; return true; }
    DEV size_t boff(const Unit& u) const { return (size_t)(u.e * 1024 + u.pn * 128) * 256 * 2; }
    DEV unsigned aoff(const Unit& u) const { return (unsigned)(u.e * 256 * 2); }
    DEV unsigned arow(const Unit& u, int r) const { return (unsigned)(u.pm * BM + r); }
};
struct PlainOrder : StaticOrder {
    static constexpr bool GATHER = false;
    static constexpr bool ROT = true;
    DEV int rot(const Unit& u) const { return ((2 * u.pm + u.pn) & 7) * KROT; }
    DEV size_t boff(const Unit& u) const { return (size_t)u.pn * 256 * 1024 * 2; }
    DEV unsigned aoff(const Unit&) const { return 0u; }
    DEV unsigned arow(const Unit& u, int r) const { return (unsigned)(u.pm * BM + r); }
};
struct EpiBf16Out {
    struct Pre {};
    static constexpr bool PAIR16 = false, DRAINS = false;
    DEV const char* gate_base(const Unit&) const { return nullptr; }
    static constexpr bool PERM = true;
    bf16_t* C;
    DEV void operator()(const f32x4 (&acc)[2][2][4][2], const Unit& u, int wr, int wc, int fr, int fq) const {
        const int row0 = u.pm * BM + wr * 64 + fr, col0 = u.pn * BM + wc * 32 + 8 * fq;
#pragma unroll
        for (int ai = 0; ai < 2; ++ai)
#pragma unroll
            for (int m = 0; m < 4; ++m) { bf16_t* rowp = C + (size_t)(row0 + ai * HALF + m * 16) * 1024 + col0;
#pragma unroll
                for (int bj = 0; bj < 2; ++bj) { const f32x4 v0 = acc[ai][bj][m][0], v1 = acc[ai][bj][m][1];
                    u32x4 w; w.x = pk2(v0[0], v0[1]); w.y = pk2(v0[2], v0[3]); w.z = pk2(v1[0], v1[1]); w.w = pk2(v1[2], v1[3]); *(u32x4*)(rowp + bj * HALF) = w; } }
    }
};
template <int MODE> struct MoeOrder {
    static constexpr bool GATHER = (MODE == 1);
    static constexpr bool ROT = true;
    DEV int rot(const Unit& u) const { return u.pn * KROT; }
    const LAS unsigned* ul;
    const int* rowtk;
    DEV bool next(int i, Unit& u) const {
        const unsigned p = (unsigned)__builtin_amdgcn_readfirstlane((int)ul[i]); if (p == 0xffffffffu) return false;
        u.pn = (int)(p & 7u); u.e = (int)((p >> 3) & 31u); u.mt = (int)((p >> 8) & 127u); u.pm = (int)((p >> 15) & 511u); u.cnt = (int)(p >> 24) + 1; return true;
    }
    DEV size_t boff(const Unit& u) const { return MODE == 1 ? ((size_t)u.e * 2048 + u.pn * 256) * 1024 * 2 : ((size_t)u.e * 1024 + u.pn * 256) * 1024 * 2; }
    DEV unsigned aoff(const Unit&) const { return 0u; }
    DEV unsigned arow(const Unit& u, int r) const {
        if (MODE == 2) return (unsigned)(u.pm * 256 + r);
        return r < u.cnt ? (unsigned)(rowtk[(size_t)u.e * NT + u.mt * 256 + r] >> 2) : 0u;
    }
    DEV const int* idx_ptr(const Unit& u) const { return rowtk + (size_t)u.e * NT + u.mt * 256; }
    DEV unsigned arow_from(const Unit& u, int r, int ix) const { return r < u.cnt ? (unsigned)(ix >> 2) : 0u; }
};
struct EpiMoe1 {
    struct Pre {};
    DEV const char* gate_base(const Unit&) const { return nullptr; }
    static constexpr bool DRAINS = true;
    static constexpr bool PERM = true, PAIR16 = true;
    bf16_t* ACT; const float* b1;
    DEV void operator()(const f32x4 (&acc)[2][2][4][2], const Unit& u, int wr, int wc, int fr, int fq) const {
        const int row0 = u.pm * BM + wr * 64 + fr, q = 4 * wc + fq, hcol0 = u.pn * BM + 16 * q;
        const float* bp = b1 + (size_t)u.e * 2048 + hcol0;
        f32x4 bv[2][2];
#pragma unroll
        for (int bj = 0; bj < 2; ++bj)
#pragma unroll
            for (int n = 0; n < 2; ++n) bv[bj][n] = *(const f32x4*)(bp + 8 * bj + 4 * n);
        asm volatile("" :: "v"(bv[0][0]), "v"(bv[0][1]), "v"(bv[1][0]), "v"(bv[1][1]));
#pragma unroll
        for (int ai = 0; ai < 2; ++ai)
#pragma unroll
            for (int m = 0; m < 4; ++m) { bf16_t* rowp = ACT + (size_t)(row0 + ai * HALF + m * 16) * 1024 + (hcol0 >> 1);
                float o[8];
#pragma unroll
                for (int bj = 0; bj < 2; ++bj) { const f32x4 v0 = acc[ai][bj][m][0] + bv[bj][0], v1 = acc[ai][bj][m][1] + bv[bj][1];
#pragma unroll
                    for (int j = 0; j < 4; ++j) { const float hg = j < 2 ? v0[2 * j] : v1[2 * j - 4], hl = j < 2 ? v0[2 * j + 1] : v1[2 * j - 3];
                        const float glu = fminf(hg, 7.f), lin = fminf(fmaxf(hl, -7.f), 7.f); o[4 * bj + j] = glu * sigmoidf_(1.702f * glu) * (lin + 1.f); } }
                u32x4 w; w.x = pk2(o[0], o[1]); w.y = pk2(o[2], o[3]); w.z = pk2(o[4], o[5]); w.w = pk2(o[6], o[7]); *(u32x4*)rowp = w; }
    }
};
struct EpiMoe2 {
    struct Pre {};
    static constexpr bool PAIR16 = false, DRAINS = true;
    DEV const char* gate_base(const Unit&) const { return nullptr; }
    static constexpr bool PERM = true;
    bf16_t* Y; const float* b2; const int* rowtk;
    DEV void operator()(const f32x4 (&acc)[2][2][4][2], const Unit& u, int wr, int wc, int fr, int fq) const {
        const int col0 = u.pn * BM + wc * 32 + 8 * fq;
        const float* bp = b2 + (size_t)u.e * 1024 + col0;
        f32x4 bv[2][2];
#pragma unroll
        for (int bj = 0; bj < 2; ++bj)
#pragma unroll
            for (int n = 0; n < 2; ++n) bv[bj][n] = *(const f32x4*)(bp + bj * HALF + 4 * n);
        const int* rt = rowtk + (size_t)u.e * NT + u.mt * 256 + wr * 64 + fr;
        int dst[2][4];
#pragma unroll
        for (int ai = 0; ai < 2; ++ai)
#pragma unroll
            for (int m = 0; m < 4; ++m) dst[ai][m] = rt[ai * HALF + m * 16];
        asm volatile("" :: "v"(bv[0][0]), "v"(bv[0][1]), "v"(bv[1][0]), "v"(bv[1][1]), "v"(dst[0][0]), "v"(dst[0][1]), "v"(dst[0][2]), "v"(dst[0][3]), "v"(dst[1][0]), "v"(dst[1][1]), "v"(dst[1][2]), "v"(dst[1][3]));
#pragma unroll
        for (int ai = 0; ai < 2; ++ai)
#pragma unroll
            for (int m = 0; m < 4; ++m) { const int r = ai * HALF + wr * 64 + m * 16 + fr;
                if (r < u.cnt) { bf16_t* rowp = Y + (size_t)dst[ai][m] * 1024 + col0;
#pragma unroll
                    for (int bj = 0; bj < 2; ++bj) { const f32x4 v0 = acc[ai][bj][m][0] + bv[bj][0], v1 = acc[ai][bj][m][1] + bv[bj][1];
                        u32x4 w; w.x = pk2(v0[0], v0[1]); w.y = pk2(v0[2], v0[3]); w.z = pk2(v1[0], v1[1]); w.w = pk2(v1[2], v1[3]); *(u32x4*)(rowp + bj * HALF) = w; } } }
    }
};
}

struct Frame {
    LAS unsigned char* lds;
    volatile LAS unsigned* MISC;
    unsigned* ctl;
    unsigned char* ws;
    int tid, lane, wave, G, bid;
};
template <class T> DEV T* wsp(const Frame& F, size_t off) { return (T*)(F.ws + off); }
DEV void frame_refresh(Frame& F) {
    int t_ = threadIdx.x; asm volatile("" : "+v"(t_)); F.tid = t_; F.lane = t_ & 63; F.wave = __builtin_amdgcn_readfirstlane(t_ >> 6);
    unsigned long long w_ = (unsigned long long)F.ws; asm volatile("" : "+s"(w_)); F.ws = (unsigned char*)(GAS unsigned char*)w_; F.ctl = (unsigned*)F.ws;
}

struct IdMap { DEV int operator()(int i) const { return i; } };
struct HpColMap { DEV int operator()(int c) const { return hp_src_col(c); } };
struct CmpRowMap { DEV int operator()(int k) const { return (k & ~63) + perm16(k & 63); } };
template <class RM, class CM>
DEV void transpose_item(const float* W, int ldw, bf16_t* WT, int ldt, int k0, int n0, LAS float* scr, int lane, RM rm, CM cm) {
    const int nn = lane & 31; const int sc = cm(n0 + nn);
#pragma unroll 8
    for (int i = 0; i < 32; ++i) { const int kk = 2 * i + (lane >> 5); scr[kk * 33 + nn] = sc >= 0 ? W[(size_t)rm(k0 + kk) * ldw + sc] : 0.f; }
    LDS_WAIT(); asm volatile("" ::: "memory");
    const int c = lane & 7;
#pragma unroll
    for (int j = 0; j < 4; ++j) { const int n = (lane >> 3) + 8 * j; const LAS float* s = scr + (8 * c) * 33 + n;
        u32x4 o; o.x = pk2(s[0 * 33], s[1 * 33]); o.y = pk2(s[2 * 33], s[3 * 33]); o.z = pk2(s[4 * 33], s[5 * 33]); o.w = pk2(s[6 * 33], s[7 * 33]);
        *(u32x4*)(WT + (size_t)(n0 + n) * ldt + k0 + 8 * c) = o; }
    LDS_WAIT(); asm volatile("" ::: "memory");
}
struct TItem { const float* W; bf16_t* WT; int ldw, ldt, k0, n0, rmap; };
DEV void titem_load(const TItem& it, f32x4 (&v)[16], int lane) {
    const int nq = lane & 15, kr = lane >> 4;
    if (it.rmap == 2) { const int n = it.n0 + 4 * nq; const int c0 = hp_src_col(n), c1 = hp_src_col(n + 1), c2 = hp_src_col(n + 2), c3 = hp_src_col(n + 3);
        const bool quad = (c0 >= 0) && (c1 == c0 + 1) && (c2 == c0 + 2) && (c3 == c0 + 3);
#pragma unroll
        for (int i = 0; i < 16; ++i) { const float* rp = it.W + (size_t)(it.k0 + 4 * i + kr) * it.ldw;
            if (quad) v[i] = __builtin_nontemporal_load((const f32x4*)(rp + c0));
            else v[i] = (f32x4){c0 >= 0 ? rp[c0] : 0.f, c1 >= 0 ? rp[c1] : 0.f, c2 >= 0 ? rp[c2] : 0.f, c3 >= 0 ? rp[c3] : 0.f}; }
        return; }
#pragma unroll
    for (int i = 0; i < 16; ++i) { int k = it.k0 + 4 * i + kr; if (it.rmap) k = (k & ~63) + perm16(k & 63); v[i] = __builtin_nontemporal_load((const f32x4*)(it.W + (size_t)k * it.ldw + it.n0 + 4 * nq)); }
}
DEV void titem_store(const TItem& it, const f32x4 (&v)[16], LAS bf16_t* scr, int lane) {
    const int nq = lane & 15, kr = lane >> 4; constexpr int SP = 66;
#pragma unroll
    for (int i = 0; i < 16; ++i) { LAS unsigned* d = (LAS unsigned*)(scr + (4 * i + kr) * SP + 4 * nq); d[0] = pk2(v[i][0], v[i][1]); d[1] = pk2(v[i][2], v[i][3]); }
    LDS_WAIT(); asm volatile("" ::: "memory");
    const int c = lane & 7;
#pragma unroll
    for (int j = 0; j < 8; ++j) { const int n = (lane >> 3) + 8 * j; const LAS bf16_t* sp = scr + (8 * c) * SP + n;
        u32x4 o; o.x = sp[0] | ((unsigned)sp[SP] << 16); o.y = sp[2 * SP] | ((unsigned)sp[3 * SP] << 16); o.z = sp[4 * SP] | ((unsigned)sp[5 * SP] << 16); o.w = sp[6 * SP] | ((unsigned)sp[7 * SP] << 16);
        __builtin_nontemporal_store(o, (u32x4*)(it.WT + (size_t)(it.n0 + n) * it.ldt + it.k0 + 8 * c)); }
    LDS_WAIT(); asm volatile("" ::: "memory");
}
constexpr long BG_PER_LAYER = 32L * 512 + 32L * 256, BG_TOTAL = NL * BG_PER_LAYER;
DEV void bg_item(const Frame& F, const Params& P, long idx, LAS bf16_t* scr, int lane) {
    const int l = (int)(idx / BG_PER_LAYER); long r = idx - (long)l * BG_PER_LAYER; TItem it;
    if (r < 32L * 512) { const int mat = l * 32 + (int)(r >> 9), q = (int)(r & 511); it = TItem{P.in[I_WE1] + (size_t)mat * 1024 * 2048, wsp<bf16_t>(F, WS_W1) + (size_t)mat * 2048 * 1024, 2048, 1024, (q >> 5) * 64, (q & 31) * 64, 0}; }
    else { r -= 32L * 512; const int mat = l * 32 + (int)(r >> 8), q = (int)(r & 255); it = TItem{P.in[I_WE2] + (size_t)mat * 1024 * 1024, wsp<bf16_t>(F, WS_W2) + (size_t)mat * 1024 * 1024, 1024, 1024, (q >> 4) * 64, (q & 15) * 64, 0}; }
    f32x4 v[16]; titem_load(it, v, lane); titem_store(it, v, scr, lane);
}
constexpr int BG_CHUNK = 8, BG_FILL_STRIDE = 4;
DEV void bg_fill(Frame F, const Params& P, unsigned* done, long limit) {
    frame_refresh(F);
    unsigned* head = F.ctl + CW_BGQ; LAS bf16_t* scr = (LAS bf16_t*)(F.lds + F.wave * 16384); const int lane = F.lane;
    if (done && (F.wave % BG_FILL_STRIDE) != 0) return;
#pragma unroll 1
    for (;;) {
        if (done) { if ((unsigned)__builtin_amdgcn_readfirstlane(__hip_atomic_load(done, __ATOMIC_RELAXED, __HIP_MEMORY_SCOPE_AGENT)) >= (unsigned)F.G) break; }
        else { if ((long)(unsigned)__builtin_amdgcn_readfirstlane(__hip_atomic_load(head, __ATOMIC_RELAXED, __HIP_MEMORY_SCOPE_AGENT)) >= limit) break; }
        unsigned base = 0u; if (lane == 0) base = atomicAdd(head, (unsigned)BG_CHUNK);
        base = (unsigned)__builtin_amdgcn_readfirstlane(base);
        if ((long)base >= BG_TOTAL) break;
#pragma unroll 1
        for (int i = 0; i < BG_CHUNK; ++i) if ((long)base + i < BG_TOTAL) bg_item(F, P, (long)base + i, scr, lane);
    }
}
DEV void p0_prologue(Frame F, const Params& P) {
    frame_refresh(F);
    LAS float* scr = (LAS float*)(F.lds + F.wave * 16384);
    const int gw = F.bid * NWAVES + F.wave, NGW = F.G * NWAVES, lane = F.lane;
    LAS bf16_t* scrh = (LAS bf16_t*)scr;
    constexpr long I_E1 = 0, I_E2 = 0, I_BRI = (long)NL * 4 * 64, I_OI = (long)NL * 256, I_C1 = (long)NL * 2 * 32;
    constexpr long I_IN64 = (long)NL * 16 * 104;
    constexpr long N64 = I_E1 + I_E2 + I_BRI + I_OI + I_C1 + I_IN64;
#define P0_DECODE(it, r_) do { long r = (r_); \
        if (r < I_E1) { const int mat = (int)(r >> 9), q = (int)(r & 511); it = TItem{P.in[I_WE1] + (size_t)mat * 1024 * 2048, wsp<bf16_t>(F, WS_W1) + (size_t)mat * 2048 * 1024, 2048, 1024, (q >> 5) * 64, (q & 31) * 64, 0}; break; } \
        r -= I_E1; \
        if (r < I_E2) { const int mat = (int)(r >> 8), q = (int)(r & 255); it = TItem{P.in[I_WE2] + (size_t)mat * 1024 * 1024, wsp<bf16_t>(F, WS_W2) + (size_t)mat * 1024 * 1024, 1024, 1024, (q >> 4) * 64, (q & 15) * 64, 0}; break; } \
        r -= I_E2; \
        if (r < I_BRI) { const int mat = (int)(r >> 6), q = (int)(r & 63); it = TItem{P.in[I_WBR] + (size_t)mat * 256 * 1024, wsp<bf16_t>(F, WS_WBR) + (size_t)mat * 1024 * 256, 1024, 256, (q >> 4) * 64, (q & 15) * 64, 0}; break; } \
        r -= I_BRI; \
        if (r < I_OI) { const int l_ = (int)(r >> 8), q = (int)(r & 255); it = TItem{P.in[I_WO] + (size_t)l_ * 1024 * 1024, wsp<bf16_t>(F, WS_WO) + (size_t)l_ * 1024 * 1024, 1024, 1024, (q >> 4) * 64, (q & 15) * 64, 0}; break; } \
        r -= I_OI; \
        if (r < I_C1) { const int mat = (int)(r >> 5), l_ = mat >> 1, kv = mat & 1; it = TItem{P.in[kv ? I_W1V : I_W1K] + (size_t)l_ * 2048 * 64, wsp<bf16_t>(F, WS_WC1) + (size_t)mat * 64 * 2048, 64, 2048, (int)(r & 31) * 64, 0, kv == 0 ? 1 : 0}; break; } \
        r -= I_C1; \
        { const int l_ = (int)(r / (16 * 104)), q = (int)(r % (16 * 104)); it = TItem{P.in[I_WIN] + (size_t)l_ * 1024 * NIN, wsp<bf16_t>(F, WS_WIN) + (size_t)l_ * NP * 1024, NIN, 1024, (q / 104) * 64, (q % 104) * 64, 2}; } } while (0)
    { f32x4 va[16], vb[16]; TItem ia, ib; long it = gw;
        if (it < N64) { P0_DECODE(ia, it); titem_load(ia, va, lane); }
#pragma unroll 1
        for (; it < N64; it += 2 * (long)NGW) {
            const long i2 = it + NGW, i3 = it + 2 * (long)NGW;
            if (i2 < N64) { P0_DECODE(ib, i2); titem_load(ib, vb, lane); }
            titem_store(ia, va, scrh, lane);
            if (i3 < N64) { P0_DECODE(ia, i3); titem_load(ia, va, lane); }
            if (i2 < N64) titem_store(ib, vb, scrh, lane);
        } }
#undef P0_DECODE
    constexpr long I_C2 = (long)NL * 2 * 2;
    for (long it = gw; it < I_C2; it += NGW) { const long r = it;
        { const int mat = (int)(r >> 1), l = mat >> 1, kv = mat & 1, nb = (int)(r & 1);
            transpose_item(P.in[kv ? I_W2V : I_W2K] + (size_t)l * 64 * 64, 64, wsp<bf16_t>(F, WS_WC2) + (size_t)mat * 64 * 64, 64, 0, nb * 32, scr, lane, IdMap(), IdMap()); }
    }
    const int gt = F.bid * NTHR + F.tid, NGT = F.G * NTHR;
    {
        const float* ws_ = P.in[I_GWS]; bf16_t* wg = wsp<bf16_t>(F, WS_WG);
        for (int i = gt; i < NL * 4 * 128 * 128; i += NGT) { const int s = i & 127, t = (i >> 7) & 127; wg[i] = (s <= t) ? f2bf(ws_[i]) : (bf16_t)0; }
    }
    {
        float* bp = wsp<float>(F, WS_BIN);
        for (int i = gt; i < NL * NP; i += NGT) { const int l = i / NP, c = i % NP, sc = hp_src_col(c); bp[i] = sc >= 0 ? P.in[I_BIN][(size_t)l * NIN + sc] : 0.f; }
    }
    {
        float* cs = wsp<float>(F, WS_CS); const int* pos = (const int*)P.in[I_POS];
        for (int i = gt; i < NT * 8; i += NGT) { const int t = i >> 3, f = i & 7;
            const double ang = (double)pos[t] * P.invf[f];
            const double twopi = 6.283185307179586476925286766559; double r = ang - twopi * rint(ang / twopi);
            const double r2 = r * r; double sn = 0.0, cn = 0.0, term = r;
#pragma unroll 1
            for (int k = 1; k <= 29; k += 2) { sn += term; term *= -r2 / (double)((k + 1) * (k + 2)); }
            term = 1.0;
#pragma unroll 1
            for (int k = 0; k <= 28; k += 2) { cn += term; term *= -r2 / (double)((k + 1) * (k + 2)); }
            cs[(size_t)t * 16 + f] = (float)cn; cs[(size_t)t * 16 + 8 + f] = (float)sn; }
    }
    {
        const f32x4* x4 = (const f32x4*)P.in[I_X]; u32x2* xb = wsp<u32x2>(F, WS_XB);
        for (int i = gt; i < NT * 256; i += NGT) { const f32x4 v = x4[i]; u32x2 w; w.x = pk2(v[0], v[1]); w.y = pk2(v[2], v[3]); xb[i] = w; }
    }
    for (int task = gw; task < NL * 2 * 32; task += NGW) { const int lk = task >> 5, part = task & 31, l = lk >> 1, kv = lk & 1;
        const float* pe = P.in[kv ? I_PEV : I_PEK] + (size_t)l * 2048 + part * 64; const float* w1 = P.in[kv ? I_W1V : I_W1K] + ((size_t)l * 2048 + part * 64) * 64;
        float a = 0.f;
#pragma unroll 16
        for (int k = 0; k < 64; ++k) a += pe[k] * w1[(size_t)k * 64 + lane];
        wsp<float>(F, WS_CB)[task * 64 + lane] = a; }
}

DEV void pb_transpose_unit(Frame F, int unit) {
    frame_refresh(F);
    const int b = unit >> 6, t0 = (unit & 63) * 64; const int tid = F.tid;
    const bf16_t* H = wsp<bf16_t>(F, WS_H); const float* cs = wsp<float>(F, WS_CS);
    const size_t rowb = (size_t)b * SEQ + t0;
    LAS bf16_t* tile = (LAS bf16_t*)F.lds; constexpr int TP = 392;
    LAS unsigned* nmx = (LAS unsigned*)(F.lds + 65536);
    u32x4 rw[2]; f32x4 rc[2], rs[2]; u32x4 vw[6], kw[4];
#pragma unroll
    for (int it = 0; it < 2; ++it) { const int task = tid + it * NTHR, tok = task >> 4, hd = (task >> 3) & 1, ch = task & 7; const size_t row = rowb + tok;
        rw[it] = *(const u32x4*)(H + row * NP + (hd ? HP_KW : HP_KS) + ch * 8);
        const float* c = cs + row * 16 + 4 * (ch & 1); rc[it] = *(const f32x4*)c; rs[it] = *(const f32x4*)(c + 8); }
#pragma unroll
    for (int it = 0; it < 6; ++it) { const int task = tid + it * NTHR, tok = task / 48, ch = task % 48;
        const int scol = ch < 8 ? HP_VS + ch * 8 : (ch < 16 ? HP_VW + (ch - 8) * 8 : HP_FV + (ch - 16) * 8);
        vw[it] = *(const u32x4*)(H + (rowb + tok) * NP + scol); }
    { const int tok = tid >> 3, part = tid & 7;
#pragma unroll
        for (int q = 0; q < 4; ++q) kw[q] = *(const u32x4*)(H + (rowb + tok) * NP + HP_FK + part * 32 + q * 8); }
    if (tid < 4) nmx[tid] = 0u;
#pragma unroll
    for (int it = 0; it < 2; ++it) { const int task = tid + it * NTHR, tok = task >> 4, hd = (task >> 3) & 1, ch = task & 7; const size_t row = rowb + tok;
        u32x4 w = rw[it]; unsigned* wp = (unsigned*)&w;
#pragma unroll
        for (int j = 0; j < 4; ++j) { const float t1 = bflo(wp[j]), t2 = bfhi(wp[j]); const unsigned rot = pk2(t1 * rc[it][j] - t2 * rs[it][j], t2 * rc[it][j] + t1 * rs[it][j]); wp[j] = (ch < 2) ? rot : wp[j]; }
        *(u32x4*)(wsp<bf16_t>(F, WS_KNSA) + row * 128 + hd * 64 + ch * 8) = w; }
#pragma unroll
    for (int it = 0; it < 6; ++it) { const int task = tid + it * NTHR, tok = task / 48, ch = task % 48; const u32x4 w = vw[it];
        *(LAS u32x2*)(tile + tok * TP + ch * 8) = (u32x2){w.x, w.y}; *(LAS u32x2*)(tile + tok * TP + ch * 8 + 4) = (u32x2){w.z, w.w}; }
    __syncthreads();
    { const int part = tid & 7; float ss = 0.f;
#pragma unroll
        for (int q = 0; q < 4; ++q) { const unsigned* wp = (const unsigned*)&kw[q];
#pragma unroll
            for (int j = 0; j < 4; ++j) { const float a = bflo(wp[j]), c = bfhi(wp[j]); ss += a * a + c * c; } }
        ss += __shfl_xor(ss, 1);
        if ((part & 1) == 0) (void)__hip_atomic_fetch_max(nmx + (part >> 1), __float_as_uint(ss), __ATOMIC_RELAXED, __HIP_MEMORY_SCOPE_WORKGROUP); }
    bf16_t* VT = wsp<bf16_t>(F, WS_VT);
#pragma unroll
    for (int it = 0; it < 6; ++it) { const int task = tid + it * NTHR, d = task % 384, sc = task / 384;
        unsigned short v[8];
#pragma unroll
        for (int j = 0; j < 8; ++j) v[j] = tile[(sc * 8 + j) * TP + d];
        u32x4 w; w.x = v[0] | ((unsigned)v[1] << 16); w.y = v[2] | ((unsigned)v[3] << 16); w.z = v[4] | ((unsigned)v[5] << 16); w.w = v[6] | ((unsigned)v[7] << 16);
        *(u32x4*)(VT + ((size_t)b * 384 + d) * SEQ + t0 + sc * 8) = w; }
    __syncthreads();
    if (tid < 4) wsp<float>(F, WS_KN)[((size_t)b * 4 + tid) * 64 + (t0 >> 6)] = sqrtf(__uint_as_float(nmx[tid])) * 1.0001f;
    __syncthreads();
}
DEV void pb_cum_unit(Frame F, int unit) {
    frame_refresh(F);
    const int b = unit >> 2, h = unit & 3, tid = F.tid;
    const float* side = wsp<float>(F, WS_SIDE);
    LAS double* sc = (LAS double*)F.lds;
    double loc[8]; double s = 0.0;
#pragma unroll
    for (int j = 0; j < 8; ++j) { const float x = side[((size_t)b * SEQ + tid * 8 + j) * 16 + 12 + h];
        const float ls = fminf(x, 0.f) - __logf(1.f + __expf(-fabsf(x)));
        s += (double)ls; loc[j] = s; }
    double inc = s;
#pragma unroll
    for (int o = 1; o < 64; o <<= 1) { const double t = __shfl_up(inc, o); if (F.lane >= o) inc += t; }
    if (F.lane == 63) sc[F.wave] = inc;
    __syncthreads();
    double wbase = 0.0;
#pragma unroll
    for (int w = 0; w < 8; ++w) wbase += (w < F.wave) ? sc[w] : 0.0;
    __syncthreads();
    sc[8 + tid] = wbase + inc - s;
    const double base = sc[8 + tid]; float* cum = wsp<float>(F, WS_CUM) + ((size_t)b * 4 + h) * SEQ + tid * 8;
#pragma unroll
    for (int j = 0; j < 8; ++j) cum[j] = (float)((base + loc[j]) * 1.4426950408889634);
    __syncthreads();
}
DEV void pb_conv_unit(Frame F, const Params& P, int l, int unit) {
    frame_refresh(F);
    const int b = unit >> 6, t0 = (unit & 63) * 64, tid = F.tid, lane = F.lane, wave = F.wave;
    const bf16_t* H = wsp<bf16_t>(F, WS_H);
    float w[31]; { const float* cw = P.in[I_CW] + (size_t)l * 31 * 256 + (tid & 255);
#pragma unroll
        for (int j = 0; j < 31; ++j) w[j] = cw[j * 256]; }
    const float bias = P.in[I_CB][l * 256 + (tid & 255)];
    LAS bf16_t* xg = (LAS bf16_t*)F.lds;
    LAS float* cv = (LAS float*)(F.lds + 49152);
    { u32x4 wv[12];
#pragma unroll
        for (int it = 0; it < 12; ++it) { const int task = tid + it * NTHR, r = task >> 6, c4 = (task & 63) * 4; const int t = t0 - 30 + r;
            wv[it] = (task < 94 * 64 && t >= 0) ? *(const u32x4*)(H + ((size_t)b * SEQ + t) * NP + HP_CAB + 2 * c4) : (u32x4){0u, 0u, 0u, 0u}; }
#pragma unroll
        for (int it = 0; it < 12; ++it) { const int task = tid + it * NTHR, r = task >> 6, c4 = (task & 63) * 4;
            if (task < 94 * 64) { const unsigned* wp = (const unsigned*)&wv[it]; float g[4];
#pragma unroll
                for (int j = 0; j < 4; ++j) g[j] = bflo(wp[j]) * sigmoidf_(bfhi(wp[j]));
                *(LAS u32x2*)(xg + r * 256 + c4) = (u32x2){pk2(g[0], g[1]), pk2(g[2], g[3])}; } } }
    __syncthreads();
    { const int c = tid & 255, half = tid >> 8;
        float xw[62];
#pragma unroll
        for (int j = 0; j < 62; ++j) xw[j] = bf2f(xg[(half * 32 + j) * 256 + c]);
#pragma unroll
        for (int tt = 0; tt < 32; ++tt) { float a = bias;
#pragma unroll
            for (int j = 0; j < 31; ++j) a += w[j] * xw[tt + j];
            cv[(half * 32 + tt) * 256 + c] = a; } }
    __syncthreads();
    { const f32x4 gg = *(const f32x4*)(P.in[I_CLNG] + l * 256 + lane * 4), bb = *(const f32x4*)(P.in[I_CLNB] + l * 256 + lane * 4);
        bf16_t* BR = wsp<bf16_t>(F, WS_BR);
#pragma unroll 1
        for (int i = 0; i < 8; ++i) { const int tt = wave * 8 + i; f32x4 v = *(const LAS f32x4*)(cv + tt * 256 + lane * 4);
            const float mean = wave_sum((v[0] + v[1]) + (v[2] + v[3])) * (1.f / 256.f); v = v - mean;
            const float var = wave_sum((v[0] * v[0] + v[1] * v[1]) + (v[2] * v[2] + v[3] * v[3])) * (1.f / 256.f);
            const float rstd = 1.f / sqrtf(var + LN_EPS); v = v * rstd * gg + bb;
#pragma unroll
            for (int j = 0; j < 4; ++j) v[j] = v[j] * sigmoidf_(v[j]);
            u32x2 o; o.x = pk2(v[0], v[1]); o.y = pk2(v[2], v[3]);
            *(u32x2*)(BR + ((size_t)b * SEQ + t0 + tt) * 1024 + 768 + lane * 4) = o; } }
    __syncthreads();
}
DEV void pb_gmlp_unit(Frame F, const Params& P, int l, int unit) {
    frame_refresh(F);
    const int t0 = unit * 128, tid = F.tid, lane = F.lane, wave = F.wave, fr = lane & 15, fq = lane >> 4;
    const bf16_t* H = wsp<bf16_t>(F, WS_H);
    LAS bf16_t* vt = (LAS bf16_t*)F.lds; constexpr int VP = 136;
    { const f32x4 gg = *(const f32x4*)(P.in[I_GLNG] + l * 256 + lane * 4), bb = *(const f32x4*)(P.in[I_GLNB] + l * 256 + lane * 4);
        u32x2 wv[16];
#pragma unroll
        for (int i = 0; i < 16; ++i) wv[i] = *(const u32x2*)(H + (size_t)(t0 + wave * 16 + i) * NP + HP_GV + lane * 4);
#pragma unroll
        for (int i = 0; i < 16; ++i) { const int s = wave * 16 + i; const u32x2 w = wv[i];
            f32x4 v = {gelu_tanh(bflo(w.x)), gelu_tanh(bfhi(w.x)), gelu_tanh(bflo(w.y)), gelu_tanh(bfhi(w.y))};
            const float mean = wave_sum((v[0] + v[1]) + (v[2] + v[3])) * (1.f / 256.f); v = v - mean;
            const float var = wave_sum((v[0] * v[0] + v[1] * v[1]) + (v[2] * v[2] + v[3] * v[3])) * (1.f / 256.f);
            const float rstd = 1.f / sqrtf(var + LN_EPS); v = v * rstd * gg + bb;
#pragma unroll
            for (int j = 0; j < 4; ++j) vt[(lane * 4 + j) * VP + s] = f2bf(v[j]); } }
    __syncthreads();
    { const int g = wave & 3, th = wave >> 2;
        const bf16_t* Wg = wsp<bf16_t>(F, WS_WG) + ((size_t)l * 4 + g) * 128 * 128;
        bf16_t* BR = wsp<bf16_t>(F, WS_BR);
        bf16x8 wf[4][4]; u32x2 uw[4][4]; float bs[4];
#pragma unroll
        for (int tb = 0; tb < 4; ++tb) { const int trow = th * 64 + tb * 16;
#pragma unroll
            for (int ks = 0; ks < 4; ++ks) wf[tb][ks] = (ks * 32 <= trow + 15) ? *(const bf16x8*)(Wg + (size_t)(trow + fr) * 128 + ks * 32 + fq * 8) : (bf16x8){0, 0, 0, 0, 0, 0, 0, 0};
#pragma unroll
            for (int db = 0; db < 4; ++db) uw[tb][db] = *(const u32x2*)(H + (size_t)(t0 + trow + fr) * NP + HP_GU + g * 64 + db * 16 + fq * 4);
            bs[tb] = P.in[I_GBS][((size_t)l * 4 + g) * 128 + trow + fr]; }
#pragma unroll
        for (int tb = 0; tb < 4; ++tb) { const int trow = th * 64 + tb * 16;
            f32x4 acc[4];
#pragma unroll
            for (int db = 0; db < 4; ++db) acc[db] = (f32x4){0.f, 0.f, 0.f, 0.f};
#pragma unroll
            for (int ks = 0; ks < 4; ++ks) if (ks * 32 <= trow + 15) {
#pragma unroll
                for (int db = 0; db < 4; ++db) { const bf16x8 vf = *(const LAS bf16x8*)(vt + (g * 64 + db * 16 + fr) * VP + ks * 32 + fq * 8);
                    acc[db] = mfma16(vf, wf[tb][ks], acc[db]); } }
            const int t = t0 + trow + fr;
#pragma unroll
            for (int db = 0; db < 4; ++db) { const int c = g * 64 + db * 16 + fq * 4; const u32x2 u2 = uw[tb][db]; const float b_ = bs[tb];
                const float o0 = gelu_tanh(bflo(u2.x)) * (acc[db][0] + b_), o1 = gelu_tanh(bfhi(u2.x)) * (acc[db][1] + b_), o2 = gelu_tanh(bflo(u2.y)) * (acc[db][2] + b_), o3 = gelu_tanh(bfhi(u2.y)) * (acc[db][3] + b_);
                u32x2 o; o.x = pk2(o0, o1); o.y = pk2(o2, o3); *(u32x2*)(BR + (size_t)t * 1024 + 512 + c) = o; } } }
    __syncthreads();
}
DEV void pb_compress_unit(Frame F, int l, int unit) {
    frame_refresh(F);
    const int kv = unit & 1, mb = (unit >> 1) & 15, b = unit >> 5; const int tid = F.tid, lane = F.lane, wave = F.wave, fr = lane & 15, fq = lane >> 4;
    const bf16_t* H = wsp<bf16_t>(F, WS_H); const float* cs = wsp<float>(F, WS_CS);
    const bf16_t* W1 = wsp<bf16_t>(F, WS_WC1) + ((size_t)l * 2 + kv) * 64 * 2048; const bf16_t* W2 = wsp<bf16_t>(F, WS_WC2) + ((size_t)l * 2 + kv) * 64 * 64;
    const f32x4 cbv = *(const f32x4*)(wsp<float>(F, WS_CB) + ((size_t)l * 2 + kv) * 32 * 64 + tid * 4);
    LAS float* red = (LAS float*)F.lds;
    LAS bf16_t* h1 = (LAS bf16_t*)(F.lds + 32768);
    f32x4 acc[4];
#pragma unroll
    for (int nb = 0; nb < 4; ++nb) acc[nb] = (f32x4){0.f, 0.f, 0.f, 0.f};
    const int c = mb * 16 + fr;
    { u32x4 aw[8]; f32x4 cco[4], csi[4];
#pragma unroll
        for (int ks_ = 0; ks_ < 8; ++ks_) { const int ks = wave * 8 + ks_; const int j = ks >> 1, dch = (ks & 1) * 32 + fq * 8; int tok = c * 16 + j; tok = tok > SEQ - 1 ? SEQ - 1 : tok;
            const size_t row = (size_t)b * SEQ + tok;
            aw[ks_] = *(const u32x4*)(H + row * NP + (kv ? HP_VC : HP_KC) + dch);
            if ((ks_ & 1) == 0) { const float* cc = cs + row * 16 + ((fq & 1) * 4); cco[ks_ >> 1] = *(const f32x4*)cc; csi[ks_ >> 1] = *(const f32x4*)(cc + 8); } }
#pragma unroll
        for (int hb = 0; hb < 2; ++hb) { bf16x8 bw[4][4];
#pragma unroll
            for (int k4 = 0; k4 < 4; ++k4)
#pragma unroll
                for (int nb = 0; nb < 4; ++nb) bw[k4][nb] = *(const bf16x8*)(W1 + (size_t)(nb * 16 + fr) * 2048 + (wave * 8 + hb * 4 + k4) * 32 + fq * 8);
#pragma unroll
            for (int k4 = 0; k4 < 4; ++k4) { const int ks_ = hb * 4 + k4; u32x4 w = aw[ks_];
                if ((ks_ & 1) == 0) { const bool rp = (kv == 0) && (fq < 2); unsigned* wp = (unsigned*)&w; const f32x4 co = cco[ks_ >> 1], si = csi[ks_ >> 1];
#pragma unroll
                    for (int q = 0; q < 4; ++q) { const float t1 = bflo(wp[q]), t2 = bfhi(wp[q]); const unsigned rot = pk2(t1 * co[q] - t2 * si[q], t2 * co[q] + t1 * si[q]); wp[q] = rp ? rot : wp[q]; } }
                const bf16x8 af = __builtin_bit_cast(bf16x8, w);
#pragma unroll
                for (int nb = 0; nb < 4; ++nb) acc[nb] = mfma16(af, bw[k4][nb], acc[nb]); } } }
#pragma unroll
    for (int nb = 0; nb < 4; ++nb)
#pragma unroll
        for (int i = 0; i < 4; ++i) red[(wave * 16 + fq * 4 + i) * 64 + nb * 16 + fr] = acc[nb][i];
    __syncthreads();
    { LAS float* cbl = (LAS float*)(F.lds + 36864);
        *(LAS f32x4*)(cbl + tid * 4) = cbv;
        __syncthreads();
#pragma unroll
        for (int it = 0; it < 2; ++it) { const int e = tid + it * NTHR, r = e >> 6, n = e & 63; float s = 0.f;
#pragma unroll
            for (int pp = 0; pp < 32; ++pp) s += cbl[pp * 64 + n];
#pragma unroll
            for (int w = 0; w < 8; ++w) s += red[(w * 16 + r) * 64 + n];
            h1[r * 72 + n] = f2bf(gelu_tanh(s)); } }
    __syncthreads();
    if (wave == 0) {
#pragma unroll
        for (int nb = 0; nb < 4; ++nb) { f32x4 o = (f32x4){0.f, 0.f, 0.f, 0.f};
#pragma unroll
            for (int ks = 0; ks < 2; ++ks) { const bf16x8 hf = *(const LAS bf16x8*)(h1 + fr * 72 + ks * 32 + fq * 8); const bf16x8 wf = *(const bf16x8*)(W2 + (size_t)(nb * 16 + fr) * 64 + ks * 32 + fq * 8);
                o = kv ? mfma16(hf, wf, o) : mfma16(wf, hf, o); }
            u32x2 w; w.x = pk2(o[0], o[1]); w.y = pk2(o[2], o[3]);
            if (kv == 0) *(u32x2*)(wsp<bf16_t>(F, WS_KCMP) + ((size_t)b * 256 + mb * 16 + fr) * 64 + nb * 16 + fq * 4) = w;
            else *(u32x2*)(wsp<bf16_t>(F, WS_VCMPT) + ((size_t)b * 64 + nb * 16 + fr) * 256 + mb * 16 + fq * 4) = w; } }
    __syncthreads();
}

constexpr int TILE_B = 9216, AT_KT = 0, AT_VT = 36864, AT_CK = 73728, AT_KC = 0, AT_VC = 36864, AT_XCH = 0, AT_TAB = 32768, AT_FXT = 74752, AT_XST = 77824;
constexpr int KTP = 72, VCP = 264, TABP = 65;
constexpr float QSCALE = 0.125f * LOG2E;
struct FlashSt { float m, l; f32x4 o[4]; };
DEV void flash_init(FlashSt& s) { s.m = -1e30f; s.l = 0.f;
#pragma unroll
    for (int d = 0; d < 4; ++d) s.o[d] = (f32x4){0.f, 0.f, 0.f, 0.f}; }
DEV bf16x8 pack_p(const f32x4& a, const f32x4& b) { u32x4 w; w.x = pk2(a[0], a[1]); w.y = pk2(a[2], a[3]); w.z = pk2(b[0], b[1]); w.w = pk2(b[2], b[3]); return __builtin_bit_cast(bf16x8, w); }
DEV bf16x8 vfrag(const LAS bf16_t* p) { const bf16x4 lo = *(const LAS bf16x4*)p, hi = *(const LAS bf16x4*)(p + 16); return __builtin_shufflevector(lo, hi, 0, 1, 2, 3, 4, 5, 6, 7); }
struct KVFrags { bf16x8 k[4][2]; bf16x8 v[4][2]; };
DEV void load_frags(KVFrags& f, const LAS bf16_t* kt, const LAS bf16_t* vt, int fr, int fq) {
#pragma unroll
    for (int kb = 0; kb < 4; ++kb) { const LAS bf16_t* kp = kt + (16 * kb + fr) * KTP + 8 * fq; f.k[kb][0] = *(const LAS bf16x8*)kp; f.k[kb][1] = *(const LAS bf16x8*)(kp + 32); }
#pragma unroll
    for (int d = 0; d < 4; ++d)
#pragma unroll
        for (int c = 0; c < 2; ++c) f.v[d][c] = vfrag(vt + (16 * d + fr) * KTP + 32 * c + 4 * fq);
}
DEV void qk_frags(f32x4 (&s)[4], const KVFrags& f, const bf16x8 (&qf)[2]) {
#pragma unroll
    for (int kb = 0; kb < 4; ++kb) { f32x4 a = mfma16(f.k[kb][0], qf[0], (f32x4){0.f, 0.f, 0.f, 0.f}); s[kb] = mfma16(f.k[kb][1], qf[1], a); }
}
DEV void flash_update(FlashSt& st, f32x4 (&s)[4], const KVFrags& f, bool on) {
    float mx = fmaxf(fmaxf(fmaxf(s[0][0], s[0][1]), fmaxf(s[0][2], s[0][3])), fmaxf(fmaxf(s[1][0], s[1][1]), fmaxf(s[1][2], s[1][3])));
    mx = fmaxf(mx, fmaxf(fmaxf(fmaxf(s[2][0], s[2][1]), fmaxf(s[2][2], s[2][3])), fmaxf(fmaxf(s[3][0], s[3][1]), fmaxf(s[3][2], s[3][3]))));
    mx = on ? mx : -INFINITY;
    mx = xr_max(mx);
    const float mn = fmaxf(st.m, mx), alpha = fexp2(st.m - mn); st.m = mn;
    const float mref = on ? mn : INFINITY;
    float sum = 0.f;
#pragma unroll
    for (int kb = 0; kb < 4; ++kb)
#pragma unroll
        for (int i = 0; i < 4; ++i) { const float p = fexp2(s[kb][i] - mref); s[kb][i] = p; sum += p; }
    st.l = st.l * alpha + sum;
#pragma unroll
    for (int d = 0; d < 4; ++d) st.o[d] = st.o[d] * alpha;
#pragma unroll
    for (int c = 0; c < 2; ++c) { const bf16x8 pf = pack_p(s[2 * c], s[2 * c + 1]);
#pragma unroll
        for (int d = 0; d < 4; ++d) st.o[d] = mfma16(f.v[d][c], pf, st.o[d]); }
}
DEV float flash_inv_l(const FlashSt& st) { const float l = xr_sum(st.l); return l > 0.f ? 1.f / l : 0.f; }
DEV bf16x8 load_q(const bf16_t* p, const float* c, bool rope, float scale) {
    u32x4 w = *(const u32x4*)p; unsigned* wp = (unsigned*)&w;
    f32x4 co = {1.f, 1.f, 1.f, 1.f}, si = {0.f, 0.f, 0.f, 0.f};
    if (c) { co = *(const f32x4*)c; si = *(const f32x4*)(c + 8); }
#pragma unroll
    for (int j = 0; j < 4; ++j) { const float t1 = bflo(wp[j]), t2 = bfhi(wp[j]);
        const float a = rope ? t1 * co[j] - t2 * si[j] : t1, bq = rope ? t2 * co[j] + t1 * si[j] : t2;
        wp[j] = pk2(a * scale, bq * scale); }
    return __builtin_bit_cast(bf16x8, w);
}
struct TileRegs { u32x4 k, v; };
DEV void tile_load(TileRegs& r, const bf16_t* kbase, size_t kpitch, const bf16_t* vtbase, int key0, int tid) {
    r.k = *(const u32x4*)(kbase + (size_t)(key0 + (tid >> 3)) * kpitch + (tid & 7) * 8);
    r.v = *(const u32x4*)(vtbase + (size_t)(tid >> 3) * SEQ + key0 + (tid & 7) * 8);
}
DEV void tile_store(const TileRegs& r, LAS bf16_t* kt, LAS bf16_t* vt, int tid) {
    *(LAS u32x4*)(kt + (tid >> 3) * KTP + (tid & 7) * 8) = r.k; *(LAS u32x4*)(vt + (tid >> 3) * KTP + (tid & 7) * 8) = r.v;
}

DEV void nsa_unit(Frame F, int b, int qt, int half) {
    frame_refresh(F);
    const int tid = F.tid, lane = F.lane, wave = F.wave, fr = lane & 15, fq = lane >> 4, sq = wave & 1, hp = (wave >> 1) & 1, ks = wave >> 2, head = 2 * hp + ks, qid = wave >> 1;
    const int ql = 32 * half + 16 * sq + fr, tq = qt * 64 + ql, cur = qt; const size_t rowq = (size_t)b * SEQ + tq;
    const bf16_t* H = wsp<bf16_t>(F, WS_H); const float* cs = wsp<float>(F, WS_CS); const float* side = wsp<float>(F, WS_SIDE);
    LAS bf16_t* KT = (LAS bf16_t*)(F.lds + AT_KT); LAS bf16_t* VT = (LAS bf16_t*)(F.lds + AT_VT);
    LAS bf16_t* KC = (LAS bf16_t*)(F.lds + AT_KC); LAS bf16_t* VC = (LAS bf16_t*)(F.lds + AT_VC);
    bf16x8 qf2[2][2], qf[2]; float gate[3];
#pragma unroll
    for (int hh = 0; hh < 2; ++hh)
#pragma unroll
        for (int dc = 0; dc < 2; ++dc) qf2[hh][dc] = load_q(H + rowq * NP + HP_NQ + (2 * hp + hh) * 64 + 32 * dc + 8 * fq, cs + rowq * 16 + 4 * (fq & 1), dc == 0 && fq < 2, QSCALE);
#pragma unroll
    for (int dc = 0; dc < 2; ++dc) qf[dc] = ks ? qf2[1][dc] : qf2[0][dc];
#pragma unroll
    for (int i = 0; i < 3; ++i) gate[i] = sigmoidf_(side[rowq * 16 + head * 3 + i]);
    { const bf16_t* kc = wsp<bf16_t>(F, WS_KCMP) + (size_t)b * 256 * 64; const bf16_t* vc = wsp<bf16_t>(F, WS_VCMPT) + (size_t)b * 64 * 256;
#pragma unroll
        for (int it = 0; it < 4; ++it) { const int id = tid + it * NTHR;
            *(LAS u32x4*)(KC + (id >> 3) * KTP + (id & 7) * 8) = *(const u32x4*)(kc + (size_t)id * 8);
            *(LAS u32x4*)(VC + (id >> 5) * VCP + (id & 31) * 8) = *(const u32x4*)(vc + (size_t)id * 8); } }
    __syncthreads();
    f32x4 res[4]; float imp[16];
    const int nkb = (4 * qt + 2 * half) / 16 + 1;
    const int cl = (tq - 31) >> 4;
    const int srcl = (lane - 16) & 63;
    {
        f32x4 sc[16]; float mx = -1e30f;
#pragma unroll
        for (int kb = 0; kb < 16; ++kb) {
            if (kb < nkb) { const LAS bf16_t* kp = KC + (16 * kb + fr) * KTP + 8 * fq;
                f32x4 a = mfma16(*(const LAS bf16x8*)kp, qf[0], (f32x4){0.f, 0.f, 0.f, 0.f}); a = mfma16(*(const LAS bf16x8*)(kp + 32), qf[1], a);
#pragma unroll
                for (int i = 0; i < 4; ++i) { a[i] = (16 * kb + 4 * fq + i <= cl) ? a[i] : -INFINITY; mx = fmaxf(mx, a[i]); }
                sc[kb] = a; }
            else sc[kb] = (f32x4){-INFINITY, -INFINITY, -INFINITY, -INFINITY}; }
        mx = xr_max(mx);
        float sum = 0.f;
#pragma unroll
        for (int kb = 0; kb < 16; ++kb) if (kb < nkb) {
#pragma unroll
            for (int i = 0; i < 4; ++i) { const float p = fexp2(sc[kb][i] - mx); sc[kb][i] = p; sum += p; } }
        else sc[kb] = (f32x4){0.f, 0.f, 0.f, 0.f};
        sum = xr_sum(sum);
        const float inv = sum > 0.f ? 1.f / sum : 0.f;
        f32x4 o[4];
#pragma unroll
        for (int d = 0; d < 4; ++d) o[d] = (f32x4){0.f, 0.f, 0.f, 0.f};
        float prevx = 0.f;
#pragma unroll
        for (int kb = 0; kb < 16; ++kb) { if (kb < nkb) { sc[kb] = sc[kb] * inv; const float x = __shfl(sc[kb][3], srcl);
                imp[kb] = ((sc[kb][0] + sc[kb][1]) + (sc[kb][2] + sc[kb][3])) + (fq > 0 ? x : prevx); prevx = x; }
            else imp[kb] = 0.f; }
#pragma unroll
        for (int cc = 0; cc < 8; ++cc) if (2 * cc < nkb) { const bf16x8 pf = pack_p(sc[2 * cc], sc[2 * cc + 1]);
#pragma unroll
            for (int d = 0; d < 4; ++d) o[d] = mfma16(vfrag(VC + (16 * d + fr) * VCP + 32 * cc + 4 * fq), pf, o[d]); }
#pragma unroll
        for (int d = 0; d < 4; ++d) res[d] = o[d] * gate[0];
    }
    unsigned mlo, mhi;
    if (cur < 16) { mlo = (2u << cur) - 1u; mhi = 0u; }
    else {
        LAS float* XCH = (LAS float*)(F.lds + AT_XCH); LAS float* TAB = (LAS float*)(F.lds + AT_TAB) + (wave * 16 + fr) * TABP;
        __syncthreads();
#pragma unroll
        for (int kb = 0; kb < 16; ++kb) XCH[(wave * 16 + kb) * 64 + lane] = imp[kb];
        __syncthreads();
#pragma unroll
        for (int kb = 0; kb < 16; ++kb) { const int j = 4 * kb + fq;
            float v = (XCH[((0 + sq) * 16 + kb) * 64 + lane] + XCH[((2 + sq) * 16 + kb) * 64 + lane]) + (XCH[((4 + sq) * 16 + kb) * 64 + lane] + XCH[((6 + sq) * 16 + kb) * 64 + lane]);
            const bool forced = (j == 0) || (j == cur) || (j == cur - 1);
            v = forced ? 1e9f : (j <= cur ? v : -1.f); imp[kb] = v; TAB[j] = v; }
        LDS_WAIT();
        int cnt[4];
#pragma unroll
        for (int k4 = 0; k4 < 4; ++k4) cnt[k4] = 0;
        float myv[4];
#pragma unroll
        for (int k4 = 0; k4 < 4; ++k4) myv[k4] = qid == 0 ? imp[k4] : (qid == 1 ? imp[4 + k4] : (qid == 2 ? imp[8 + k4] : imp[12 + k4]));
#pragma unroll 4
        for (int jj = 0; jj < 64; ++jj) { const float vv = TAB[jj];
#pragma unroll
            for (int k4 = 0; k4 < 4; ++k4) { const int j = 4 * (4 * qid + k4) + fq; cnt[k4] += ((vv > myv[k4]) || (vv == myv[k4] && jj < j)) ? 1 : 0; } }
        mlo = 0u; mhi = 0u;
#pragma unroll
        for (int k4 = 0; k4 < 4; ++k4) { const int j = 4 * (4 * qid + k4) + fq; const unsigned bit = (cnt[k4] < 16 && j <= cur) ? 1u : 0u; if (j < 32) mlo |= bit << (j & 31); else mhi |= bit << (j & 31); }
        mlo = xr_or(mlo); mhi = xr_or(mhi);
        LAS unsigned* MSK = (LAS unsigned*)(F.lds + AT_CK);
        if (fq == 0) { MSK[(wave * 16 + fr) * 2] = mlo; MSK[(wave * 16 + fr) * 2 + 1] = mhi; }
        __syncthreads();
        mlo = (MSK[((0 + sq) * 16 + fr) * 2] | MSK[((2 + sq) * 16 + fr) * 2]) | (MSK[((4 + sq) * 16 + fr) * 2] | MSK[((6 + sq) * 16 + fr) * 2]);
        mhi = (MSK[((0 + sq) * 16 + fr) * 2 + 1] | MSK[((2 + sq) * 16 + fr) * 2 + 1]) | (MSK[((4 + sq) * 16 + fr) * 2 + 1] | MSK[((6 + sq) * 16 + fr) * 2 + 1]);
    }
    __syncthreads();
#pragma unroll 1
    for (int br = 0; br < 2; ++br) {
        const bf16_t* kbase = wsp<bf16_t>(F, WS_KNSA) + (size_t)b * SEQ * 128 + br * 64;
        const bf16_t* vtb = wsp<bf16_t>(F, WS_VT) + ((size_t)b * 384 + br * 64) * SEQ;
        const int j0 = br == 0 ? 0 : (qt > 8 ? qt - 8 : 0);
        const int np = (cur - j0 + 2) >> 1;
        FlashSt st2[2]; flash_init(st2[0]); flash_init(st2[1]);
        TileRegs ra[2], rb[2];
#define NSA_LOADP(R, p) do { _Pragma("unroll") for (int tt_ = 0; tt_ < 2; ++tt_) { const int j_ = j0 + 2 * (p) + tt_; if (j_ <= cur) tile_load(R[tt_], kbase, 128, vtb, j_ * 64, tid); } } while (0)
#define NSA_STOREP(R, p, buf) do { _Pragma("unroll") for (int tt_ = 0; tt_ < 2; ++tt_) { const int j_ = j0 + 2 * (p) + tt_; if (j_ <= cur) tile_store(R[tt_], KT + ((buf) * 2 + tt_) * 64 * KTP, VT + ((buf) * 2 + tt_) * 64 * KTP, tid); } } while (0)
#define NSA_COMPP(p, buf) do { const int j = j0 + 2 * (p) + ks; if (j <= cur) { \
            const LAS bf16_t* kt = KT + ((buf) * 2 + ks) * 64 * KTP; const LAS bf16_t* vt = VT + ((buf) * 2 + ks) * 64 * KTP; \
            const bool on = (br == 0) ? (((j < 32 ? (mlo >> j) : (mhi >> (j - 32))) & 1u) != 0u) : true; \
            if (__any(on)) { KVFrags fg; load_frags(fg, kt, vt, fr, fq); asm volatile("" ::: "memory"); \
                const bool edge = (j == cur) || (br == 1 && j == qt - 8); const int hi = (j == cur) ? ql : 63, lo = (br == 1 && j == qt - 8) ? ql : -1; \
                _Pragma("unroll") for (int hh = 0; hh < 2; ++hh) { f32x4 s[4]; qk_frags(s, fg, qf2[hh]); \
                    if (edge) { _Pragma("unroll") for (int kb = 0; kb < 4; ++kb) _Pragma("unroll") for (int i = 0; i < 4; ++i) { const int kl = 16 * kb + 4 * fq + i; s[kb][i] = (kl <= hi && kl > lo) ? s[kb][i] : -INFINITY; } } \
                    flash_update(st2[hh], s, fg, on); } } } } while (0)
        NSA_LOADP(ra, 0); NSA_LOADP(rb, 1);
#pragma unroll 1
        for (int p = 0; p < np; p += 2) {
            NSA_STOREP(ra, p, 0); __syncthreads(); NSA_LOADP(ra, p + 2); NSA_COMPP(p, 0);
            if (p + 1 < np) { NSA_STOREP(rb, p + 1, 1); __syncthreads(); NSA_LOADP(rb, p + 3); NSA_COMPP(p + 1, 1); }
        }
#undef NSA_LOADP
#undef NSA_STOREP
#undef NSA_COMPP
        { LAS float* XS = (LAS float*)(F.lds + AT_XST) + wave * (18 * 64) + lane;
            XS[0] = ks ? st2[0].m : st2[1].m; XS[64] = ks ? st2[0].l : st2[1].l;
#pragma unroll
            for (int d = 0; d < 4; ++d)
#pragma unroll
                for (int i = 0; i < 4; ++i) XS[(2 + 4 * d + i) * 64] = ks ? st2[0].o[d][i] : st2[1].o[d][i];
            __syncthreads();
            const LAS float* XP = (const LAS float*)(F.lds + AT_XST) + (wave ^ 4) * (18 * 64) + lane;
            FlashSt st; st.m = ks ? st2[1].m : st2[0].m; st.l = ks ? st2[1].l : st2[0].l;
#pragma unroll
            for (int d = 0; d < 4; ++d) st.o[d] = ks ? st2[1].o[d] : st2[0].o[d];
            const float mb = XP[0], lb = XP[64]; const float m = fmaxf(st.m, mb), fa = fexp2(st.m - m), fb = fexp2(mb - m);
            st.l = st.l * fa + lb * fb;
#pragma unroll
            for (int d = 0; d < 4; ++d)
#pragma unroll
                for (int i = 0; i < 4; ++i) st.o[d][i] = st.o[d][i] * fa + XP[(2 + 4 * d + i) * 64] * fb;
            const float sc = flash_inv_l(st) * (br == 0 ? gate[1] : gate[2]);
#pragma unroll
            for (int d = 0; d < 4; ++d) res[d] += st.o[d] * sc; }
        __syncthreads();
    }
    bf16_t* BR = wsp<bf16_t>(F, WS_BR);
#pragma unroll
    for (int d = 0; d < 4; ++d) { u32x2 w; w.x = pk2(res[d][0], res[d][1]); w.y = pk2(res[d][2], res[d][3]);
        *(u32x2*)(BR + rowq * 1024 + head * 64 + 16 * d + 4 * fq) = w; }
}

DEV void fox_unit(Frame F, int b, int h, int qb) {
    frame_refresh(F);
    const int tid = F.tid, lane = F.lane, wave = F.wave, fr = lane & 15, fq = lane >> 4;
    const int q0 = qb * 256, qw = q0 + 32 * wave;
    const bf16_t* H = wsp<bf16_t>(F, WS_H); const float* cum = wsp<float>(F, WS_CUM) + ((size_t)b * 4 + h) * SEQ;
    LAS bf16_t* KT = (LAS bf16_t*)(F.lds + AT_KT); LAS bf16_t* VT = (LAS bf16_t*)(F.lds + AT_VT); LAS float* CK = (LAS float*)(F.lds + AT_CK);
    LAS float* KNP = (LAS float*)(F.lds + AT_FXT); LAS float* CKL = KNP + 64; LAS float* WMIN = KNP + 128; LAS float* WQN = KNP + 136;
    const float cref = cum[q0];
    bf16x8 qf[2][2]; float qn2 = 0.f;
#pragma unroll
    for (int sb = 0; sb < 2; ++sb) { float ss = 0.f;
#pragma unroll
        for (int dc = 0; dc < 2; ++dc) { qf[sb][dc] = load_q(H + ((size_t)b * SEQ + qw + 16 * sb + fr) * NP + HP_FQ + h * 64 + 32 * dc + 8 * fq, nullptr, false, QSCALE);
            const u32x4 w = __builtin_bit_cast(u32x4, qf[sb][dc]); const unsigned* wp = (const unsigned*)&w;
#pragma unroll
            for (int j = 0; j < 4; ++j) { const float a = bflo(wp[j]), c = bfhi(wp[j]); ss += a * a + c * c; } }
        ss = xr_sum(ss); qn2 = fmaxf(qn2, ss); }
#pragma unroll
    for (int o = 1; o < 16; o <<= 1) qn2 = fmaxf(qn2, __shfl_xor(qn2, o));
    if (lane == 0) WQN[wave] = sqrtf(qn2) * 1.0001f;
    if (tid < 64) {
        float kn = wsp<float>(F, WS_KN)[((size_t)b * 4 + h) * 64 + tid];
#pragma unroll
        for (int o = 1; o < 64; o <<= 1) { const float t = __shfl_up(kn, o); if (tid >= o) kn = fmaxf(kn, t); }
        KNP[tid] = kn; CKL[tid] = cum[64 * tid + 63] - cref; }
    const bf16_t* kbase = H + (size_t)b * SEQ * NP + HP_FK + h * 64; const bf16_t* vtb = wsp<bf16_t>(F, WS_VT) + ((size_t)b * 384 + 128 + h * 64) * SEQ;
    FlashSt st[2]; flash_init(st[0]); flash_init(st[1]);
    __syncthreads();
    int np = 2;
    { float qn = WQN[0];
#pragma unroll
        for (int w = 1; w < 8; ++w) qn = fmaxf(qn, WQN[w]);
        const float wk = wsp<float>(F, WS_KN)[((size_t)b * 4 + h) * 64 + 4 * qb + (lane & 3)];
        float kown = fmaxf(wk, __shfl_xor(wk, 1)); kown = fmaxf(kown, __shfl_xor(kown, 2)); kown = __shfl(kown, 0);
        const float thr = -qn * kown - 40.f;
#pragma unroll 1
        for (int Jn = 4 * qb - 1; Jn >= 0; Jn -= 2) { if (qn * KNP[Jn] - CKL[Jn] < thr) break; ++np; } }
    np = __builtin_amdgcn_readfirstlane(np);
#define FOX_TILE(p, tt) ((p) < 2 ? 4 * qb + 2 * (p) + (tt) : 4 * qb - 1 - 2 * ((p) - 2) - (tt))
    TileRegs ra[2], rb[2]; f32x4 cka[2], ckb[2];
#define FOX_LOADP(R, C, p) do { if ((p) < np) { _Pragma("unroll") for (int tt_ = 0; tt_ < 2; ++tt_) { const int j_ = FOX_TILE(p, tt_); if (j_ >= 0) { tile_load(R[tt_], kbase, NP, vtb, j_ * 64, tid); if (tid < 16) C[tt_] = *(const f32x4*)(cum + j_ * 64 + 4 * tid); } } } } while (0)
#define FOX_STOREP(R, C, p, buf) do { _Pragma("unroll") for (int tt_ = 0; tt_ < 2; ++tt_) { const int j_ = FOX_TILE(p, tt_); if (j_ >= 0) { tile_store(R[tt_], KT + ((buf) * 2 + tt_) * 64 * KTP, VT + ((buf) * 2 + tt_) * 64 * KTP, tid); \
            if (tid < 16) *(LAS f32x4*)(CK + ((buf) * 2 + tt_) * 64 + 4 * tid) = C[tt_] - cref; } } } while (0)
#define FOX_COMPP(p, buf) do { _Pragma("unroll") for (int tt_ = 0; tt_ < 2; ++tt_) { const int J = FOX_TILE(p, tt_); const int key0 = 64 * J; if (J >= 0 && key0 <= qw + 31) { \
            const LAS bf16_t* kt = KT + ((buf) * 2 + tt_) * 64 * KTP; const LAS bf16_t* vt = VT + ((buf) * 2 + tt_) * 64 * KTP; const LAS float* ck = CK + ((buf) * 2 + tt_) * 64; \
            KVFrags fg; load_frags(fg, kt, vt, fr, fq); \
            f32x4 dk[4]; _Pragma("unroll") for (int kb = 0; kb < 4; ++kb) dk[kb] = *(const LAS f32x4*)(ck + 16 * kb + 4 * fq); \
            asm volatile("" ::: "memory"); \
            const bool diag = key0 + 63 > qw; \
            _Pragma("unroll") for (int sb = 0; sb < 2; ++sb) { f32x4 s[4]; qk_frags(s, fg, qf[sb]); const int qa = qw + 16 * sb + fr; \
                _Pragma("unroll") for (int kb = 0; kb < 4; ++kb) { s[kb] = s[kb] - dk[kb]; \
                    if (diag) { _Pragma("unroll") for (int i = 0; i < 4; ++i) s[kb][i] = (key0 + 16 * kb + 4 * fq + i <= qa) ? s[kb][i] : -INFINITY; } } \
                flash_update(st[sb], s, fg, true); } } } } while (0)
    FOX_LOADP(ra, cka, 0); FOX_LOADP(rb, ckb, 1);
#pragma unroll 1
    for (int p = 0; p < np; p += 2) {
        FOX_STOREP(ra, cka, p, 0); __syncthreads(); FOX_LOADP(ra, cka, p + 2); FOX_COMPP(p, 0);
        if (p + 1 < np) { FOX_STOREP(rb, ckb, p + 1, 1); __syncthreads(); FOX_LOADP(rb, ckb, p + 3); FOX_COMPP(p + 1, 1); }
    }
#undef FOX_TILE
#undef FOX_LOADP
#undef FOX_STOREP
#undef FOX_COMPP
    bf16_t* BR = wsp<bf16_t>(F, WS_BR);
#pragma unroll
    for (int sb = 0; sb < 2; ++sb) { const float sc = flash_inv_l(st[sb]); const size_t row = (size_t)b * SEQ + qw + 16 * sb + fr;
#pragma unroll
        for (int d = 0; d < 4; ++d) { const f32x4 o = st[sb].o[d] * sc; u32x2 w; w.x = pk2(o[0], o[1]); w.y = pk2(o[2], o[3]);
            *(u32x2*)(BR + row * 1024 + 256 + h * 64 + 16 * d + 4 * fq) = w; } }
    __syncthreads();
}

DEV void ln1_router_phase(Frame F, const Params& P, int l) {
    frame_refresh(F);
    const int tid = F.tid, lane = F.lane, wave = F.wave, fr = lane & 15, fq = lane >> 4;
    LAS float* xs = (LAS float*)F.lds;
    LAS float* part = (LAS float*)(F.lds + 69632);
    constexpr int XP = 1028;
    const bf16_t* mix = wsp<bf16_t>(F, WS_MIX); bf16_t* xb = wsp<bf16_t>(F, WS_XB);
    const float* g1 = P.in[I_LN1G] + (size_t)l * 1024; const float* b1 = P.in[I_LN1B] + (size_t)l * 1024;
    float wf[2][32];
    { const float* wr = P.in[I_WR] + (size_t)l * 1024 * 32 + (size_t)(128 * wave + 32 * fq) * 32 + fr;
#pragma unroll
        for (int s_ = 0; s_ < 32; ++s_) { wf[0][s_] = wr[s_ * 32]; wf[1][s_] = wr[s_ * 32 + 16]; } }
    const float brt = P.in[I_BR][l * 32 + (tid & 31)];
    unsigned* cnt = F.ctl + CW_CNT + l * 32 * 64; int* rowtk = wsp<int>(F, WS_ROWTK); float* tokw = wsp<float>(F, WS_TOKW);
    LAS unsigned* lcnt = (LAS unsigned*)(F.lds + 90112);
    LAS unsigned* lsel = lcnt + 64;
    if (tid < 64) lcnt[tid] = 0u;
    int nsel = 0;
    __syncthreads();
    u32x4 va[2][2], vm[2][2];
    f32x4 gg1[2][2], bb1[2][2];
#pragma unroll
    for (int j = 0; j < 2; ++j)
#pragma unroll
        for (int h = 0; h < 2; ++h) { gg1[j][h] = *(const f32x4*)(g1 + j * 512 + lane * 8 + 4 * h); bb1[j][h] = *(const f32x4*)(b1 + j * 512 + lane * 8 + 4 * h); }
    int unit = F.bid;
    if (unit < NT / 16) {
#pragma unroll
        for (int i = 0; i < 2; ++i)
#pragma unroll
            for (int j = 0; j < 2; ++j) { const size_t o = (size_t)(unit * 16 + wave * 2 + i) * 1024 + j * 512 + lane * 8; va[i][j] = *(const u32x4*)(xb + o); vm[i][j] = *(const u32x4*)(mix + o); } }
#pragma unroll 1
    for (; unit < NT / 16; unit += F.G) {
        const int r0 = unit * 16;
#pragma unroll
        for (int i = 0; i < 2; ++i) { const int r = wave * 2 + i; const size_t row = (size_t)(r0 + r);
            f32x4 v[2][2]; float s = 0.f;
#pragma unroll
            for (int j = 0; j < 2; ++j) { const unsigned* xp_ = (const unsigned*)&va[i][j]; const unsigned* mp_ = (const unsigned*)&vm[i][j];
#pragma unroll
                for (int h = 0; h < 2; ++h) { const f32x4 xa = {bflo(xp_[2 * h]), bfhi(xp_[2 * h]), bflo(xp_[2 * h + 1]), bfhi(xp_[2 * h + 1])}, ma = {bflo(mp_[2 * h]), bfhi(mp_[2 * h]), bflo(mp_[2 * h + 1]), bfhi(mp_[2 * h + 1])};
                    v[j][h] = xa * DN_ALPHA + ma; s += (v[j][h][0] + v[j][h][1]) + (v[j][h][2] + v[j][h][3]); } }
            const float mean = wave_sum(s) * (1.f / 1024.f); float q = 0.f;
#pragma unroll
            for (int j = 0; j < 2; ++j)
#pragma unroll
                for (int h = 0; h < 2; ++h) { v[j][h] = v[j][h] - mean; q += (v[j][h][0] * v[j][h][0] + v[j][h][1] * v[j][h][1]) + (v[j][h][2] * v[j][h][2] + v[j][h][3] * v[j][h][3]); }
            const float rstd = 1.f / sqrtf(wave_sum(q) * (1.f / 1024.f) + LN_EPS);
#pragma unroll
            for (int j = 0; j < 2; ++j) { const f32x4 o0 = v[j][0] * rstd * gg1[j][0] + bb1[j][0], o1 = v[j][1] * rstd * gg1[j][1] + bb1[j][1];
                *(LAS f32x4*)(xs + r * XP + j * 512 + lane * 8) = o0; *(LAS f32x4*)(xs + r * XP + j * 512 + lane * 8 + 4) = o1;
                u32x4 w; w.x = pk2(o0[0], o0[1]); w.y = pk2(o0[2], o0[3]); w.z = pk2(o1[0], o1[1]); w.w = pk2(o1[2], o1[3]); *(u32x4*)(xb + row * 1024 + j * 512 + lane * 8) = w; } }
        { const int un = unit + F.G;
            if (un < NT / 16) {
#pragma unroll
                for (int i = 0; i < 2; ++i)
#pragma unroll
                    for (int j = 0; j < 2; ++j) { const size_t o = (size_t)(un * 16 + wave * 2 + i) * 1024 + j * 512 + lane * 8; va[i][j] = *(const u32x4*)(xb + o); vm[i][j] = *(const u32x4*)(mix + o); } } }
        __syncthreads();
        { f32x4 c0 = (f32x4){0.f, 0.f, 0.f, 0.f}, c1 = c0; const LAS float* xp = xs + fr * XP + 128 * wave + 32 * fq;
#pragma unroll
            for (int s4 = 0; s4 < 8; ++s4) { const f32x4 xa = *(const LAS f32x4*)(xp + 4 * s4);
#pragma unroll
                for (int i = 0; i < 4; ++i) { c0 = __builtin_amdgcn_mfma_f32_16x16x4f32(xa[i], wf[0][4 * s4 + i], c0, 0, 0, 0); c1 = __builtin_amdgcn_mfma_f32_16x16x4f32(xa[i], wf[1][4 * s4 + i], c1, 0, 0, 0); } }
#pragma unroll
            for (int i = 0; i < 4; ++i) { part[(wave * 16 + 4 * fq + i) * 32 + fr] = c0[i]; part[(wave * 16 + 4 * fq + i) * 32 + 16 + fr] = c1[i]; } }
        __syncthreads();
        { const int r = tid >> 5, e = tid & 31; float v = brt;
#pragma unroll
            for (int w = 0; w < 8; ++w) v += part[(w * 16 + r) * 32 + e];
            float bv[4]; int bi[4]; float cur = v;
#define DPP_F(x, ctrl) __builtin_bit_cast(float, __builtin_amdgcn_update_dpp(0, __builtin_bit_cast(int, (x)), (ctrl), 0xf, 0xf, true))
#define DPP_I(x, ctrl) __builtin_amdgcn_update_dpp(0, (x), (ctrl), 0xf, 0xf, true)
#define ARGMAX_STEP(OV, OI) do { const float ov_ = (OV); const int oi_ = (OI); const bool take_ = (ov_ > mv) || (ov_ == mv && oi_ < mi); mv = take_ ? ov_ : mv; mi = take_ ? oi_ : mi; } while (0)
#pragma unroll
            for (int k = 0; k < 4; ++k) { float mv = cur; int mi = e;
                ARGMAX_STEP(DPP_F(mv, 0xB1), DPP_I(mi, 0xB1));
                ARGMAX_STEP(DPP_F(mv, 0x4E), DPP_I(mi, 0x4E));
                ARGMAX_STEP(DPP_F(mv, 0x141), DPP_I(mi, 0x141));
                ARGMAX_STEP(DPP_F(mv, 0x140), DPP_I(mi, 0x140));
                { const auto rv_ = __builtin_amdgcn_permlane16_swap(__float_as_uint(mv), __float_as_uint(mv), false, false); const auto ri_ = __builtin_amdgcn_permlane16_swap((unsigned)mi, (unsigned)mi, false, false);
                    mv = __uint_as_float(rv_[0]); mi = (int)ri_[0]; ARGMAX_STEP(__uint_as_float(rv_[1]), (int)ri_[1]); }
                bv[k] = mv; bi[k] = mi; if (e == mi) cur = -INFINITY; }
#undef DPP_F
#undef DPP_I
#undef ARGMAX_STEP
            if (e < 4) { float ex[4], sum = 0.f;
#pragma unroll
                for (int k = 0; k < 4; ++k) { ex[k] = __expf(bv[k] - bv[0]); sum += ex[k]; }
                const int k = e; const int t = r0 + r; const int ide = k == 0 ? bi[0] : (k == 1 ? bi[1] : (k == 2 ? bi[2] : bi[3])); const float exk = k == 0 ? ex[0] : (k == 1 ? ex[1] : (k == 2 ? ex[2] : ex[3]));
                const unsigned ls = __hip_atomic_fetch_add(lcnt + ide, 1u, __ATOMIC_RELAXED, __HIP_MEMORY_SCOPE_WORKGROUP);
                const int li = nsel + r * 4 + k; lsel[2 * li] = ((unsigned)ide << 24) | ls; lsel[2 * li + 1] = (unsigned)(t * 4 + k); tokw[t * 4 + k] = exk / sum; } }
        nsel += 64;
        __syncthreads();
    }
    if (tid < 32) { const unsigned c = lcnt[tid]; lcnt[32 + tid] = c ? atomicAdd(cnt + tid * 64, c) : 0u; }
    __syncthreads();
    for (int i = tid; i < nsel; i += NTHR) { const unsigned a = lsel[2 * i], tk = lsel[2 * i + 1]; const unsigned e = a >> 24; rowtk[(size_t)e * NT + lcnt[32 + e] + (a & 0xffffffu)] = (int)tk; }
    __syncthreads();
}
DEV void ln2_rows(Frame F, const Params& P, int l) {
    frame_refresh(F);
    const int lane = F.lane; const int gw = F.bid * NWAVES + F.wave, NGW = F.G * NWAVES;
    bf16_t* xb = wsp<bf16_t>(F, WS_XB); const bf16_t* yb = wsp<bf16_t>(F, WS_YBUF); const float* tokw = wsp<float>(F, WS_TOKW);
    const float* g2 = P.in[I_LN2G] + (size_t)l * 1024; const float* b2 = P.in[I_LN2B] + (size_t)l * 1024;
    float* dst = (l == NL - 1) ? P.out : nullptr;
    f32x4 wkn; u32x4 xn[2]; u32x4 yn[2][4];
#define LN2_LOAD(row_) do { wkn = *(const f32x4*)(tokw + (size_t)(row_) * 4); _Pragma("unroll") for (int j = 0; j < 2; ++j) { xn[j] = *(const u32x4*)(xb + (size_t)(row_) * 1024 + j * 512 + lane * 8); \
        _Pragma("unroll") for (int k = 0; k < 4; ++k) yn[j][k] = *(const u32x4*)(yb + ((size_t)(row_) * 4 + k) * 1024 + j * 512 + lane * 8); } } while (0)
    f32x4 gg[2][2], bb[2][2];
#pragma unroll
    for (int j = 0; j < 2; ++j)
#pragma unroll
        for (int h = 0; h < 2; ++h) { gg[j][h] = *(const f32x4*)(g2 + j * 512 + lane * 8 + 4 * h); bb[j][h] = *(const f32x4*)(b2 + j * 512 + lane * 8 + 4 * h); }
    if (gw < NT) LN2_LOAD(gw);
#pragma unroll 1
    for (int row = gw; row < NT; row += NGW) {
        const f32x4 wk = wkn;
        f32x4 v[2][2]; float s = 0.f;
#pragma unroll
        for (int j = 0; j < 2; ++j) { const unsigned* xp = (const unsigned*)&xn[j];
            f32x4 a0 = (f32x4){bflo(xp[0]), bfhi(xp[0]), bflo(xp[1]), bfhi(xp[1])} * DN_ALPHA, a1 = (f32x4){bflo(xp[2]), bfhi(xp[2]), bflo(xp[3]), bfhi(xp[3])} * DN_ALPHA;
#pragma unroll
            for (int k = 0; k < 4; ++k) { const unsigned* yp = (const unsigned*)&yn[j][k]; const float w = wk[k];
                a0[0] += w * bflo(yp[0]); a0[1] += w * bfhi(yp[0]); a0[2] += w * bflo(yp[1]); a0[3] += w * bfhi(yp[1]);
                a1[0] += w * bflo(yp[2]); a1[1] += w * bfhi(yp[2]); a1[2] += w * bflo(yp[3]); a1[3] += w * bfhi(yp[3]); }
            v[j][0] = a0; v[j][1] = a1; s += ((a0[0] + a0[1]) + (a0[2] + a0[3])) + ((a1[0] + a1[1]) + (a1[2] + a1[3])); }
        if (row + NGW < NT) LN2_LOAD(row + NGW);
        const float mean = wave_sum(s) * (1.f / 1024.f); float q = 0.f;
#pragma unroll
        for (int j = 0; j < 2; ++j)
#pragma unroll
            for (int h = 0; h < 2; ++h) { v[j][h] = v[j][h] - mean; q += (v[j][h][0] * v[j][h][0] + v[j][h][1] * v[j][h][1]) + (v[j][h][2] * v[j][h][2] + v[j][h][3] * v[j][h][3]); }
        const float rstd = 1.f / sqrtf(wave_sum(q) * (1.f / 1024.f) + LN_EPS);
#pragma unroll
        for (int j = 0; j < 2; ++j) { const f32x4 o0 = v[j][0] * rstd * gg[j][0] + bb[j][0], o1 = v[j][1] * rstd * gg[j][1] + bb[j][1];
            if (dst) { *(f32x4*)(dst + (size_t)row * 1024 + j * 512 + lane * 8) = o0; *(f32x4*)(dst + (size_t)row * 1024 + j * 512 + lane * 8 + 4) = o1; }
            else { u32x4 w; w.x = pk2(o0[0], o0[1]); w.y = pk2(o0[2], o0[3]); w.z = pk2(o1[0], o1[1]); w.w = pk2(o1[2], o1[3]); *(u32x4*)(xb + (size_t)row * 1024 + j * 512 + lane * 8) = w; } } }
#undef LN2_LOAD
}

constexpr int NPH = 9;
constexpr int N_PHASES = 1 + NL * NPH;
__global__ void __launch_bounds__(NTHR, 2) fwd_kernel(Params P) {
    extern __shared__ __attribute__((aligned(16))) unsigned char lds_raw[];
    Frame F;
    F.lds = (LAS unsigned char*)lds_raw; F.MISC = (volatile LAS unsigned*)(F.lds + MISC_OFF);
    F.tid = threadIdx.x; F.lane = F.tid & 63; F.wave = __builtin_amdgcn_readfirstlane(F.tid >> 6); F.G = gridDim.x; F.bid = blockIdx.x;
    F.ws = P.ws; F.ctl = (unsigned*)(P.ws + WS_CTL);
    for (int u = F.tid; u < 1024; u += NTHR) F.MISC[u] = 0u;
    __syncthreads();
    const int lo = P.ph_lo, hi = P.ph_hi;
    const bool multi = (hi - lo) > 1;
    XcdBarrier bar; bar.bar = F.ctl + CW_BAR; bar.x = 0; bar.st = F.MISC + 8;
    if (multi) bar = xcd_barrier_post(F.ctl + CW_BAR, F.MISC + 8);
#ifndef PHMASK
#define PHMASK 0xFFFF
#endif
#define IN(k) (lo <= (k) && (k) < hi)
#define EN(i) ((PHMASK >> (i)) & 1)
#ifndef DUP_PHASE
#define DUP_PHASE -1
#endif
#define REP(i) for (int rep_ = 0; rep_ < ((DUP_PHASE) == (i) ? 2 : 1); ++rep_)
#define SEAM(k) do { if (IN(k) && IN((k) + 1)) xcd_barrier(bar); } while (0)
#define FILL(k) do { __syncthreads(); if (F.tid == 0) atomicAdd(F.ctl + CW_DONE + (k) * 64, 1u); bg_fill(F, P, F.ctl + CW_DONE + (k) * 64, BG_TOTAL); } while (0)

    if (EN(9) && IN(0)) { REP(9) p0_prologue(F, P); }
    SEAM(0);
#pragma unroll 1
    for (int l = 0; l < NL; ++l) {
        const int pb = 1 + l * NPH;
        if (EN(0) && IN(pb + 0)) REP(0) {
            pg8::Gemm g{wsp<bf16_t>(F, WS_XB), wsp<bf16_t>(F, WS_WIN) + (size_t)l * NP * 1024, 1024, 1024};
            pg8::PlainOrder S; S.init(NT / 256, NP / 256, F.G, F.bid);
            pg8::EpiInProj E{wsp<bf16_t>(F, WS_H), wsp<float>(F, WS_BIN) + (size_t)l * NP, wsp<float>(F, WS_SIDE), wsp<bf16_t>(F, WS_MGT)};
            pg8::gemm_phase<pg8::EpiInProj, pg8::PlainOrder, true>(F.lds, g, S, E);
            FILL(pb + 0);
        }
        SEAM(pb + 0);
        if (EN(1) && IN(pb + 1)) REP(1) {
            unsigned* qctr = F.ctl + CW_QUEUE + l * 64 + 16;
            for (;;) {
                if (F.tid == 0) F.MISC[16] = atomicAdd(qctr, 1u);
                __syncthreads();
                const int L = (int)F.MISC[16];
                __syncthreads();
                if (L >= 528) break;
                if (L < 128) pb_gmlp_unit(F, P, l, L);
                else if (L < 256) pb_compress_unit(F, l, L - 128);
                else if (L < 512) { pb_conv_unit(F, P, l, L - 256); pb_transpose_unit(F, L - 256); }
                else pb_cum_unit(F, L - 512);
            }
        }
        SEAM(pb + 1);
        if (EN(2) && IN(pb + 2)) REP(2) {
            unsigned* qctr = F.ctl + CW_QUEUE + l * 64 + rep_ * 32;
            for (;;) {
                if (F.tid == 0) F.MISC[16] = atomicAdd(qctr, 1u);
                __syncthreads();
                const unsigned L = F.MISC[16];
                __syncthreads();
#ifdef ATT_TWICE
                if (L >= 1536u) break;
                const int Lm = (int)(L % 768u);
#else
                if (L >= 768u) break;
                const int Lm = (int)L;
#endif
                if (Lm < 512) nsa_unit(F, Lm & 3, 63 - (Lm >> 3), (Lm >> 2) & 1);
                else { const int idx = Lm - 512; fox_unit(F, idx & 3, (idx >> 2) & 3, 15 - (idx >> 4)); }
            }
            FILL(pb + 2);
        }
        SEAM(pb + 2);
        if (EN(3) && IN(pb + 3)) REP(3) {
            pg8::Gemm g{wsp<bf16_t>(F, WS_BR), wsp<bf16_t>(F, WS_WBR) + (size_t)l * 4096 * 256, 1024, 256};
            pg8::BrOrder S{F.G, F.bid};
            pg8::EpiBrGate E{wsp<bf16_t>(F, WS_MGT), wsp<bf16_t>(F, WS_GBF)};
            pg8::gemm_phase<pg8::EpiBrGate, pg8::BrOrder, true, true>(F.lds, g, S, E);
        }
        SEAM(pb + 3);
        if (EN(4) && IN(pb + 4)) REP(4) {
            pg8::Gemm g{wsp<bf16_t>(F, WS_GBF), wsp<bf16_t>(F, WS_WO) + (size_t)l * 1024 * 1024, 1024, 1024};
            pg8::PlainOrder S; S.init(NT / 256, 4, F.G, F.bid);
            pg8::EpiBf16Out E{wsp<bf16_t>(F, WS_MIX)};
            pg8::gemm_phase<pg8::EpiBf16Out, pg8::PlainOrder, true>(F.lds, g, S, E);
        }
        SEAM(pb + 4);
        if (EN(5) && IN(pb + 5)) { ln1_router_phase(F, P, l); bg_fill(F, P, nullptr, (long)(l + 1) * BG_PER_LAYER); }
        SEAM(pb + 5);
        if ((EN(6) || EN(7)) && (IN(pb + 6) || IN(pb + 7))) {
            LAS int* tp = (LAS int*)(F.lds + MISC_OFF + 1024);
            if (F.tid == 0) { int run = 0; const unsigned* cnt = F.ctl + CW_CNT + l * 32 * 64;
                for (int e = 0; e < 32; ++e) { const int c = (int)__hip_atomic_load(cnt + e * 64, __ATOMIC_RELAXED, __HIP_MEMORY_SCOPE_AGENT); tp[e] = run; tp[40 + e] = c; run += (c + 255) >> 8; }
                tp[32] = run; }
            __syncthreads();
            LAS unsigned* ul = (LAS unsigned*)(F.lds + MISC_OFF + 1536);
            int ut_ = F.tid; asm volatile("" : "+v"(ut_));
            if (ut_ < 128) { const int m2 = ut_ >> 6, i = ut_ & 63, sh = m2 ? 2 : 3;
                const int x = F.bid & 7, j = F.bid >> 3, W = F.G >> 3;
                const int U = tp[32] << sh, s0 = (x * U) >> 3, s1 = ((x + 1) * U) >> 3, L = s0 + i * W + j;
                unsigned pk = 0xffffffffu;
                if (L < s1) { const int tile = L >> sh, pn = L & ((1 << sh) - 1);
                    int e = (tp[16] <= tile) ? 16 : 0;
                    e += (tp[e + 8] <= tile) ? 8 : 0; e += (tp[e + 4] <= tile) ? 4 : 0; e += (tp[e + 2] <= tile) ? 2 : 0; e += (tp[e + 1] <= tile) ? 1 : 0;
                    const int mt = tile - tp[e], rem = tp[40 + e] - mt * 256, cn = rem < 256 ? rem : 256;
                    pk = (unsigned)pn | ((unsigned)e << 3) | ((unsigned)mt << 8) | ((unsigned)tile << 15) | ((unsigned)(cn - 1) << 24); }
                ul[ut_] = pk; }
            __syncthreads();
            if (EN(6) && IN(pb + 6)) REP(6) {
                pg8::Gemm g{wsp<bf16_t>(F, WS_XB), wsp<bf16_t>(F, WS_W1) + (size_t)l * 32 * 2048 * 1024, 1024, 1024};
                pg8::MoeOrder<1> S{ul, wsp<int>(F, WS_ROWTK)};
                pg8::EpiMoe1 E{wsp<bf16_t>(F, WS_ACT), P.in[I_BE1] + (size_t)l * 32 * 2048};
                pg8::gemm_phase<pg8::EpiMoe1, pg8::MoeOrder<1>, true>(F.lds, g, S, E);
                FILL(pb + 6);
            }
            SEAM(pb + 6);
            if (EN(7) && IN(pb + 7)) REP(7) {
                pg8::Gemm g{wsp<bf16_t>(F, WS_ACT), wsp<bf16_t>(F, WS_W2) + (size_t)l * 32 * 1024 * 1024, 1024, 1024};
                pg8::MoeOrder<2> S{ul + 64, wsp<int>(F, WS_ROWTK)};
                pg8::EpiMoe2 E{wsp<bf16_t>(F, WS_YBUF), P.in[I_BE2] + (size_t)l * 32 * 1024, wsp<int>(F, WS_ROWTK)};
                pg8::gemm_phase<pg8::EpiMoe2, pg8::MoeOrder<2>, true>(F.lds, g, S, E);
                FILL(pb + 7);
            }
        }
        SEAM(pb + 7);
        if (EN(8) && IN(pb + 8)) REP(8) ln2_rows(F, P, l);
        SEAM(pb + 8);
    }
#undef IN
#undef SEAM
}

#ifndef MK_SPLIT
#define MK_SPLIT 0
#endif
extern "C" void kernel_launch(void* const* d_in, const int* in_sizes, int n_in, void* d_out, int out_size, void* d_ws, size_t ws_size, hipStream_t stream) {
    static int grid = 0;
    if (grid == 0) {
        if (n_in != 30 || out_size != NT * 1024 || ws_size < WS_END) { fprintf(stderr, "kernel_launch: unexpected shapes (n_in %d out %d ws %zu need %zu)\n", n_in, out_size, ws_size, (size_t)WS_END); grid = -1; return; }
        int dev = 0, cus = 0, per_cu = 0;
        if (hipGetDevice(&dev) != hipSuccess || hipDeviceGetAttribute(&cus, hipDeviceAttributeMultiprocessorCount, dev) != hipSuccess) { grid = -1; return; }
        if (hipFuncSetAttribute((const void*)fwd_kernel, hipFuncAttributeMaxDynamicSharedMemorySize, LDS_BYTES) != hipSuccess) { fprintf(stderr, "kernel_launch: hipFuncSetAttribute failed\n"); grid = -1; return; }
        if (hipOccupancyMaxActiveBlocksPerMultiprocessor(&per_cu, (const void*)fwd_kernel, NTHR, LDS_BYTES) != hipSuccess || per_cu < 1) fprintf(stderr, "kernel_launch: occupancy query says %d\n", per_cu);
        (void)hipGetLastError();
        grid = cus;
    }
    if (grid < 0) return;
    (void)hipMemsetAsync((char*)d_ws + WS_CTL, 0, CTL_BYTES, stream);
    Params p; memset(&p, 0, sizeof(p));
    for (int i = 0; i < 30; ++i) p.in[i] = (const float*)d_in[i];
    p.out = (float*)d_out; p.ws = (unsigned char*)d_ws;
    for (int i = 0; i < 8; ++i) p.invf[i] = std::pow(500000.0, -(double)i / 8.0);
#if MK_SPLIT
    for (int ph = 0; ph < N_PHASES; ++ph) { p.ph_lo = ph; p.ph_hi = ph + 1; hipLaunchKernelGGL(fwd_kernel, dim3(grid), dim3(NTHR), LDS_BYTES, stream, p); }
#else
    p.ph_lo = 0; p.ph_hi = N_PHASES; hipLaunchKernelGGL(fwd_kernel, dim3(grid), dim3(NTHR), LDS_BYTES, stream, p);
#endif
}
```

```cpp
#include <hip/hip_runtime.h>
#include <cstdio>
#include <cstdint>
#include <cmath>
#include <cstring>

#define DEV __device__ __forceinline__
#define LAS __attribute__((address_space(3)))
#define GAS __attribute__((address_space(1)))

typedef unsigned short bf16_t;
typedef short bf16x8 __attribute__((ext_vector_type(8)));
typedef short bf16x4 __attribute__((ext_vector_type(4)));
typedef float f32x4 __attribute__((ext_vector_type(4)));
typedef float f32x2 __attribute__((ext_vector_type(2)));
typedef unsigned u32x4 __attribute__((ext_vector_type(4)));
typedef unsigned u32x2 __attribute__((ext_vector_type(2)));

constexpr int NB = 4, SEQ = 4096, DM = 1024, NL = 4, NT = NB * SEQ;
constexpr int NIN = 6544, NP = 6656;
constexpr int NE = 32;
constexpr int NWAVES = 8, NTHR = 512;
constexpr float LN_EPS = 1e-5f;
constexpr float DN_ALPHA = 1.6817928305074292f;
constexpr float LOG2E = 1.4426950408889634f;
constexpr int HP_NQ = 0, HP_KC = 256, HP_VC = 320, HP_KS = 384, HP_VS = 448, HP_KW = 512, HP_VW = 576, HP_SP = 640;
constexpr int HP_FQ = 768, HP_FK = 1024, HP_FV = 1280, HP_GU = 1536, HP_GV = 1792, HP_CAB = 2048, HP_MG = 2560;

constexpr size_t al256(size_t x) { return (x + 255) & ~(size_t)255; }
constexpr size_t WS_CTL = 0, CTL_BYTES = 1u << 20;
constexpr size_t WS_WIN = CTL_BYTES;
constexpr size_t WS_BIN = WS_WIN + al256((size_t)NL * NP * 1024 * 2);
constexpr size_t WS_WBR = WS_BIN + al256((size_t)NL * NP * 4);
constexpr size_t WS_WO = WS_WBR + al256((size_t)NL * 4096 * 256 * 2);
constexpr size_t WS_W1 = WS_WO + al256((size_t)NL * 1024 * 1024 * 2);
constexpr size_t WS_W2 = WS_W1 + al256((size_t)NL * 32 * 2048 * 1024 * 2);
constexpr size_t WS_WC1 = WS_W2 + al256((size_t)NL * 32 * 1024 * 1024 * 2);
constexpr size_t WS_WC2 = WS_WC1 + al256((size_t)NL * 2 * 64 * 2048 * 2);
constexpr size_t WS_CB = WS_WC2 + al256((size_t)NL * 2 * 64 * 64 * 2);
constexpr size_t WS_WG = WS_CB + al256((size_t)NL * 2 * 32 * 64 * 4);
constexpr size_t WS_CS = WS_WG + al256((size_t)NL * 4 * 128 * 128 * 2);
constexpr size_t WS_XRES = WS_CS + al256((size_t)NT * 16 * 4);
constexpr size_t WS_XB = WS_XRES + al256((size_t)NT * 1024 * 4);
constexpr size_t WS_H = WS_XB + al256((size_t)NT * 1024 * 2);
constexpr size_t WS_SIDE = WS_H + al256((size_t)NT * NP * 2);
constexpr size_t WS_KNSA = WS_SIDE + al256((size_t)NT * 16 * 4);
constexpr size_t WS_VT = WS_KNSA + al256((size_t)NT * 128 * 2);
constexpr size_t WS_CUM = WS_VT + al256((size_t)NB * 384 * SEQ * 2);
constexpr size_t WS_KCMP = WS_CUM + al256((size_t)NB * 4 * SEQ * 4);
constexpr size_t WS_VCMPT = WS_KCMP + al256((size_t)NB * 256 * 64 * 2);
constexpr size_t WS_BR = WS_VCMPT + al256((size_t)NB * 64 * 256 * 2);
constexpr size_t WS_G32 = WS_BR + al256((size_t)NT * 1024 * 2);
constexpr size_t WS_GBF = WS_G32 + al256((size_t)NT * 1024 * 4);
constexpr size_t WS_MIX = WS_GBF + al256((size_t)NT * 1024 * 2);
constexpr size_t WS_TOKW = WS_MIX + al256((size_t)NT * 1024 * 4);
constexpr size_t WS_ROWTK = WS_TOKW + al256((size_t)NT * 4 * 4);
constexpr int PMAX_TILES = NT * 4 / 256 + NE;
constexpr size_t WS_ACT = WS_ROWTK + al256((size_t)NE * NT * 4);
constexpr size_t WS_YBUF = WS_ACT + al256((size_t)PMAX_TILES * 256 * 1024 * 2);
constexpr size_t WS_MGT = WS_YBUF + al256((size_t)NT * 4 * 1024 * 2);
constexpr size_t WS_KN = WS_MGT + al256((size_t)NT * 4096 * 2);
constexpr size_t WS_END = WS_KN + al256((size_t)NB * 4 * 64 * 4);

constexpr int CW_BAR = 4096;
constexpr int CW_CNT = 32768;
constexpr int CW_QUEUE = 20480;
constexpr int CW_BGQ = 24576;
constexpr int CW_DONE = 28672;

constexpr int RING_BYTES = 131072;
constexpr int MISC_OFF = RING_BYTES;
constexpr int LDS_BYTES = 147456;

DEV float bf2f(bf16_t v) { return __uint_as_float((unsigned)v << 16); }
DEV float bflo(unsigned w) { return __uint_as_float(w << 16); }
DEV float bfhi(unsigned w) { return __uint_as_float(w & 0xffff0000u); }
DEV unsigned pk2(float lo, float hi) { typedef __bf16 b2 __attribute__((ext_vector_type(2))); f32x2 v = {lo, hi}; b2 b = __builtin_convertvector(v, b2); return __builtin_bit_cast(unsigned, b); }
DEV bf16_t f2bf(float f) { return (bf16_t)(pk2(f, 0.f) & 0xffffu); }
DEV float fexp2(float x) { return __builtin_amdgcn_exp2f(x); }
DEV float frcp(float x) { return __builtin_amdgcn_rcpf(x); }
DEV float sigmoidf_(float x) { return frcp(1.f + fexp2(-x * LOG2E)); }
DEV float gelu_tanh(float x) { const float u = 1.5957691216057308f * (x + 0.044715f * x * x * x); return x * frcp(1.f + fexp2(-u * LOG2E)); }
#define WS_DPP(x, ctrl) __builtin_bit_cast(float, __builtin_amdgcn_update_dpp(0, __builtin_bit_cast(int, (x)), (ctrl), 0xf, 0xf, true))
DEV float wave_sum(float v) {
    v += WS_DPP(v, 0xB1); v += WS_DPP(v, 0x4E); v += WS_DPP(v, 0x141); v += WS_DPP(v, 0x140);
    const int vi = __builtin_bit_cast(int, v);
    const float r0 = __builtin_bit_cast(float, __builtin_amdgcn_readlane(vi, 0)), r1 = __builtin_bit_cast(float, __builtin_amdgcn_readlane(vi, 16));
    const float r2 = __builtin_bit_cast(float, __builtin_amdgcn_readlane(vi, 32)), r3 = __builtin_bit_cast(float, __builtin_amdgcn_readlane(vi, 48));
    return (r0 + r1) + (r2 + r3);
}
typedef unsigned u32x2_t __attribute__((ext_vector_type(2)));
DEV float xr_max(float v) {
    { const unsigned u = __float_as_uint(v); const auto r = __builtin_amdgcn_permlane16_swap(u, u, false, false); v = fmaxf(__uint_as_float(r[0]), __uint_as_float(r[1])); }
    { const unsigned u = __float_as_uint(v); const auto r = __builtin_amdgcn_permlane32_swap(u, u, false, false); v = fmaxf(__uint_as_float(r[0]), __uint_as_float(r[1])); }
    return v;
}
DEV float xr_sum(float v) {
    { const unsigned u = __float_as_uint(v); const auto r = __builtin_amdgcn_permlane16_swap(u, u, false, false); v = __uint_as_float(r[0]) + __uint_as_float(r[1]); }
    { const unsigned u = __float_as_uint(v); const auto r = __builtin_amdgcn_permlane32_swap(u, u, false, false); v = __uint_as_float(r[0]) + __uint_as_float(r[1]); }
    return v;
}
DEV unsigned xr_or(unsigned u) {
    { const auto r = __builtin_amdgcn_permlane16_swap(u, u, false, false); u = r[0] | r[1]; }
    { const auto r = __builtin_amdgcn_permlane32_swap(u, u, false, false); u = r[0] | r[1]; }
    return u;
}
DEV f32x4 mfma16(bf16x8 a, bf16x8 b, f32x4 c) { return __builtin_amdgcn_mfma_f32_16x16x32_bf16(a, b, c, 0, 0, 0); }
#define LDS_WAIT() asm volatile("s_waitcnt lgkmcnt(0)" ::: "memory")
#define VM_WAIT() asm volatile("s_waitcnt vmcnt(0)" ::: "memory")

__host__ __device__ __forceinline__ int perm16(int dp) { return dp < 16 ? ((dp & 1) ? 8 + (dp >> 1) : (dp >> 1)) : dp; }
__host__ __device__ __forceinline__ int hp_src_col(int c) {
    if (c < 256) return (c & ~63) + perm16(c & 63);
    if (c < 320) return 256 + perm16(c - 256);
    if (c < 384) return c;
    if (c < 448) return 384 + perm16(c - 384);
    if (c < 512) return c;
    if (c < 576) return 512 + perm16(c - 512);
    if (c < 640) return c;
    if (c < 652) return c;
    if (c < 656) return 1420 + (c - 652);
    if (c < 768) return -1;
    if (c < 1024) return 652 + (c - 768);
    if (c < 1280) return 908 + (c - 1024);
    if (c < 1536) return 1164 + (c - 1280);
    if (c < 1792) return 1424 + (c - 1536);
    if (c < 2048) return 1680 + (c - 1792);
    if (c < 2560) { const int i = c - 2048; return (i & 1) ? 2192 + (i >> 1) : 1936 + (i >> 1); }
    return 2448 + (c - 2560);
}

namespace pg8 {
constexpr int BM = 256, BK = 64, HALF = 128, HTB = HALF * BK * 2, STAGE_BYTES = 8 * HTB, NXCD = 8, WGM = 8;
__host__ __device__ __forceinline__ int lds_byte(int r, int c) { const int st = (r >> 4) * 2 + (c >> 5), rr = r & 15, cc = c & 31, ob = rr * 64 + cc * 2; return st * 1024 + (ob ^ (((ob >> 9) & 1) << 5)); }
__host__ __device__ __forceinline__ void stage_rc(int b, int& R, int& C) { const int st = b / 1024, sb = b % 1024, swz = sb ^ (((sb >> 9) & 1) << 5); R = (st >> 1) * 16 + swz / 64; C = (st & 1) * 32 + (swz % 64) / 2; }
__host__ __device__ __forceinline__ int perm32(int rho) { const int n = rho >> 4, i = rho & 15; return 8 * (i >> 2) + 4 * n + (i & 3); }

struct Unit { int pm, pn, e, mt, cnt; };
constexpr int KROT = 1;
struct Gemm { const bf16_t* A; const bf16_t* Bt; int lda; int K; };

template <class Epi, class Sched, bool ALIGN_EPI, bool HALFN = false>
DEV void gemm_phase(LAS unsigned char* lds, const Gemm g, const Sched& S, const Epi& E) {
    int tid_ = threadIdx.x; asm volatile("" : "+v"(tid_));
    const int tid = tid_, wid = __builtin_amdgcn_readfirstlane(tid >> 6), lane = tid & 63, wr = wid >> 2, wc = wid & 3, fr = lane & 15, fq = lane >> 4;
    const int K = g.K, nt = K / BK;
#define PG8_KOF(t_, r_) ((size_t)((t_) + (r_) - (((t_) + (r_)) >= nt ? nt : 0)) * kstep)
    unsigned voffA[2], voffB[2];
#pragma unroll
    for (int i = 0; i < 2; ++i) { int R, C; stage_rc(tid * 16 + i * 8192, R, C); int Rb = Epi::PERM ? ((R & ~31) + perm32(R & 31)) : R;
        if constexpr (Epi::PAIR16) Rb = 16 * (Rb >> 3) + (Rb & 7);
        voffA[i] = (unsigned)(R * g.lda + C) * 2u; voffB[i] = (unsigned)(Rb * K + C) * 2u; }
    const unsigned hstepA = (unsigned)HALF * (unsigned)g.lda * 2u;
    const size_t kstep = (size_t)(BK * 2);
    const size_t hstepB = (size_t)(Epi::PAIR16 ? 8 : HALF) * K * 2;
    unsigned voffG[2];
#pragma unroll
    for (int i = 0; i < 2; ++i) { const unsigned off = (unsigned)tid * 16u + (unsigned)i * 8192u; voffG[i] = (off >> 8) * 512u + (off & 255u); }
    constexpr size_t GPIECE = 64 * 512;
    const unsigned ldsw = (unsigned)wid * 1024u;
    const int aoff = lds_byte(wr * 64 + fr, fq * 8), boff = lds_byte(wc * 32 + fr, fq * 8);
    const char* const Abase = (const char*)g.A;
#define PG8_SA(b, h) (((b) * 2 + (h)) * HTB)
#define PG8_SB(b, h) ((4 + (b) * 2 + (h)) * HTB)
#define PG8_STAGE_B(bufoff, gbase, voff) do { _Pragma("unroll") for (int _i = 0; _i < 2; ++_i) \
        __builtin_amdgcn_global_load_lds((const unsigned*)((const char*)(gbase) + (voff)[_i]), (LAS unsigned*)(lds + (bufoff) + ldsw + _i * 8192), 16, 0, 0); } while (0)
#define PG8_STAGE_B1(bufoff, gbase, gatep) do { if constexpr (HALFN) PG8_STAGE_B(bufoff, gatep, voffG); else PG8_STAGE_B(bufoff, (gbase) + hstepB, voffB); } while (0)
#define PG8_STAGE_A(bufoff, koff, offs) do { _Pragma("unroll") for (int _i = 0; _i < 2; ++_i) { \
        if constexpr (Sched::GATHER) __builtin_amdgcn_global_load_lds((const unsigned*)(Abase + (size_t)(koff) + (offs)[_i]), (LAS unsigned*)(lds + (bufoff) + ldsw + _i * 8192), 16, 0, 0); \
        else __builtin_amdgcn_global_load_lds((const unsigned*)(Abase + ((size_t)(koff) + (size_t)__builtin_amdgcn_readfirstlane((offs)[_i])) + voffA[_i]), (LAS unsigned*)(lds + (bufoff) + ldsw + _i * 8192), 16, 0, 0); } } while (0)
#define PG8_LDA(dst, b, h) do { _Pragma("unroll") for (int m = 0; m < 4; ++m) _Pragma("unroll") for (int k = 0; k < 2; ++k) dst[m][k] = *(const LAS bf16x8*)(lds + PG8_SA(b, h) + aoff + m * 2048 + k * 1024); } while (0)
#define PG8_LDB(dst, b, h) do { _Pragma("unroll") for (int n = 0; n < 2; ++n) _Pragma("unroll") for (int k = 0; k < 2; ++k) dst[n][k] = *(const LAS bf16x8*)(lds + PG8_SB(b, h) + boff + n * 2048 + k * 1024); } while (0)
#define PG8_MMA(ai, bj, At, Bt) do { __builtin_amdgcn_s_setprio(1); _Pragma("unroll") for (int m = 0; m < 4; ++m) _Pragma("unroll") for (int n = 0; n < 2; ++n) _Pragma("unroll") for (int k = 0; k < 2; ++k) \
        acc[ai][bj][m][n] = __builtin_amdgcn_mfma_f32_16x16x32_bf16(Bt[n][k], At[m][k], acc[ai][bj][m][n], 0, 0, 0); __builtin_amdgcn_s_setprio(0); } while (0)
#define PG8_WAIT_V(n) asm volatile("s_waitcnt vmcnt(" #n ")" ::: "memory")
#define PG8_WAIT_L(n) asm volatile("s_waitcnt lgkmcnt(" #n ")" ::: "memory")
#define PG8_BAR __builtin_amdgcn_s_barrier()
#define PG8_SCHED __builtin_amdgcn_sched_barrier(0)
#define PG8_MKOFF(dst, u) do { if constexpr (Sched::GATHER) { const unsigned _ao = S.aoff(u); _Pragma("unroll") for (int _h = 0; _h < 2; ++_h) _Pragma("unroll") for (int _i = 0; _i < 2; ++_i) { \
        int _R, _C; stage_rc(tid * 16 + _i * 8192, _R, _C); dst[_h][_i] = _ao + (S.arow(u, _h * HALF + _R) * (unsigned)g.lda + (unsigned)_C) * 2u; } } \
    else { const unsigned _ub = S.aoff(u) + S.arow(u, 0) * (unsigned)g.lda * 2u; _Pragma("unroll") for (int _h = 0; _h < 2; ++_h) _Pragma("unroll") for (int _i = 0; _i < 2; ++_i) dst[_h][_i] = _ub + (unsigned)_h * hstepA; } } while (0)
    Unit cur, nxt; int ui = 0;
    if (!S.next(0, cur)) return;
    f32x4 acc[2][2][4][2];
#pragma unroll
    for (int a = 0; a < 2; ++a)
#pragma unroll
        for (int b = 0; b < 2; ++b)
#pragma unroll
            for (int m = 0; m < 4; ++m)
#pragma unroll
                for (int n = 0; n < 2; ++n) acc[a][b][m][n] = (f32x4){0.f, 0.f, 0.f, 0.f};
    bf16x8 At[4][2], B0[2][2], B1[2][2];
    unsigned oc[2][2], on[2][2];
    PG8_MKOFF(oc, cur);
    const char* cB = (const char*)g.Bt + S.boff(cur);
    const char* cG = E.gate_base(cur);
    int rc = 0; if constexpr (Sched::ROT) rc = S.rot(cur);
    { const size_t k0 = PG8_KOF(0, rc);
    PG8_STAGE_B(PG8_SB(0, 0), cB + k0, voffB); PG8_STAGE_B1(PG8_SB(0, 1), cB + k0, cG); PG8_STAGE_A(PG8_SA(0, 0), k0, oc[0]); PG8_STAGE_A(PG8_SA(0, 1), k0, oc[1]); }
    if (wr == 1) PG8_BAR;
    PG8_WAIT_V(2); PG8_BAR;
    { const size_t k1 = PG8_KOF(1, rc);
    PG8_STAGE_B(PG8_SB(1, 0), cB + k1, voffB); PG8_STAGE_A(PG8_SA(1, 0), k1, oc[0]); PG8_STAGE_B1(PG8_SB(1, 1), cB + k1, cG + GPIECE); }
    PG8_WAIT_V(6); PG8_BAR;
    typename Epi::Pre pre;
    for (;;) {
        const bool has_next = S.next(ui + 1, nxt);
        const char* nB = cB; const char* nG = cG;
        int rn = 0; if constexpr (Sched::ROT) { if (has_next) rn = S.rot(nxt); }
        LAS int* const idxb = (LAS int*)(lds + STAGE_BYTES + 2048) + ((ui + 1) & 1) * 256;
        if (has_next) { nB = (const char*)g.Bt + S.boff(nxt); nG = E.gate_base(nxt);
            if constexpr (Sched::GATHER) { if (wid < 4) __builtin_amdgcn_global_load_lds((const unsigned*)(S.idx_ptr(nxt) + tid), (LAS unsigned*)(idxb + wid * 64), 4, 0, 0); }
            else PG8_MKOFF(on, nxt); }
        else {
#pragma unroll
            for (int h = 0; h < 2; ++h)
#pragma unroll
                for (int i = 0; i < 2; ++i) on[h][i] = oc[h][i];
        }
#pragma unroll 1
        for (int t = 0; t < nt; t += 2) {
            const bool last = (t == nt - 2);
            const size_t k1 = PG8_KOF(t + 1, rc);
            const size_t k2 = last ? PG8_KOF(0, rn) : PG8_KOF(t + 2, rc), k3 = last ? PG8_KOF(1, rn) : PG8_KOF(t + 3, rc);
            if constexpr (Sched::GATHER) { if (last && has_next) {
                const unsigned ao_ = S.aoff(nxt);
#pragma unroll
                for (int h = 0; h < 2; ++h)
#pragma unroll
                    for (int i = 0; i < 2; ++i) { int R_, C_; stage_rc(tid * 16 + i * 8192, R_, C_); const int r_ = h * HALF + R_; const int ix_ = idxb[r_];
                        on[h][i] = ao_ + (S.arow_from(nxt, r_, ix_) * (unsigned)g.lda + (unsigned)C_) * 2u; } } }
            unsigned o2[2][2]; const unsigned lastm = last ? 0xffffffffu : 0u;
#pragma unroll
            for (int h = 0; h < 2; ++h)
#pragma unroll
                for (int i = 0; i < 2; ++i) o2[h][i] = oc[h][i] ^ ((oc[h][i] ^ on[h][i]) & lastm);
            const char* b2 = (last ? nB : cB) + k2; const char* b3 = (last ? nB : cB) + k3;
            const char* g2 = last ? nG : cG + (size_t)(t + 2) * GPIECE; const char* g3 = g2 + GPIECE;
            PG8_LDB(B0, 0, 0); if constexpr (!HALFN) PG8_LDB(B1, 0, 1); else { if (wr == 0) E.gate_read(pre, lds + PG8_SB(0, 1), t >> 1, wc, fr, fq); } PG8_SCHED; PG8_LDA(At, 0, 0); PG8_STAGE_A(PG8_SA(1, 1), k1, oc[1]);
            PG8_WAIT_V(8); PG8_WAIT_L(0); PG8_BAR; PG8_MMA(0, 0, At, B0); if constexpr (!HALFN) PG8_MMA(0, 1, At, B1); PG8_BAR; PG8_SCHED;
            PG8_LDA(At, 0, 1); PG8_STAGE_B(PG8_SB(0, 0), b2, voffB); PG8_STAGE_B1(PG8_SB(0, 1), b2, g2); PG8_STAGE_A(PG8_SA(0, 0), k2, o2[0]);
            PG8_WAIT_V(8); PG8_WAIT_L(0); PG8_BAR; PG8_MMA(1, 0, At, B0); if constexpr (!HALFN) PG8_MMA(1, 1, At, B1); PG8_BAR; PG8_SCHED;
            PG8_LDB(B0, 1, 0); if constexpr (!HALFN) PG8_LDB(B1, 1, 1); else { if (wr == 1) E.gate_read(pre, lds + PG8_SB(1, 1), t >> 1, wc, fr, fq); } PG8_SCHED; PG8_LDA(At, 1, 0); PG8_STAGE_A(PG8_SA(0, 1), k2, o2[1]);
            PG8_WAIT_V(8); PG8_WAIT_L(0); PG8_BAR; PG8_MMA(0, 0, At, B0); if constexpr (!HALFN) PG8_MMA(0, 1, At, B1); PG8_BAR; PG8_SCHED;
            PG8_LDA(At, 1, 1); PG8_STAGE_B(PG8_SB(1, 0), b3, voffB); PG8_STAGE_B1(PG8_SB(1, 1), b3, g3); PG8_STAGE_A(PG8_SA(1, 0), k3, o2[0]);
            PG8_WAIT_V(8); PG8_WAIT_L(0); PG8_BAR; PG8_MMA(1, 0, At, B0); if constexpr (!HALFN) PG8_MMA(1, 1, At, B1); PG8_BAR; PG8_SCHED;
        }
        if constexpr (ALIGN_EPI) { if (wr == 0) PG8_BAR; }
        if constexpr (HALFN) E.fold(acc, pre, cur, wr, wc, fr, fq); else E(acc, cur, wr, wc, fr, fq);
        if (!has_next) break;
#pragma unroll
        for (int a = 0; a < 2; ++a)
#pragma unroll
            for (int b = 0; b < 2; ++b)
#pragma unroll
                for (int m = 0; m < 4; ++m)
#pragma unroll
                    for (int n = 0; n < 2; ++n) { if (!HALFN || b == 0) acc[a][b][m][n] = (f32x4){0.f, 0.f, 0.f, 0.f}; }
        cur = nxt; cB = nB; cG = nG; ++ui; rc = rn;
#pragma unroll
        for (int h = 0; h < 2; ++h)
#pragma unroll
            for (int i = 0; i < 2; ++i) oc[h][i] = on[h][i];
        if constexpr (ALIGN_EPI) { if (wr == 1) PG8_BAR; }
    }
    PG8_WAIT_V(0);
    if constexpr (!ALIGN_EPI) { if (wr == 0) PG8_BAR; }
    PG8_BAR;
#undef PG8_SA
#undef PG8_SB
#undef PG8_STAGE_A
#undef PG8_STAGE_B1
#undef PG8_STAGE_B
#undef PG8_LDA
#undef PG8_LDB
#undef PG8_MMA
#undef PG8_WAIT_V
#undef PG8_WAIT_L
#undef PG8_BAR
#undef PG8_SCHED
#undef PG8_MKOFF
#undef PG8_KOF
}

struct StaticOrder {
    int nM, nN, nwg, G, c;
    DEV void init(int nM_, int nN_, int G_, int c_) { nM = nM_; nN = nN_; nwg = nM * nN; G = G_; c = c_; }
    DEV bool next(int i, Unit& u) const {
        const long L = (long)i * G + c; if (L >= nwg) return false;
        int wgid = (int)L; { const int q = nwg / NXCD, r = nwg % NXCD, xcd = wgid % NXCD, off = wgid / NXCD; wgid = (xcd < r ? xcd * (q + 1) : r * (q + 1) + (xcd - r) * q) + off; }
        const int nig = WGM * nN, gid = wgid / nig, fm = gid * WGM, gsz = (nM - fm) < WGM ? (nM - fm) : WGM;
        u.pm = fm + ((wgid % nig) % gsz); u.pn = (wgid % nig) / gsz; u.e = 0; u.mt = 0; u.cnt = 256; return true;
    }
};
}

#define XB_TMO      128
#define XB_XCNT(j)  (256  + 64 * (j))
#define XB_XSUB(j)  (1280 + 64 * (j))
#define XB_XGEN(j)  (2304 + 64 * (j))
#define XB_TOP      3328
#define XB_TOPGEN   3392
#define XCD_BAR_WORDS 3456
#define XB_SPIN_CAP (1u << 20)
DEV unsigned xb_ld(unsigned* p)              { return __hip_atomic_load(p, __ATOMIC_RELAXED, __HIP_MEMORY_SCOPE_AGENT); }
DEV unsigned xb_add(unsigned* p, unsigned v) { return __hip_atomic_fetch_add(p, v, __ATOMIC_RELAXED, __HIP_MEMORY_SCOPE_AGENT); }
DEV void xb_ld16(const unsigned* base, unsigned (&c)[16]) {
    asm volatile("global_load_dword %0, %16, off sc1\n\t" "global_load_dword %1, %16, off offset:256 sc1\n\t" "global_load_dword %2, %16, off offset:512 sc1\n\t" "global_load_dword %3, %16, off offset:768 sc1\n\t" "global_load_dword %4, %16, off offset:1024 sc1\n\t" "global_load_dword %5, %16, off offset:1280 sc1\n\t" "global_load_dword %6, %16, off offset:1536 sc1\n\t" "global_load_dword %7, %16, off offset:1792 sc1\n\t" "global_load_dword %8, %16, off offset:2048 sc1\n\t" "global_load_dword %9, %16, off offset:2304 sc1\n\t" "global_load_dword %10, %16, off offset:2560 sc1\n\t" "global_load_dword %11, %16, off offset:2816 sc1\n\t" "global_load_dword %12, %16, off offset:3072 sc1\n\t" "global_load_dword %13, %16, off offset:3328 sc1\n\t" "global_load_dword %14, %16, off offset:3584 sc1\n\t" "global_load_dword %15, %16, off offset:3840 sc1\n\t" "s_waitcnt vmcnt(0)"
        : "=&v"(c[0]), "=&v"(c[1]), "=&v"(c[2]), "=&v"(c[3]), "=&v"(c[4]), "=&v"(c[5]), "=&v"(c[6]), "=&v"(c[7]), "=&v"(c[8]), "=&v"(c[9]), "=&v"(c[10]), "=&v"(c[11]), "=&v"(c[12]), "=&v"(c[13]), "=&v"(c[14]), "=&v"(c[15]) : "v"(base) : "memory");
}
DEV unsigned xb_xcc_id() { return (unsigned)__builtin_amdgcn_s_getreg((3 << 11) | 20) & 0xFu; }
#define XB_SPIN(cond, bar) do { unsigned _sp = 0; while (cond) { __builtin_amdgcn_s_sleep(1); \
    if ((++_sp & 255u) == 0u) { if (xb_ld(&(bar)[XB_TMO])) break; if (_sp > XB_SPIN_CAP) { atomicAdd(&(bar)[XB_TMO], 1u); break; } } } } while (0)
struct XcdBarrier { unsigned* bar; unsigned x; volatile LAS unsigned* st; };
DEV XcdBarrier xcd_barrier_post(unsigned* bar, volatile LAS unsigned* st) {
    XcdBarrier b; b.bar = bar; b.x = xb_xcc_id(); b.st = st;
    if (threadIdx.x == 0) (void)xb_add(&bar[XB_XCNT(b.x)], 1u);
    return b;
}
DEV void xcd_barrier_complete(unsigned* bar, unsigned x, unsigned& nloc, unsigned& nx) {
    const unsigned G = gridDim.x * gridDim.y * gridDim.z;
    unsigned sum, cnt, mine, sp = 0u;
    for (;;) {
        sum = 0u; cnt = 0u; mine = 0u;
        unsigned cc[16]; xb_ld16(&bar[XB_XCNT(0)], cc);
#pragma unroll
        for (unsigned j = 0; j < 16; ++j) { const unsigned c = cc[j]; sum += c; cnt += (c > 0u) ? 1u : 0u; mine = (j == x) ? c : mine; }
        if (sum == G) break;
        __builtin_amdgcn_s_sleep(1);
        if ((++sp & 255u) == 0u) { if (xb_ld(&bar[XB_TMO])) break; if (sp > XB_SPIN_CAP) { atomicAdd(&bar[XB_TMO], 1u); break; } }
    }
    nloc = mine > 0u ? mine : 1u; nx = cnt > 0u ? cnt : 1u;
}
DEV void xcd_barrier(const XcdBarrier& b) {
    asm volatile("s_waitcnt vmcnt(0)" ::: "memory");
    __syncthreads();
    if (threadIdx.x == 0) {
        unsigned* bar = b.bar;
        __builtin_amdgcn_s_waitcnt(0);
        unsigned nloc = b.st[0], nx = b.st[1];
        if (nloc == 0u) { xcd_barrier_complete(bar, b.x, nloc, nx); b.st[0] = nloc; b.st[1] = nx; }
        const unsigned old = xb_add(&bar[XB_XSUB(b.x)], 1u);
        const unsigned gen = old / nloc;
        if (old + 1u == (gen + 1u) * nloc) {
            __builtin_amdgcn_fence(__ATOMIC_RELEASE, "agent");
            asm volatile("s_waitcnt vmcnt(0)" ::: "memory");
            (void)xb_add(&bar[XB_TOP], 1u);
        }
        XB_SPIN(xb_ld(&bar[XB_TOP]) < (gen + 1u) * nx, bar);
        __builtin_amdgcn_fence(__ATOMIC_ACQUIRE, "agent");
        asm volatile("s_waitcnt vmcnt(0)" ::: "memory");
    }
    __syncthreads();
}

struct Params {
    const float* in[30];
    float* out;
    unsigned char* ws;
    int ph_lo, ph_hi;
    double invf[8];
};
enum { I_X = 0, I_POS, I_WIN, I_BIN, I_PEK, I_PEV, I_W1K, I_W2K, I_W1V, I_W2V, I_GLNG, I_GLNB, I_GWS, I_GBS, I_CW, I_CB, I_CLNG, I_CLNB,
       I_WBR, I_WO, I_LN1G, I_LN1B, I_WR, I_BR, I_WE1, I_BE1, I_WE2, I_BE2, I_LN2G, I_LN2B };

namespace pg8 {
struct EpiInProj {
    struct Pre {};
    static constexpr bool PAIR16 = false;
    DEV const char* gate_base(const Unit&) const { return nullptr; }
    static constexpr bool PERM = true;
    bf16_t* H; const float* bias; float* side; bf16_t* MGT;
    DEV void operator()(const f32x4 (&acc)[2][2][4][2], const Unit& u, int wr, int wc, int fr, int fq) const {
        const int row0 = u.pm * BM + wr * 64 + fr, col0 = u.pn * BM + wc * 32 + 8 * fq;
        f32x4 bv[2][2];
#pragma unroll
        for (int bj = 0; bj < 2; ++bj)
#pragma unroll
            for (int n = 0; n < 2; ++n) bv[bj][n] = *(const f32x4*)(bias + col0 + bj * HALF + 4 * n);
        if (u.pn >= 10) {
            bf16_t* tile = MGT + ((size_t)u.pm * 16 + (u.pn - 10)) * 65536 + (wr * 64 + fr) * 256 + wc * 32 + 8 * fq;
#pragma unroll
            for (int ai = 0; ai < 2; ++ai)
#pragma unroll
                for (int m = 0; m < 4; ++m)
#pragma unroll
                    for (int bj = 0; bj < 2; ++bj) { const f32x4 v0 = acc[ai][bj][m][0] + bv[bj][0], v1 = acc[ai][bj][m][1] + bv[bj][1];
                        u32x4 w; w.x = pk2(sigmoidf_(v0[0]), sigmoidf_(v0[1])); w.y = pk2(sigmoidf_(v0[2]), sigmoidf_(v0[3])); w.z = pk2(sigmoidf_(v1[0]), sigmoidf_(v1[1])); w.w = pk2(sigmoidf_(v1[2]), sigmoidf_(v1[3]));
                        *(u32x4*)(tile + (ai * HALF + m * 16) * 256 + bj * HALF) = w; }
            return; }
        const bool special = (u.pn == 2) && (wc == 0) && (fq < 2);
#pragma unroll
        for (int ai = 0; ai < 2; ++ai)
#pragma unroll
            for (int m = 0; m < 4; ++m) { const int row = row0 + ai * HALF + m * 16; bf16_t* rowp = H + (size_t)row * NP + col0;
#pragma unroll
                for (int bj = 0; bj < 2; ++bj) { const f32x4 v0 = acc[ai][bj][m][0] + bv[bj][0], v1 = acc[ai][bj][m][1] + bv[bj][1];
                    u32x4 w; w.x = pk2(v0[0], v0[1]); w.y = pk2(v0[2], v0[3]); w.z = pk2(v1[0], v1[1]); w.w = pk2(v1[2], v1[3]);
                    *(u32x4*)(rowp + bj * HALF) = w;
                    if (bj == 1 && special) { float* sp = side + (size_t)row * 16 + 8 * fq; *(f32x4*)sp = v0; *(f32x4*)(sp + 4) = v1; } } }
    }
};
struct EpiBrGate {
    static constexpr bool PERM = true;
    struct Pre { u32x4 g[2][4]; };
    static constexpr bool PAIR16 = false;
    const bf16_t* MGT; bf16_t* GBF;
    DEV const char* gate_base(const Unit& u) const { return (const char*)(MGT + ((size_t)u.pm * 16 + u.e * 4 + (u.pn >> 1)) * 65536 + (u.pn & 1) * 128); }
    DEV void gate_read(Pre& p, const LAS unsigned char* slot, int idx, int wc, int fr, int fq) const {
        const LAS unsigned char* q = slot + fr * 256 + (wc * 32 + 8 * fq) * 2;
        if (idx == 0) {
#pragma unroll
            for (int m = 0; m < 4; ++m) p.g[0][m] = *(const LAS u32x4*)(q + m * 16 * 256); }
        else {
#pragma unroll
            for (int m = 0; m < 4; ++m) p.g[1][m] = *(const LAS u32x4*)(q + m * 16 * 256); }
    }
    DEV void fold(f32x4 (&acc)[2][2][4][2], const Pre& p, const Unit& u, int wr, int wc, int fr, int fq) const {
        const int n = u.e;
#pragma unroll
        for (int ai = 0; ai < 2; ++ai)
#pragma unroll
            for (int m = 0; m < 4; ++m) { const u32x4 g = p.g[ai][m]; const f32x4 a0 = acc[ai][0][m][0], a1 = acc[ai][0][m][1];
                f32x4 t0, t1;
                t0[0] = a0[0] * bflo(g.x); t0[1] = a0[1] * bfhi(g.x); t0[2] = a0[2] * bflo(g.y); t0[3] = a0[3] * bfhi(g.y);
                t1[0] = a1[0] * bflo(g.z); t1[1] = a1[1] * bfhi(g.z); t1[2] = a1[2] * bflo(g.w); t1[3] = a1[3] * bfhi(g.w);
                if (n == 0) { acc[ai][1][m][0] = t0; acc[ai][1][m][1] = t1; } else { acc[ai][1][m][0] += t0; acc[ai][1][m][1] += t1; } }
        if (n == 3) { const int row0 = u.pm * BM + wr * 64 + fr, col0 = u.pn * HALF + wc * 32 + 8 * fq;
#pragma unroll
            for (int ai = 0; ai < 2; ++ai)
#pragma unroll
                for (int m = 0; m < 4; ++m) { const f32x4 v0 = acc[ai][1][m][0], v1 = acc[ai][1][m][1];
                    u32x4 w; w.x = pk2(v0[0], v0[1]); w.y = pk2(v0[2], v0[3]); w.z = pk2(v1[0], v1[1]); w.w = pk2(v1[2], v1[3]);
                    *(u32x4*)(GBF + (size_t)(row0 + ai * HALF + m * 16) * 1024 + col0) = w; } }
    }
};
struct BrOrder {
    static constexpr bool GATHER = false;
    static constexpr bool ROT = false;
    int G, c;
    DEV bool next(int i, Unit& u) const { const int x = c & 7, q = (c >> 3) + (i >> 2) * (G >> 3); if (q >= 64 || (G & 7)) { if (!(G & 7)) return false; const int tile = c + (i >> 2) * G; if (tile >= 512) return false; u.pm = tile >> 3; u.pn = tile & 7; }
        else { u.pm = x + 8 * (q >> 3); u.pn = q & 7; }
        u.e = i & 3; u.mt = 0; u.cnt = 256; return true; }
    DEV size_t boff(const Unit& u) const { return (size_t)(u.e * 1024 + u.pn * 128) * 256 * 2; }
    DEV unsigned aoff(const Unit& u) const { return (unsigned)(u.e * 256 * 2); }
    DEV unsigned arow(const Unit& u, int r) const { return (unsigned)(u.pm * BM + r); }
};
struct PlainOrder : StaticOrder {
    static constexpr bool GATHER = false;
    static constexpr bool ROT = true;
    DEV int rot(const Unit& u) const { return ((2 * u.pm + u.pn) & 7) * KROT; }
    DEV size_t boff(const Unit& u) const { return (size_t)u.pn * 256 * 1024 * 2; }
    DEV unsigned aoff(const Unit&) const { return 0u; }
    DEV unsigned arow(const Unit& u, int r) const { return (unsigned)(u.pm * BM + r); }
};
struct EpiBf16Out {
    struct Pre {};
    static constexpr bool PAIR16 = false;
    DEV const char* gate_base(const Unit&) const { return nullptr; }
    static constexpr bool PERM = true;
    bf16_t* C;
    DEV void operator()(const f32x4 (&acc)[2][2][4][2], const Unit& u, int wr, int wc, int fr, int fq) const {
        const int row0 = u.pm * BM + wr * 64 + fr, col0 = u.pn * BM + wc * 32 + 8 * fq;
#pragma unroll
        for (int ai = 0; ai < 2; ++ai)
#pragma unroll
            for (int m = 0; m < 4; ++m) { bf16_t* rowp = C + (size_t)(row0 + ai * HALF + m * 16) * 1024 + col0;
#pragma unroll
                for (int bj = 0; bj < 2; ++bj) { const f32x4 v0 = acc[ai][bj][m][0], v1 = acc[ai][bj][m][1];
                    u32x4 w; w.x = pk2(v0[0], v0[1]); w.y = pk2(v0[2], v0[3]); w.z = pk2(v1[0], v1[1]); w.w = pk2(v1[2], v1[3]); *(u32x4*)(rowp + bj * HALF) = w; } }
    }
};
template <int MODE> struct MoeOrder {
    static constexpr bool GATHER = (MODE == 1);
    static constexpr bool ROT = true;
    DEV int rot(const Unit& u) const { return u.pn * KROT; }
    const LAS unsigned* ul;
    const int* rowtk;
    DEV bool next(int i, Unit& u) const {
        const unsigned p = (unsigned)__builtin_amdgcn_readfirstlane((int)ul[i]); if (p == 0xffffffffu) return false;
        u.pn = (int)(p & 7u); u.e = (int)((p >> 3) & 31u); u.mt = (int)((p >> 8) & 127u); u.pm = (int)((p >> 15) & 511u); u.cnt = (int)(p >> 24) + 1; return true;
    }
    DEV size_t boff(const Unit& u) const { return MODE == 1 ? ((size_t)u.e * 2048 + u.pn * 256) * 1024 * 2 : ((size_t)u.e * 1024 + u.pn * 256) * 1024 * 2; }
    DEV unsigned aoff(const Unit&) const { return 0u; }
    DEV unsigned arow(const Unit& u, int r) const {
        if (MODE == 2) return (unsigned)(u.pm * 256 + r);
        return r < u.cnt ? (unsigned)(rowtk[(size_t)u.e * NT + u.mt * 256 + r] >> 2) : 0u;
    }
    DEV const int* idx_ptr(const Unit& u) const { return rowtk + (size_t)u.e * NT + u.mt * 256; }
    DEV unsigned arow_from(const Unit& u, int r, int ix) const { return r < u.cnt ? (unsigned)(ix >> 2) : 0u; }
};
struct EpiMoe1 {
    struct Pre {};
    DEV const char* gate_base(const Unit&) const { return nullptr; }
    static constexpr bool PERM = true, PAIR16 = true;
    bf16_t* ACT; const float* b1;
    DEV void operator()(const f32x4 (&acc)[2][2][4][2], const Unit& u, int wr, int wc, int fr, int fq) const {
        const int row0 = u.pm * BM + wr * 64 + fr, q = 4 * wc + fq, hcol0 = u.pn * BM + 16 * q;
        const float* bp = b1 + (size_t)u.e * 2048 + hcol0;
        f32x4 bv[2][2];
#pragma unroll
        for (int bj = 0; bj < 2; ++bj)
#pragma unroll
            for (int n = 0; n < 2; ++n) bv[bj][n] = *(const f32x4*)(bp + 8 * bj + 4 * n);
#pragma unroll
        for (int ai = 0; ai < 2; ++ai)
#pragma unroll
            for (int m = 0; m < 4; ++m) { bf16_t* rowp = ACT + (size_t)(row0 + ai * HALF + m * 16) * 1024 + (hcol0 >> 1);
                float o[8];
#pragma unroll
                for (int bj = 0; bj < 2; ++bj) { const f32x4 v0 = acc[ai][bj][m][0] + bv[bj][0], v1 = acc[ai][bj][m][1] + bv[bj][1];
#pragma unroll
                    for (int j = 0; j < 4; ++j) { const float hg = j < 2 ? v0[2 * j] : v1[2 * j - 4], hl = j < 2 ? v0[2 * j + 1] : v1[2 * j - 3];
                        const float glu = fminf(hg, 7.f), lin = fminf(fmaxf(hl, -7.f), 7.f); o[4 * bj + j] = glu * sigmoidf_(1.702f * glu) * (lin + 1.f); } }
                u32x4 w; w.x = pk2(o[0], o[1]); w.y = pk2(o[2], o[3]); w.z = pk2(o[4], o[5]); w.w = pk2(o[6], o[7]); *(u32x4*)rowp = w; }
    }
};
struct EpiMoe2 {
    struct Pre {};
    static constexpr bool PAIR16 = false;
    DEV const char* gate_base(const Unit&) const { return nullptr; }
    static constexpr bool PERM = true;
    bf16_t* Y; const float* b2; const int* rowtk;
    DEV void operator()(const f32x4 (&acc)[2][2][4][2], const Unit& u, int wr, int wc, int fr, int fq) const {
        const int col0 = u.pn * BM + wc * 32 + 8 * fq;
        const float* bp = b2 + (size_t)u.e * 1024 + col0;
        f32x4 bv[2][2];
#pragma unroll
        for (int bj = 0; bj < 2; ++bj)
#pragma unroll
            for (int n = 0; n < 2; ++n) bv[bj][n] = *(const f32x4*)(bp + bj * HALF + 4 * n);
        const int* rt = rowtk + (size_t)u.e * NT + u.mt * 256 + wr * 64 + fr;
        int dst[2][4];
#pragma unroll
        for (int ai = 0; ai < 2; ++ai)
#pragma unroll
            for (int m = 0; m < 4; ++m) dst[ai][m] = rt[ai * HALF + m * 16];
        asm volatile("" :: "v"(bv[0][0]), "v"(bv[0][1]), "v"(bv[1][0]), "v"(bv[1][1]), "v"(dst[0][0]), "v"(dst[0][1]), "v"(dst[0][2]), "v"(dst[0][3]), "v"(dst[1][0]), "v"(dst[1][1]), "v"(dst[1][2]), "v"(dst[1][3]));
#pragma unroll
        for (int ai = 0; ai < 2; ++ai)
#pragma unroll
            for (int m = 0; m < 4; ++m) { const int r = ai * HALF + wr * 64 + m * 16 + fr;
                if (r < u.cnt) { bf16_t* rowp = Y + (size_t)dst[ai][m] * 1024 + col0;
#pragma unroll
                    for (int bj = 0; bj < 2; ++bj) { const f32x4 v0 = acc[ai][bj][m][0] + bv[bj][0], v1 = acc[ai][bj][m][1] + bv[bj][1];
                        u32x4 w; w.x = pk2(v0[0], v0[1]); w.y = pk2(v0[2], v0[3]); w.z = pk2(v1[0], v1[1]); w.w = pk2(v1[2], v1[3]); *(u32x4*)(rowp + bj * HALF) = w; } } }
    }
};
}

struct Frame {
    LAS unsigned char* lds;
    volatile LAS unsigned* MISC;
    unsigned* ctl;
    unsigned char* ws;
    int tid, lane, wave, G, bid;
};
template <class T> DEV T* wsp(const Frame& F, size_t off) { return (T*)(F.ws + off); }
DEV void frame_refresh(Frame& F) {
    int t_ = threadIdx.x; asm volatile("" : "+v"(t_)); F.tid = t_; F.lane = t_ & 63; F.wave = __builtin_amdgcn_readfirstlane(t_ >> 6);
    unsigned long long w_ = (unsigned long long)F.ws; asm volatile("" : "+s"(w_)); F.ws = (unsigned char*)(GAS unsigned char*)w_; F.ctl = (unsigned*)F.ws;
}

struct IdMap { DEV int operator()(int i) const { return i; } };
struct HpColMap { DEV int operator()(int c) const { return hp_src_col(c); } };
struct CmpRowMap { DEV int operator()(int k) const { return (k & ~63) + perm16(k & 63); } };
template <class RM, class CM>
DEV void transpose_item(const float* W, int ldw, bf16_t* WT, int ldt, int k0, int n0, LAS float* scr, int lane, RM rm, CM cm) {
    const int nn = lane & 31; const int sc = cm(n0 + nn);
#pragma unroll 8
    for (int i = 0; i < 32; ++i) { const int kk = 2 * i + (lane >> 5); scr[kk * 33 + nn] = sc >= 0 ? W[(size_t)rm(k0 + kk) * ldw + sc] : 0.f; }
    LDS_WAIT(); asm volatile("" ::: "memory");
    const int c = lane & 7;
#pragma unroll
    for (int j = 0; j < 4; ++j) { const int n = (lane >> 3) + 8 * j; const LAS float* s = scr + (8 * c) * 33 + n;
        u32x4 o; o.x = pk2(s[0 * 33], s[1 * 33]); o.y = pk2(s[2 * 33], s[3 * 33]); o.z = pk2(s[4 * 33], s[5 * 33]); o.w = pk2(s[6 * 33], s[7 * 33]);
        *(u32x4*)(WT + (size_t)(n0 + n) * ldt + k0 + 8 * c) = o; }
    LDS_WAIT(); asm volatile("" ::: "memory");
}
struct TItem { const float* W; bf16_t* WT; int ldw, ldt, k0, n0, rmap; };
DEV void titem_load(const TItem& it, f32x4 (&v)[16], int lane) {
    const int nq = lane & 15, kr = lane >> 4;
    if (it.rmap == 2) { const int n = it.n0 + 4 * nq; const int c0 = hp_src_col(n), c1 = hp_src_col(n + 1), c2 = hp_src_col(n + 2), c3 = hp_src_col(n + 3);
        const bool quad = (c0 >= 0) && (c1 == c0 + 1) && (c2 == c0 + 2) && (c3 == c0 + 3);
#pragma unroll
        for (int i = 0; i < 16; ++i) { const float* rp = it.W + (size_t)(it.k0 + 4 * i + kr) * it.ldw;
            if (quad) v[i] = __builtin_nontemporal_load((const f32x4*)(rp + c0));
            else v[i] = (f32x4){c0 >= 0 ? rp[c0] : 0.f, c1 >= 0 ? rp[c1] : 0.f, c2 >= 0 ? rp[c2] : 0.f, c3 >= 0 ? rp[c3] : 0.f}; }
        return; }
#pragma unroll
    for (int i = 0; i < 16; ++i) { int k = it.k0 + 4 * i + kr; if (it.rmap) k = (k & ~63) + perm16(k & 63); v[i] = __builtin_nontemporal_load((const f32x4*)(it.W + (size_t)k * it.ldw + it.n0 + 4 * nq)); }
}
DEV void titem_store(const TItem& it, const f32x4 (&v)[16], LAS bf16_t* scr, int lane) {
    const int nq = lane & 15, kr = lane >> 4; constexpr int SP = 66;
#pragma unroll
    for (int i = 0; i < 16; ++i) { LAS unsigned* d = (LAS unsigned*)(scr + (4 * i + kr) * SP + 4 * nq); d[0] = pk2(v[i][0], v[i][1]); d[1] = pk2(v[i][2], v[i][3]); }
    LDS_WAIT(); asm volatile("" ::: "memory");
    const int c = lane & 7;
#pragma unroll
    for (int j = 0; j < 8; ++j) { const int n = (lane >> 3) + 8 * j; const LAS bf16_t* sp = scr + (8 * c) * SP + n;
        u32x4 o; o.x = sp[0] | ((unsigned)sp[SP] << 16); o.y = sp[2 * SP] | ((unsigned)sp[3 * SP] << 16); o.z = sp[4 * SP] | ((unsigned)sp[5 * SP] << 16); o.w = sp[6 * SP] | ((unsigned)sp[7 * SP] << 16);
        __builtin_nontemporal_store(o, (u32x4*)(it.WT + (size_t)(it.n0 + n) * it.ldt + it.k0 + 8 * c)); }
    LDS_WAIT(); asm volatile("" ::: "memory");
}
constexpr long BG_PER_LAYER = 32L * 512 + 32L * 256, BG_TOTAL = NL * BG_PER_LAYER;
DEV TItem bg_decode(const Frame& F, const Params& P, long idx) {
    const int l = (int)(idx / BG_PER_LAYER); long r = idx - (long)l * BG_PER_LAYER; TItem it;
    if (r < 32L * 512) { const int mat = l * 32 + (int)(r >> 9), q = (int)(r & 511); it = TItem{P.in[I_WE1] + (size_t)mat * 1024 * 2048, wsp<bf16_t>(F, WS_W1) + (size_t)mat * 2048 * 1024, 2048, 1024, (q >> 5) * 64, (q & 31) * 64, 0}; }
    else { r -= 32L * 512; const int mat = l * 32 + (int)(r >> 8), q = (int)(r & 255); it = TItem{P.in[I_WE2] + (size_t)mat * 1024 * 1024, wsp<bf16_t>(F, WS_W2) + (size_t)mat * 1024 * 1024, 1024, 1024, (q >> 4) * 64, (q & 15) * 64, 0}; }
    return it;
}
constexpr int BG_CHUNK = 8, BG_FILL_STRIDE = 4;
DEV void bg_fill(Frame F, const Params& P, unsigned* done, long limit) {
    frame_refresh(F);
    unsigned* head = F.ctl + CW_BGQ; LAS bf16_t* scr = (LAS bf16_t*)(F.lds + F.wave * 16384); const int lane = F.lane;
    if (done && (F.wave % BG_FILL_STRIDE) != 0) return;
#pragma unroll 1
    for (;;) {
        if (done) { if ((unsigned)__builtin_amdgcn_readfirstlane(__hip_atomic_load(done, __ATOMIC_RELAXED, __HIP_MEMORY_SCOPE_AGENT)) >= (unsigned)F.G) break; }
        else { if ((long)(unsigned)__builtin_amdgcn_readfirstlane(__hip_atomic_load(head, __ATOMIC_RELAXED, __HIP_MEMORY_SCOPE_AGENT)) >= limit) break; }
        unsigned base = 0u; if (lane == 0) base = atomicAdd(head, (unsigned)BG_CHUNK);
        base = (unsigned)__builtin_amdgcn_readfirstlane(base);
        if ((long)base >= BG_TOTAL) break;
        f32x4 va[16], vb[16]; TItem ia = bg_decode(F, P, (long)base), ib; titem_load(ia, va, lane);
#pragma unroll 1
        for (int i = 0; i < BG_CHUNK; i += 2) {
            ib = bg_decode(F, P, (long)base + i + 1); titem_load(ib, vb, lane);
            titem_store(ia, va, scr, lane);
            if (i + 2 < BG_CHUNK) { ia = bg_decode(F, P, (long)base + i + 2); titem_load(ia, va, lane); }
            titem_store(ib, vb, scr, lane);
        }
    }
}
DEV void p0_prologue(Frame F, const Params& P) {
    frame_refresh(F);
    LAS float* scr = (LAS float*)(F.lds + F.wave * 16384);
    const int gw = F.bid * NWAVES + F.wave, NGW = F.G * NWAVES, lane = F.lane;
    LAS bf16_t* scrh = (LAS bf16_t*)scr;
    constexpr long I_E1 = 0, I_E2 = 0, I_BRI = (long)NL * 4 * 64, I_OI = (long)NL * 256, I_C1 = (long)NL * 2 * 32;
    constexpr long I_IN64 = (long)NL * 16 * 104;
    constexpr long N64 = I_E1 + I_E2 + I_BRI + I_OI + I_C1 + I_IN64;
#define P0_DECODE(it, r_) do { long r = (r_); \
        if (r < I_E1) { const int mat = (int)(r >> 9), q = (int)(r & 511); it = TItem{P.in[I_WE1] + (size_t)mat * 1024 * 2048, wsp<bf16_t>(F, WS_W1) + (size_t)mat * 2048 * 1024, 2048, 1024, (q >> 5) * 64, (q & 31) * 64, 0}; break; } \
        r -= I_E1; \
        if (r < I_E2) { const int mat = (int)(r >> 8), q = (int)(r & 255); it = TItem{P.in[I_WE2] + (size_t)mat * 1024 * 1024, wsp<bf16_t>(F, WS_W2) + (size_t)mat * 1024 * 1024, 1024, 1024, (q >> 4) * 64, (q & 15) * 64, 0}; break; } \
        r -= I_E2; \
        if (r < I_BRI) { const int mat = (int)(r >> 6), q = (int)(r & 63); it = TItem{P.in[I_WBR] + (size_t)mat * 256 * 1024, wsp<bf16_t>(F, WS_WBR) + (size_t)mat * 1024 * 256, 1024, 256, (q >> 4) * 64, (q & 15) * 64, 0}; break; } \
        r -= I_BRI; \
        if (r < I_OI) { const int l_ = (int)(r >> 8), q = (int)(r & 255); it = TItem{P.in[I_WO] + (size_t)l_ * 1024 * 1024, wsp<bf16_t>(F, WS_WO) + (size_t)l_ * 1024 * 1024, 1024, 1024, (q >> 4) * 64, (q & 15) * 64, 0}; break; } \
        r -= I_OI; \
        if (r < I_C1) { const int mat = (int)(r >> 5), l_ = mat >> 1, kv = mat & 1; it = TItem{P.in[kv ? I_W1V : I_W1K] + (size_t)l_ * 2048 * 64, wsp<bf16_t>(F, WS_WC1) + (size_t)mat * 64 * 2048, 64, 2048, (int)(r & 31) * 64, 0, kv == 0 ? 1 : 0}; break; } \
        r -= I_C1; \
        { const int l_ = (int)(r / (16 * 104)), q = (int)(r % (16 * 104)); it = TItem{P.in[I_WIN] + (size_t)l_ * 1024 * NIN, wsp<bf16_t>(F, WS_WIN) + (size_t)l_ * NP * 1024, NIN, 1024, (q / 104) * 64, (q % 104) * 64, 2}; } } while (0)
    { f32x4 va[16], vb[16]; TItem ia, ib; long it = gw;
        if (it < N64) { P0_DECODE(ia, it); titem_load(ia, va, lane); }
#pragma unroll 1
        for (; it < N64; it += 2 * (long)NGW) {
            const long i2 = it + NGW, i3 = it + 2 * (long)NGW;
            if (i2 < N64) { P0_DECODE(ib, i2); titem_load(ib, vb, lane); }
            titem_store(ia, va, scrh, lane);
            if (i3 < N64) { P0_DECODE(ia, i3); titem_load(ia, va, lane); }
            if (i2 < N64) titem_store(ib, vb, scrh, lane);
        } }
#undef P0_DECODE
    constexpr long I_C2 = (long)NL * 2 * 2;
    for (long it = gw; it < I_C2; it += NGW) { const long r = it;
        { const int mat = (int)(r >> 1), l = mat >> 1, kv = mat & 1, nb = (int)(r & 1);
            transpose_item(P.in[kv ? I_W2V : I_W2K] + (size_t)l * 64 * 64, 64, wsp<bf16_t>(F, WS_WC2) + (size_t)mat * 64 * 64, 64, 0, nb * 32, scr, lane, IdMap(), IdMap()); }
    }
    const int gt = F.bid * NTHR + F.tid, NGT = F.G * NTHR;
    {
        const float* ws_ = P.in[I_GWS]; bf16_t* wg = wsp<bf16_t>(F, WS_WG);
        for (int i = gt; i < NL * 4 * 128 * 128; i += NGT) { const int s = i & 127, t = (i >> 7) & 127; wg[i] = (s <= t) ? f2bf(ws_[i]) : (bf16_t)0; }
    }
    {
        float* bp = wsp<float>(F, WS_BIN);
        for (int i = gt; i < NL * NP; i += NGT) { const int l = i / NP, c = i % NP, sc = hp_src_col(c); bp[i] = sc >= 0 ? P.in[I_BIN][(size_t)l * NIN + sc] : 0.f; }
    }
    {
        float* cs = wsp<float>(F, WS_CS); const int* pos = (const int*)P.in[I_POS];
        for (int i = gt; i < NT * 8; i += NGT) { const int t = i >> 3, f = i & 7;
            const double ang = (double)pos[t] * P.invf[f];
            const double twopi = 6.283185307179586476925286766559; double r = ang - twopi * rint(ang * (1.0 / twopi));
            const double r2 = r * r; double sn = 0.0, cn = 0.0, term = r;
#pragma unroll
            for (int k = 1; k <= 29; k += 2) { sn += term; term *= r2 * (-1.0 / (double)((k + 1) * (k + 2))); }
            term = 1.0;
#pragma unroll
            for (int k = 0; k <= 28; k += 2) { cn += term; term *= r2 * (-1.0 / (double)((k + 1) * (k + 2))); }
            cs[(size_t)t * 16 + f] = (float)cn; cs[(size_t)t * 16 + 8 + f] = (float)sn; }
    }
    {
        const f32x4* x4 = (const f32x4*)P.in[I_X]; u32x2* xb = wsp<u32x2>(F, WS_XB);
#pragma unroll 1
        for (int i0 = gt; i0 < NT * 256; i0 += 8 * NGT) { f32x4 v[8];
#pragma unroll
            for (int j = 0; j < 8; ++j) { const int i = i0 + j * NGT; v[j] = (i < NT * 256) ? __builtin_nontemporal_load(x4 + i) : (f32x4){0.f, 0.f, 0.f, 0.f}; }
#pragma unroll
            for (int j = 0; j < 8; ++j) { const int i = i0 + j * NGT; if (i < NT * 256) { u32x2 w; w.x = pk2(v[j][0], v[j][1]); w.y = pk2(v[j][2], v[j][3]); xb[i] = w; } } }
    }
    for (int task = gw; task < NL * 2 * 32; task += NGW) { const int lk = task >> 5, part = task & 31, l = lk >> 1, kv = lk & 1;
        const float* pe = P.in[kv ? I_PEV : I_PEK] + (size_t)l * 2048 + part * 64; const float* w1 = P.in[kv ? I_W1V : I_W1K] + ((size_t)l * 2048 + part * 64) * 64;
        float a = 0.f;
#pragma unroll 16
        for (int k = 0; k < 64; ++k) a += pe[k] * w1[(size_t)k * 64 + lane];
        wsp<float>(F, WS_CB)[task * 64 + lane] = a; }
}

DEV void pb_transpose_unit(Frame F, int unit) {
    frame_refresh(F);
    const int b = unit >> 6, t0 = (unit & 63) * 64; const int tid = F.tid;
    const bf16_t* H = wsp<bf16_t>(F, WS_H); const float* cs = wsp<float>(F, WS_CS);
    const size_t rowb = (size_t)b * SEQ + t0;
    LAS bf16_t* tile = (LAS bf16_t*)F.lds; constexpr int TP = 392;
    LAS unsigned* nmx = (LAS unsigned*)(F.lds + 65536);
    u32x4 rw[2]; f32x4 rc[2], rs[2]; u32x4 vw[6], kw[4];
#pragma unroll
    for (int it = 0; it < 2; ++it) { const int task = tid + it * NTHR, tok = task >> 4, hd = (task >> 3) & 1, ch = task & 7; const size_t row = rowb + tok;
        rw[it] = *(const u32x4*)(H + row * NP + (hd ? HP_KW : HP_KS) + ch * 8);
        const float* c = cs + row * 16 + 4 * (ch & 1); rc[it] = *(const f32x4*)c; rs[it] = *(const f32x4*)(c + 8); }
#pragma unroll
    for (int it = 0; it < 6; ++it) { const int task = tid + it * NTHR, tok = task / 48, ch = task % 48;
        const int scol = ch < 8 ? HP_VS + ch * 8 : (ch < 16 ? HP_VW + (ch - 8) * 8 : HP_FV + (ch - 16) * 8);
        vw[it] = *(const u32x4*)(H + (rowb + tok) * NP + scol); }
    { const int tok = tid >> 3, part = tid & 7;
#pragma unroll
        for (int q = 0; q < 4; ++q) kw[q] = *(const u32x4*)(H + (rowb + tok) * NP + HP_FK + part * 32 + q * 8); }
    if (tid < 4) nmx[tid] = 0u;
#pragma unroll
    for (int it = 0; it < 2; ++it) { const int task = tid + it * NTHR, tok = task >> 4, hd = (task >> 3) & 1, ch = task & 7; const size_t row = rowb + tok;
        u32x4 w = rw[it]; unsigned* wp = (unsigned*)&w;
#pragma unroll
        for (int j = 0; j < 4; ++j) { const float t1 = bflo(wp[j]), t2 = bfhi(wp[j]); const unsigned rot = pk2(t1 * rc[it][j] - t2 * rs[it][j], t2 * rc[it][j] + t1 * rs[it][j]); wp[j] = (ch < 2) ? rot : wp[j]; }
        *(u32x4*)(wsp<bf16_t>(F, WS_KNSA) + row * 128 + hd * 64 + ch * 8) = w; }
#pragma unroll
    for (int it = 0; it < 6; ++it) { const int task = tid + it * NTHR, tok = task / 48, ch = task % 48; const u32x4 w = vw[it];
        *(LAS u32x2*)(tile + tok * TP + ch * 8) = (u32x2){w.x, w.y}; *(LAS u32x2*)(tile + tok * TP + ch * 8 + 4) = (u32x2){w.z, w.w}; }
    __syncthreads();
    { const int part = tid & 7; float ss = 0.f;
#pragma unroll
        for (int q = 0; q < 4; ++q) { const unsigned* wp = (const unsigned*)&kw[q];
#pragma unroll
            for (int j = 0; j < 4; ++j) { const float a = bflo(wp[j]), c = bfhi(wp[j]); ss += a * a + c * c; } }
        ss += __shfl_xor(ss, 1);
        if ((part & 1) == 0) (void)__hip_atomic_fetch_max(nmx + (part >> 1), __float_as_uint(ss), __ATOMIC_RELAXED, __HIP_MEMORY_SCOPE_WORKGROUP); }
    bf16_t* VT = wsp<bf16_t>(F, WS_VT);
#pragma unroll
    for (int it = 0; it < 6; ++it) { const int task = tid + it * NTHR, d = task % 384, sc = task / 384;
        unsigned short v[8];
#pragma unroll
        for (int j = 0; j < 8; ++j) v[j] = tile[(sc * 8 + j) * TP + d];
        u32x4 w; w.x = v[0] | ((unsigned)v[1] << 16); w.y = v[2] | ((unsigned)v[3] << 16); w.z = v[4] | ((unsigned)v[5] << 16); w.w = v[6] | ((unsigned)v[7] << 16);
        *(u32x4*)(VT + ((size_t)b * 384 + d) * SEQ + t0 + sc * 8) = w; }
    __syncthreads();
    if (tid < 4) wsp<float>(F, WS_KN)[((size_t)b * 4 + tid) * 64 + (t0 >> 6)] = sqrtf(__uint_as_float(nmx[tid])) * 1.0001f;
    __syncthreads();
}
DEV void pb_cum_unit(Frame F, int unit) {
    frame_refresh(F);
    const int b = unit >> 2, h = unit & 3, tid = F.tid;
    const float* side = wsp<float>(F, WS_SIDE);
    LAS double* sc = (LAS double*)F.lds;
    double loc[8]; double s = 0.0;
#pragma unroll
    for (int j = 0; j < 8; ++j) { const float x = side[((size_t)b * SEQ + tid * 8 + j) * 16 + 12 + h];
        const float ls = fminf(x, 0.f) - __logf(1.f + __expf(-fabsf(x)));
        s += (double)ls; loc[j] = s; }
    double inc = s;
#pragma unroll
    for (int o = 1; o < 64; o <<= 1) { const double t = __shfl_up(inc, o); if (F.lane >= o) inc += t; }
    if (F.lane == 63) sc[F.wave] = inc;
    __syncthreads();
    double wbase = 0.0;
#pragma unroll
    for (int w = 0; w < 8; ++w) wbase += (w < F.wave) ? sc[w] : 0.0;
    __syncthreads();
    sc[8 + tid] = wbase + inc - s;
    const double base = sc[8 + tid]; float* cum = wsp<float>(F, WS_CUM) + ((size_t)b * 4 + h) * SEQ + tid * 8;
#pragma unroll
    for (int j = 0; j < 8; ++j) cum[j] = (float)((base + loc[j]) * 1.4426950408889634);
    __syncthreads();
}
DEV void pb_conv_unit(Frame F, const Params& P, int l, int unit) {
    frame_refresh(F);
    const int b = unit >> 6, t0 = (unit & 63) * 64, tid = F.tid, lane = F.lane, wave = F.wave;
    const bf16_t* H = wsp<bf16_t>(F, WS_H);
    float w[31]; { const float* cw = P.in[I_CW] + (size_t)l * 31 * 256 + (tid & 255);
#pragma unroll
        for (int j = 0; j < 31; ++j) w[j] = cw[j * 256]; }
    const float bias = P.in[I_CB][l * 256 + (tid & 255)];
    LAS bf16_t* xg = (LAS bf16_t*)F.lds;
    LAS float* cv = (LAS float*)(F.lds + 49152);
    { u32x4 wv[12];
#pragma unroll
        for (int it = 0; it < 12; ++it) { const int task = tid + it * NTHR, r = task >> 6, c4 = (task & 63) * 4; const int t = t0 - 30 + r;
            wv[it] = (task < 94 * 64 && t >= 0) ? *(const u32x4*)(H + ((size_t)b * SEQ + t) * NP + HP_CAB + 2 * c4) : (u32x4){0u, 0u, 0u, 0u}; }
#pragma unroll
        for (int it = 0; it < 12; ++it) { const int task = tid + it * NTHR, r = task >> 6, c4 = (task & 63) * 4;
            if (task < 94 * 64) { const unsigned* wp = (const unsigned*)&wv[it]; float g[4];
#pragma unroll
                for (int j = 0; j < 4; ++j) g[j] = bflo(wp[j]) * sigmoidf_(bfhi(wp[j]));
                *(LAS u32x2*)(xg + r * 256 + c4) = (u32x2){pk2(g[0], g[1]), pk2(g[2], g[3])}; } } }
    __syncthreads();
    { const int c = tid & 255, half = tid >> 8;
        float xw[62];
#pragma unroll
        for (int j = 0; j < 62; ++j) xw[j] = bf2f(xg[(half * 32 + j) * 256 + c]);
#pragma unroll
        for (int tt = 0; tt < 32; ++tt) { float a = bias;
#pragma unroll
            for (int j = 0; j < 31; ++j) a += w[j] * xw[tt + j];
            cv[(half * 32 + tt) * 256 + c] = a; } }
    __syncthreads();
    { const f32x4 gg = *(const f32x4*)(P.in[I_CLNG] + l * 256 + lane * 4), bb = *(const f32x4*)(P.in[I_CLNB] + l * 256 + lane * 4);
        bf16_t* BR = wsp<bf16_t>(F, WS_BR);
#pragma unroll 1
        for (int i = 0; i < 8; ++i) { const int tt = wave * 8 + i; f32x4 v = *(const LAS f32x4*)(cv + tt * 256 + lane * 4);
            const float mean = wave_sum((v[0] + v[1]) + (v[2] + v[3])) * (1.f / 256.f); v = v - mean;
            const float var = wave_sum((v[0] * v[0] + v[1] * v[1]) + (v[2] * v[2] + v[3] * v[3])) * (1.f / 256.f);
            const float rstd = 1.f / sqrtf(var + LN_EPS); v = v * rstd * gg + bb;
#pragma unroll
            for (int j = 0; j < 4; ++j) v[j] = v[j] * sigmoidf_(v[j]);
            u32x2 o; o.x = pk2(v[0], v[1]); o.y = pk2(v[2], v[3]);
            *(u32x2*)(BR + ((size_t)b * SEQ + t0 + tt) * 1024 + 768 + lane * 4) = o; } }
    __syncthreads();
}
DEV void pb_gmlp_unit(Frame F, const Params& P, int l, int unit) {
    frame_refresh(F);
    const int t0 = unit * 128, tid = F.tid, lane = F.lane, wave = F.wave, fr = lane & 15, fq = lane >> 4;
    const bf16_t* H = wsp<bf16_t>(F, WS_H);
    LAS bf16_t* vt = (LAS bf16_t*)F.lds; constexpr int VP = 136;
    { const f32x4 gg = *(const f32x4*)(P.in[I_GLNG] + l * 256 + lane * 4), bb = *(const f32x4*)(P.in[I_GLNB] + l * 256 + lane * 4);
        u32x2 wv[16];
#pragma unroll
        for (int i = 0; i < 16; ++i) wv[i] = *(const u32x2*)(H + (size_t)(t0 + wave * 16 + i) * NP + HP_GV + lane * 4);
#pragma unroll
        for (int i = 0; i < 16; ++i) { const int s = wave * 16 + i; const u32x2 w = wv[i];
            f32x4 v = {gelu_tanh(bflo(w.x)), gelu_tanh(bfhi(w.x)), gelu_tanh(bflo(w.y)), gelu_tanh(bfhi(w.y))};
            const float mean = wave_sum((v[0] + v[1]) + (v[2] + v[3])) * (1.f / 256.f); v = v - mean;
            const float var = wave_sum((v[0] * v[0] + v[1] * v[1]) + (v[2] * v[2] + v[3] * v[3])) * (1.f / 256.f);
            const float rstd = 1.f / sqrtf(var + LN_EPS); v = v * rstd * gg + bb;
#pragma unroll
            for (int j = 0; j < 4; ++j) vt[(lane * 4 + j) * VP + s] = f2bf(v[j]); } }
    __syncthreads();
    { const int g = wave & 3, th = wave >> 2;
        const bf16_t* Wg = wsp<bf16_t>(F, WS_WG) + ((size_t)l * 4 + g) * 128 * 128;
        bf16_t* BR = wsp<bf16_t>(F, WS_BR);
        bf16x8 wf[4][4]; u32x2 uw[4][4]; float bs[4];
#pragma unroll
        for (int tb = 0; tb < 4; ++tb) { const int trow = th * 64 + tb * 16;
#pragma unroll
            for (int ks = 0; ks < 4; ++ks) wf[tb][ks] = (ks * 32 <= trow + 15) ? *(const bf16x8*)(Wg + (size_t)(trow + fr) * 128 + ks * 32 + fq * 8) : (bf16x8){0, 0, 0, 0, 0, 0, 0, 0};
#pragma unroll
            for (int db = 0; db < 4; ++db) uw[tb][db] = *(const u32x2*)(H + (size_t)(t0 + trow + fr) * NP + HP_GU + g * 64 + db * 16 + fq * 4);
            bs[tb] = P.in[I_GBS][((size_t)l * 4 + g) * 128 + trow + fr]; }
#pragma unroll
        for (int tb = 0; tb < 4; ++tb) { const int trow = th * 64 + tb * 16;
            f32x4 acc[4];
#pragma unroll
            for (int db = 0; db < 4; ++db) acc[db] = (f32x4){0.f, 0.f, 0.f, 0.f};
#pragma unroll
            for (int ks = 0; ks < 4; ++ks) if (ks * 32 <= trow + 15) {
#pragma unroll
                for (int db = 0; db < 4; ++db) { const bf16x8 vf = *(const LAS bf16x8*)(vt + (g * 64 + db * 16 + fr) * VP + ks * 32 + fq * 8);
                    acc[db] = mfma16(vf, wf[tb][ks], acc[db]); } }
            const int t = t0 + trow + fr;
#pragma unroll
            for (int db = 0; db < 4; ++db) { const int c = g * 64 + db * 16 + fq * 4; const u32x2 u2 = uw[tb][db]; const float b_ = bs[tb];
                const float o0 = gelu_tanh(bflo(u2.x)) * (acc[db][0] + b_), o1 = gelu_tanh(bfhi(u2.x)) * (acc[db][1] + b_), o2 = gelu_tanh(bflo(u2.y)) * (acc[db][2] + b_), o3 = gelu_tanh(bfhi(u2.y)) * (acc[db][3] + b_);
                u32x2 o; o.x = pk2(o0, o1); o.y = pk2(o2, o3); *(u32x2*)(BR + (size_t)t * 1024 + 512 + c) = o; } } }
    __syncthreads();
}
DEV void pb_compress_unit(Frame F, int l, int unit) {
    frame_refresh(F);
    const int kv = unit & 1, mb = (unit >> 1) & 15, b = unit >> 5; const int tid = F.tid, lane = F.lane, wave = F.wave, fr = lane & 15, fq = lane >> 4;
    const bf16_t* H = wsp<bf16_t>(F, WS_H); const float* cs = wsp<float>(F, WS_CS);
    const bf16_t* W1 = wsp<bf16_t>(F, WS_WC1) + ((size_t)l * 2 + kv) * 64 * 2048; const bf16_t* W2 = wsp<bf16_t>(F, WS_WC2) + ((size_t)l * 2 + kv) * 64 * 64;
    const f32x4 cbv = *(const f32x4*)(wsp<float>(F, WS_CB) + ((size_t)l * 2 + kv) * 32 * 64 + tid * 4);
    LAS float* red = (LAS float*)F.lds;
    LAS bf16_t* h1 = (LAS bf16_t*)(F.lds + 32768);
    f32x4 acc[4];
#pragma unroll
    for (int nb = 0; nb < 4; ++nb) acc[nb] = (f32x4){0.f, 0.f, 0.f, 0.f};
    const int c = mb * 16 + fr;
    { u32x4 aw[8]; f32x4 cco[4], csi[4];
#pragma unroll
        for (int ks_ = 0; ks_ < 8; ++ks_) { const int ks = wave * 8 + ks_; const int j = ks >> 1, dch = (ks & 1) * 32 + fq * 8; int tok = c * 16 + j; tok = tok > SEQ - 1 ? SEQ - 1 : tok;
            const size_t row = (size_t)b * SEQ + tok;
            aw[ks_] = *(const u32x4*)(H + row * NP + (kv ? HP_VC : HP_KC) + dch);
            if ((ks_ & 1) == 0) { const float* cc = cs + row * 16 + ((fq & 1) * 4); cco[ks_ >> 1] = *(const f32x4*)cc; csi[ks_ >> 1] = *(const f32x4*)(cc + 8); } }
#pragma unroll
        for (int hb = 0; hb < 2; ++hb) { bf16x8 bw[4][4];
#pragma unroll
            for (int k4 = 0; k4 < 4; ++k4)
#pragma unroll
                for (int nb = 0; nb < 4; ++nb) bw[k4][nb] = *(const bf16x8*)(W1 + (size_t)(nb * 16 + fr) * 2048 + (wave * 8 + hb * 4 + k4) * 32 + fq * 8);
#pragma unroll
            for (int k4 = 0; k4 < 4; ++k4) { const int ks_ = hb * 4 + k4; u32x4 w = aw[ks_];
                if ((ks_ & 1) == 0) { const bool rp = (kv == 0) && (fq < 2); unsigned* wp = (unsigned*)&w; const f32x4 co = cco[ks_ >> 1], si = csi[ks_ >> 1];
#pragma unroll
                    for (int q = 0; q < 4; ++q) { const float t1 = bflo(wp[q]), t2 = bfhi(wp[q]); const unsigned rot = pk2(t1 * co[q] - t2 * si[q], t2 * co[q] + t1 * si[q]); wp[q] = rp ? rot : wp[q]; } }
                const bf16x8 af = __builtin_bit_cast(bf16x8, w);
#pragma unroll
                for (int nb = 0; nb < 4; ++nb) acc[nb] = mfma16(af, bw[k4][nb], acc[nb]); } } }
#pragma unroll
    for (int nb = 0; nb < 4; ++nb)
#pragma unroll
        for (int i = 0; i < 4; ++i) red[(wave * 16 + fq * 4 + i) * 64 + nb * 16 + fr] = acc[nb][i];
    __syncthreads();
    { LAS float* cbl = (LAS float*)(F.lds + 36864);
        *(LAS f32x4*)(cbl + tid * 4) = cbv;
        __syncthreads();
#pragma unroll
        for (int it = 0; it < 2; ++it) { const int e = tid + it * NTHR, r = e >> 6, n = e & 63; float s = 0.f;
#pragma unroll
            for (int pp = 0; pp < 32; ++pp) s += cbl[pp * 64 + n];
#pragma unroll
            for (int w = 0; w < 8; ++w) s += red[(w * 16 + r) * 64 + n];
            h1[r * 72 + n] = f2bf(gelu_tanh(s)); } }
    __syncthreads();
    if (wave == 0) {
#pragma unroll
        for (int nb = 0; nb < 4; ++nb) { f32x4 o = (f32x4){0.f, 0.f, 0.f, 0.f};
#pragma unroll
            for (int ks = 0; ks < 2; ++ks) { const bf16x8 hf = *(const LAS bf16x8*)(h1 + fr * 72 + ks * 32 + fq * 8); const bf16x8 wf = *(const bf16x8*)(W2 + (size_t)(nb * 16 + fr) * 64 + ks * 32 + fq * 8);
                o = kv ? mfma16(hf, wf, o) : mfma16(wf, hf, o); }
            u32x2 w; w.x = pk2(o[0], o[1]); w.y = pk2(o[2], o[3]);
            if (kv == 0) *(u32x2*)(wsp<bf16_t>(F, WS_KCMP) + ((size_t)b * 256 + mb * 16 + fr) * 64 + nb * 16 + fq * 4) = w;
            else *(u32x2*)(wsp<bf16_t>(F, WS_VCMPT) + ((size_t)b * 64 + nb * 16 + fr) * 256 + mb * 16 + fq * 4) = w; } }
    __syncthreads();
}

constexpr int TILE_B = 9216, AT_KT = 0, AT_VT = 36864, AT_CK = 73728, AT_KC = 0, AT_VC = 36864, AT_XCH = 0, AT_TAB = 32768, AT_FXT = 74752, AT_XST = 77824;
constexpr int KTP = 72, VCP = 264, TABP = 65;
constexpr float QSCALE = 0.125f * LOG2E;
struct FlashSt { float m, l; f32x4 o[4]; };
DEV void flash_init(FlashSt& s) { s.m = -1e30f; s.l = 0.f;
#pragma unroll
    for (int d = 0; d < 4; ++d) s.o[d] = (f32x4){0.f, 0.f, 0.f, 0.f}; }
DEV bf16x8 pack_p(const f32x4& a, const f32x4& b) { u32x4 w; w.x = pk2(a[0], a[1]); w.y = pk2(a[2], a[3]); w.z = pk2(b[0], b[1]); w.w = pk2(b[2], b[3]); return __builtin_bit_cast(bf16x8, w); }
DEV bf16x8 vfrag(const LAS bf16_t* p) { const bf16x4 lo = *(const LAS bf16x4*)p, hi = *(const LAS bf16x4*)(p + 16); return __builtin_shufflevector(lo, hi, 0, 1, 2, 3, 4, 5, 6, 7); }
struct KVFrags { bf16x8 k[4][2]; bf16x8 v[4][2]; };
DEV void load_frags(KVFrags& f, const LAS bf16_t* kt, const LAS bf16_t* vt, int fr, int fq) {
#pragma unroll
    for (int kb = 0; kb < 4; ++kb) { const LAS bf16_t* kp = kt + (16 * kb + fr) * KTP + 8 * fq; f.k[kb][0] = *(const LAS bf16x8*)kp; f.k[kb][1] = *(const LAS bf16x8*)(kp + 32); }
#pragma unroll
    for (int d = 0; d < 4; ++d)
#pragma unroll
        for (int c = 0; c < 2; ++c) f.v[d][c] = vfrag(vt + (16 * d + fr) * KTP + 32 * c + 4 * fq);
}
DEV void qk_frags(f32x4 (&s)[4], const KVFrags& f, const bf16x8 (&qf)[2]) {
#pragma unroll
    for (int kb = 0; kb < 4; ++kb) { f32x4 a = mfma16(f.k[kb][0], qf[0], (f32x4){0.f, 0.f, 0.f, 0.f}); s[kb] = mfma16(f.k[kb][1], qf[1], a); }
}
DEV void flash_update(FlashSt& st, f32x4 (&s)[4], const KVFrags& f, bool on) {
    float mx = fmaxf(fmaxf(fmaxf(s[0][0], s[0][1]), fmaxf(s[0][2], s[0][3])), fmaxf(fmaxf(s[1][0], s[1][1]), fmaxf(s[1][2], s[1][3])));
    mx = fmaxf(mx, fmaxf(fmaxf(fmaxf(s[2][0], s[2][1]), fmaxf(s[2][2], s[2][3])), fmaxf(fmaxf(s[3][0], s[3][1]), fmaxf(s[3][2], s[3][3]))));
    mx = on ? mx : -INFINITY;
    mx = xr_max(mx);
    const float mn = fmaxf(st.m, mx), alpha = fexp2(st.m - mn); st.m = mn;
    const float mref = on ? mn : INFINITY;
    float sum = 0.f;
#pragma unroll
    for (int kb = 0; kb < 4; ++kb)
#pragma unroll
        for (int i = 0; i < 4; ++i) { const float p = fexp2(s[kb][i] - mref); s[kb][i] = p; sum += p; }
    st.l = st.l * alpha + sum;
#pragma unroll
    for (int d = 0; d < 4; ++d) st.o[d] = st.o[d] * alpha;
#pragma unroll
    for (int c = 0; c < 2; ++c) { const bf16x8 pf = pack_p(s[2 * c], s[2 * c + 1]);
#pragma unroll
        for (int d = 0; d < 4; ++d) st.o[d] = mfma16(f.v[d][c], pf, st.o[d]); }
}
DEV float flash_inv_l(const FlashSt& st) { const float l = xr_sum(st.l); return l > 0.f ? 1.f / l : 0.f; }
DEV bf16x8 load_q(const bf16_t* p, const float* c, bool rope, float scale) {
    u32x4 w = *(const u32x4*)p; unsigned* wp = (unsigned*)&w;
    f32x4 co = {1.f, 1.f, 1.f, 1.f}, si = {0.f, 0.f, 0.f, 0.f};
    if (c) { co = *(const f32x4*)c; si = *(const f32x4*)(c + 8); }
#pragma unroll
    for (int j = 0; j < 4; ++j) { const float t1 = bflo(wp[j]), t2 = bfhi(wp[j]);
        const float a = rope ? t1 * co[j] - t2 * si[j] : t1, bq = rope ? t2 * co[j] + t1 * si[j] : t2;
        wp[j] = pk2(a * scale, bq * scale); }
    return __builtin_bit_cast(bf16x8, w);
}
struct TileRegs { u32x4 k, v; };
DEV void tile_load(TileRegs& r, const bf16_t* kbase, size_t kpitch, const bf16_t* vtbase, int key0, int tid) {
    r.k = *(const u32x4*)(kbase + (size_t)(key0 + (tid >> 3)) * kpitch + (tid & 7) * 8);
    r.v = *(const u32x4*)(vtbase + (size_t)(tid >> 3) * SEQ + key0 + (tid & 7) * 8);
}
DEV void tile_store(const TileRegs& r, LAS bf16_t* kt, LAS bf16_t* vt, int tid) {
    *(LAS u32x4*)(kt + (tid >> 3) * KTP + (tid & 7) * 8) = r.k; *(LAS u32x4*)(vt + (tid >> 3) * KTP + (tid & 7) * 8) = r.v;
}

DEV void nsa_unit(Frame F, int b, int qt, int half) {
    frame_refresh(F);
    const int tid = F.tid, lane = F.lane, wave = F.wave, fr = lane & 15, fq = lane >> 4, sq = wave & 1, hp = (wave >> 1) & 1, ks = wave >> 2, head = 2 * hp + ks, qid = wave >> 1;
    const int ql = 32 * half + 16 * sq + fr, tq = qt * 64 + ql, cur = qt; const size_t rowq = (size_t)b * SEQ + tq;
    const bf16_t* H = wsp<bf16_t>(F, WS_H); const float* cs = wsp<float>(F, WS_CS); const float* side = wsp<float>(F, WS_SIDE);
    LAS bf16_t* KT = (LAS bf16_t*)(F.lds + AT_KT); LAS bf16_t* VT = (LAS bf16_t*)(F.lds + AT_VT);
    LAS bf16_t* KC = (LAS bf16_t*)(F.lds + AT_KC); LAS bf16_t* VC = (LAS bf16_t*)(F.lds + AT_VC);
    bf16x8 qf2[2][2], qf[2]; float gate[3];
#pragma unroll
    for (int hh = 0; hh < 2; ++hh)
#pragma unroll
        for (int dc = 0; dc < 2; ++dc) qf2[hh][dc] = load_q(H + rowq * NP + HP_NQ + (2 * hp + hh) * 64 + 32 * dc + 8 * fq, cs + rowq * 16 + 4 * (fq & 1), dc == 0 && fq < 2, QSCALE);
#pragma unroll
    for (int dc = 0; dc < 2; ++dc) qf[dc] = ks ? qf2[1][dc] : qf2[0][dc];
#pragma unroll
    for (int i = 0; i < 3; ++i) gate[i] = sigmoidf_(side[rowq * 16 + head * 3 + i]);
    { const bf16_t* kc = wsp<bf16_t>(F, WS_KCMP) + (size_t)b * 256 * 64; const bf16_t* vc = wsp<bf16_t>(F, WS_VCMPT) + (size_t)b * 64 * 256;
#pragma unroll
        for (int it = 0; it < 4; ++it) { const int id = tid + it * NTHR;
            *(LAS u32x4*)(KC + (id >> 3) * KTP + (id & 7) * 8) = *(const u32x4*)(kc + (size_t)id * 8);
            *(LAS u32x4*)(VC + (id >> 5) * VCP + (id & 31) * 8) = *(const u32x4*)(vc + (size_t)id * 8); } }
    __syncthreads();
    f32x4 res[4]; float imp[16];
    const int nkb = (4 * qt + 2 * half) / 16 + 1;
    const int cl = (tq - 31) >> 4;
    const int srcl = (lane - 16) & 63;
    {
        f32x4 sc[16]; float mx = -1e30f;
#pragma unroll
        for (int kb = 0; kb < 16; ++kb) {
            if (kb < nkb) { const LAS bf16_t* kp = KC + (16 * kb + fr) * KTP + 8 * fq;
                f32x4 a = mfma16(*(const LAS bf16x8*)kp, qf[0], (f32x4){0.f, 0.f, 0.f, 0.f}); a = mfma16(*(const LAS bf16x8*)(kp + 32), qf[1], a);
#pragma unroll
                for (int i = 0; i < 4; ++i) { a[i] = (16 * kb + 4 * fq + i <= cl) ? a[i] : -INFINITY; mx = fmaxf(mx, a[i]); }
                sc[kb] = a; }
            else sc[kb] = (f32x4){-INFINITY, -INFINITY, -INFINITY, -INFINITY}; }
        mx = xr_max(mx);
        float sum = 0.f;
#pragma unroll
        for (int kb = 0; kb < 16; ++kb) if (kb < nkb) {
#pragma unroll
            for (int i = 0; i < 4; ++i) { const float p = fexp2(sc[kb][i] - mx); sc[kb][i] = p; sum += p; } }
        else sc[kb] = (f32x4){0.f, 0.f, 0.f, 0.f};
        sum = xr_sum(sum);
        const float inv = sum > 0.f ? 1.f / sum : 0.f;
        f32x4 o[4];
#pragma unroll
        for (int d = 0; d < 4; ++d) o[d] = (f32x4){0.f, 0.f, 0.f, 0.f};
        float prevx = 0.f;
#pragma unroll
        for (int kb = 0; kb < 16; ++kb) { if (kb < nkb) { sc[kb] = sc[kb] * inv; const float x = __shfl(sc[kb][3], srcl);
                imp[kb] = ((sc[kb][0] + sc[kb][1]) + (sc[kb][2] + sc[kb][3])) + (fq > 0 ? x : prevx); prevx = x; }
            else imp[kb] = 0.f; }
#pragma unroll
        for (int cc = 0; cc < 8; ++cc) if (2 * cc < nkb) { const bf16x8 pf = pack_p(sc[2 * cc], sc[2 * cc + 1]);
#pragma unroll
            for (int d = 0; d < 4; ++d) o[d] = mfma16(vfrag(VC + (16 * d + fr) * VCP + 32 * cc + 4 * fq), pf, o[d]); }
#pragma unroll
        for (int d = 0; d < 4; ++d) res[d] = o[d] * gate[0];
    }
    unsigned mlo, mhi;
    if (cur < 16) { mlo = (2u << cur) - 1u; mhi = 0u; }
    else {
        LAS float* XCH = (LAS float*)(F.lds + AT_XCH); LAS float* TAB = (LAS float*)(F.lds + AT_TAB) + (wave * 16 + fr) * TABP;
        __syncthreads();
#pragma unroll
        for (int kb = 0; kb < 16; ++kb) XCH[(wave * 16 + kb) * 64 + lane] = imp[kb];
        __syncthreads();
#pragma unroll
        for (int kb = 0; kb < 16; ++kb) { const int j = 4 * kb + fq;
            float v = (XCH[((0 + sq) * 16 + kb) * 64 + lane] + XCH[((2 + sq) * 16 + kb) * 64 + lane]) + (XCH[((4 + sq) * 16 + kb) * 64 + lane] + XCH[((6 + sq) * 16 + kb) * 64 + lane]);
            const bool forced = (j == 0) || (j == cur) || (j == cur - 1);
            v = forced ? 1e9f : (j <= cur ? v : -1.f); imp[kb] = v; TAB[j] = v; }
        LDS_WAIT();
        int cnt[4];
#pragma unroll
        for (int k4 = 0; k4 < 4; ++k4) cnt[k4] = 0;
        float myv[4];
#pragma unroll
        for (int k4 = 0; k4 < 4; ++k4) myv[k4] = qid == 0 ? imp[k4] : (qid == 1 ? imp[4 + k4] : (qid == 2 ? imp[8 + k4] : imp[12 + k4]));
#pragma unroll 4
        for (int jj = 0; jj < 64; ++jj) { const float vv = TAB[jj];
#pragma unroll
            for (int k4 = 0; k4 < 4; ++k4) { const int j = 4 * (4 * qid + k4) + fq; cnt[k4] += ((vv > myv[k4]) || (vv == myv[k4] && jj < j)) ? 1 : 0; } }
        mlo = 0u; mhi = 0u;
#pragma unroll
        for (int k4 = 0; k4 < 4; ++k4) { const int j = 4 * (4 * qid + k4) + fq; const unsigned bit = (cnt[k4] < 16 && j <= cur) ? 1u : 0u; if (j < 32) mlo |= bit << (j & 31); else mhi |= bit << (j & 31); }
        mlo = xr_or(mlo); mhi = xr_or(mhi);
        LAS unsigned* MSK = (LAS unsigned*)(F.lds + AT_CK);
        if (fq == 0) { MSK[(wave * 16 + fr) * 2] = mlo; MSK[(wave * 16 + fr) * 2 + 1] = mhi; }
        __syncthreads();
        mlo = (MSK[((0 + sq) * 16 + fr) * 2] | MSK[((2 + sq) * 16 + fr) * 2]) | (MSK[((4 + sq) * 16 + fr) * 2] | MSK[((6 + sq) * 16 + fr) * 2]);
        mhi = (MSK[((0 + sq) * 16 + fr) * 2 + 1] | MSK[((2 + sq) * 16 + fr) * 2 + 1]) | (MSK[((4 + sq) * 16 + fr) * 2 + 1] | MSK[((6 + sq) * 16 + fr) * 2 + 1]);
    }
    __syncthreads();
#pragma unroll 1
    for (int br = 0; br < 2; ++br) {
        const bf16_t* kbase = wsp<bf16_t>(F, WS_KNSA) + (size_t)b * SEQ * 128 + br * 64;
        const bf16_t* vtb = wsp<bf16_t>(F, WS_VT) + ((size_t)b * 384 + br * 64) * SEQ;
        const int j0 = br == 0 ? 0 : (qt > 8 ? qt - 8 : 0);
        const int np = (cur - j0 + 2) >> 1;
        FlashSt st2[2]; flash_init(st2[0]); flash_init(st2[1]);
        TileRegs ra[2], rb[2];
#define NSA_LOADP(R, p) do { _Pragma("unroll") for (int tt_ = 0; tt_ < 2; ++tt_) { const int j_ = j0 + 2 * (p) + tt_; if (j_ <= cur) tile_load(R[tt_], kbase, 128, vtb, j_ * 64, tid); } } while (0)
#define NSA_STOREP(R, p, buf) do { _Pragma("unroll") for (int tt_ = 0; tt_ < 2; ++tt_) { const int j_ = j0 + 2 * (p) + tt_; if (j_ <= cur) tile_store(R[tt_], KT + ((buf) * 2 + tt_) * 64 * KTP, VT + ((buf) * 2 + tt_) * 64 * KTP, tid); } } while (0)
#define NSA_COMPP(p, buf) do { const int j = j0 + 2 * (p) + ks; if (j <= cur) { \
            const LAS bf16_t* kt = KT + ((buf) * 2 + ks) * 64 * KTP; const LAS bf16_t* vt = VT + ((buf) * 2 + ks) * 64 * KTP; \
            const bool on = (br == 0) ? (((j < 32 ? (mlo >> j) : (mhi >> (j - 32))) & 1u) != 0u) : true; \
            if (__any(on)) { KVFrags fg; load_frags(fg, kt, vt, fr, fq); asm volatile("" ::: "memory"); \
                const bool edge = (j == cur) || (br == 1 && j == qt - 8); const int hi = (j == cur) ? ql : 63, lo = (br == 1 && j == qt - 8) ? ql : -1; \
                _Pragma("unroll") for (int hh = 0; hh < 2; ++hh) { f32x4 s[4]; qk_frags(s, fg, qf2[hh]); \
                    if (edge) { _Pragma("unroll") for (int kb = 0; kb < 4; ++kb) _Pragma("unroll") for (int i = 0; i < 4; ++i) { const int kl = 16 * kb + 4 * fq + i; s[kb][i] = (kl <= hi && kl > lo) ? s[kb][i] : -INFINITY; } } \
                    flash_update(st2[hh], s, fg, on); } } } } while (0)
        NSA_LOADP(ra, 0); NSA_LOADP(rb, 1);
#pragma unroll 1
        for (int p = 0; p < np; p += 2) {
            NSA_STOREP(ra, p, 0); __syncthreads(); NSA_LOADP(ra, p + 2); NSA_COMPP(p, 0);
            if (p + 1 < np) { NSA_STOREP(rb, p + 1, 1); __syncthreads(); NSA_LOADP(rb, p + 3); NSA_COMPP(p + 1, 1); }
        }
#undef NSA_LOADP
#undef NSA_STOREP
#undef NSA_COMPP
        { LAS float* XS = (LAS float*)(F.lds + AT_XST) + wave * (18 * 64) + lane;
            XS[0] = ks ? st2[0].m : st2[1].m; XS[64] = ks ? st2[0].l : st2[1].l;
#pragma unroll
            for (int d = 0; d < 4; ++d)
#pragma unroll
                for (int i = 0; i < 4; ++i) XS[(2 + 4 * d + i) * 64] = ks ? st2[0].o[d][i] : st2[1].o[d][i];
            __syncthreads();
            const LAS float* XP = (const LAS float*)(F.lds + AT_XST) + (wave ^ 4) * (18 * 64) + lane;
            FlashSt st; st.m = ks ? st2[1].m : st2[0].m; st.l = ks ? st2[1].l : st2[0].l;
#pragma unroll
            for (int d = 0; d < 4; ++d) st.o[d] = ks ? st2[1].o[d] : st2[0].o[d];
            const float mb = XP[0], lb = XP[64]; const float m = fmaxf(st.m, mb), fa = fexp2(st.m - m), fb = fexp2(mb - m);
            st.l = st.l * fa + lb * fb;
#pragma unroll
            for (int d = 0; d < 4; ++d)
#pragma unroll
                for (int i = 0; i < 4; ++i) st.o[d][i] = st.o[d][i] * fa + XP[(2 + 4 * d + i) * 64] * fb;
            const float sc = flash_inv_l(st) * (br == 0 ? gate[1] : gate[2]);
#pragma unroll
            for (int d = 0; d < 4; ++d) res[d] += st.o[d] * sc; }
        __syncthreads();
    }
    bf16_t* BR = wsp<bf16_t>(F, WS_BR);
#pragma unroll
    for (int d = 0; d < 4; ++d) { u32x2 w; w.x = pk2(res[d][0], res[d][1]); w.y = pk2(res[d][2], res[d][3]);
        *(u32x2*)(BR + rowq * 1024 + head * 64 + 16 * d + 4 * fq) = w; }
}

DEV void fox_unit(Frame F, int b, int h, int qb) {
    frame_refresh(F);
    const int tid = F.tid, lane = F.lane, wave = F.wave, fr = lane & 15, fq = lane >> 4;
    const int q0 = qb * 256, qw = q0 + 32 * wave;
    const bf16_t* H = wsp<bf16_t>(F, WS_H); const float* cum = wsp<float>(F, WS_CUM) + ((size_t)b * 4 + h) * SEQ;
    LAS bf16_t* KT = (LAS bf16_t*)(F.lds + AT_KT); LAS bf16_t* VT = (LAS bf16_t*)(F.lds + AT_VT); LAS float* CK = (LAS float*)(F.lds + AT_CK);
    LAS float* KNP = (LAS float*)(F.lds + AT_FXT); LAS float* CKL = KNP + 64; LAS float* WMIN = KNP + 128; LAS float* WQN = KNP + 136;
    const float cref = cum[q0];
    bf16x8 qf[2][2]; float qn2 = 0.f;
#pragma unroll
    for (int sb = 0; sb < 2; ++sb) { float ss = 0.f;
#pragma unroll
        for (int dc = 0; dc < 2; ++dc) { qf[sb][dc] = load_q(H + ((size_t)b * SEQ + qw + 16 * sb + fr) * NP + HP_FQ + h * 64 + 32 * dc + 8 * fq, nullptr, false, QSCALE);
            const u32x4 w = __builtin_bit_cast(u32x4, qf[sb][dc]); const unsigned* wp = (const unsigned*)&w;
#pragma unroll
            for (int j = 0; j < 4; ++j) { const float a = bflo(wp[j]), c = bfhi(wp[j]); ss += a * a + c * c; } }
        ss = xr_sum(ss); qn2 = fmaxf(qn2, ss); }
#pragma unroll
    for (int o = 1; o < 16; o <<= 1) qn2 = fmaxf(qn2, __shfl_xor(qn2, o));
    if (lane == 0) WQN[wave] = sqrtf(qn2) * 1.0001f;
    if (tid < 64) {
        float kn = wsp<float>(F, WS_KN)[((size_t)b * 4 + h) * 64 + tid];
#pragma unroll
        for (int o = 1; o < 64; o <<= 1) { const float t = __shfl_up(kn, o); if (tid >= o) kn = fmaxf(kn, t); }
        KNP[tid] = kn; CKL[tid] = cum[64 * tid + 63] - cref; }
    const bf16_t* kbase = H + (size_t)b * SEQ * NP + HP_FK + h * 64; const bf16_t* vtb = wsp<bf16_t>(F, WS_VT) + ((size_t)b * 384 + 128 + h * 64) * SEQ;
    FlashSt st[2]; flash_init(st[0]); flash_init(st[1]);
    __syncthreads();
    int np = 2;
    { float qn = WQN[0];
#pragma unroll
        for (int w = 1; w < 8; ++w) qn = fmaxf(qn, WQN[w]);
        const float wk = wsp<float>(F, WS_KN)[((size_t)b * 4 + h) * 64 + 4 * qb + (lane & 3)];
        float kown = fmaxf(wk, __shfl_xor(wk, 1)); kown = fmaxf(kown, __shfl_xor(kown, 2)); kown = __shfl(kown, 0);
        const float thr = -qn * kown - 40.f;
#pragma unroll 1
        for (int Jn = 4 * qb - 1; Jn >= 0; Jn -= 2) { if (qn * KNP[Jn] - CKL[Jn] < thr) break; ++np; } }
    np = __builtin_amdgcn_readfirstlane(np);
#define FOX_TILE(p, tt) ((p) < 2 ? 4 * qb + 2 * (p) + (tt) : 4 * qb - 1 - 2 * ((p) - 2) - (tt))
    TileRegs ra[2], rb[2]; f32x4 cka[2], ckb[2];
#define FOX_LOADP(R, C, p) do { if ((p) < np) { _Pragma("unroll") for (int tt_ = 0; tt_ < 2; ++tt_) { const int j_ = FOX_TILE(p, tt_); if (j_ >= 0) { tile_load(R[tt_], kbase, NP, vtb, j_ * 64, tid); if (tid < 16) C[tt_] = *(const f32x4*)(cum + j_ * 64 + 4 * tid); } } } } while (0)
#define FOX_STOREP(R, C, p, buf) do { _Pragma("unroll") for (int tt_ = 0; tt_ < 2; ++tt_) { const int j_ = FOX_TILE(p, tt_); if (j_ >= 0) { tile_store(R[tt_], KT + ((buf) * 2 + tt_) * 64 * KTP, VT + ((buf) * 2 + tt_) * 64 * KTP, tid); \
            if (tid < 16) *(LAS f32x4*)(CK + ((buf) * 2 + tt_) * 64 + 4 * tid) = C[tt_] - cref; } } } while (0)
#define FOX_COMPP(p, buf) do { _Pragma("unroll") for (int tt_ = 0; tt_ < 2; ++tt_) { const int J = FOX_TILE(p, tt_); const int key0 = 64 * J; if (J >= 0 && key0 <= qw + 31) { \
            const LAS bf16_t* kt = KT + ((buf) * 2 + tt_) * 64 * KTP; const LAS bf16_t* vt = VT + ((buf) * 2 + tt_) * 64 * KTP; const LAS float* ck = CK + ((buf) * 2 + tt_) * 64; \
            KVFrags fg; load_frags(fg, kt, vt, fr, fq); \
            f32x4 dk[4]; _Pragma("unroll") for (int kb = 0; kb < 4; ++kb) dk[kb] = *(const LAS f32x4*)(ck + 16 * kb + 4 * fq); \
            asm volatile("" ::: "memory"); \
            const bool diag = key0 + 63 > qw; \
            _Pragma("unroll") for (int sb = 0; sb < 2; ++sb) { f32x4 s[4]; qk_frags(s, fg, qf[sb]); const int qa = qw + 16 * sb + fr; \
                _Pragma("unroll") for (int kb = 0; kb < 4; ++kb) { s[kb] = s[kb] - dk[kb]; \
                    if (diag) { _Pragma("unroll") for (int i = 0; i < 4; ++i) s[kb][i] = (key0 + 16 * kb + 4 * fq + i <= qa) ? s[kb][i] : -INFINITY; } } \
                flash_update(st[sb], s, fg, true); } } } } while (0)
    FOX_LOADP(ra, cka, 0); FOX_LOADP(rb, ckb, 1);
#pragma unroll 1
    for (int p = 0; p < np; p += 2) {
        FOX_STOREP(ra, cka, p, 0); __syncthreads(); FOX_LOADP(ra, cka, p + 2); FOX_COMPP(p, 0);
        if (p + 1 < np) { FOX_STOREP(rb, ckb, p + 1, 1); __syncthreads(); FOX_LOADP(rb, ckb, p + 3); FOX_COMPP(p + 1, 1); }
    }
#undef FOX_TILE
#undef FOX_LOADP
#undef FOX_STOREP
#undef FOX_COMPP
    bf16_t* BR = wsp<bf16_t>(F, WS_BR);
#pragma unroll
    for (int sb = 0; sb < 2; ++sb) { const float sc = flash_inv_l(st[sb]); const size_t row = (size_t)b * SEQ + qw + 16 * sb + fr;
#pragma unroll
        for (int d = 0; d < 4; ++d) { const f32x4 o = st[sb].o[d] * sc; u32x2 w; w.x = pk2(o[0], o[1]); w.y = pk2(o[2], o[3]);
            *(u32x2*)(BR + row * 1024 + 256 + h * 64 + 16 * d + 4 * fq) = w; } }
    __syncthreads();
}

DEV void ln1_router_phase(Frame F, const Params& P, int l) {
    frame_refresh(F);
    const int tid = F.tid, lane = F.lane, wave = F.wave, fr = lane & 15, fq = lane >> 4;
    LAS float* xs = (LAS float*)F.lds;
    LAS float* part = (LAS float*)(F.lds + 69632);
    constexpr int XP = 1028;
    const bf16_t* mix = wsp<bf16_t>(F, WS_MIX); bf16_t* xb = wsp<bf16_t>(F, WS_XB);
    const float* g1 = P.in[I_LN1G] + (size_t)l * 1024; const float* b1 = P.in[I_LN1B] + (size_t)l * 1024;
    float wf[2][32];
    { const float* wr = P.in[I_WR] + (size_t)l * 1024 * 32 + (size_t)(128 * wave + 32 * fq) * 32 + fr;
#pragma unroll
        for (int s_ = 0; s_ < 32; ++s_) { wf[0][s_] = wr[s_ * 32]; wf[1][s_] = wr[s_ * 32 + 16]; } }
    const float brt = P.in[I_BR][l * 32 + (tid & 31)];
    unsigned* cnt = F.ctl + CW_CNT + l * 32 * 64; int* rowtk = wsp<int>(F, WS_ROWTK); float* tokw = wsp<float>(F, WS_TOKW);
    LAS unsigned* lcnt = (LAS unsigned*)(F.lds + 90112);
    LAS unsigned* lsel = lcnt + 64;
    if (tid < 64) lcnt[tid] = 0u;
    int nsel = 0;
    __syncthreads();
    u32x4 va[2][2], vm[2][2];
    f32x4 gg1[2][2], bb1[2][2];
#pragma unroll
    for (int j = 0; j < 2; ++j)
#pragma unroll
        for (int h = 0; h < 2; ++h) { gg1[j][h] = *(const f32x4*)(g1 + j * 512 + lane * 8 + 4 * h); bb1[j][h] = *(const f32x4*)(b1 + j * 512 + lane * 8 + 4 * h); }
    int unit = F.bid;
    if (unit < NT / 16) {
#pragma unroll
        for (int i = 0; i < 2; ++i)
#pragma unroll
            for (int j = 0; j < 2; ++j) { const size_t o = (size_t)(unit * 16 + wave * 2 + i) * 1024 + j * 512 + lane * 8; va[i][j] = *(const u32x4*)(xb + o); vm[i][j] = *(const u32x4*)(mix + o); } }
#pragma unroll 1
    for (; unit < NT / 16; unit += F.G) {
        const int r0 = unit * 16;
#pragma unroll
        for (int i = 0; i < 2; ++i) { const int r = wave * 2 + i; const size_t row = (size_t)(r0 + r);
            f32x4 v[2][2]; float s = 0.f;
#pragma unroll
            for (int j = 0; j < 2; ++j) { const unsigned* xp_ = (const unsigned*)&va[i][j]; const unsigned* mp_ = (const unsigned*)&vm[i][j];
#pragma unroll
                for (int h = 0; h < 2; ++h) { const f32x4 xa = {bflo(xp_[2 * h]), bfhi(xp_[2 * h]), bflo(xp_[2 * h + 1]), bfhi(xp_[2 * h + 1])}, ma = {bflo(mp_[2 * h]), bfhi(mp_[2 * h]), bflo(mp_[2 * h + 1]), bfhi(mp_[2 * h + 1])};
                    v[j][h] = xa * DN_ALPHA + ma; s += (v[j][h][0] + v[j][h][1]) + (v[j][h][2] + v[j][h][3]); } }
            const float mean = wave_sum(s) * (1.f / 1024.f); float q = 0.f;
#pragma unroll
            for (int j = 0; j < 2; ++j)
#pragma unroll
                for (int h = 0; h < 2; ++h) { v[j][h] = v[j][h] - mean; q += (v[j][h][0] * v[j][h][0] + v[j][h][1] * v[j][h][1]) + (v[j][h][2] * v[j][h][2] + v[j][h][3] * v[j][h][3]); }
            const float rstd = 1.f / sqrtf(wave_sum(q) * (1.f / 1024.f) + LN_EPS);
#pragma unroll
            for (int j = 0; j < 2; ++j) { const f32x4 o0 = v[j][0] * rstd * gg1[j][0] + bb1[j][0], o1 = v[j][1] * rstd * gg1[j][1] + bb1[j][1];
                *(LAS f32x4*)(xs + r * XP + j * 512 + lane * 8) = o0; *(LAS f32x4*)(xs + r * XP + j * 512 + lane * 8 + 4) = o1;
                u32x4 w; w.x = pk2(o0[0], o0[1]); w.y = pk2(o0[2], o0[3]); w.z = pk2(o1[0], o1[1]); w.w = pk2(o1[2], o1[3]); *(u32x4*)(xb + row * 1024 + j * 512 + lane * 8) = w; } }
        { const int un = unit + F.G;
            if (un < NT / 16) {
#pragma unroll
                for (int i = 0; i < 2; ++i)
#pragma unroll
                    for (int j = 0; j < 2; ++j) { const size_t o = (size_t)(un * 16 + wave * 2 + i) * 1024 + j * 512 + lane * 8; va[i][j] = *(const u32x4*)(xb + o); vm[i][j] = *(const u32x4*)(mix + o); } } }
        __syncthreads();
        { f32x4 c0 = (f32x4){0.f, 0.f, 0.f, 0.f}, c1 = c0; const LAS float* xp = xs + fr * XP + 128 * wave + 32 * fq;
#pragma unroll
            for (int s4 = 0; s4 < 8; ++s4) { const f32x4 xa = *(const LAS f32x4*)(xp + 4 * s4);
#pragma unroll
                for (int i = 0; i < 4; ++i) { c0 = __builtin_amdgcn_mfma_f32_16x16x4f32(xa[i], wf[0][4 * s4 + i], c0, 0, 0, 0); c1 = __builtin_amdgcn_mfma_f32_16x16x4f32(xa[i], wf[1][4 * s4 + i], c1, 0, 0, 0); } }
#pragma unroll
            for (int i = 0; i < 4; ++i) { part[(wave * 16 + 4 * fq + i) * 32 + fr] = c0[i]; part[(wave * 16 + 4 * fq + i) * 32 + 16 + fr] = c1[i]; } }
        __syncthreads();
        { const int r = tid >> 5, e = tid & 31; float v = brt;
#pragma unroll
            for (int w = 0; w < 8; ++w) v += part[(w * 16 + r) * 32 + e];
            float bv[4]; int bi[4]; float cur = v;
#define DPP_F(x, ctrl) __builtin_bit_cast(float, __builtin_amdgcn_update_dpp(0, __builtin_bit_cast(int, (x)), (ctrl), 0xf, 0xf, true))
#define DPP_I(x, ctrl) __builtin_amdgcn_update_dpp(0, (x), (ctrl), 0xf, 0xf, true)
#define ARGMAX_STEP(OV, OI) do { const float ov_ = (OV); const int oi_ = (OI); const bool take_ = (ov_ > mv) || (ov_ == mv && oi_ < mi); mv = take_ ? ov_ : mv; mi = take_ ? oi_ : mi; } while (0)
#pragma unroll
            for (int k = 0; k < 4; ++k) { float mv = cur; int mi = e;
                ARGMAX_STEP(DPP_F(mv, 0xB1), DPP_I(mi, 0xB1));
                ARGMAX_STEP(DPP_F(mv, 0x4E), DPP_I(mi, 0x4E));
                ARGMAX_STEP(DPP_F(mv, 0x141), DPP_I(mi, 0x141));
                ARGMAX_STEP(DPP_F(mv, 0x140), DPP_I(mi, 0x140));
                { const auto rv_ = __builtin_amdgcn_permlane16_swap(__float_as_uint(mv), __float_as_uint(mv), false, false); const auto ri_ = __builtin_amdgcn_permlane16_swap((unsigned)mi, (unsigned)mi, false, false);
                    mv = __uint_as_float(rv_[0]); mi = (int)ri_[0]; ARGMAX_STEP(__uint_as_float(rv_[1]), (int)ri_[1]); }
                bv[k] = mv; bi[k] = mi; if (e == mi) cur = -INFINITY; }
#undef DPP_F
#undef DPP_I
#undef ARGMAX_STEP
            if (e < 4) { float ex[4], sum = 0.f;
#pragma unroll
                for (int k = 0; k < 4; ++k) { ex[k] = __expf(bv[k] - bv[0]); sum += ex[k]; }
                const int k = e; const int t = r0 + r; const int ide = k == 0 ? bi[0] : (k == 1 ? bi[1] : (k == 2 ? bi[2] : bi[3])); const float exk = k == 0 ? ex[0] : (k == 1 ? ex[1] : (k == 2 ? ex[2] : ex[3]));
                const unsigned ls = __hip_atomic_fetch_add(lcnt + ide, 1u, __ATOMIC_RELAXED, __HIP_MEMORY_SCOPE_WORKGROUP);
                const int li = nsel + r * 4 + k; lsel[2 * li] = ((unsigned)ide << 24) | ls; lsel[2 * li + 1] = (unsigned)(t * 4 + k); tokw[t * 4 + k] = exk / sum; } }
        nsel += 64;
        __syncthreads();
    }
    if (tid < 32) { const unsigned c = lcnt[tid]; lcnt[32 + tid] = c ? atomicAdd(cnt + tid * 64, c) : 0u; }
    __syncthreads();
    for (int i = tid; i < nsel; i += NTHR) { const unsigned a = lsel[2 * i], tk = lsel[2 * i + 1]; const unsigned e = a >> 24; rowtk[(size_t)e * NT + lcnt[32 + e] + (a & 0xffffffu)] = (int)tk; }
    __syncthreads();
}
DEV void ln2_rows(Frame F, const Params& P, int l) {
    frame_refresh(F);
    const int lane = F.lane; const int gw = F.bid * NWAVES + F.wave, NGW = F.G * NWAVES;
    bf16_t* xb = wsp<bf16_t>(F, WS_XB); const bf16_t* yb = wsp<bf16_t>(F, WS_YBUF); const float* tokw = wsp<float>(F, WS_TOKW);
    const float* g2 = P.in[I_LN2G] + (size_t)l * 1024; const float* b2 = P.in[I_LN2B] + (size_t)l * 1024;
    float* dst = (l == NL - 1) ? P.out : nullptr;
    f32x4 wkn; u32x4 xn[2]; u32x4 yn[2][4];
#define LN2_LOAD(row_) do { wkn = *(const f32x4*)(tokw + (size_t)(row_) * 4); _Pragma("unroll") for (int j = 0; j < 2; ++j) { xn[j] = *(const u32x4*)(xb + (size_t)(row_) * 1024 + j * 512 + lane * 8); \
        _Pragma("unroll") for (int k = 0; k < 4; ++k) yn[j][k] = *(const u32x4*)(yb + ((size_t)(row_) * 4 + k) * 1024 + j * 512 + lane * 8); } } while (0)
    f32x4 gg[2][2], bb[2][2];
#pragma unroll
    for (int j = 0; j < 2; ++j)
#pragma unroll
        for (int h = 0; h < 2; ++h) { gg[j][h] = *(const f32x4*)(g2 + j * 512 + lane * 8 + 4 * h); bb[j][h] = *(const f32x4*)(b2 + j * 512 + lane * 8 + 4 * h); }
    if (gw < NT) LN2_LOAD(gw);
#pragma unroll 1
    for (int row = gw; row < NT; row += NGW) {
        const f32x4 wk = wkn;
        f32x4 v[2][2]; float s = 0.f;
#pragma unroll
        for (int j = 0; j < 2; ++j) { const unsigned* xp = (const unsigned*)&xn[j];
            f32x4 a0 = (f32x4){bflo(xp[0]), bfhi(xp[0]), bflo(xp[1]), bfhi(xp[1])} * DN_ALPHA, a1 = (f32x4){bflo(xp[2]), bfhi(xp[2]), bflo(xp[3]), bfhi(xp[3])} * DN_ALPHA;
#pragma unroll
            for (int k = 0; k < 4; ++k) { const unsigned* yp = (const unsigned*)&yn[j][k]; const float w = wk[k];
                a0[0] += w * bflo(yp[0]); a0[1] += w * bfhi(yp[0]); a0[2] += w * bflo(yp[1]); a0[3] += w * bfhi(yp[1]);
                a1[0] += w * bflo(yp[2]); a1[1] += w * bfhi(yp[2]); a1[2] += w * bflo(yp[3]); a1[3] += w * bfhi(yp[3]); }
            v[j][0] = a0; v[j][1] = a1; s += ((a0[0] + a0[1]) + (a0[2] + a0[3])) + ((a1[0] + a1[1]) + (a1[2] + a1[3])); }
        if (row + NGW < NT) LN2_LOAD(row + NGW);
        const float mean = wave_sum(s) * (1.f / 1024.f); float q = 0.f;
#pragma unroll
        for (int j = 0; j < 2; ++j)
#pragma unroll
            for (int h = 0; h < 2; ++h) { v[j][h] = v[j][h] - mean; q += (v[j][h][0] * v[j][h][0] + v[j][h][1] * v[j][h][1]) + (v[j][h][2] * v[j][h][2] + v[j][h][3] * v[j][h][3]); }
        const float rstd = 1.f / sqrtf(wave_sum(q) * (1.f / 1024.f) + LN_EPS);
#pragma unroll
        for (int j = 0; j < 2; ++j) { const f32x4 o0 = v[j][0] * rstd * gg[j][0] + bb[j][0], o1 = v[j][1] * rstd * gg[j][1] + bb[j][1];
            if (dst) { *(f32x4*)(dst + (size_t)row * 1024 + j * 512 + lane * 8) = o0; *(f32x4*)(dst + (size_t)row * 1024 + j * 512 + lane * 8 + 4) = o1; }
            else { u32x4 w; w.x = pk2(o0[0], o0[1]); w.y = pk2(o0[2], o0[3]); w.z = pk2(o1[0], o1[1]); w.w = pk2(o1[2], o1[3]); *(u32x4*)(xb + (size_t)row * 1024 + j * 512 + lane * 8) = w; } } }
#undef LN2_LOAD
}

constexpr int NPH = 9;
constexpr int N_PHASES = 1 + NL * NPH;
__global__ void __launch_bounds__(NTHR, 2) fwd_kernel(Params P) {
    extern __shared__ __attribute__((aligned(16))) unsigned char lds_raw[];
    Frame F;
    F.lds = (LAS unsigned char*)lds_raw; F.MISC = (volatile LAS unsigned*)(F.lds + MISC_OFF);
    F.tid = threadIdx.x; F.lane = F.tid & 63; F.wave = __builtin_amdgcn_readfirstlane(F.tid >> 6); F.G = gridDim.x; F.bid = blockIdx.x;
    F.ws = P.ws; F.ctl = (unsigned*)(P.ws + WS_CTL);
    for (int u = F.tid; u < 1024; u += NTHR) F.MISC[u] = 0u;
    __syncthreads();
    const int lo = P.ph_lo, hi = P.ph_hi;
    const bool multi = (hi - lo) > 1;
    XcdBarrier bar; bar.bar = F.ctl + CW_BAR; bar.x = 0; bar.st = F.MISC + 8;
    if (multi) bar = xcd_barrier_post(F.ctl + CW_BAR, F.MISC + 8);
#ifndef PHMASK
#define PHMASK 0xFFFF
#endif
#define IN(k) (lo <= (k) && (k) < hi)
#define EN(i) ((PHMASK >> (i)) & 1)
#ifndef DUP_PHASE
#define DUP_PHASE -1
#endif
#define REP(i) for (int rep_ = 0; rep_ < ((DUP_PHASE) == (i) ? 2 : 1); ++rep_)
#define SEAM(k) do { if (IN(k) && IN((k) + 1)) xcd_barrier(bar); } while (0)
#define FILL(k) do { __syncthreads(); if (F.tid == 0) atomicAdd(F.ctl + CW_DONE + (k) * 64, 1u); bg_fill(F, P, F.ctl + CW_DONE + (k) * 64, BG_TOTAL); } while (0)

    if (EN(9) && IN(0)) { REP(9) p0_prologue(F, P); }
    SEAM(0);
#pragma unroll 1
    for (int l = 0; l < NL; ++l) {
        const int pb = 1 + l * NPH;
        if (EN(0) && IN(pb + 0)) REP(0) {
            pg8::Gemm g{wsp<bf16_t>(F, WS_XB), wsp<bf16_t>(F, WS_WIN) + (size_t)l * NP * 1024, 1024, 1024};
            pg8::PlainOrder S; S.init(NT / 256, NP / 256, F.G, F.bid);
            pg8::EpiInProj E{wsp<bf16_t>(F, WS_H), wsp<float>(F, WS_BIN) + (size_t)l * NP, wsp<float>(F, WS_SIDE), wsp<bf16_t>(F, WS_MGT)};
            pg8::gemm_phase<pg8::EpiInProj, pg8::PlainOrder, true>(F.lds, g, S, E);
            FILL(pb + 0);
        }
        SEAM(pb + 0);
        if (EN(1) && IN(pb + 1)) REP(1) {
            unsigned* qctr = F.ctl + CW_QUEUE + l * 64 + 16;
            bool first1 = true;
            for (;;) {
                if (F.tid == 0) F.MISC[16] = first1 ? (unsigned)F.bid : atomicAdd(qctr, 1u) + (unsigned)F.G;
                first1 = false;
                __syncthreads();
                const int L = (int)F.MISC[16];
                __syncthreads();
                if (L >= 528) break;
                if (L < 128) pb_gmlp_unit(F, P, l, L);
                else if (L < 256) pb_compress_unit(F, l, L - 128);
                else if (L < 512) { pb_conv_unit(F, P, l, L - 256); pb_transpose_unit(F, L - 256); }
                else pb_cum_unit(F, L - 512);
            }
        }
        SEAM(pb + 1);
        if (EN(2) && IN(pb + 2)) REP(2) {
            unsigned* qctr = F.ctl + CW_QUEUE + l * 64 + rep_ * 32;
            bool first2 = true;
            for (;;) {
                if (F.tid == 0) F.MISC[16] = first2 ? (unsigned)F.bid : atomicAdd(qctr, 1u) + (unsigned)F.G;
                first2 = false;
                __syncthreads();
                const unsigned L = F.MISC[16];
                __syncthreads();
#ifdef ATT_TWICE
                if (L >= 1536u) break;
                const int Lm = (int)(L % 768u);
#else
                if (L >= 768u) break;
                const int Lm = (int)L;
#endif
                if (Lm < 512) nsa_unit(F, Lm & 3, 63 - (Lm >> 3), (Lm >> 2) & 1);
                else { const int idx = Lm - 512; fox_unit(F, idx & 3, (idx >> 2) & 3, 15 - (idx >> 4)); }
            }
            FILL(pb + 2);
        }
        SEAM(pb + 2);
        if (EN(3) && IN(pb + 3)) REP(3) {
            pg8::Gemm g{wsp<bf16_t>(F, WS_BR), wsp<bf16_t>(F, WS_WBR) + (size_t)l * 4096 * 256, 1024, 256};
            pg8::BrOrder S{F.G, F.bid};
            pg8::EpiBrGate E{wsp<bf16_t>(F, WS_MGT), wsp<bf16_t>(F, WS_GBF)};
            pg8::gemm_phase<pg8::EpiBrGate, pg8::BrOrder, true, true>(F.lds, g, S, E);
        }
        SEAM(pb + 3);
        if (EN(4) && IN(pb + 4)) REP(4) {
            pg8::Gemm g{wsp<bf16_t>(F, WS_GBF), wsp<bf16_t>(F, WS_WO) + (size_t)l * 1024 * 1024, 1024, 1024};
            pg8::PlainOrder S; S.init(NT / 256, 4, F.G, F.bid);
            pg8::EpiBf16Out E{wsp<bf16_t>(F, WS_MIX)};
            pg8::gemm_phase<pg8::EpiBf16Out, pg8::PlainOrder, true>(F.lds, g, S, E);
        }
        SEAM(pb + 4);
        if (EN(5) && IN(pb + 5)) { ln1_router_phase(F, P, l); bg_fill(F, P, nullptr, (long)(l + 1) * BG_PER_LAYER); }
        SEAM(pb + 5);
        if ((EN(6) || EN(7)) && (IN(pb + 6) || IN(pb + 7))) {
            LAS int* tp = (LAS int*)(F.lds + MISC_OFF + 1024);
            { int ct_ = F.tid; asm volatile("" : "+v"(ct_));
              if (ct_ < 32) { const unsigned* cnt = F.ctl + CW_CNT + l * 32 * 64; tp[40 + ct_] = (int)__hip_atomic_load(cnt + ct_ * 64, __ATOMIC_RELAXED, __HIP_MEMORY_SCOPE_AGENT); } }
            __syncthreads();
            if (F.tid == 0) { int run = 0;
                for (int e = 0; e < 32; ++e) { tp[e] = run; run += (tp[40 + e] + 255) >> 8; }
                tp[32] = run; }
            __syncthreads();
            LAS unsigned* ul = (LAS unsigned*)(F.lds + MISC_OFF + 1536);
            int ut_ = F.tid; asm volatile("" : "+v"(ut_));
            if (ut_ < 128) { const int m2 = ut_ >> 6, i = ut_ & 63, sh = m2 ? 2 : 3;
                const int x = F.bid & 7, j = F.bid >> 3, W = F.G >> 3;
                const int U = tp[32] << sh, s0 = (x * U) >> 3, s1 = ((x + 1) * U) >> 3, L = s0 + i * W + j;
                unsigned pk = 0xffffffffu;
                if (L < s1) { const int tile = L >> sh, pn = L & ((1 << sh) - 1);
                    int e = (tp[16] <= tile) ? 16 : 0;
                    e += (tp[e + 8] <= tile) ? 8 : 0; e += (tp[e + 4] <= tile) ? 4 : 0; e += (tp[e + 2] <= tile) ? 2 : 0; e += (tp[e + 1] <= tile) ? 1 : 0;
                    const int mt = tile - tp[e], rem = tp[40 + e] - mt * 256, cn = rem < 256 ? rem : 256;
                    pk = (unsigned)pn | ((unsigned)e << 3) | ((unsigned)mt << 8) | ((unsigned)tile << 15) | ((unsigned)(cn - 1) << 24); }
                ul[ut_] = pk; }
            __syncthreads();
            if (EN(6) && IN(pb + 6)) REP(6) {
                pg8::Gemm g{wsp<bf16_t>(F, WS_XB), wsp<bf16_t>(F, WS_W1) + (size_t)l * 32 * 2048 * 1024, 1024, 1024};
                pg8::MoeOrder<1> S{ul, wsp<int>(F, WS_ROWTK)};
                pg8::EpiMoe1 E{wsp<bf16_t>(F, WS_ACT), P.in[I_BE1] + (size_t)l * 32 * 2048};
                pg8::gemm_phase<pg8::EpiMoe1, pg8::MoeOrder<1>, true>(F.lds, g, S, E);
                FILL(pb + 6);
            }
            SEAM(pb + 6);
            if (EN(7) && IN(pb + 7)) REP(7) {
                pg8::Gemm g{wsp<bf16_t>(F, WS_ACT), wsp<bf16_t>(F, WS_W2) + (size_t)l * 32 * 1024 * 1024, 1024, 1024};
                pg8::MoeOrder<2> S{ul + 64, wsp<int>(F, WS_ROWTK)};
                pg8::EpiMoe2 E{wsp<bf16_t>(F, WS_YBUF), P.in[I_BE2] + (size_t)l * 32 * 1024, wsp<int>(F, WS_ROWTK)};
                pg8::gemm_phase<pg8::EpiMoe2, pg8::MoeOrder<2>, true>(F.lds, g, S, E);
                FILL(pb + 7);
            }
        }
        SEAM(pb + 7);
        if (EN(8) && IN(pb + 8)) REP(8) ln2_rows(F, P, l);
        SEAM(pb + 8);
    }
#undef IN
#undef SEAM
}

#ifndef MK_SPLIT
#define MK_SPLIT 0
#endif
extern "C" void kernel_launch(void* const* d_in, const int* in_sizes, int n_in, void* d_out, int out_size, void* d_ws, size_t ws_size, hipStream_t stream) {
    static int grid = 0;
    if (grid == 0) {
        if (n_in != 30 || out_size != NT * 1024 || ws_size < WS_END) { fprintf(stderr, "kernel_launch: unexpected shapes (n_in %d out %d ws %zu need %zu)\n", n_in, out_size, ws_size, (size_t)WS_END); grid = -1; return; }
        int dev = 0, cus = 0, per_cu = 0;
        if (hipGetDevice(&dev) != hipSuccess || hipDeviceGetAttribute(&cus, hipDeviceAttributeMultiprocessorCount, dev) != hipSuccess) { grid = -1; return; }
        if (hipFuncSetAttribute((const void*)fwd_kernel, hipFuncAttributeMaxDynamicSharedMemorySize, LDS_BYTES) != hipSuccess) { fprintf(stderr, "kernel_launch: hipFuncSetAttribute failed\n"); grid = -1; return; }
        if (hipOccupancyMaxActiveBlocksPerMultiprocessor(&per_cu, (const void*)fwd_kernel, NTHR, LDS_BYTES) != hipSuccess || per_cu < 1) fprintf(stderr, "kernel_launch: occupancy query says %d\n", per_cu);
        (void)hipGetLastError();
        grid = cus;
    }
    if (grid < 0) return;
    (void)hipMemsetAsync((char*)d_ws + WS_CTL, 0, 196608, stream);
    Params p; memset(&p, 0, sizeof(p));
    for (int i = 0; i < 30; ++i) p.in[i] = (const float*)d_in[i];
    p.out = (float*)d_out; p.ws = (unsigned char*)d_ws;
    for (int i = 0; i < 8; ++i) p.invf[i] = std::pow(500000.0, -(double)i / 8.0);
#if MK_SPLIT
    for (int ph = 0; ph < N_PHASES; ++ph) { p.ph_lo = ph; p.ph_hi = ph + 1; hipLaunchKernelGGL(fwd_kernel, dim3(grid), dim3(NTHR), LDS_BYTES, stream, p); }
#else
    p.ph_lo = 0; p.ph_hi = N_PHASES; hipLaunchKernelGGL(fwd_kernel, dim3(grid), dim3(NTHR), LDS_BYTES, stream, p);
#endif
}
```
